# Optimizing an MI355X kernel written in HIP

```python
import jax, jax.numpy as jnp
from jax import lax
import numpy as np

D_MODEL = 2048
BATCH = 2
SEQ = 8192
DEPTH = 2

HEAD_DIM = 64
N_HEADS_TOTAL = D_MODEL // HEAD_DIM
HA = N_HEADS_TOTAL // 4
KVA = 2
HB = N_HEADS_TOTAL // 4
KVB = 2
HC = N_HEADS_TOTAL - HA - HB
SCALE = HEAD_DIM ** -0.5
BLOCK = 128
WINDOW_A = 128
CMP_BLOCK = 32
CMP_STRIDE = 16
CMP_HIDDEN = 128
SEL_BLOCK = 64
N_SELECT = 16
WINDOW_B = 512
FORCE_SCORE = 1e4
N_GROUPS = 4
EXPERTS_PER_GROUP = 8
N_EXPERTS = N_GROUPS * EXPERTS_PER_GROUP
TOP_K = 2
D_EXPERT = 512
MOE_BLOCK = 128
IN_SIZES = (HA * HEAD_DIM, KVA * HEAD_DIM, KVA * HEAD_DIM,
            HB * HEAD_DIM,
            KVB * HEAD_DIM, KVB * HEAD_DIM,
            KVB * HEAD_DIM, KVB * HEAD_DIM,
            KVB * HEAD_DIM, KVB * HEAD_DIM,
            HB * 3,
            HC * HEAD_DIM, HC * HEAD_DIM, HC * HEAD_DIM)
D_IN = sum(IN_SIZES)

kernel_name = "hybrid_swa_nsa_stickbreak_hmoe_deepnorm"


def layer_norm(x, g=None, b=None, eps=1e-5):
    xf = x.astype(jnp.float32)
    mu = xf.mean(-1, keepdims=True)
    var = jnp.square(xf - mu).mean(-1, keepdims=True)
    y = (xf - mu) * lax.rsqrt(var + eps)
    if g is not None:
        y = y * g.astype(jnp.float32) + b.astype(jnp.float32)
    return y.astype(x.dtype)


def group_rms(o, eps=1e-6):
    B, S = o.shape[:2]
    of = o.reshape(B, S, -1).astype(jnp.float32)
    return (of * lax.rsqrt(jnp.mean(of * of, -1, keepdims=True) + eps)).astype(o.dtype)


def alibi_slopes(n):
    return jnp.exp2(-8.0 * jnp.arange(1, n + 1, dtype=jnp.float32) / n)


def masked_softmax(s, mask, sink=None):
    s = jnp.where(mask, s, -jnp.inf)
    m = jnp.max(s, -1, keepdims=True)
    if sink is not None:
        m = jnp.maximum(m, sink)
    m = jnp.where(jnp.isfinite(m), m, 0.0)
    e = jnp.exp(s - m)
    den = e.sum(-1, keepdims=True)
    if sink is not None:
        den = den + jnp.exp(sink - m)
    return e / jnp.maximum(den, 1e-30)


def banded_window_attention(q, k, v, window, slopes, sinks=None):
    B, S, H, D = q.shape
    G = k.shape[2]
    R = H // G
    nb = S // BLOCK
    span = window + BLOCK
    kp = jnp.pad(k, ((0, 0), (window, 0), (0, 0), (0, 0)))
    vp = jnp.pad(v, ((0, 0), (window, 0), (0, 0), (0, 0)))
    qb = q.reshape(B, nb, BLOCK, G, R, D)
    slope = slopes.reshape(G, R)[None, :, :, None, None]
    sink = None if sinks is None else sinks.astype(jnp.float32).reshape(G, R)[None, :, :, None, None]
    offs_q = jnp.arange(BLOCK)
    offs_k = jnp.arange(span)

    def one_block(i):
        qi = lax.dynamic_index_in_dim(qb, i, axis=1, keepdims=False)
        ki = lax.dynamic_slice_in_dim(kp, i * BLOCK, span, axis=1)
        vi = lax.dynamic_slice_in_dim(vp, i * BLOCK, span, axis=1)
        t = i * BLOCK + offs_q
        s_pos = i * BLOCK - window + offs_k
        dist = t[:, None] - s_pos[None, :]
        mask = (dist >= 0) & (dist < window) & (s_pos[None, :] >= 0)
        s = jnp.einsum('bqgrd,bkgd->bgrqk', qi, ki).astype(jnp.float32) * SCALE
        s = s - slope * dist.astype(jnp.float32)
        p = masked_softmax(s, mask, sink)
        o = jnp.einsum('bgrqk,bkgd->bqgrd', p.astype(vi.dtype), vi)
        return o.reshape(B, BLOCK, H, D)

    out = lax.map(one_block, jnp.arange(nb))
    return out.transpose(1, 0, 2, 3, 4).reshape(B, S, H, D)


def compress_blocks(x, pe, w1, w2):
    B, S, G, D = x.shape
    nc = (S - CMP_BLOCK) // CMP_STRIDE + 1
    idx = jnp.arange(nc)[:, None] * CMP_STRIDE + jnp.arange(CMP_BLOCK)[None, :]
    blocks = x[:, idx] + pe[None, None, :, None, :]
    flat = blocks.transpose(0, 1, 3, 2, 4).reshape(B, nc, G, CMP_BLOCK * D)
    return jax.nn.gelu(flat @ w1) @ w2


def nsa_compressed_and_selected(q, kc, vc, ks_all, vs_all, slopes):
    B, S, H, D = q.shape
    G = kc.shape[2]
    R = H // G
    nb = S // BLOCK
    nc = kc.shape[1]
    nsel = S // SEL_BLOCK
    n_pick = min(N_SELECT, nsel)
    qb = q.reshape(B, nb, BLOCK, G, R, D)
    cmp_start = jnp.arange(nc) * CMP_STRIDE
    cmp_end = cmp_start + CMP_BLOCK - 1
    sel_idx = jnp.arange(nsel)
    sel_start = sel_idx * SEL_BLOCK
    overlap = ((cmp_end[:, None] >= sel_start[None, :]) &
               (cmp_start[:, None] < sel_start[None, :] + SEL_BLOCK)).astype(jnp.float32)
    kst = ks_all.transpose(0, 2, 1, 3)
    vst = vs_all.transpose(0, 2, 1, 3)
    slope = slopes.reshape(G, R)[None, :, :, None, None]
    bi = jnp.arange(B)[:, None, None, None]
    gi = jnp.arange(G)[None, None, :, None]
    offs_q = jnp.arange(BLOCK)
    offs_sel = jnp.arange(SEL_BLOCK)

    def one_block(i):
        qi = lax.dynamic_index_in_dim(qb, i, axis=1, keepdims=False)
        t = i * BLOCK + offs_q
        dist_c = t[:, None] - cmp_end[None, :]
        sc = jnp.einsum('bqgrd,bngd->bgrqn', qi, kc).astype(jnp.float32) * SCALE
        sc = sc - slope * dist_c.astype(jnp.float32)
        pc = masked_softmax(sc, dist_c >= 0)
        o_c = jnp.einsum('bgrqn,bngd->bqgrd', pc.astype(vc.dtype), vc)
        imp = jnp.einsum('bgrqn,nj->bqgj', pc, overlap)
        cur = t // SEL_BLOCK
        forced = (sel_idx[None, :] == 0) | (sel_idx[None, :] == cur[:, None]) | (sel_idx[None, :] == cur[:, None] - 1)
        valid = sel_start[None, :] <= t[:, None]
        imp = jnp.where(valid[None, :, None, :],
                        jnp.where(forced[None, :, None, :], FORCE_SCORE, imp), -1.0)
        _, sel = lax.top_k(imp, n_pick)
        tok = (sel[..., None] * SEL_BLOCK + offs_sel).reshape(B, BLOCK, G, n_pick * SEL_BLOCK)
        ks = kst[bi, gi, tok]
        vs = vst[bi, gi, tok]
        dist_s = (t[None, :, None, None] - tok).transpose(0, 2, 1, 3)[:, :, None]
        ss = jnp.einsum('bqgrd,bqgkd->bgrqk', qi, ks).astype(jnp.float32) * SCALE
        ss = ss - slope * dist_s.astype(jnp.float32)
        ps = masked_softmax(ss, dist_s >= 0)
        o_s = jnp.einsum('bgrqk,bqgkd->bqgrd', ps.astype(vs.dtype), vs)
        return o_c.reshape(B, BLOCK, H, D), o_s.reshape(B, BLOCK, H, D)

    o_c, o_s = lax.map(one_block, jnp.arange(nb))
    unblock = lambda o: o.transpose(1, 0, 2, 3, 4).reshape(B, S, H, D)
    return unblock(o_c), unblock(o_s)


def stick_breaking_attention(q, k, v):
    B, S, H, D = q.shape
    nb = S // BLOCK
    qb = q.reshape(B, nb, BLOCK, H, D)
    s_pos = jnp.arange(S)
    offs_q = jnp.arange(BLOCK)
    vf = v.astype(jnp.float32)

    def one_block(i):
        qi = lax.dynamic_index_in_dim(qb, i, axis=1, keepdims=False)
        t = i * BLOCK + offs_q
        mask = s_pos[None, :] < t[:, None]
        z = jnp.einsum('bqhd,bkhd->bhqk', qi, k).astype(jnp.float32) * SCALE
        log_1mb = jnp.where(mask, jax.nn.log_sigmoid(-z), 0.0)
        tail = lax.cumsum(log_1mb, axis=3, reverse=True) - log_1mb
        a = jnp.where(mask, jnp.exp(jax.nn.log_sigmoid(z) + tail), 0.0)
        return jnp.einsum('bhqk,bkhd->bqhd', a, vf)

    out = lax.map(one_block, jnp.arange(nb))
    return out.transpose(1, 0, 2, 3, 4).reshape(B, S, H, D).astype(q.dtype)


def hybrid_mixer(h, w_in, sinks, cmp_pe_k, cmp_w1_k, cmp_w2_k, cmp_pe_v, cmp_w1_v, cmp_w2_v, mix_gain, w_out):
    B, S, _ = h.shape
    proj = h @ w_in
    split_at = np.cumsum(IN_SIZES)[:-1].tolist()
    (qa, ka, va, qb, kb_c, vb_c, kb_s, vb_s, kb_w, vb_w, gb, qc, kc, vc) = jnp.split(proj, split_at, axis=-1)
    heads = lambda t: t.reshape(B, S, -1, HEAD_DIM)
    slopes = alibi_slopes(HA + HB)
    o_a = banded_window_attention(heads(qa), heads(ka), heads(va), WINDOW_A, slopes[:HA], sinks)
    qbh = heads(qb)
    k_cmp = compress_blocks(heads(kb_c), cmp_pe_k, cmp_w1_k, cmp_w2_k)
    v_cmp = compress_blocks(heads(vb_c), cmp_pe_v, cmp_w1_v, cmp_w2_v)
    o_cmp, o_slc = nsa_compressed_and_selected(qbh, k_cmp, v_cmp, heads(kb_s), heads(vb_s), slopes[HA:])
    o_win = banded_window_attention(qbh, heads(kb_w), heads(vb_w), WINDOW_B, slopes[HA:])
    g = jax.nn.sigmoid(gb.reshape(B, S, HB, 3))
    o_b = g[..., 0:1] * o_cmp + g[..., 1:2] * o_slc + g[..., 2:3] * o_win
    o_c = stick_breaking_attention(heads(qc), heads(kc), heads(vc))
    merged = jnp.concatenate([group_rms(o_a), group_rms(o_b), group_rms(o_c)], axis=-1) * mix_gain
    return merged @ w_out


def hierarchical_moe(h, w_rg, b_rg, w_re, b_re, w_gate, w_up, w_down):
    B, S, D = h.shape
    N = B * S
    xt = h.reshape(N, D)
    pg = jax.nn.softmax((xt @ w_rg + b_rg).astype(jnp.float32), axis=-1)
    g_sel = jnp.argmax(pg, axis=-1)
    p_group = jnp.max(pg, axis=-1)
    le = jnp.einsum('nd,gde->nge', xt, w_re) + b_re
    le_sel = jnp.take_along_axis(le, g_sel[:, None, None], axis=1)[:, 0]
    pe = jax.nn.softmax(le_sel.astype(jnp.float32), axis=-1)
    top_p, top_e = lax.top_k(pe, TOP_K)
    gate = p_group[:, None] * top_p / jnp.sum(top_p, -1, keepdims=True)
    expert = g_sel[:, None] * EXPERTS_PER_GROUP + top_e
    A = N * TOP_K
    e_flat = expert.reshape(A)
    tok = jnp.repeat(jnp.arange(N), TOP_K)
    w_flat = gate.reshape(A)
    counts = jnp.zeros((N_EXPERTS,), jnp.int32).at[e_flat].add(1)
    padded = (counts + MOE_BLOCK - 1) // MOE_BLOCK * MOE_BLOCK
    pad_end = jnp.cumsum(padded)
    pad_start = pad_end - padded
    start = jnp.cumsum(counts) - counts
    order = jnp.argsort(e_flat)
    e_sorted = e_flat[order]
    tok_sorted = tok[order]
    dest = pad_start[e_sorted] + (jnp.arange(A) - start[e_sorted])
    n_blocks = -(-A // MOE_BLOCK) + N_EXPERTS
    rows = n_blocks * MOE_BLOCK
    buf = jnp.zeros((rows, D), h.dtype).at[dest].set(xt[tok_sorted])
    blk_start = jnp.arange(n_blocks) * MOE_BLOCK
    blk_expert = jnp.minimum(jnp.sum(blk_start[:, None] >= pad_end[None, :], axis=1), N_EXPERTS - 1)

    def expert_block(args):
        xblk, e = args
        hid = jax.nn.silu(xblk @ w_gate[e]) * (xblk @ w_up[e])
        return hid @ w_down[e]

    yb = lax.map(expert_block, (buf.reshape(n_blocks, MOE_BLOCK, D), blk_expert)).reshape(rows, D)
    y = yb[dest] * w_flat[order][:, None].astype(h.dtype)
    out = jax.ops.segment_sum(y, tok_sorted, num_segments=N)
    return out.reshape(B, S, D)


def setup_inputs(seed: int = 0) -> dict:
    key = jax.random.key(seed)
    ks = jax.random.split(key, 28)
    L, D = DEPTH, D_MODEL
    beta = (8.0 * DEPTH) ** -0.25

    def nrm(k, shape, scale):
        return jax.random.normal(k, shape, jnp.float32) * scale

    return {
        "x": nrm(ks[0], (BATCH, SEQ, D), 1.0),
        "c": nrm(ks[1], (BATCH, D), 1.0),
        "w_ada": nrm(ks[2], (L, D, 6 * D), 0.1 * D ** -0.5),
        "b_ada": nrm(ks[3], (L, 6 * D), 0.02),
        "w_in": nrm(ks[4], (L, D, D_IN), D ** -0.5),
        "sinks": nrm(ks[5], (L, HA), 0.5),
        "cmp_pe_k": nrm(ks[6], (L, CMP_BLOCK, HEAD_DIM), 0.02),
        "cmp_w1_k": nrm(ks[7], (L, CMP_BLOCK * HEAD_DIM, CMP_HIDDEN), (CMP_BLOCK * HEAD_DIM) ** -0.5),
        "cmp_w2_k": nrm(ks[8], (L, CMP_HIDDEN, HEAD_DIM), CMP_HIDDEN ** -0.5),
        "cmp_pe_v": nrm(ks[9], (L, CMP_BLOCK, HEAD_DIM), 0.02),
        "cmp_w1_v": nrm(ks[10], (L, CMP_BLOCK * HEAD_DIM, CMP_HIDDEN), (CMP_BLOCK * HEAD_DIM) ** -0.5),
        "cmp_w2_v": nrm(ks[11], (L, CMP_HIDDEN, HEAD_DIM), CMP_HIDDEN ** -0.5),
        "mix_gain": 1.0 + nrm(ks[12], (L, D), 0.02),
        "w_out": nrm(ks[13], (L, D, D), beta * D ** -0.5),
        "ln1_g": 1.0 + nrm(ks[14], (L, D), 0.02),
        "ln1_b": nrm(ks[15], (L, D), 0.02),
        "w_rg": nrm(ks[16], (L, D, N_GROUPS), D ** -0.5),
        "b_rg": nrm(ks[17], (L, N_GROUPS), 0.01),
        "w_re": nrm(ks[18], (L, N_GROUPS, D, EXPERTS_PER_GROUP), D ** -0.5),
        "b_re": nrm(ks[19], (L, N_GROUPS, EXPERTS_PER_GROUP), 0.01),
        "w_gate": nrm(ks[20], (L, N_EXPERTS, D, D_EXPERT), D ** -0.5),
        "w_up": nrm(ks[21], (L, N_EXPERTS, D, D_EXPERT), D ** -0.5),
        "w_down": nrm(ks[22], (L, N_EXPERTS, D_EXPERT, D), beta * D_EXPERT ** -0.5),
        "ln2_g": 1.0 + nrm(ks[23], (L, D), 0.02),
        "ln2_b": nrm(ks[24], (L, D), 0.02),
    }


def reference(x, c, w_ada, b_ada, w_in, sinks, cmp_pe_k, cmp_w1_k, cmp_w2_k, cmp_pe_v, cmp_w1_v, cmp_w2_v,
              mix_gain, w_out, ln1_g, ln1_b, w_rg, b_rg, w_re, b_re, w_gate, w_up, w_down, ln2_g, ln2_b):
    alpha = (2.0 * DEPTH) ** 0.25
    cs = jax.nn.silu(c)
    for l in range(DEPTH):
        mod = (cs @ w_ada[l] + b_ada[l])[:, None, :]
        sh1, sc1, g1, sh2, sc2, g2 = jnp.split(mod, 6, axis=-1)
        h = layer_norm(x) * (1.0 + sc1) + sh1
        y = hybrid_mixer(h, w_in[l], sinks[l], cmp_pe_k[l], cmp_w1_k[l], cmp_w2_k[l],
                         cmp_pe_v[l], cmp_w1_v[l], cmp_w2_v[l], mix_gain[l], w_out[l])
        x = layer_norm(alpha * x + (1.0 + g1) * y, ln1_g[l], ln1_b[l])
        h = layer_norm(x) * (1.0 + sc2) + sh2
        y = hierarchical_moe(h, w_rg[l], b_rg[l], w_re[l], b_re[l], w_gate[l], w_up[l], w_down[l])
        x = layer_norm(alpha * x + (1.0 + g2) * y, ln2_g[l], ln2_b[l])
    return x
```

```cpp
#include <hip/hip_runtime.h>
#include <cstdio>
#include <cstdint>
#include <utility>
#define MK_ONE_LAUNCH 0
namespace pg8 {
#define PG8_LAS __attribute__((address_space(3)))
typedef unsigned short bf16_t;
typedef short bf16x8 __attribute__((ext_vector_type(8)));
typedef float f32x4 __attribute__((ext_vector_type(4)));
typedef unsigned u32x4 __attribute__((ext_vector_type(4)));
constexpr int BM = 256, BK = 64, HALF = 128, HTB = HALF * BK * 2  , STAGE_BYTES = 8 * HTB, NXCD = 8, WGM = 8;

__host__ __device__ __forceinline__ int lds_byte(int r, int c) { const int st = (r >> 4) * 2 + (c >> 5), rr = r & 15, cc = c & 31, ob = rr * 64 + cc * 2; return st * 1024 + (ob ^ (((ob >> 9) & 1) << 5)); }
__host__ __device__ __forceinline__ void stage_rc(int b, int& R, int& C) { const int st = b / 1024, sb = b % 1024, swz = sb ^ (((sb >> 9) & 1) << 5); R = (st >> 1) * 16 + swz / 64; C = (st & 1) * 32 + (swz % 64) / 2; }
__host__ __device__ __forceinline__ int perm32(int rho) { const int n = rho >> 4, i = rho & 15; return 8 * (i >> 2) + 4 * n + (i & 3); }

struct Unit { int pm, pn; };
struct Gemm { const bf16_t* A; const bf16_t* Bt; int M, N, K; };

struct StaticOrder {
    int nM, nN, nwg, G, c;
    __host__ __device__ void init(int M, int N, int G_, int c_) { nM = M / BM; nN = N / BM; nwg = nM * nN; G = G_; c = c_; }
    __host__ __device__ bool next(int i, Unit& u) const {
        const long L = (long)i * G + c; if (L >= nwg) return false;
        int wgid = (int)L; { const int q = nwg / NXCD, r = nwg % NXCD, xcd = wgid % NXCD, off = wgid / NXCD; wgid = (xcd < r ? xcd * (q + 1) : r * (q + 1) + (xcd - r) * q) + off; }
        const int nig = WGM * nN, gid = wgid / nig, fm = gid * WGM, gsz = (nM - fm) < WGM ? (nM - fm) : WGM;
        u.pm = fm + ((wgid % nig) % gsz); u.pn = (wgid % nig) / gsz; return true;
    }
    __device__ __forceinline__ void a_ready(const Unit&) const {}
    __device__ __forceinline__ void done(const Unit&) const {}
};
__device__ __forceinline__ unsigned cvt_pk_bf16(float lo, float hi) { unsigned r; asm volatile("v_cvt_pk_bf16_f32 %0, %1, %2" : "=v"(r) : "v"(lo), "v"(hi)); return r; }
typedef float f32x2 __attribute__((ext_vector_type(2)));
__device__ __forceinline__ unsigned short f2bf_rne(float f) { unsigned u = __builtin_bit_cast(unsigned, f); return (unsigned short)((u + 0x7fffu + ((u >> 16) & 1u)) >> 16); }

struct EpiProj {
    static constexpr bool PERM = true, AFTER_DRAIN = false;
    bf16_t* P; bf16_t* VT; int ldp; int nt_row; int ldvt;
    __device__ __forceinline__ void operator()(const f32x4 (&acc)[2][2][4][2], const Unit& u, int wr, int wc, int fr, int fq) const {
        const int row0 = u.pm * BM + wr * 64 + fr;
        if (u.pn < nt_row) {
            const int col0 = u.pn * BM + wc * 32 + 8 * fq;
#pragma unroll
            for (int ai = 0; ai < 2; ++ai)
#pragma unroll
                for (int m = 0; m < 4; ++m) { bf16_t* rowp = P + (size_t)(row0 + ai * HALF + m * 16) * ldp + col0;
#pragma unroll
                    for (int bj = 0; bj < 2; ++bj) { const f32x4 v0 = acc[ai][bj][m][0], v1 = acc[ai][bj][m][1];
                        u32x4 w; w.x = cvt_pk_bf16(v0[0], v0[1]); w.y = cvt_pk_bf16(v0[2], v0[3]); w.z = cvt_pk_bf16(v1[0], v1[1]); w.w = cvt_pk_bf16(v1[2], v1[3]);
                        *(u32x4*)(rowp + bj * HALF) = w; } }
        } else {
            const int c0 = (u.pn - nt_row) * BM + wc * 32 + 8 * fq;
#pragma unroll
            for (int bj = 0; bj < 2; ++bj)
#pragma unroll
                for (int n = 0; n < 2; ++n)
#pragma unroll
                    for (int e = 0; e < 4; ++e) { bf16_t* cp = VT + (size_t)(c0 + bj * HALF + n * 4 + e) * ldvt + row0;
#pragma unroll
                        for (int ai = 0; ai < 2; ++ai)
#pragma unroll
                            for (int m = 0; m < 4; ++m) cp[ai * HALF + m * 16] = f2bf_rne(acc[ai][bj][m][n][e]); }
        }
    }
};

struct EpiResid {
    static constexpr bool PERM = false, AFTER_DRAIN = false;
    const float* xin; float* out; const float* gate0; int gate_bstride; int rows_per_batch; int ldc; float alpha;
    __device__ __forceinline__ void operator()(const f32x4 (&acc)[2][2][4][2], const Unit& u, int wr, int wc, int fr, int fq) const {
        const int col0 = u.pn * BM + wc * 32 + 4 * fq;
        const float* gv = gate0 + (size_t)((u.pm * BM) / rows_per_batch) * gate_bstride;
#pragma unroll
        for (int bj = 0; bj < 2; ++bj)
#pragma unroll
            for (int n = 0; n < 2; ++n) { const int c = col0 + bj * HALF + n * 16; const f32x4 g1 = *(const f32x4*)(gv + c) + 1.0f;
#pragma unroll
                for (int ai = 0; ai < 2; ++ai)
#pragma unroll
                    for (int m = 0; m < 4; ++m) { const size_t off = (size_t)(u.pm * BM + ai * HALF + wr * 64 + m * 16 + fr) * ldc + c;
                        const f32x4 xv = *(const f32x4*)(xin + off); *(f32x4*)(out + off) = xv * alpha + g1 * acc[ai][bj][m][n]; } }
    }
};

struct EpiSwiGLU {
    static constexpr bool PERM = true, AFTER_DRAIN = false;
    bf16_t* H; int ldh;
    __device__ __forceinline__ void operator()(const f32x4 (&acc)[2][2][4][2], const Unit& u, int wr, int wc, int fr, int fq) const {
        const int row0 = u.pm * BM + wr * 64 + fr, pnl = u.pn & 3;
        const int j0 = pnl * 128 + wc * 16 + 4 * fq;
#pragma unroll
        for (int ai = 0; ai < 2; ++ai)
#pragma unroll
            for (int m = 0; m < 4; ++m) { bf16_t* rowp = H + (size_t)(row0 + ai * HALF + m * 16) * ldh + j0;
#pragma unroll
                for (int bj = 0; bj < 2; ++bj) { const f32x4 v0 = acc[ai][bj][m][0], v1 = acc[ai][bj][m][1];
                    const float h0 = v0[0] / (1.0f + __expf(-v0[0])) * v0[1], h1 = v0[2] / (1.0f + __expf(-v0[2])) * v0[3];
                    const float h2 = v1[0] / (1.0f + __expf(-v1[0])) * v1[1], h3 = v1[2] / (1.0f + __expf(-v1[2])) * v1[3];
                    typedef unsigned u32x2 __attribute__((ext_vector_type(2)));
                    u32x2 w; w.x = cvt_pk_bf16(h0, h1); w.y = cvt_pk_bf16(h2, h3);
                    *(u32x2*)(rowp + bj * 64) = w; } }
    }
};

struct EpiDown {
    static constexpr bool PERM = true, AFTER_DRAIN = false;
    bf16_t* Y; int ldy; const int* rowinfo; const float* gatew;
    __device__ __forceinline__ void operator()(const f32x4 (&acc)[2][2][4][2], const Unit& u, int wr, int wc, int fr, int fq) const {
        const int row0 = u.pm * BM + wr * 64 + fr, pnl = u.pn & 7;
        const int col0 = pnl * BM + wc * 32 + 8 * fq;
#pragma unroll
        for (int ai = 0; ai < 2; ++ai)
#pragma unroll
            for (int m = 0; m < 4; ++m) { const int aid = rowinfo[row0 + ai * HALF + m * 16];
                if (aid >= 0) { const float gw = gatew[aid]; bf16_t* rowp = Y + (size_t)aid * ldy + col0;
#pragma unroll
                    for (int bj = 0; bj < 2; ++bj) { const f32x4 v0 = acc[ai][bj][m][0] * gw, v1 = acc[ai][bj][m][1] * gw;
                        u32x4 w; w.x = cvt_pk_bf16(v0[0], v0[1]); w.y = cvt_pk_bf16(v0[2], v0[3]); w.z = cvt_pk_bf16(v1[0], v1[1]); w.w = cvt_pk_bf16(v1[2], v1[3]);
                        *(u32x4*)(rowp + bj * HALF) = w; } } }
    }
};

struct MoeOrder {
    int ntiles, NT, G, c; const int* tile_e;
    __device__ __forceinline__ bool next(int i, Unit& u) const {
        const int x = c & 7, ci = c >> 3, per = G >> 3;
        const int q = i * per + ci, rt = x + 8 * (q / NT);
        if (rt >= ntiles) return false;
        u.pm = rt; u.pn = tile_e[rt] * NT + (q % NT); return true;
    }
    __device__ __forceinline__ void a_ready(const Unit&) const {}
    __device__ __forceinline__ void done(const Unit&) const {}
};
template <class Epi, class Sched, bool ALIGN_EPI = false, bool SP2 = false>
__device__ __forceinline__ void gemm_phase(PG8_LAS unsigned char* lds, const Gemm g, const Sched& S, const Epi& E) {
    int tid_ = threadIdx.x; asm volatile("" : "+v"(tid_));
    const int tid = tid_, wid = __builtin_amdgcn_readfirstlane(tid >> 6), lane = tid & 63, wr = wid >> 2, wc = wid & 3, fr = lane & 15, fq = lane >> 4;
    const int K = g.K, nt = K / BK;
    unsigned voffA[2], voffB[2];
#pragma unroll
    for (int i = 0; i < 2; ++i) { int R, C; stage_rc(tid * 16 + i * 8192, R, C); const int Rb = Epi::PERM ? ((R & ~31) + perm32(R & 31)) : R;
        voffA[i] = (unsigned)(R * K + C) * 2u; voffB[i] = (unsigned)(Rb * K + C) * 2u; }
    const size_t kstep = (size_t)(BK * 2);
    const size_t hstep = (size_t)HALF * K * 2;
    const size_t tstep = 2 * hstep;
    const unsigned ldsw = (unsigned)wid * 1024u;
    const int aoff = lds_byte(wr * 64 + fr, fq * 8), boff = lds_byte(wc * 32 + fr, fq * 8);
#define PG8_SA(b, h) (((b) * 2 + (h)) * HTB)
#define PG8_SB(b, h) ((4 + (b) * 2 + (h)) * HTB)
#define PG8_STAGE(bufoff, gbase, voff) do { _Pragma("unroll") for (int _i = 0; _i < 2; ++_i) \
        __builtin_amdgcn_global_load_lds((const unsigned*)((const char*)(gbase) + (voff)[_i]), (PG8_LAS unsigned*)(lds + (bufoff) + ldsw + _i * 8192), 16, 0, 0); } while (0)
#define PG8_LDA(dst, b, h) do { _Pragma("unroll") for (int m = 0; m < 4; ++m) _Pragma("unroll") for (int k = 0; k < 2; ++k) dst[m][k] = *(const PG8_LAS bf16x8*)(lds + PG8_SA(b, h) + aoff + m * 2048 + k * 1024); } while (0)
#define PG8_LDB(dst, b, h) do { _Pragma("unroll") for (int n = 0; n < 2; ++n) _Pragma("unroll") for (int k = 0; k < 2; ++k) dst[n][k] = *(const PG8_LAS bf16x8*)(lds + PG8_SB(b, h) + boff + n * 2048 + k * 1024); } while (0)
#define PG8_MMA(ai, bj, At, Bt) do { __builtin_amdgcn_s_setprio(1); _Pragma("unroll") for (int m = 0; m < 4; ++m) _Pragma("unroll") for (int n = 0; n < 2; ++n) _Pragma("unroll") for (int k = 0; k < 2; ++k) \
        acc[ai][bj][m][n] = __builtin_amdgcn_mfma_f32_16x16x32_bf16(Bt[n][k], At[m][k], acc[ai][bj][m][n], 0, 0, 0); __builtin_amdgcn_s_setprio(0); } while (0)
#define PG8_WAIT_V(n) asm volatile("s_waitcnt vmcnt(" #n ")" ::: "memory")
#define PG8_WAIT_L(n) asm volatile("s_waitcnt lgkmcnt(" #n ")" ::: "memory")
#define PG8_BAR __builtin_amdgcn_s_barrier()
#define PG8_SCHED __builtin_amdgcn_sched_barrier(0)
    Unit cur, nxt; int ui = 0;
    if (!S.next(0, cur)) return;
    f32x4 acc[2][2][4][2];
#pragma unroll
    for (int a = 0; a < 2; ++a)
#pragma unroll
        for (int b = 0; b < 2; ++b)
#pragma unroll
            for (int m = 0; m < 4; ++m)
#pragma unroll
                for (int n = 0; n < 2; ++n) acc[a][b][m][n] = (f32x4){0.f, 0.f, 0.f, 0.f};
    bf16x8 At[4][2], B0[2][2], B1[2][2];
    const char* cA = (const char*)g.A + (size_t)cur.pm * tstep; const char* cB = (const char*)g.Bt + (size_t)cur.pn * tstep;
    S.a_ready(cur);
    if constexpr (SP2) {
        PG8_STAGE(PG8_SB(0, 0), cB, voffB); PG8_STAGE(PG8_SB(0, 1), cB + hstep, voffB); PG8_STAGE(PG8_SA(0, 0), cA, voffA); PG8_STAGE(PG8_SA(0, 1), cA + hstep, voffA);
        if (wr == 1) PG8_BAR;
        PG8_WAIT_V(2); PG8_BAR;
        PG8_STAGE(PG8_SB(1, 0), cB + kstep, voffB); PG8_STAGE(PG8_SA(1, 0), cA + kstep, voffA); PG8_STAGE(PG8_SB(1, 1), cB + hstep + kstep, voffB);
        PG8_WAIT_V(6); PG8_BAR;
    } else {
        PG8_STAGE(PG8_SB(0, 0), cB, voffB); PG8_STAGE(PG8_SA(0, 0), cA, voffA); PG8_STAGE(PG8_SB(0, 1), cB + hstep, voffB); PG8_STAGE(PG8_SA(0, 1), cA + hstep, voffA);
        if (wr == 1) PG8_BAR;
        PG8_WAIT_V(4); PG8_BAR;
        PG8_STAGE(PG8_SB(1, 0), cB + kstep, voffB); PG8_STAGE(PG8_SA(1, 0), cA + kstep, voffA); PG8_STAGE(PG8_SB(1, 1), cB + hstep + kstep, voffB);
        PG8_WAIT_V(6); PG8_BAR;
    }
    for (;;) {
        const bool has_next = S.next(ui + 1, nxt);
        const char* nA = has_next ? (const char*)g.A + (size_t)nxt.pm * tstep : cA; const char* nB = has_next ? (const char*)g.Bt + (size_t)nxt.pn * tstep : cB;
        for (int t = 0; t < nt; t += 2) {
            const bool last = (t == nt - 2);
            const char* a1 = cA + (size_t)(t + 1) * kstep;
            const char* a2 = last ? nA : cA + (size_t)(t + 2) * kstep; const char* b2 = last ? nB : cB + (size_t)(t + 2) * kstep;
            const char* a3 = a2 + kstep; const char* b3 = b2 + kstep;
            if (last && has_next) S.a_ready(nxt);
            if constexpr (SP2) {
            PG8_LDB(B0, 0, 0); PG8_LDB(B1, 0, 1); PG8_SCHED; PG8_LDA(At, 0, 0); PG8_STAGE(PG8_SA(1, 1), a1 + hstep, voffA);
            PG8_WAIT_V(8); PG8_WAIT_L(0); PG8_BAR; PG8_MMA(0, 0, At, B0); PG8_MMA(0, 1, At, B1); PG8_BAR; PG8_SCHED;
            PG8_LDA(At, 0, 1); PG8_STAGE(PG8_SB(0, 0), b2, voffB); PG8_STAGE(PG8_SB(0, 1), b2 + hstep, voffB); PG8_STAGE(PG8_SA(0, 0), a2, voffA);
            PG8_WAIT_V(8); PG8_WAIT_L(0); PG8_BAR; PG8_MMA(1, 0, At, B0); PG8_MMA(1, 1, At, B1); PG8_BAR; PG8_SCHED;
            PG8_LDB(B0, 1, 0); PG8_LDB(B1, 1, 1); PG8_SCHED; PG8_LDA(At, 1, 0); PG8_STAGE(PG8_SA(0, 1), a2 + hstep, voffA);
            PG8_WAIT_V(8); PG8_WAIT_L(0); PG8_BAR; PG8_MMA(0, 0, At, B0); PG8_MMA(0, 1, At, B1); PG8_BAR; PG8_SCHED;
            PG8_LDA(At, 1, 1); PG8_STAGE(PG8_SB(1, 0), b3, voffB); PG8_STAGE(PG8_SB(1, 1), b3 + hstep, voffB); PG8_STAGE(PG8_SA(1, 0), a3, voffA);
            PG8_WAIT_V(8); PG8_WAIT_L(0); PG8_BAR; PG8_MMA(1, 0, At, B0); PG8_MMA(1, 1, At, B1); PG8_BAR; PG8_SCHED;
            } else {
            PG8_LDB(B0, 0, 0); PG8_SCHED; PG8_LDA(At, 0, 0); PG8_STAGE(PG8_SA(1, 1), a1 + hstep, voffA);
            PG8_WAIT_L(8); PG8_BAR; PG8_WAIT_L(0); PG8_MMA(0, 0, At, B0); PG8_BAR; PG8_SCHED;
            PG8_LDB(B1, 0, 1); PG8_STAGE(PG8_SB(0, 0), b2, voffB);
            PG8_BAR; PG8_WAIT_L(0); PG8_MMA(0, 1, At, B1); PG8_BAR;
            PG8_LDA(At, 0, 1); PG8_STAGE(PG8_SA(0, 0), a2, voffA);
            PG8_BAR; PG8_WAIT_L(0); PG8_MMA(1, 0, At, B0); PG8_BAR; PG8_SCHED;
            PG8_STAGE(PG8_SB(0, 1), b2 + hstep, voffB);
            PG8_WAIT_V(6); PG8_BAR; PG8_MMA(1, 1, At, B1); PG8_BAR;
            PG8_LDB(B0, 1, 0); PG8_SCHED; PG8_LDA(At, 1, 0); PG8_STAGE(PG8_SA(0, 1), a2 + hstep, voffA);
            PG8_WAIT_L(8); PG8_BAR; PG8_WAIT_L(0); PG8_MMA(0, 0, At, B0); PG8_BAR; PG8_SCHED;
            PG8_LDB(B1, 1, 1); PG8_STAGE(PG8_SB(1, 0), b3, voffB);
            PG8_BAR; PG8_WAIT_L(0); PG8_MMA(0, 1, At, B1); PG8_BAR;
            PG8_LDA(At, 1, 1); PG8_STAGE(PG8_SA(1, 0), a3, voffA);
            PG8_BAR; PG8_WAIT_L(0); PG8_MMA(1, 0, At, B0); PG8_BAR; PG8_SCHED;
            PG8_STAGE(PG8_SB(1, 1), b3 + hstep, voffB);
            PG8_WAIT_V(6); PG8_BAR; PG8_MMA(1, 1, At, B1); PG8_BAR;
            }
        }
        if constexpr (ALIGN_EPI) { if (wr == 0) PG8_BAR; }
        if constexpr (!Epi::AFTER_DRAIN) { E(acc, cur, wr, wc, fr, fq); S.done(cur); }
        if (!has_next) break;
#pragma unroll
        for (int a = 0; a < 2; ++a)
#pragma unroll
            for (int b = 0; b < 2; ++b)
#pragma unroll
                for (int m = 0; m < 4; ++m)
#pragma unroll
                    for (int n = 0; n < 2; ++n) acc[a][b][m][n] = (f32x4){0.f, 0.f, 0.f, 0.f};
        cur = nxt; cA = nA; cB = nB; ++ui;
        if constexpr (ALIGN_EPI) { if (wr == 1) PG8_BAR; }
    }
    PG8_WAIT_V(0);
    if constexpr (!ALIGN_EPI) { if (wr == 0) PG8_BAR; }
    PG8_BAR;
    if constexpr (Epi::AFTER_DRAIN) { E.fused(acc, cur, wr, wc, fr, fq, lds, wid, lane); S.done(cur); }
#undef PG8_SA
#undef PG8_SB
#undef PG8_STAGE
#undef PG8_LDA
#undef PG8_LDB
#undef PG8_MMA
#undef PG8_WAIT_V
#undef PG8_WAIT_L
#undef PG8_BAR
#undef PG8_SCHED
}
}
constexpr int NWAVES = 8;
constexpr int NB = 2, SEQ = 8192, DM = 2048, MTOK = NB * SEQ, DEPTH = 2, HD = 64;
constexpr int NEXP = 32, DEXP = 512, NASSIGN = MTOK * 2;
constexpr int D_IN = 5144;
constexpr int NPROJ = 3840, NVT = 1536, NIN = NPROJ + NVT;
constexpr int P_QA = 0, P_KA = 512, P_QB = 640, P_KBC = 1152, P_VBC = 1280, P_KBS = 1408, P_KBW = 1536, P_QC = 1664, P_KC = 2688, P_GB = 3712;
constexpr int V_C = 0, V_A = 1024, V_BS = 1152, V_BW = 1280;
constexpr int NT_ROW = NPROJ / 256;
constexpr float LN_EPS = 1e-5f, RMS_EPS = 1e-6f, ALPHA = 1.41421356237309515f;
constexpr float LOG2E = 1.44269504088896341f, LN2 = 0.693147180559945309f;
constexpr float SC2 = 0.125f * LOG2E;
constexpr int MAXROWS = 40960;
constexpr float SB_EXIT = -104.0f;

constexpr size_t MiB = 1u << 20;
constexpr size_t WS_CTL = 0, CTL_ZERO_BYTES = 1 * MiB;
constexpr size_t WS_MOD = 1 * MiB;
constexpr size_t WS_SMALL = 2 * MiB;
constexpr size_t WS_LIST = 4 * MiB;
constexpr size_t WS_WCMP = 6 * MiB;
constexpr size_t WS_WIN = 8 * MiB;
constexpr size_t WS_WOUT = 30 * MiB;
constexpr size_t WS_WGU = 38 * MiB;
constexpr size_t WS_WD = 166 * MiB;
constexpr size_t WS_XA = 230 * MiB;
constexpr size_t WS_XB = 358 * MiB;
constexpr size_t WS_HB = 486 * MiB;
constexpr size_t WS_PROJ = 550 * MiB;
constexpr size_t WS_VT = WS_PROJ + (size_t)MTOK * NPROJ * 2;
constexpr size_t WS_XS = WS_PROJ;
constexpr size_t WS_OCAT = 720 * MiB;
constexpr size_t WS_YS = WS_OCAT;
constexpr size_t WS_HID = 848 * MiB;
constexpr size_t WS_END = 888 * MiB;
static_assert(WS_VT + (size_t)NVT * MTOK * 2 <= WS_OCAT && WS_XS + (size_t)MAXROWS * DM * 2 <= WS_OCAT, "proj/vT/xs region");
static_assert(WS_WIN + (size_t)NIN * DM * 2 <= WS_WOUT && WS_WGU + (size_t)NEXP * 1024 * DM * 2 <= WS_WD && WS_WD + (size_t)NEXP * DM * DEXP * 2 <= WS_XA, "weight regions");
constexpr size_t SM_KCMP = 0;
constexpr size_t SM_VCMPT = 256 * 1024;
constexpr size_t SM_GATEW = 512 * 1024;
constexpr size_t SM_ROWINFO = 640 * 1024;
constexpr size_t SM_TILE = 800 * 1024;
constexpr int CW_BAR = 4096;
constexpr int CW_CNT = 16384;

constexpr int RING_OFF = 0, RING_BYTES = 131072;
constexpr int LDSCTL_OFF = RING_BYTES, MISC_OFF = LDSCTL_OFF + 320;
constexpr int LDS_BYTES = 147456;

#define GAS __attribute__((address_space(1)))
#define LAS __attribute__((address_space(3)))
typedef unsigned short bf16;
typedef unsigned v4u __attribute__((ext_vector_type(4)));
typedef unsigned v2u __attribute__((ext_vector_type(2)));
typedef float f32x4 __attribute__((ext_vector_type(4)));
typedef short bf16x8 __attribute__((ext_vector_type(8)));
typedef GAS unsigned gu32;
#define RLX_AGENT __ATOMIC_RELAXED, __HIP_MEMORY_SCOPE_AGENT
#define LDS_WAIT() asm volatile("s_waitcnt lgkmcnt(0)" ::: "memory")
#define VM_WAIT() asm volatile("s_waitcnt vmcnt(0)" ::: "memory")
__device__ __forceinline__ unsigned f2bf(float f) { unsigned u = __builtin_bit_cast(unsigned, f); return (u + 0x7fffu + ((u >> 16) & 1u)) >> 16; }
__device__ __forceinline__ unsigned pk2(float lo, float hi) { return f2bf(lo) | (f2bf(hi) << 16); }
__device__ __forceinline__ float bf2f(unsigned short h) { return __builtin_bit_cast(float, (unsigned)h << 16); }
__device__ __forceinline__ float bflo(unsigned w) { return __builtin_bit_cast(float, w << 16); }
__device__ __forceinline__ float bfhi(unsigned w) { return __builtin_bit_cast(float, w & 0xffff0000u); }
__device__ __forceinline__ float ex2(float x) { return __builtin_amdgcn_exp2f(x); }
__device__ __forceinline__ float lg2(float x) { return __builtin_amdgcn_logf(x); }
__device__ __forceinline__ bf16x8 ldg8(const bf16* p) { return *(const GAS bf16x8*)p; }
__device__ __forceinline__ f32x4 mfma16(bf16x8 a, bf16x8 b, f32x4 c) { return __builtin_amdgcn_mfma_f32_16x16x32_bf16(a, b, c, 0, 0, 0); }
__device__ __forceinline__ bf16x8 pack8(float a0, float a1, float a2, float a3, float a4, float a5, float a6, float a7) {
    v4u w; w.x = pg8::cvt_pk_bf16(a0, a1); w.y = pg8::cvt_pk_bf16(a2, a3); w.z = pg8::cvt_pk_bf16(a4, a5); w.w = pg8::cvt_pk_bf16(a6, a7);
    return __builtin_bit_cast(bf16x8, w);
}
__device__ __forceinline__ float wave_sum(float v) {
#pragma unroll
    for (int o = 1; o < 64; o <<= 1) v += __shfl_xor(v, o);
    return v;
}
#define XB_TMO      128
#define XB_XCNT(j)  (256  + 64 * (j))
#define XB_XSUB(j)  (1280 + 64 * (j))
#define XB_XGEN(j)  (2304 + 64 * (j))
#define XB_TOP      3328
#define XB_TOPGEN   3392
#define XCD_BAR_WORDS 3456
#define XB_SPIN_CAP (1u << 18)

__device__ __forceinline__ unsigned xb_ld(unsigned* p)              { return __hip_atomic_load(p, __ATOMIC_RELAXED, __HIP_MEMORY_SCOPE_AGENT); }
__device__ __forceinline__ unsigned xb_add(unsigned* p, unsigned v) { return __hip_atomic_fetch_add(p, v, __ATOMIC_RELAXED, __HIP_MEMORY_SCOPE_AGENT); }
__device__ __forceinline__ unsigned xb_xcc_id() { return (unsigned)__builtin_amdgcn_s_getreg((3 << 11) | 20) & 0xFu; }
#define XB_SPIN(cond, bar) do { unsigned _sp = 0; while (cond) { __builtin_amdgcn_s_sleep(1); \
    if ((++_sp & 255u) == 0u) { if (xb_ld(&(bar)[XB_TMO])) break; if (_sp > XB_SPIN_CAP) { atomicAdd(&(bar)[XB_TMO], 1u); break; } } } } while (0)

struct XcdBarrier {
    unsigned* bar; unsigned x;
    volatile LAS unsigned* st;
};

__device__ __forceinline__ XcdBarrier xcd_barrier_post(unsigned* bar, volatile LAS unsigned* st) {
    XcdBarrier b; b.bar = bar; b.x = xb_xcc_id(); b.st = st;
    if (threadIdx.x == 0) (void)xb_add(&bar[XB_XCNT(b.x)], 1u);
    return b;
}
__device__ __forceinline__ void xcd_barrier_complete(unsigned* bar, unsigned x, unsigned& nloc, unsigned& nx) {
    const unsigned G = gridDim.x * gridDim.y * gridDim.z;
    unsigned sum, cnt, mine, sp = 0u;
    for (;;) {
        sum = 0u; cnt = 0u; mine = 0u;
#pragma unroll
        for (unsigned j = 0; j < 16; ++j) { const unsigned c = xb_ld(&bar[XB_XCNT(j)]); sum += c; cnt += (c > 0u) ? 1u : 0u; mine = (j == x) ? c : mine; }
        if (sum == G) break;
        __builtin_amdgcn_s_sleep(1);
        if ((++sp & 255u) == 0u) { if (xb_ld(&bar[XB_TMO])) break; if (sp > XB_SPIN_CAP) { atomicAdd(&bar[XB_TMO], 1u); break; } }
    }
    nloc = mine > 0u ? mine : 1u; nx = cnt > 0u ? cnt : 1u;
}

__device__ __forceinline__ void xcd_barrier(const XcdBarrier& b) {
    asm volatile("s_waitcnt vmcnt(0)" ::: "memory");
    __syncthreads();
    if (threadIdx.x == 0) {
        unsigned* bar = b.bar;
        __builtin_amdgcn_s_waitcnt(0);
        unsigned nloc = b.st[0], nx = b.st[1];
        if (nloc == 0u) { xcd_barrier_complete(bar, b.x, nloc, nx); b.st[0] = nloc; b.st[1] = nx; }
        const unsigned old = xb_add(&bar[XB_XSUB(b.x)], 1u);
        const unsigned gen = old / nloc;
        if (old + 1u == (gen + 1u) * nloc) {
            __builtin_amdgcn_fence(__ATOMIC_RELEASE, "agent");
            asm volatile("s_waitcnt vmcnt(0)" ::: "memory");
            const unsigned og = xb_add(&bar[XB_TOP], 1u);
            const unsigned tg = og / nx;
            if (og + 1u == (tg + 1u) * nx) xb_add(&bar[XB_TOPGEN], 1u);
            else XB_SPIN(xb_ld(&bar[XB_TOPGEN]) == tg, bar);
            __builtin_amdgcn_fence(__ATOMIC_ACQUIRE, "agent");
            xb_add(&bar[XB_XGEN(b.x)], 1u);
            asm volatile("s_waitcnt vmcnt(0)" ::: "memory");
        } else {
            XB_SPIN(xb_ld(&bar[XB_XGEN(b.x)]) == gen, bar);
            __builtin_amdgcn_fence(__ATOMIC_ACQUIRE, "agent");
            asm volatile("s_waitcnt vmcnt(0)" ::: "memory");
        }
    }
    __syncthreads();
}
struct Frame {
    LAS unsigned char* lds;
    volatile LAS unsigned* MISC;
    int tid, lane, wave;
    int vcu, G;
};
constexpr int PTR_OFF = LDSCTL_OFF + 1024;
__device__ __forceinline__ unsigned char* tabp(const Frame& F, int i) {
    const unsigned long long v = ((LAS unsigned long long*)(F.lds + PTR_OFF))[i];
    const unsigned lo = __builtin_amdgcn_readfirstlane((unsigned)v), hi = __builtin_amdgcn_readfirstlane((unsigned)(v >> 32));
    return (unsigned char*)(((unsigned long long)hi << 32) | lo);
}
__device__ __forceinline__ const float* inp(const Frame& F, int i) { return (const float*)tabp(F, i); }
__device__ __forceinline__ unsigned char* wsp(const Frame& F) { return tabp(F, 25); }
__device__ __forceinline__ float* outp(const Frame& F) { return (float*)tabp(F, 26); }
__device__ __forceinline__ gu32* ctlp(const Frame& F) { return (gu32*)(tabp(F, 25) + WS_CTL); }
enum { I_X = 0, I_C, I_WADA, I_BADA, I_WIN, I_SINKS, I_PEK, I_W1K, I_W2K, I_PEV, I_W1V, I_W2V, I_MIXG, I_WOUT, I_LN1G, I_LN1B, I_WRG, I_BRG, I_WRE, I_BRE, I_WGATE, I_WUP, I_WDOWN, I_LN2G, I_LN2B };

__device__ __forceinline__ void ada_phase(Frame& F) {
    LAS float* cs = (LAS float*)(F.lds + 73728);
    LAS float* red = (LAS float*)(F.lds + 73728 + 16384);
    const float* c = inp(F, I_C);
    for (int i = F.tid; i < NB * DM; i += NWAVES * 64) { const float v = c[i]; cs[i] = v / (1.0f + __expf(-v)); }
    __syncthreads();
    float* mod = (float*)(wsp(F) + WS_MOD);
    for (int u = F.vcu; u < DEPTH * 96; u += F.G) {
        const int l = u / 96, cb = u % 96, col = cb * 128 + 2 * F.lane;
        const float* W = inp(F, I_WADA) + (size_t)l * DM * (6 * DM) + col;
        float a00 = 0.f, a01 = 0.f, a10 = 0.f, a11 = 0.f;
        const int k0 = F.wave * 256;
#pragma unroll 8
        for (int kk = 0; kk < 256; ++kk) { const int k = k0 + kk; typedef float f32x2_ __attribute__((ext_vector_type(2))); const f32x2_ w = *(const GAS f32x2_*)(W + (size_t)k * (6 * DM));
            const float s0 = cs[k], s1 = cs[DM + k]; a00 += s0 * w.x; a01 += s0 * w.y; a10 += s1 * w.x; a11 += s1 * w.y; }
        red[(F.wave * 2 + 0) * 128 + 2 * F.lane] = a00; red[(F.wave * 2 + 0) * 128 + 2 * F.lane + 1] = a01;
        red[(F.wave * 2 + 1) * 128 + 2 * F.lane] = a10; red[(F.wave * 2 + 1) * 128 + 2 * F.lane + 1] = a11;
        __syncthreads();
        if (F.tid < 256) { const int b = F.tid >> 7, j = F.tid & 127; float s = 0.f;
#pragma unroll
            for (int w = 0; w < 8; ++w) s += red[(w * 2 + b) * 128 + j];
            mod[((size_t)l * NB + b) * (6 * DM) + cb * 128 + j] = s + inp(F, I_BADA)[(size_t)l * 6 * DM + cb * 128 + j]; }
        __syncthreads();
    }
}

__device__ __forceinline__ void tr_item(const float* W, int ldw, int K, bf16* WT, size_t drow0, int rs, int src0, int nvalid, int k0, LAS float* scr, int lane) {
    const int nn = lane & 31;
#pragma unroll 8
    for (int i = 0; i < 32; ++i) { const int kk = 2 * i + (lane >> 5);
        scr[kk * 33 + nn] = (nn < nvalid) ? *(const GAS float*)(W + (size_t)(k0 + kk) * ldw + src0 + nn) : 0.f; }
    LDS_WAIT(); asm volatile("" ::: "memory");
    const int c = lane & 7;
#pragma unroll
    for (int j = 0; j < 4; ++j) { const int n = (lane >> 3) + 8 * j; const LAS float* s = scr + (8 * c) * 33 + n;
        v4u o; o.x = pk2(s[0 * 33], s[1 * 33]); o.y = pk2(s[2 * 33], s[3 * 33]); o.z = pk2(s[4 * 33], s[5 * 33]); o.w = pk2(s[6 * 33], s[7 * 33]);
        *(GAS v4u*)(WT + (drow0 + (size_t)n * rs) * K + k0 + 8 * c) = o; }
    LDS_WAIT(); asm volatile("" ::: "memory");
}
__device__ __forceinline__ void win_src(int n0, int& src0, int& nvalid) {
    nvalid = 32;
    if (n0 < 512) src0 = n0;
    else if (n0 < 640) src0 = 512 + (n0 - 512);
    else if (n0 < 1152) src0 = 768 + (n0 - 640);
    else if (n0 < 1280) src0 = 1280 + (n0 - 1152);
    else if (n0 < 1408) src0 = 1408 + (n0 - 1280);
    else if (n0 < 1536) src0 = 1536 + (n0 - 1408);
    else if (n0 < 1664) src0 = 1792 + (n0 - 1536);
    else if (n0 < 2688) src0 = 2072 + (n0 - 1664);
    else if (n0 < 3712) src0 = 3096 + (n0 - 2688);
    else if (n0 < 3744) { src0 = 2048; nvalid = 24; }
    else if (n0 < 3840) { src0 = 0; nvalid = 0; }
    else if (n0 < 4864) src0 = 4120 + (n0 - 3840);
    else if (n0 < 4992) src0 = 640 + (n0 - 4864);
    else if (n0 < 5120) src0 = 1664 + (n0 - 4992);
    else if (n0 < 5248) src0 = 1920 + (n0 - 5120);
    else { src0 = 0; nvalid = 0; }
}
__device__ __forceinline__ void convert_layer(Frame& F, int l) {
    LAS float* scr = (LAS float*)(F.lds + F.wave * 8704);
    const int gw = F.vcu * NWAVES + F.wave, NGW = F.G * NWAVES;
    constexpr int I_A = 32 * (NIN / 32), I_B = 32 * 64, I_G = NEXP * 512, I_U = NEXP * 512, I_D = NEXP * 512, I_1 = 128, I_2 = 4;
    constexpr int NITEMS = I_A + I_B + I_G + I_U + I_D + 2 * I_1 + 2 * I_2;
    bf16* Win_t = (bf16*)(wsp(F) + WS_WIN); bf16* Wout_t = (bf16*)(wsp(F) + WS_WOUT); bf16* Wgu_t = (bf16*)(wsp(F) + WS_WGU); bf16* Wd_t = (bf16*)(wsp(F) + WS_WD);
    bf16* W1t = (bf16*)(wsp(F) + WS_WCMP); bf16* W2t = (bf16*)(wsp(F) + WS_WCMP + 2 * 128 * 2048 * 2);
    for (int it = gw; it < NITEMS; it += NGW) {
        int r = it;
        if (r < I_A) { const int nblk = NIN / 32, kb = r / nblk, nb = r % nblk; int src0, nv; win_src(nb * 32, src0, nv);
            tr_item(inp(F, I_WIN) + (size_t)l * DM * D_IN, D_IN, DM, Win_t, (size_t)nb * 32, 1, src0, nv, kb * 64, scr, F.lane); continue; } r -= I_A;
        if (r < I_B) { const int kb = r / 64, nb = r % 64;
            tr_item(inp(F, I_WOUT) + (size_t)l * DM * DM, DM, DM, Wout_t, (size_t)nb * 32, 1, nb * 32, 32, kb * 64, scr, F.lane); continue; } r -= I_B;
        if (r < I_G) { const int e = r / 512, q = r % 512, kb = q / 16, nb = q % 16;
            tr_item(inp(F, I_WGATE) + ((size_t)l * NEXP + e) * DM * DEXP, DEXP, DM, Wgu_t, (size_t)e * 1024 + nb * 64, 2, nb * 32, 32, kb * 64, scr, F.lane); continue; } r -= I_G;
        if (r < I_U) { const int e = r / 512, q = r % 512, kb = q / 16, nb = q % 16;
            tr_item(inp(F, I_WUP) + ((size_t)l * NEXP + e) * DM * DEXP, DEXP, DM, Wgu_t, (size_t)e * 1024 + nb * 64 + 1, 2, nb * 32, 32, kb * 64, scr, F.lane); continue; } r -= I_U;
        if (r < I_D) { const int e = r / 512, q = r % 512, kb = q / 64, nb = q % 64;
            tr_item(inp(F, I_WDOWN) + ((size_t)l * NEXP + e) * DEXP * DM, DM, DEXP, Wd_t, (size_t)e * DM + nb * 32, 1, nb * 32, 32, kb * 64, scr, F.lane); continue; } r -= I_D;
        if (r < 2 * I_1) { const int kv = r / I_1, q = r % I_1, kb = q / 4, nb = q % 4;
            tr_item(inp(F, kv ? I_W1V : I_W1K) + (size_t)l * 2048 * 128, 128, 2048, W1t + (size_t)kv * 128 * 2048, (size_t)nb * 32, 1, nb * 32, 32, kb * 64, scr, F.lane); continue; } r -= 2 * I_1;
        { const int kv = r / I_2, q = r % I_2, kb = q / 2, nb = q % 2;
            tr_item(inp(F, kv ? I_W2V : I_W2K) + (size_t)l * 128 * 64, 64, 128, W2t + (size_t)kv * 64 * 128, (size_t)nb * 32, 1, nb * 32, 32, kb * 64, scr, F.lane); }
    }
}

struct Row { f32x4 v[8]; };
__device__ __forceinline__ void row_load(Row& r, const float* p, int lane) {
#pragma unroll
    for (int j = 0; j < 8; ++j) r.v[j] = *((const GAS f32x4*)p + lane + 64 * j);
}
__device__ __forceinline__ void row_store(const Row& r, float* p, int lane) {
#pragma unroll
    for (int j = 0; j < 8; ++j) *((GAS f32x4*)p + lane + 64 * j) = r.v[j];
}
__device__ __forceinline__ void row_store_bf16(const Row& r, bf16* p, int lane) {
#pragma unroll
    for (int j = 0; j < 8; ++j) { v2u w; w.x = pk2(r.v[j].x, r.v[j].y); w.y = pk2(r.v[j].z, r.v[j].w); *((GAS v2u*)p + lane + 64 * j) = w; }
}
__device__ __forceinline__ void row_normalize(Row& r) {
    float s = 0.f;
#pragma unroll
    for (int j = 0; j < 8; ++j) s += (r.v[j].x + r.v[j].y) + (r.v[j].z + r.v[j].w);
    const float mean = wave_sum(s) * (1.0f / DM); float s2 = 0.f;
#pragma unroll
    for (int j = 0; j < 8; ++j) { r.v[j] = r.v[j] - mean; s2 += (r.v[j].x * r.v[j].x + r.v[j].y * r.v[j].y) + (r.v[j].z * r.v[j].z + r.v[j].w * r.v[j].w); }
    const float rstd = 1.0f / sqrtf(wave_sum(s2) * (1.0f / DM) + LN_EPS);
#pragma unroll
    for (int j = 0; j < 8; ++j) r.v[j] = r.v[j] * rstd;
}
__device__ __forceinline__ void row_affine(Row& r, const float* a, float add1, const float* b, int lane) {
#pragma unroll
    for (int j = 0; j < 8; ++j) { const f32x4 av = *((const GAS f32x4*)a + lane + 64 * j) + add1, bv = *((const GAS f32x4*)b + lane + 64 * j); r.v[j] = r.v[j] * av + bv; }
}
__device__ __forceinline__ const float* modp(Frame& F, int l, int b, int which) { return (const float*)(wsp(F) + WS_MOD) + ((size_t)l * NB + b) * (6 * DM) + which * DM; }

__device__ __forceinline__ void ln_in_phase(Frame& F) {
    const int gw = F.vcu * NWAVES + F.wave, NGW = F.G * NWAVES;
    bf16* hb = (bf16*)(wsp(F) + WS_HB);
    for (int m = gw; m < MTOK; m += NGW) { const int b = m / SEQ; Row r; row_load(r, inp(F, I_X) + (size_t)m * DM, F.lane); row_normalize(r);
        row_affine(r, modp(F, 0, b, 1), 1.0f, modp(F, 0, b, 0), F.lane); row_store_bf16(r, hb + (size_t)m * DM, F.lane); }
}

__device__ __forceinline__ void merge_phase(Frame& F, int l) {
    const int gw = F.vcu * NWAVES + F.wave, NGW = F.G * NWAVES;
    const float* oc = (const float*)(wsp(F) + WS_OCAT); bf16* hb = (bf16*)(wsp(F) + WS_HB); const float* mg = inp(F, I_MIXG) + (size_t)l * DM;
    for (int m = gw; m < MTOK; m += NGW) { Row r; row_load(r, oc + (size_t)m * DM, F.lane);
        float sa = 0.f, sb = 0.f, sc = 0.f;
#pragma unroll
        for (int j = 0; j < 8; ++j) { const float q = (r.v[j].x * r.v[j].x + r.v[j].y * r.v[j].y) + (r.v[j].z * r.v[j].z + r.v[j].w * r.v[j].w); if (j < 2) sa += q; else if (j < 4) sb += q; else sc += q; }
        const float ra = 1.0f / sqrtf(wave_sum(sa) * (1.0f / 512.0f) + RMS_EPS), rb = 1.0f / sqrtf(wave_sum(sb) * (1.0f / 512.0f) + RMS_EPS), rc = 1.0f / sqrtf(wave_sum(sc) * (1.0f / 1024.0f) + RMS_EPS);
#pragma unroll
        for (int j = 0; j < 8; ++j) { const float s = j < 2 ? ra : (j < 4 ? rb : rc); const f32x4 g = *((const GAS f32x4*)mg + F.lane + 64 * j); r.v[j] = r.v[j] * s * g; }
        row_store_bf16(r, hb + (size_t)m * DM, F.lane); }
}

__device__ __forceinline__ void post_mixer_phase(Frame& F, int l) {
    const int gw = F.vcu * NWAVES + F.wave, NGW = F.G * NWAVES;
    float* xa = (float*)(wsp(F) + WS_XA); bf16* hb = (bf16*)(wsp(F) + WS_HB);
    const float* wrg = inp(F, I_WRG) + (size_t)l * DM * 4; const float* brg = inp(F, I_BRG) + l * 4;
    const float* wre = inp(F, I_WRE) + (size_t)l * 4 * DM * 8; const float* bre = inp(F, I_BRE) + l * 32;
    unsigned* cnt = (unsigned*)(ctlp(F) + CW_CNT + l * 32); int* list = (int*)(wsp(F) + WS_LIST); float* gatew = (float*)(wsp(F) + WS_SMALL + SM_GATEW);
    for (int m = gw; m < MTOK; m += NGW) { const int b = m / SEQ; Row r; row_load(r, xa + (size_t)m * DM, F.lane); row_normalize(r);
        row_affine(r, inp(F, I_LN1G) + (size_t)l * DM, 0.0f, inp(F, I_LN1B) + (size_t)l * DM, F.lane); row_store(r, xa + (size_t)m * DM, F.lane);
        row_normalize(r); row_affine(r, modp(F, l, b, 4), 1.0f, modp(F, l, b, 3), F.lane); row_store_bf16(r, hb + (size_t)m * DM, F.lane);
        f32x4 lg = (f32x4){0.f, 0.f, 0.f, 0.f};
#pragma unroll
        for (int j = 0; j < 8; ++j) { const GAS f32x4* wp = (const GAS f32x4*)wrg + (size_t)(4 * F.lane + 256 * j);
            lg += wp[0] * r.v[j].x; lg += wp[1] * r.v[j].y; lg += wp[2] * r.v[j].z; lg += wp[3] * r.v[j].w; }
        float g0 = wave_sum(lg.x) + brg[0], g1 = wave_sum(lg.y) + brg[1], g2 = wave_sum(lg.z) + brg[2], g3 = wave_sum(lg.w) + brg[3];
        int gs = 0; float gm = g0; if (g1 > gm) { gm = g1; gs = 1; } if (g2 > gm) { gm = g2; gs = 2; } if (g3 > gm) { gm = g3; gs = 3; }
        const float pgroup = 1.0f / (__expf(g0 - gm) + __expf(g1 - gm) + __expf(g2 - gm) + __expf(g3 - gm));
        gs = __builtin_amdgcn_readfirstlane(gs);
        f32x4 ea = (f32x4){0.f, 0.f, 0.f, 0.f}, eb = (f32x4){0.f, 0.f, 0.f, 0.f};
        const float* wg = wre + (size_t)gs * DM * 8;
#pragma unroll
        for (int j = 0; j < 8; ++j) { const GAS f32x4* wp = (const GAS f32x4*)wg + (size_t)(4 * F.lane + 256 * j) * 2;
            ea += wp[0] * r.v[j].x; eb += wp[1] * r.v[j].x; ea += wp[2] * r.v[j].y; eb += wp[3] * r.v[j].y;
            ea += wp[4] * r.v[j].z; eb += wp[5] * r.v[j].z; ea += wp[6] * r.v[j].w; eb += wp[7] * r.v[j].w; }
        float le[8];
        le[0] = wave_sum(ea.x) + bre[gs * 8 + 0]; le[1] = wave_sum(ea.y) + bre[gs * 8 + 1]; le[2] = wave_sum(ea.z) + bre[gs * 8 + 2]; le[3] = wave_sum(ea.w) + bre[gs * 8 + 3];
        le[4] = wave_sum(eb.x) + bre[gs * 8 + 4]; le[5] = wave_sum(eb.y) + bre[gs * 8 + 5]; le[6] = wave_sum(eb.z) + bre[gs * 8 + 6]; le[7] = wave_sum(eb.w) + bre[gs * 8 + 7];
        int t1 = 0; float m1 = le[0];
#pragma unroll
        for (int i = 1; i < 8; ++i) if (le[i] > m1) { m1 = le[i]; t1 = i; }
        int t2 = -1; float m2 = -3.0e38f;
#pragma unroll
        for (int i = 0; i < 8; ++i) if (i != t1 && le[i] > m2) { m2 = le[i]; t2 = i; }
        const float e2 = __expf(m2 - m1), inv = pgroup / (1.0f + e2);
        if (F.lane == 0) {
            const int x1 = gs * 8 + t1, x2 = gs * 8 + t2;
            const unsigned p1 = __hip_atomic_fetch_add(cnt + x1, 1u, RLX_AGENT); list[(size_t)x1 * MTOK + p1] = m * 2; gatew[m * 2] = inv;
            const unsigned p2 = __hip_atomic_fetch_add(cnt + x2, 1u, RLX_AGENT); list[(size_t)x2 * MTOK + p2] = m * 2 + 1; gatew[m * 2 + 1] = inv * e2;
        }
    }
}

__device__ __forceinline__ void gather_phase(Frame& F, int l) {
    LAS int* tb = (LAS int*)(F.lds + 0);
    const unsigned* cnt = (const unsigned*)(ctlp(F) + CW_CNT + l * 32);
    if (F.tid < 32) tb[F.tid] = (int)__hip_atomic_load(cnt + F.tid, RLX_AGENT);
    __syncthreads();
    if (F.tid == 0) { int row = 0, tile = 0;
        for (int e = 0; e < NEXP; ++e) { tb[32 + e] = row; const int nt = (tb[e] + 255) >> 8; for (int t = 0; t < nt; ++t) tb[64 + tile + t] = e; tile += nt; row += nt * 256; }
        tb[224] = tile; }
    __syncthreads();
    const int ntiles = tb[224];
    int* gt = (int*)(wsp(F) + WS_SMALL + SM_TILE);
    if (blockIdx.x == 0) { if (F.tid < 160) gt[F.tid] = (F.tid < ntiles) ? tb[64 + F.tid] : 0; if (F.tid == 0) gt[200] = ntiles; }
    const int gw = F.vcu * NWAVES + F.wave, NGW = F.G * NWAVES;
    const int* list = (const int*)(wsp(F) + WS_LIST); int* rowinfo = (int*)(wsp(F) + WS_SMALL + SM_ROWINFO);
    const bf16* hb = (const bf16*)(wsp(F) + WS_HB); bf16* xs = (bf16*)(wsp(F) + WS_XS);
    for (int R = gw; R < ntiles * 256; R += NGW) { const int e = tb[64 + (R >> 8)], pos = R - tb[32 + e];
        int aid = -1; if (pos < tb[e]) aid = list[(size_t)e * MTOK + pos];
        GAS v4u* dst = (GAS v4u*)(xs + (size_t)R * DM) + F.lane;
        if (aid >= 0) { const GAS v4u* src = (const GAS v4u*)(hb + (size_t)(aid >> 1) * DM) + F.lane;
#pragma unroll
            for (int j = 0; j < 4; ++j) dst[64 * j] = src[64 * j]; }
        else {
#pragma unroll
            for (int j = 0; j < 4; ++j) dst[64 * j] = (v4u){0u, 0u, 0u, 0u}; }
        if (F.lane == 0) rowinfo[R] = aid; }
    __syncthreads();
}

__device__ __forceinline__ void post_moe_phase(Frame& F, int l, float* dst, bool next_h) {
    const int gw = F.vcu * NWAVES + F.wave, NGW = F.G * NWAVES;
    const float* xa = (const float*)(wsp(F) + WS_XA); const bf16* ys = (const bf16*)(wsp(F) + WS_YS); bf16* hb = (bf16*)(wsp(F) + WS_HB);
    for (int m = gw; m < MTOK; m += NGW) { const int b = m / SEQ; Row r; row_load(r, xa + (size_t)m * DM, F.lane);
        const float* g2 = modp(F, l, b, 5);
#pragma unroll
        for (int j = 0; j < 8; ++j) { const v2u y0 = *((const GAS v2u*)(ys + (size_t)(2 * m) * DM) + F.lane + 64 * j), y1 = *((const GAS v2u*)(ys + (size_t)(2 * m + 1) * DM) + F.lane + 64 * j);
            const f32x4 y = (f32x4){bflo(y0.x) + bflo(y1.x), bfhi(y0.x) + bfhi(y1.x), bflo(y0.y) + bflo(y1.y), bfhi(y0.y) + bfhi(y1.y)};
            const f32x4 gv = *((const GAS f32x4*)g2 + F.lane + 64 * j) + 1.0f; r.v[j] = r.v[j] * ALPHA + gv * y; }
        row_normalize(r); row_affine(r, inp(F, I_LN2G) + (size_t)l * DM, 0.0f, inp(F, I_LN2B) + (size_t)l * DM, F.lane); row_store(r, dst + (size_t)m * DM, F.lane);
        if (next_h) { row_normalize(r); row_affine(r, modp(F, l + 1, b, 1), 1.0f, modp(F, l + 1, b, 0), F.lane); row_store_bf16(r, hb + (size_t)m * DM, F.lane); } }
}
struct Flash { f32x4 O[4][4]; float m[4], l[4]; };

__device__ __forceinline__ void flash_init(Flash& S, float m0, float m1, float m2, float m3) {
#pragma unroll
    for (int db = 0; db < 4; ++db)
#pragma unroll
        for (int qb = 0; qb < 4; ++qb) S.O[db][qb] = (f32x4){0.f, 0.f, 0.f, 0.f};
    S.m[0] = m0; S.m[1] = m1; S.m[2] = m2; S.m[3] = m3; S.l[0] = S.l[1] = S.l[2] = S.l[3] = 0.f;
}
__device__ __forceinline__ void flash_step(Flash& S, const f32x4 (&Sv)[2][4], bf16x8 (&Pf)[4]) {
#pragma unroll
    for (int qb = 0; qb < 4; ++qb) {
        float mx = fmaxf(fmaxf(fmaxf(Sv[0][qb][0], Sv[0][qb][1]), fmaxf(Sv[0][qb][2], Sv[0][qb][3])), fmaxf(fmaxf(Sv[1][qb][0], Sv[1][qb][1]), fmaxf(Sv[1][qb][2], Sv[1][qb][3])));
        mx = fmaxf(mx, __shfl_xor(mx, 16)); mx = fmaxf(mx, __shfl_xor(mx, 32));
        const float mn = fmaxf(S.m[qb], mx), al = ex2(S.m[qb] - mn); S.m[qb] = mn;
        float p[8];
#pragma unroll
        for (int h = 0; h < 2; ++h)
#pragma unroll
            for (int r = 0; r < 4; ++r) p[4 * h + r] = ex2(Sv[h][qb][r] - mn);
        S.l[qb] = S.l[qb] * al + ((p[0] + p[1]) + (p[2] + p[3])) + ((p[4] + p[5]) + (p[6] + p[7]));
#pragma unroll
        for (int db = 0; db < 4; ++db) S.O[db][qb] = S.O[db][qb] * al;
        Pf[qb] = pack8(p[0], p[1], p[2], p[3], p[4], p[5], p[6], p[7]);
    }
}
__device__ __forceinline__ void flash_pv(Flash& S, const bf16* vrow0  , size_t ldv, const bf16x8 (&Pf)[4]) {
#pragma unroll
    for (int db = 0; db < 4; ++db) { const bf16x8 Vf = ldg8(vrow0 + (size_t)(16 * db) * ldv);
#pragma unroll
        for (int qb = 0; qb < 4; ++qb) S.O[db][qb] = mfma16(Vf, Pf[qb], S.O[db][qb]); }
}
__device__ __forceinline__ float flash_inv(const Flash& S, int qb, bool has_sink, float sink2) {
    float lt = S.l[qb]; lt += __shfl_xor(lt, 16); lt += __shfl_xor(lt, 32);
    if (has_sink) lt += ex2(sink2 - S.m[qb]);
    return lt > 0.f ? 1.0f / lt : 0.f;
}
__device__ __forceinline__ float sigmoidf_(float x) { return 1.0f / (1.0f + __expf(-x)); }
__device__ __forceinline__ float slope2_of(int hidx) { return LOG2E * exp2f(-0.5f * (float)(hidx + 1)); }

template <int W, int MODE>
__device__ __forceinline__ void win_unit(Frame& F, int l, int b, int g, int q0) {
    const int lane = F.lane, c = lane & 15, kq = lane >> 4;
    const bf16* proj = (const bf16*)(wsp(F) + WS_PROJ); const bf16* vT = (const bf16*)(wsp(F) + WS_VT); float* ocat = (float*)(wsp(F) + WS_OCAT);
    constexpr int QOFF = MODE == 0 ? P_QA : P_QB, KOFF = MODE == 0 ? P_KA : P_KBW, VROW = MODE == 0 ? V_A : V_BW, OCOL = MODE == 0 ? 0 : 512, HBASE = MODE == 0 ? 0 : 8;
    const size_t tb = (size_t)b * SEQ; const int t = q0 + c;
    const bf16* qrow = proj + (tb + t) * NPROJ;
    bf16x8 Qf[4][2];
#pragma unroll
    for (int qb = 0; qb < 4; ++qb)
#pragma unroll
        for (int ds = 0; ds < 2; ++ds) Qf[qb][ds] = ldg8(qrow + QOFF + (g * 4 + qb) * 64 + ds * 32 + kq * 8);
    float sl2[4], sk2[4];
#pragma unroll
    for (int qb = 0; qb < 4; ++qb) { sl2[qb] = slope2_of(HBASE + g * 4 + qb); sk2[qb] = MODE == 0 ? inp(F, I_SINKS)[l * 8 + g * 4 + qb] * LOG2E : -1.0e30f; }
    Flash S; flash_init(S, sk2[0], sk2[1], sk2[2], sk2[3]);
    int klo = q0 - (W - 1); if (klo < 0) klo = 0; klo &= ~31;
    const int khi = (q0 + 15) & ~31;
    for (int kbase = klo; kbase <= khi; kbase += 32) {
        f32x4 Sv[2][4];
#pragma unroll
        for (int h = 0; h < 2; ++h) { const int key = kbase + 8 * (c >> 2) + 4 * h + (c & 3); const bf16* kr = proj + (tb + key) * NPROJ + KOFF + g * 64 + kq * 8;
            const bf16x8 K0 = ldg8(kr), K1 = ldg8(kr + 32);
#pragma unroll
            for (int qb = 0; qb < 4; ++qb) { f32x4 a = mfma16(K0, Qf[qb][0], (f32x4){0.f, 0.f, 0.f, 0.f}); Sv[h][qb] = mfma16(K1, Qf[qb][1], a); } }
#pragma unroll
        for (int h = 0; h < 2; ++h)
#pragma unroll
            for (int r = 0; r < 4; ++r) { const int dist = t - (kbase + 8 * kq + 4 * h + r); const bool vis = dist >= 0 && dist < W; const float fd = (float)dist;
#pragma unroll
                for (int qb = 0; qb < 4; ++qb) Sv[h][qb][r] = vis ? Sv[h][qb][r] * SC2 - sl2[qb] * fd : -INFINITY; }
        bf16x8 Pf[4]; flash_step(S, Sv, Pf);
        flash_pv(S, vT + (size_t)(VROW + g * 64 + c) * MTOK + tb + kbase + 8 * kq, MTOK, Pf);
    }
#pragma unroll
    for (int qb = 0; qb < 4; ++qb) { float sc = flash_inv(S, qb, MODE == 0, sk2[qb]);
        if (MODE == 1) sc *= sigmoidf_(bf2f(qrow[P_GB + (g * 4 + qb) * 3 + 2]));
        float* op = ocat + (tb + t) * DM + OCOL + (g * 4 + qb) * 64 + 4 * kq;
#pragma unroll
        for (int db = 0; db < 4; ++db) *(GAS f32x4*)(op + 16 * db) = S.O[db][qb] * sc; }
}

__device__ __forceinline__ void sb_unit(Frame& F, int b, int hc, int q0) {
    const int lane = F.lane, c = lane & 15, kq = lane >> 4;
    const bf16* proj = (const bf16*)(wsp(F) + WS_PROJ); const bf16* vT = (const bf16*)(wsp(F) + WS_VT); float* ocat = (float*)(wsp(F) + WS_OCAT);
    const size_t tb = (size_t)b * SEQ;
    bf16x8 Qf[4][2];
#pragma unroll
    for (int qb = 0; qb < 4; ++qb)
#pragma unroll
        for (int ds = 0; ds < 2; ++ds) Qf[qb][ds] = ldg8(proj + (tb + q0 + 16 * qb + c) * NPROJ + P_QC + hc * 64 + ds * 32 + kq * 8);
    f32x4 O[4][4]; float carry[4];
#pragma unroll
    for (int qb = 0; qb < 4; ++qb) { carry[qb] = 0.f;
#pragma unroll
        for (int db = 0; db < 4; ++db) O[db][qb] = (f32x4){0.f, 0.f, 0.f, 0.f}; }
    for (int kbase = q0 + 32; kbase >= 0; kbase -= 32) {
        f32x4 Sv[2][4];
#pragma unroll
        for (int h = 0; h < 2; ++h) { const int key = kbase + 8 * (c >> 2) + 4 * h + (c & 3); const bf16* kr = proj + (tb + key) * NPROJ + P_KC + hc * 64 + kq * 8;
            const bf16x8 K0 = ldg8(kr), K1 = ldg8(kr + 32);
#pragma unroll
            for (int qb = 0; qb < 4; ++qb) { f32x4 a = mfma16(K0, Qf[qb][0], (f32x4){0.f, 0.f, 0.f, 0.f}); Sv[h][qb] = mfma16(K1, Qf[qb][1], a); } }
        bf16x8 Pf[4];
#pragma unroll
        for (int qb = 0; qb < 4; ++qb) { const int t = q0 + 16 * qb + c;
            float L[8], ls[8];
#pragma unroll
            for (int h = 0; h < 2; ++h)
#pragma unroll
                for (int r = 0; r < 4; ++r) { const int j = 4 * h + r; const float z = Sv[h][qb][r] * 0.125f; const bool msk = (kbase + 8 * kq + j) >= t;
                    const float sp = fmaxf(z, 0.f) + LN2 * lg2(1.0f + ex2(-fabsf(z) * LOG2E));
                    L[j] = msk ? 0.f : -sp; ls[j] = msk ? -INFINITY : z - sp; }
            float ex_[8]; float run = 0.f;
#pragma unroll
            for (int j = 7; j >= 0; --j) { ex_[j] = run; run += L[j]; }
            const float t1 = __shfl_xor(run, 16), t2 = __shfl_xor(run, 32), t3 = __shfl_xor(run, 48);
            const float X = ((kq ^ 1) > kq ? t1 : 0.f) + ((kq ^ 2) > kq ? t2 : 0.f) + ((kq ^ 3) > kq ? t3 : 0.f);
            const float base = carry[qb] + X;
            float a[8];
#pragma unroll
            for (int j = 0; j < 8; ++j) a[j] = ex2((ls[j] + base + ex_[j]) * LOG2E);
            carry[qb] += (run + t1) + (t2 + t3);
            Pf[qb] = pack8(a[0], a[1], a[2], a[3], a[4], a[5], a[6], a[7]); }
        const bf16* vr = vT + (size_t)(V_C + hc * 64 + c) * MTOK + tb + kbase + 8 * kq;
#pragma unroll
        for (int db = 0; db < 4; ++db) { const bf16x8 Vf = ldg8(vr + (size_t)(16 * db) * MTOK);
#pragma unroll
            for (int qb = 0; qb < 4; ++qb) O[db][qb] = mfma16(Vf, Pf[qb], O[db][qb]); }
        const bool fin = (carry[0] < SB_EXIT) && (carry[1] < SB_EXIT) && (carry[2] < SB_EXIT) && (carry[3] < SB_EXIT);
        if (__all(fin)) break;
    }
#pragma unroll
    for (int qb = 0; qb < 4; ++qb) { float* op = ocat + (tb + q0 + 16 * qb + c) * DM + 1024 + hc * 64 + 4 * kq;
#pragma unroll
        for (int db = 0; db < 4; ++db) *(GAS f32x4*)(op + 16 * db) = O[db][qb]; }
}

__device__ __forceinline__ float gelu_tanh(float x) { const float u = 0.7978845608028654f * (x + 0.044715f * x * x * x); const float e = __expf(2.0f * u); return 0.5f * x * (2.0f - 2.0f / (e + 1.0f)); }
__device__ __forceinline__ void cmp_mlp_unit(Frame& F, int l, int unit) {
    const int lane = F.lane, c = lane & 15, kq = lane >> 4;
    const int nt = unit & 31, g = (unit >> 5) & 1, b = (unit >> 6) & 1, kv = unit >> 7;
    const bf16* proj = (const bf16*)(wsp(F) + WS_PROJ);
    const bf16* W1t = (const bf16*)(wsp(F) + WS_WCMP) + (size_t)kv * 128 * 2048; const bf16* W2t = (const bf16*)(wsp(F) + WS_WCMP + 2 * 128 * 2048 * 2) + (size_t)kv * 64 * 128;
    const float* pe = inp(F, kv ? I_PEV : I_PEK) + (size_t)l * 32 * 64;
    const int n = nt * 16 + c; const size_t tb = (size_t)b * SEQ; const int xoff = (kv ? P_VBC : P_KBC) + g * 64;
    f32x4 H[4][2];
#pragma unroll
    for (int s = 0; s < 4; ++s) { H[s][0] = (f32x4){0.f, 0.f, 0.f, 0.f}; H[s][1] = (f32x4){0.f, 0.f, 0.f, 0.f}; }
    for (int ks = 0; ks < 64; ++ks) {
        const int lt = ks >> 1, d0 = (ks & 1) * 32 + 8 * kq; int tok = 16 * n + lt; if (tok > SEQ - 1) tok = SEQ - 1;
        const bf16x8 xr = ldg8(proj + (tb + tok) * NPROJ + xoff + d0);
        const f32x4 p0 = *(const GAS f32x4*)(pe + lt * 64 + d0), p1 = *(const GAS f32x4*)(pe + lt * 64 + d0 + 4);
        const bf16x8 Xf = pack8(bf2f((unsigned short)xr[0]) + p0[0], bf2f((unsigned short)xr[1]) + p0[1], bf2f((unsigned short)xr[2]) + p0[2], bf2f((unsigned short)xr[3]) + p0[3],
                                bf2f((unsigned short)xr[4]) + p1[0], bf2f((unsigned short)xr[5]) + p1[1], bf2f((unsigned short)xr[6]) + p1[2], bf2f((unsigned short)xr[7]) + p1[3]);
#pragma unroll
        for (int s = 0; s < 4; ++s)
#pragma unroll
            for (int h = 0; h < 2; ++h) { const int hid = 32 * s + 8 * (c >> 2) + 4 * h + (c & 3);
                H[s][h] = mfma16(ldg8(W1t + (size_t)hid * 2048 + ks * 32 + 8 * kq), Xf, H[s][h]); }
    }
    f32x4 Y[4];
#pragma unroll
    for (int eb = 0; eb < 4; ++eb) Y[eb] = (f32x4){0.f, 0.f, 0.f, 0.f};
#pragma unroll
    for (int s = 0; s < 4; ++s) {
        const bf16x8 Hf = pack8(gelu_tanh(H[s][0][0]), gelu_tanh(H[s][0][1]), gelu_tanh(H[s][0][2]), gelu_tanh(H[s][0][3]), gelu_tanh(H[s][1][0]), gelu_tanh(H[s][1][1]), gelu_tanh(H[s][1][2]), gelu_tanh(H[s][1][3]));
#pragma unroll
        for (int eb = 0; eb < 4; ++eb) Y[eb] = mfma16(ldg8(W2t + (size_t)(16 * eb + c) * 128 + 32 * s + 8 * kq), Hf, Y[eb]);
    }
    const bool valid = n <= 510;
    if (kv == 0) { bf16* kc = (bf16*)(wsp(F) + WS_SMALL + SM_KCMP) + ((size_t)(b * 2 + g) * 512 + n) * 64 + 4 * kq;
#pragma unroll
        for (int eb = 0; eb < 4; ++eb) { v2u w; w.x = valid ? pk2(Y[eb][0], Y[eb][1]) : 0u; w.y = valid ? pk2(Y[eb][2], Y[eb][3]) : 0u; *(GAS v2u*)(kc + 16 * eb) = w; } }
    else { bf16* vc = (bf16*)(wsp(F) + WS_SMALL + SM_VCMPT) + (size_t)(b * 2 + g) * 64 * 512 + n;
#pragma unroll
        for (int eb = 0; eb < 4; ++eb)
#pragma unroll
            for (int r = 0; r < 4; ++r) vc[(size_t)(16 * eb + 4 * kq + r) * 512] = valid ? (bf16)f2bf(Y[eb][r]) : (bf16)0; }
}

constexpr int IMP_STRIDE = 132;
constexpr int A2_WAVE_LDS = 16 * IMP_STRIDE * 4 + 512 + 256;
__device__ __forceinline__ void nsa_unit(Frame& F, int b, int g, int q0) {
    const int lane = F.lane, c = lane & 15, kq = lane >> 4;
    const bf16* proj = (const bf16*)(wsp(F) + WS_PROJ); const bf16* vT = (const bf16*)(wsp(F) + WS_VT); float* ocat = (float*)(wsp(F) + WS_OCAT);
    const bf16* kcmp = (const bf16*)(wsp(F) + WS_SMALL + SM_KCMP) + (size_t)(b * 2 + g) * 512 * 64;
    const bf16* vcmpT = (const bf16*)(wsp(F) + WS_SMALL + SM_VCMPT) + (size_t)(b * 2 + g) * 64 * 512;
    LAS float* imp = (LAS float*)(F.lds + F.wave * A2_WAVE_LDS);
    LAS float* scv = imp + 16 * IMP_STRIDE;
    LAS unsigned* selm = (LAS unsigned*)(scv + 128);
    const size_t tb = (size_t)b * SEQ; const int t = q0 + c;
    const bf16* qrow = proj + (tb + t) * NPROJ;
    bf16x8 Qf[4][2];
#pragma unroll
    for (int qb = 0; qb < 4; ++qb)
#pragma unroll
        for (int ds = 0; ds < 2; ++ds) Qf[qb][ds] = ldg8(qrow + P_QB + (g * 4 + qb) * 64 + ds * 32 + kq * 8);
    float sl2[4];
#pragma unroll
    for (int qb = 0; qb < 4; ++qb) sl2[qb] = slope2_of(8 + g * 4 + qb);
    for (int i = lane; i < 16 * IMP_STRIDE; i += 64) imp[i] = 0.f;
    const int tmax = q0 + 15; const int nmax = tmax >= 31 ? ((tmax - 31) >> 4) : -1;
    Flash S; flash_init(S, -1.0e30f, -1.0e30f, -1.0e30f, -1.0e30f);
    for (int nbase = 0; nbase <= nmax; nbase += 32) {
        f32x4 Sv[2][4];
#pragma unroll
        for (int h = 0; h < 2; ++h) { const int nn = nbase + 8 * (c >> 2) + 4 * h + (c & 3); const bf16* kr = kcmp + (size_t)nn * 64 + kq * 8;
            const bf16x8 K0 = ldg8(kr), K1 = ldg8(kr + 32);
#pragma unroll
            for (int qb = 0; qb < 4; ++qb) { f32x4 a = mfma16(K0, Qf[qb][0], (f32x4){0.f, 0.f, 0.f, 0.f}); Sv[h][qb] = mfma16(K1, Qf[qb][1], a); } }
#pragma unroll
        for (int h = 0; h < 2; ++h)
#pragma unroll
            for (int r = 0; r < 4; ++r) { const int dist = t - 16 * (nbase + 8 * kq + 4 * h + r) - 31; const bool vis = dist >= 0; const float fd = (float)dist;
#pragma unroll
                for (int qb = 0; qb < 4; ++qb) Sv[h][qb][r] = vis ? Sv[h][qb][r] * SC2 - sl2[qb] * fd : -INFINITY; }
        bf16x8 Pf[4]; flash_step(S, Sv, Pf);
        flash_pv(S, vcmpT + (size_t)c * 512 + nbase + 8 * kq, 512, Pf);
    }
    float inv[4];
#pragma unroll
    for (int qb = 0; qb < 4; ++qb) { inv[qb] = flash_inv(S, qb, false, 0.f);
        const float sc = inv[qb] * sigmoidf_(bf2f(qrow[P_GB + (g * 4 + qb) * 3 + 0]));
        float* op = ocat + (tb + t) * DM + 512 + (g * 4 + qb) * 64 + 4 * kq;
#pragma unroll
        for (int db = 0; db < 4; ++db) { const f32x4 old = *(const GAS f32x4*)(op + 16 * db); *(GAS f32x4*)(op + 16 * db) = old + S.O[db][qb] * sc; } }
    LDS_WAIT();
    for (int nbase = 0; nbase <= nmax; nbase += 32) {
        f32x4 Sv[2][4];
#pragma unroll
        for (int h = 0; h < 2; ++h) { const int nn = nbase + 8 * (c >> 2) + 4 * h + (c & 3); const bf16* kr = kcmp + (size_t)nn * 64 + kq * 8;
            const bf16x8 K0 = ldg8(kr), K1 = ldg8(kr + 32);
#pragma unroll
            for (int qb = 0; qb < 4; ++qb) { f32x4 a = mfma16(K0, Qf[qb][0], (f32x4){0.f, 0.f, 0.f, 0.f}); Sv[h][qb] = mfma16(K1, Qf[qb][1], a); } }
        float G[2], Wl[2];
#pragma unroll
        for (int h = 0; h < 2; ++h) { float gs = 0.f, last = 0.f;
#pragma unroll
            for (int r = 0; r < 4; ++r) { const int dist = t - 16 * (nbase + 8 * kq + 4 * h + r) - 31; const bool vis = dist >= 0; const float fd = (float)dist; float pv = 0.f;
#pragma unroll
                for (int qb = 0; qb < 4; ++qb) pv += vis ? ex2(Sv[h][qb][r] * SC2 - sl2[qb] * fd - S.m[qb]) * inv[qb] : 0.f;
                gs += pv; last = pv; }
            G[h] = gs; Wl[h] = last; }
        const int j0 = (nbase >> 2) + 2 * kq;
        LAS float* ip = imp + c * IMP_STRIDE + j0;
        ip[0] += G[0]; LDS_WAIT();
        ip[1] += G[1]; LDS_WAIT();
        ip[1] += Wl[0]; LDS_WAIT();
        ip[2] += Wl[1]; LDS_WAIT();
    }
    unsigned long long ulo = 0ull, uhi = 0ull;
    for (int cq = 0; cq < 16; ++cq) {
        const int tq = q0 + cq, cur = tq >> 6;
        const int ja = lane, jb = lane + 64;
        float va = -1.0f, vb = -1.0f;
        if (ja <= cur) va = (ja == 0 || ja == cur || ja == cur - 1) ? 1.0e4f : imp[cq * IMP_STRIDE + ja];
        if (jb <= cur) vb = (jb == cur || jb == cur - 1) ? 1.0e4f : imp[cq * IMP_STRIDE + jb];
        scv[ja] = va; scv[jb] = vb; LDS_WAIT();
        int ra = 0, rb = 0;
        for (int jj = 0; jj <= cur; ++jj) { const float vj = scv[jj];
            ra += (vj > va || (vj == va && jj < ja)) ? 1 : 0; rb += (vj > vb || (vj == vb && jj < jb)) ? 1 : 0; }
        const unsigned long long mlo = __ballot(ja <= cur && ra < 16), mhi = __ballot(jb <= cur && rb < 16);
        ulo |= mlo; uhi |= mhi;
        if (lane == 0) { selm[cq * 4 + 0] = (unsigned)mlo; selm[cq * 4 + 1] = (unsigned)(mlo >> 32); selm[cq * 4 + 2] = (unsigned)mhi; selm[cq * 4 + 3] = (unsigned)(mhi >> 32); }
        LDS_WAIT();
    }
    const unsigned long long mylo = (unsigned long long)selm[c * 4 + 0] | ((unsigned long long)selm[c * 4 + 1] << 32);
    const unsigned long long myhi = (unsigned long long)selm[c * 4 + 2] | ((unsigned long long)selm[c * 4 + 3] << 32);
    flash_init(S, -1.0e30f, -1.0e30f, -1.0e30f, -1.0e30f);
    for (int j = tmax >> 6; j >= 0; --j) {
        const bool in_u = j < 64 ? ((ulo >> j) & 1ull) != 0ull : ((uhi >> (j - 64)) & 1ull) != 0ull;
        if (!in_u) continue;
        const bool mine = j < 64 ? ((mylo >> j) & 1ull) != 0ull : ((myhi >> (j - 64)) & 1ull) != 0ull;
#pragma unroll 1
        for (int hs = 0; hs < 2; ++hs) { const int kbase = 64 * j + 32 * hs;
            f32x4 Sv[2][4];
#pragma unroll
            for (int h = 0; h < 2; ++h) { const int key = kbase + 8 * (c >> 2) + 4 * h + (c & 3); const bf16* kr = proj + (tb + key) * NPROJ + P_KBS + g * 64 + kq * 8;
                const bf16x8 K0 = ldg8(kr), K1 = ldg8(kr + 32);
#pragma unroll
                for (int qb = 0; qb < 4; ++qb) { f32x4 a = mfma16(K0, Qf[qb][0], (f32x4){0.f, 0.f, 0.f, 0.f}); Sv[h][qb] = mfma16(K1, Qf[qb][1], a); } }
#pragma unroll
            for (int h = 0; h < 2; ++h)
#pragma unroll
                for (int r = 0; r < 4; ++r) { const int dist = t - (kbase + 8 * kq + 4 * h + r); const bool vis = mine && dist >= 0; const float fd = (float)dist;
#pragma unroll
                    for (int qb = 0; qb < 4; ++qb) Sv[h][qb][r] = vis ? Sv[h][qb][r] * SC2 - sl2[qb] * fd : -INFINITY; }
            bf16x8 Pf[4]; flash_step(S, Sv, Pf);
            flash_pv(S, vT + (size_t)(V_BS + g * 64 + c) * MTOK + tb + kbase + 8 * kq, MTOK, Pf); }
    }
#pragma unroll
    for (int qb = 0; qb < 4; ++qb) { const float sc = flash_inv(S, qb, false, 0.f) * sigmoidf_(bf2f(qrow[P_GB + (g * 4 + qb) * 3 + 1]));
        float* op = ocat + (tb + t) * DM + 512 + (g * 4 + qb) * 64 + 4 * kq;
#pragma unroll
        for (int db = 0; db < 4; ++db) { const f32x4 old = *(const GAS f32x4*)(op + 16 * db); *(GAS f32x4*)(op + 16 * db) = old + S.O[db][qb] * sc; } }
    LDS_WAIT();
}

__device__ __forceinline__ void attn1_phase(Frame& F, int l) {
    const int gw = F.vcu * NWAVES + F.wave, NGW = F.G * NWAVES;
    if (F.wave == 0) for (int u = F.vcu; u < 256; u += F.G) cmp_mlp_unit(F, l, u);
    for (int u = gw; u < 2048; u += NGW) win_unit<512, 1>(F, l, u >> 10, (u >> 9) & 1, (u & 511) * 16);
    for (int u = gw; u < 4096; u += NGW) sb_unit(F, u >> 11, (u >> 7) & 15, (u & 127) * 64);
    for (int u = gw; u < 2048; u += NGW) win_unit<128, 0>(F, l, u >> 10, (u >> 9) & 1, (u & 511) * 16);
}
__device__ __forceinline__ void attn2_phase(Frame& F) {
    const int gw = F.vcu * NWAVES + F.wave, NGW = F.G * NWAVES;
    for (int u = gw; u < 2048; u += NGW) nsa_unit(F, u >> 10, (u >> 9) & 1, (u & 511) * 16);
}
#ifndef MK_ONE_LAUNCH
#define MK_ONE_LAUNCH 1
#endif
#ifndef PHASE_MASK
#define PHASE_MASK 0xFFFF
#endif
constexpr int N_PHASES = 2 + 10 * DEPTH;
struct Args { const float* in[25]; float* out; unsigned char* ws; };
#define IN(k) (LO <= (k) && (k) < HI)
#define SEAM(k) do { if constexpr (IN(k) && IN((k) + 1)) xcd_barrier(bar); asm volatile("" : "+v"(F.tid), "+v"(F.lane) :: "memory"); } while (0)
template <int L, int LO, int HI>
__device__ __forceinline__ void layer_phases(Frame& F, const XcdBarrier& bar) {
    constexpr int l = L, pb = 2 + 10 * L;
    if constexpr (IN(pb + 0) && (PHASE_MASK & 4)) {
        pg8::Gemm g{(const pg8::bf16_t*)(wsp(F) + WS_HB), (const pg8::bf16_t*)(wsp(F) + WS_WIN), MTOK, NIN, DM}; pg8::StaticOrder S; S.init(MTOK, NIN, F.G, (int)blockIdx.x);
        pg8::EpiProj E{(pg8::bf16_t*)(wsp(F) + WS_PROJ), (pg8::bf16_t*)(wsp(F) + WS_VT), NPROJ, NT_ROW, MTOK};
        pg8::gemm_phase<pg8::EpiProj, pg8::StaticOrder, true, true>(F.lds + RING_OFF, g, S, E);
    }
    SEAM(pb + 0);
    if constexpr (IN(pb + 1) && (PHASE_MASK & 8)) attn1_phase(F, l);
    SEAM(pb + 1);
    if constexpr (IN(pb + 2) && (PHASE_MASK & 16)) attn2_phase(F);
    SEAM(pb + 2);
    if constexpr (IN(pb + 3) && (PHASE_MASK & 32)) merge_phase(F, l);
    SEAM(pb + 3);
    if constexpr (IN(pb + 4) && (PHASE_MASK & 64)) {
        const float* xin = (l == 0) ? inp(F, I_X) : (const float*)(wsp(F) + WS_XB);
        pg8::Gemm g{(const pg8::bf16_t*)(wsp(F) + WS_HB), (const pg8::bf16_t*)(wsp(F) + WS_WOUT), MTOK, DM, DM}; pg8::StaticOrder S; S.init(MTOK, DM, F.G, (int)blockIdx.x);
        pg8::EpiResid E{xin, (float*)(wsp(F) + WS_XA), (const float*)(wsp(F) + WS_MOD) + (size_t)l * NB * 6 * DM + 2 * DM, 6 * DM, SEQ, DM, ALPHA};
        pg8::gemm_phase<pg8::EpiResid, pg8::StaticOrder, true, true>(F.lds + RING_OFF, g, S, E);
    }
    SEAM(pb + 4);
    if constexpr (IN(pb + 5) && (PHASE_MASK & 128)) post_mixer_phase(F, l);
    SEAM(pb + 5);
    if constexpr (IN(pb + 6) && (PHASE_MASK & 256)) gather_phase(F, l);
    SEAM(pb + 6);
    if constexpr (IN(pb + 7) && (PHASE_MASK & 512)) {
        const int* gt = (const int*)(wsp(F) + WS_SMALL + SM_TILE);
        pg8::Gemm g{(const pg8::bf16_t*)(wsp(F) + WS_XS), (const pg8::bf16_t*)(wsp(F) + WS_WGU), MAXROWS, NEXP * 1024, DM};
        pg8::MoeOrder S{gt[200], 4, F.G, (int)blockIdx.x, gt};
        pg8::EpiSwiGLU E{(pg8::bf16_t*)(wsp(F) + WS_HID), DEXP};
        pg8::gemm_phase<pg8::EpiSwiGLU, pg8::MoeOrder, true, true>(F.lds + RING_OFF, g, S, E);
    }
    SEAM(pb + 7);
    if constexpr (IN(pb + 8) && (PHASE_MASK & 1024)) {
        const int* gt = (const int*)(wsp(F) + WS_SMALL + SM_TILE);
        pg8::Gemm g{(const pg8::bf16_t*)(wsp(F) + WS_HID), (const pg8::bf16_t*)(wsp(F) + WS_WD), MAXROWS, NEXP * DM, DEXP};
        pg8::MoeOrder S{gt[200], 8, F.G, (int)blockIdx.x, gt};
        pg8::EpiDown E{(pg8::bf16_t*)(wsp(F) + WS_YS), DM, (const int*)(wsp(F) + WS_SMALL + SM_ROWINFO), (const float*)(wsp(F) + WS_SMALL + SM_GATEW)};
        pg8::gemm_phase<pg8::EpiDown, pg8::MoeOrder, true, true>(F.lds + RING_OFF, g, S, E);
    }
    SEAM(pb + 8);
    if constexpr (IN(pb + 9) && (PHASE_MASK & 2048)) {
        post_moe_phase(F, l, (l == DEPTH - 1) ? outp(F) : (float*)(wsp(F) + WS_XB), l < DEPTH - 1);
        if (l < DEPTH - 1) convert_layer(F, l + 1);
    }
    SEAM(pb + 9);
}
template <int LO, int HI>
__global__ void __launch_bounds__(NWAVES * 64, 2) fwd_kernel(Args args) {
    extern __shared__ __attribute__((aligned(16))) unsigned char lds[];
    Frame F;
    F.lds = (LAS unsigned char*)lds;
    F.MISC = (volatile LAS unsigned*)(F.lds + MISC_OFF);
    F.tid = threadIdx.x; F.lane = F.tid & 63; F.wave = __builtin_amdgcn_readfirstlane(F.tid >> 6);
    F.G = gridDim.x; { const int bx = blockIdx.x; F.vcu = (F.G % 8 == 0) ? (bx % 8) * (F.G / 8) + bx / 8 : bx; }
    for (int u = F.tid; u < (LDS_BYTES - LDSCTL_OFF) / 4; u += NWAVES * 64) ((LAS unsigned*)(F.lds + LDSCTL_OFF))[u] = 0u;
    __syncthreads();
    if (F.tid < 25) ((LAS unsigned long long*)(F.lds + PTR_OFF))[F.tid] = (unsigned long long)args.in[F.tid];
    if (F.tid == 25) ((LAS unsigned long long*)(F.lds + PTR_OFF))[25] = (unsigned long long)args.ws;
    if (F.tid == 26) ((LAS unsigned long long*)(F.lds + PTR_OFF))[26] = (unsigned long long)args.out;
    __syncthreads();
    XcdBarrier bar; bar.bar = (unsigned*)(ctlp(F) + CW_BAR); bar.x = 0; bar.st = nullptr;
    if constexpr (HI - LO > 1) bar = xcd_barrier_post((unsigned*)(ctlp(F) + CW_BAR), F.MISC + 8);
    if constexpr (IN(0) && (PHASE_MASK & 1)) { ada_phase(F); convert_layer(F, 0); }
    SEAM(0);
    if constexpr (IN(1) && (PHASE_MASK & 2)) ln_in_phase(F);
    SEAM(1);
    layer_phases<0, LO, HI>(F, bar);
    layer_phases<1, LO, HI>(F, bar);
}
#undef IN
#undef SEAM

#if MK_ONE_LAUNCH
#define FWD_MAIN (fwd_kernel<0, N_PHASES>)
static bool set_lds_attr() { return hipFuncSetAttribute((const void*)FWD_MAIN, hipFuncAttributeMaxDynamicSharedMemorySize, LDS_BYTES) == hipSuccess; }
#else
#define FWD_MAIN (fwd_kernel<0, 1>)
template <int... P> static bool set_lds_attr_seq(std::integer_sequence<int, P...>) { bool ok = true; ((ok = ok && hipFuncSetAttribute((const void*)(fwd_kernel<P, P + 1>), hipFuncAttributeMaxDynamicSharedMemorySize, LDS_BYTES) == hipSuccess), ...); return ok; }
static bool set_lds_attr() { return set_lds_attr_seq(std::make_integer_sequence<int, N_PHASES>{}); }
template <int P> static void launch_one(int grid, hipStream_t stream, const Args& a) { hipLaunchKernelGGL((fwd_kernel<P, P + 1>), dim3(grid), dim3(NWAVES * 64), LDS_BYTES, stream, a); }
template <int... P> static void launch_phases(std::integer_sequence<int, P...>, int grid, hipStream_t stream, const Args& a) { (launch_one<P>(grid, stream, a), ...); }
#endif
extern "C" void kernel_launch(void* const* d_in, const int* in_sizes, int n_in, void* d_out, int out_size, void* d_ws, size_t ws_size, hipStream_t stream) {
    static int grid = 0;
    if (grid == 0) {
        if (n_in != 25 || out_size != MTOK * DM || ws_size < WS_END) { fprintf(stderr, "kernel_launch: unexpected problem shape (n_in %d, out %d, ws %zu)\n", n_in, out_size, ws_size); grid = -1; return; }
        int dev = 0, cus = 0, per_cu = 0;
        if (hipGetDevice(&dev) != hipSuccess || hipDeviceGetAttribute(&cus, hipDeviceAttributeMultiprocessorCount, dev) != hipSuccess) { grid = -1; return; }
        if (!set_lds_attr()) { fprintf(stderr, "kernel_launch: hipFuncSetAttribute failed\n"); grid = -1; return; }
        if (hipOccupancyMaxActiveBlocksPerMultiprocessor(&per_cu, (const void*)FWD_MAIN, NWAVES * 64, LDS_BYTES) != hipSuccess || per_cu < 1)
            fprintf(stderr, "kernel_launch: note: occupancy query reports %d workgroups per CU\n", per_cu);
        (void)hipGetLastError();
        grid = cus;
        if (grid > 256) grid = 256;
        grid &= ~7;
    }
    if (grid <= 0) return;
    (void)in_sizes;
    if (hipMemsetAsync((char*)d_ws + WS_CTL, 0, CTL_ZERO_BYTES, stream) != hipSuccess) return;
    Args a{};
    for (int i = 0; i < 25; ++i) a.in[i] = (const float*)d_in[i];
    a.out = (float*)d_out; a.ws = (unsigned char*)d_ws;
#if MK_ONE_LAUNCH
    hipLaunchKernelGGL((fwd_kernel<0, N_PHASES>), dim3(grid), dim3(NWAVES * 64), LDS_BYTES, stream, a);
#else
    launch_phases(std::make_integer_sequence<int, N_PHASES>{}, grid, stream, a);
#endif
}
```

```cpp
#include <hip/hip_runtime.h>
#include <cstdio>
#include <cstdint>
#include <utility>
#define MK_ONE_LAUNCH 1
namespace pg8 {
#define PG8_LAS __attribute__((address_space(3)))
typedef unsigned short bf16_t;
typedef short bf16x8 __attribute__((ext_vector_type(8)));
typedef float f32x4 __attribute__((ext_vector_type(4)));
typedef unsigned u32x4 __attribute__((ext_vector_type(4)));
constexpr int BM = 256, BK = 64, HALF = 128, HTB = HALF * BK * 2  , STAGE_BYTES = 8 * HTB, NXCD = 8, WGM = 8;

__host__ __device__ __forceinline__ int lds_byte(int r, int c) { const int st = (r >> 4) * 2 + (c >> 5), rr = r & 15, cc = c & 31, ob = rr * 64 + cc * 2; return st * 1024 + (ob ^ (((ob >> 9) & 1) << 5)); }
__host__ __device__ __forceinline__ void stage_rc(int b, int& R, int& C) { const int st = b / 1024, sb = b % 1024, swz = sb ^ (((sb >> 9) & 1) << 5); R = (st >> 1) * 16 + swz / 64; C = (st & 1) * 32 + (swz % 64) / 2; }
__host__ __device__ __forceinline__ int perm32(int rho) { const int n = rho >> 4, i = rho & 15; return 8 * (i >> 2) + 4 * n + (i & 3); }

struct Unit { int pm, pn; };
struct Gemm { const bf16_t* A; const bf16_t* Bt; int M, N, K; };

struct StaticOrder {
    int nM, nN, nwg, G, c;
    __host__ __device__ void init(int M, int N, int G_, int c_) { nM = M / BM; nN = N / BM; nwg = nM * nN; G = G_; c = c_; }
    __host__ __device__ bool next(int i, Unit& u) const {
        const long L = (long)i * G + c; if (L >= nwg) return false;
        int wgid = (int)L; { const int q = nwg / NXCD, r = nwg % NXCD, xcd = wgid % NXCD, off = wgid / NXCD; wgid = (xcd < r ? xcd * (q + 1) : r * (q + 1) + (xcd - r) * q) + off; }
        const int nig = WGM * nN, gid = wgid / nig, fm = gid * WGM, gsz = (nM - fm) < WGM ? (nM - fm) : WGM;
        u.pm = fm + ((wgid % nig) % gsz); u.pn = (wgid % nig) / gsz; return true;
    }
    __device__ __forceinline__ void a_ready(const Unit&) const {}
    __device__ __forceinline__ void done(const Unit&) const {}
};
__device__ __forceinline__ unsigned cvt_pk_bf16(float lo, float hi) { unsigned r; asm volatile("v_cvt_pk_bf16_f32 %0, %1, %2" : "=v"(r) : "v"(lo), "v"(hi)); return r; }
typedef float f32x2 __attribute__((ext_vector_type(2)));
__device__ __forceinline__ unsigned short f2bf_rne(float f) { unsigned u = __builtin_bit_cast(unsigned, f); return (unsigned short)((u + 0x7fffu + ((u >> 16) & 1u)) >> 16); }

struct EpiProj {
    static constexpr bool PERM = true, AFTER_DRAIN = false;
    bf16_t* P; bf16_t* VT; int ldp; int nt_row; int ldvt;
    __device__ __forceinline__ void operator()(const f32x4 (&acc)[2][2][4][2], const Unit& u, int wr, int wc, int fr, int fq) const {
        const int row0 = u.pm * BM + wr * 64 + fr;
        if (u.pn < nt_row) {
            const int col0 = u.pn * BM + wc * 32 + 8 * fq;
#pragma unroll
            for (int ai = 0; ai < 2; ++ai)
#pragma unroll
                for (int m = 0; m < 4; ++m) { bf16_t* rowp = P + (size_t)(row0 + ai * HALF + m * 16) * ldp + col0;
#pragma unroll
                    for (int bj = 0; bj < 2; ++bj) { const f32x4 v0 = acc[ai][bj][m][0], v1 = acc[ai][bj][m][1];
                        u32x4 w; w.x = cvt_pk_bf16(v0[0], v0[1]); w.y = cvt_pk_bf16(v0[2], v0[3]); w.z = cvt_pk_bf16(v1[0], v1[1]); w.w = cvt_pk_bf16(v1[2], v1[3]);
                        *(u32x4*)(rowp + bj * HALF) = w; } }
        } else {
            const int c0 = (u.pn - nt_row) * BM + wc * 32 + 8 * fq;
#pragma unroll
            for (int bj = 0; bj < 2; ++bj)
#pragma unroll
                for (int n = 0; n < 2; ++n)
#pragma unroll
                    for (int e = 0; e < 4; ++e) { bf16_t* cp = VT + (size_t)(c0 + bj * HALF + n * 4 + e) * ldvt + row0;
#pragma unroll
                        for (int ai = 0; ai < 2; ++ai)
#pragma unroll
                            for (int m = 0; m < 4; ++m) cp[ai * HALF + m * 16] = f2bf_rne(acc[ai][bj][m][n][e]); }
        }
    }
};

struct EpiResid {
    static constexpr bool PERM = false, AFTER_DRAIN = false;
    const float* xin; float* out; const float* gate0; int gate_bstride; int rows_per_batch; int ldc; float alpha;
    __device__ __forceinline__ void operator()(const f32x4 (&acc)[2][2][4][2], const Unit& u, int wr, int wc, int fr, int fq) const {
        const int col0 = u.pn * BM + wc * 32 + 4 * fq;
        const float* gv = gate0 + (size_t)((u.pm * BM) / rows_per_batch) * gate_bstride;
#pragma unroll
        for (int bj = 0; bj < 2; ++bj)
#pragma unroll
            for (int n = 0; n < 2; ++n) { const int c = col0 + bj * HALF + n * 16; const f32x4 g1 = *(const f32x4*)(gv + c) + 1.0f;
#pragma unroll
                for (int ai = 0; ai < 2; ++ai)
#pragma unroll
                    for (int m = 0; m < 4; ++m) { const size_t off = (size_t)(u.pm * BM + ai * HALF + wr * 64 + m * 16 + fr) * ldc + c;
                        const f32x4 xv = *(const f32x4*)(xin + off); *(f32x4*)(out + off) = xv * alpha + g1 * acc[ai][bj][m][n]; } }
    }
};

struct EpiSwiGLU {
    static constexpr bool PERM = true, AFTER_DRAIN = false;
    bf16_t* H; int ldh;
    __device__ __forceinline__ void operator()(const f32x4 (&acc)[2][2][4][2], const Unit& u, int wr, int wc, int fr, int fq) const {
        const int row0 = u.pm * BM + wr * 64 + fr, pnl = u.pn & 3;
        const int j0 = pnl * 128 + wc * 16 + 4 * fq;
#pragma unroll
        for (int ai = 0; ai < 2; ++ai)
#pragma unroll
            for (int m = 0; m < 4; ++m) { bf16_t* rowp = H + (size_t)(row0 + ai * HALF + m * 16) * ldh + j0;
#pragma unroll
                for (int bj = 0; bj < 2; ++bj) { const f32x4 v0 = acc[ai][bj][m][0], v1 = acc[ai][bj][m][1];
                    const float h0 = v0[0] / (1.0f + __expf(-v0[0])) * v0[1], h1 = v0[2] / (1.0f + __expf(-v0[2])) * v0[3];
                    const float h2 = v1[0] / (1.0f + __expf(-v1[0])) * v1[1], h3 = v1[2] / (1.0f + __expf(-v1[2])) * v1[3];
                    typedef unsigned u32x2 __attribute__((ext_vector_type(2)));
                    u32x2 w; w.x = cvt_pk_bf16(h0, h1); w.y = cvt_pk_bf16(h2, h3);
                    *(u32x2*)(rowp + bj * 64) = w; } }
    }
};

struct EpiDown {
    static constexpr bool PERM = true, AFTER_DRAIN = false;
    bf16_t* Y; int ldy; const int* rowinfo; const float* gatew;
    __device__ __forceinline__ void operator()(const f32x4 (&acc)[2][2][4][2], const Unit& u, int wr, int wc, int fr, int fq) const {
        const int row0 = u.pm * BM + wr * 64 + fr, pnl = u.pn & 7;
        const int col0 = pnl * BM + wc * 32 + 8 * fq;
#pragma unroll
        for (int ai = 0; ai < 2; ++ai)
#pragma unroll
            for (int m = 0; m < 4; ++m) { const int aid = rowinfo[row0 + ai * HALF + m * 16];
                if (aid >= 0) { const float gw = gatew[aid]; bf16_t* rowp = Y + (size_t)aid * ldy + col0;
#pragma unroll
                    for (int bj = 0; bj < 2; ++bj) { const f32x4 v0 = acc[ai][bj][m][0] * gw, v1 = acc[ai][bj][m][1] * gw;
                        u32x4 w; w.x = cvt_pk_bf16(v0[0], v0[1]); w.y = cvt_pk_bf16(v0[2], v0[3]); w.z = cvt_pk_bf16(v1[0], v1[1]); w.w = cvt_pk_bf16(v1[2], v1[3]);
                        *(u32x4*)(rowp + bj * HALF) = w; } } }
    }
};

struct MoeOrder {
    int ntiles, NT, G, c; const int* tile_e;
    __device__ __forceinline__ bool next(int i, Unit& u) const {
        const int x = c & 7, ci = c >> 3, per = G >> 3;
        const int q = i * per + ci, rt = x + 8 * (q / NT);
        if (rt >= ntiles) return false;
        u.pm = rt; u.pn = tile_e[rt] * NT + (q % NT); return true;
    }
    __device__ __forceinline__ void a_ready(const Unit&) const {}
    __device__ __forceinline__ void done(const Unit&) const {}
};
template <class Epi, class Sched, bool ALIGN_EPI = false, bool SP2 = false>
__device__ __forceinline__ void gemm_phase(PG8_LAS unsigned char* lds, const Gemm g, const Sched& S, const Epi& E) {
    int tid_ = threadIdx.x; asm volatile("" : "+v"(tid_));
    const int tid = tid_, wid = __builtin_amdgcn_readfirstlane(tid >> 6), lane = tid & 63, wr = wid >> 2, wc = wid & 3, fr = lane & 15, fq = lane >> 4;
    const int K = g.K, nt = K / BK;
    unsigned voffA[2], voffB[2];
#pragma unroll
    for (int i = 0; i < 2; ++i) { int R, C; stage_rc(tid * 16 + i * 8192, R, C); const int Rb = Epi::PERM ? ((R & ~31) + perm32(R & 31)) : R;
        voffA[i] = (unsigned)(R * K + C) * 2u; voffB[i] = (unsigned)(Rb * K + C) * 2u; }
    const size_t kstep = (size_t)(BK * 2);
    const size_t hstep = (size_t)HALF * K * 2;
    const size_t tstep = 2 * hstep;
    const unsigned ldsw = (unsigned)wid * 1024u;
    const int aoff = lds_byte(wr * 64 + fr, fq * 8), boff = lds_byte(wc * 32 + fr, fq * 8);
#define PG8_SA(b, h) (((b) * 2 + (h)) * HTB)
#define PG8_SB(b, h) ((4 + (b) * 2 + (h)) * HTB)
#define PG8_STAGE(bufoff, gbase, voff) do { _Pragma("unroll") for (int _i = 0; _i < 2; ++_i) \
        __builtin_amdgcn_global_load_lds((const unsigned*)((const char*)(gbase) + (voff)[_i]), (PG8_LAS unsigned*)(lds + (bufoff) + ldsw + _i * 8192), 16, 0, 0); } while (0)
#define PG8_LDA(dst, b, h) do { _Pragma("unroll") for (int m = 0; m < 4; ++m) _Pragma("unroll") for (int k = 0; k < 2; ++k) dst[m][k] = *(const PG8_LAS bf16x8*)(lds + PG8_SA(b, h) + aoff + m * 2048 + k * 1024); } while (0)
#define PG8_LDB(dst, b, h) do { _Pragma("unroll") for (int n = 0; n < 2; ++n) _Pragma("unroll") for (int k = 0; k < 2; ++k) dst[n][k] = *(const PG8_LAS bf16x8*)(lds + PG8_SB(b, h) + boff + n * 2048 + k * 1024); } while (0)
#define PG8_MMA(ai, bj, At, Bt) do { __builtin_amdgcn_s_setprio(1); _Pragma("unroll") for (int m = 0; m < 4; ++m) _Pragma("unroll") for (int n = 0; n < 2; ++n) _Pragma("unroll") for (int k = 0; k < 2; ++k) \
        acc[ai][bj][m][n] = __builtin_amdgcn_mfma_f32_16x16x32_bf16(Bt[n][k], At[m][k], acc[ai][bj][m][n], 0, 0, 0); __builtin_amdgcn_s_setprio(0); } while (0)
#define PG8_WAIT_V(n) asm volatile("s_waitcnt vmcnt(" #n ")" ::: "memory")
#define PG8_WAIT_L(n) asm volatile("s_waitcnt lgkmcnt(" #n ")" ::: "memory")
#define PG8_BAR __builtin_amdgcn_s_barrier()
#define PG8_SCHED __builtin_amdgcn_sched_barrier(0)
    Unit cur, nxt; int ui = 0;
    if (!S.next(0, cur)) return;
    f32x4 acc[2][2][4][2];
#pragma unroll
    for (int a = 0; a < 2; ++a)
#pragma unroll
        for (int b = 0; b < 2; ++b)
#pragma unroll
            for (int m = 0; m < 4; ++m)
#pragma unroll
                for (int n = 0; n < 2; ++n) acc[a][b][m][n] = (f32x4){0.f, 0.f, 0.f, 0.f};
    bf16x8 At[4][2], B0[2][2], B1[2][2];
    const char* cA = (const char*)g.A + (size_t)cur.pm * tstep; const char* cB = (const char*)g.Bt + (size_t)cur.pn * tstep;
    S.a_ready(cur);
    if constexpr (SP2) {
        PG8_STAGE(PG8_SB(0, 0), cB, voffB); PG8_STAGE(PG8_SB(0, 1), cB + hstep, voffB); PG8_STAGE(PG8_SA(0, 0), cA, voffA); PG8_STAGE(PG8_SA(0, 1), cA + hstep, voffA);
        if (wr == 1) PG8_BAR;
        PG8_WAIT_V(2); PG8_BAR;
        PG8_STAGE(PG8_SB(1, 0), cB + kstep, voffB); PG8_STAGE(PG8_SA(1, 0), cA + kstep, voffA); PG8_STAGE(PG8_SB(1, 1), cB + hstep + kstep, voffB);
        PG8_WAIT_V(6); PG8_BAR;
    } else {
        PG8_STAGE(PG8_SB(0, 0), cB, voffB); PG8_STAGE(PG8_SA(0, 0), cA, voffA); PG8_STAGE(PG8_SB(0, 1), cB + hstep, voffB); PG8_STAGE(PG8_SA(0, 1), cA + hstep, voffA);
        if (wr == 1) PG8_BAR;
        PG8_WAIT_V(4); PG8_BAR;
        PG8_STAGE(PG8_SB(1, 0), cB + kstep, voffB); PG8_STAGE(PG8_SA(1, 0), cA + kstep, voffA); PG8_STAGE(PG8_SB(1, 1), cB + hstep + kstep, voffB);
        PG8_WAIT_V(6); PG8_BAR;
    }
    for (;;) {
        const bool has_next = S.next(ui + 1, nxt);
        const char* nA = has_next ? (const char*)g.A + (size_t)nxt.pm * tstep : cA; const char* nB = has_next ? (const char*)g.Bt + (size_t)nxt.pn * tstep : cB;
        for (int t = 0; t < nt; t += 2) {
            const bool last = (t == nt - 2);
            const char* a1 = cA + (size_t)(t + 1) * kstep;
            const char* a2 = last ? nA : cA + (size_t)(t + 2) * kstep; const char* b2 = last ? nB : cB + (size_t)(t + 2) * kstep;
            const char* a3 = a2 + kstep; const char* b3 = b2 + kstep;
            if (last && has_next) S.a_ready(nxt);
            if constexpr (SP2) {
            PG8_LDB(B0, 0, 0); PG8_LDB(B1, 0, 1); PG8_SCHED; PG8_LDA(At, 0, 0); PG8_STAGE(PG8_SA(1, 1), a1 + hstep, voffA);
            PG8_WAIT_V(8); PG8_WAIT_L(0); PG8_BAR; PG8_MMA(0, 0, At, B0); PG8_MMA(0, 1, At, B1); PG8_BAR; PG8_SCHED;
            PG8_LDA(At, 0, 1); PG8_STAGE(PG8_SB(0, 0), b2, voffB); PG8_STAGE(PG8_SB(0, 1), b2 + hstep, voffB); PG8_STAGE(PG8_SA(0, 0), a2, voffA);
            PG8_WAIT_V(8); PG8_WAIT_L(0); PG8_BAR; PG8_MMA(1, 0, At, B0); PG8_MMA(1, 1, At, B1); PG8_BAR; PG8_SCHED;
            PG8_LDB(B0, 1, 0); PG8_LDB(B1, 1, 1); PG8_SCHED; PG8_LDA(At, 1, 0); PG8_STAGE(PG8_SA(0, 1), a2 + hstep, voffA);
            PG8_WAIT_V(8); PG8_WAIT_L(0); PG8_BAR; PG8_MMA(0, 0, At, B0); PG8_MMA(0, 1, At, B1); PG8_BAR; PG8_SCHED;
            PG8_LDA(At, 1, 1); PG8_STAGE(PG8_SB(1, 0), b3, voffB); PG8_STAGE(PG8_SB(1, 1), b3 + hstep, voffB); PG8_STAGE(PG8_SA(1, 0), a3, voffA);
            PG8_WAIT_V(8); PG8_WAIT_L(0); PG8_BAR; PG8_MMA(1, 0, At, B0); PG8_MMA(1, 1, At, B1); PG8_BAR; PG8_SCHED;
            } else {
            PG8_LDB(B0, 0, 0); PG8_SCHED; PG8_LDA(At, 0, 0); PG8_STAGE(PG8_SA(1, 1), a1 + hstep, voffA);
            PG8_WAIT_L(8); PG8_BAR; PG8_WAIT_L(0); PG8_MMA(0, 0, At, B0); PG8_BAR; PG8_SCHED;
            PG8_LDB(B1, 0, 1); PG8_STAGE(PG8_SB(0, 0), b2, voffB);
            PG8_BAR; PG8_WAIT_L(0); PG8_MMA(0, 1, At, B1); PG8_BAR;
            PG8_LDA(At, 0, 1); PG8_STAGE(PG8_SA(0, 0), a2, voffA);
            PG8_BAR; PG8_WAIT_L(0); PG8_MMA(1, 0, At, B0); PG8_BAR; PG8_SCHED;
            PG8_STAGE(PG8_SB(0, 1), b2 + hstep, voffB);
            PG8_WAIT_V(6); PG8_BAR; PG8_MMA(1, 1, At, B1); PG8_BAR;
            PG8_LDB(B0, 1, 0); PG8_SCHED; PG8_LDA(At, 1, 0); PG8_STAGE(PG8_SA(0, 1), a2 + hstep, voffA);
            PG8_WAIT_L(8); PG8_BAR; PG8_WAIT_L(0); PG8_MMA(0, 0, At, B0); PG8_BAR; PG8_SCHED;
            PG8_LDB(B1, 1, 1); PG8_STAGE(PG8_SB(1, 0), b3, voffB);
            PG8_BAR; PG8_WAIT_L(0); PG8_MMA(0, 1, At, B1); PG8_BAR;
            PG8_LDA(At, 1, 1); PG8_STAGE(PG8_SA(1, 0), a3, voffA);
            PG8_BAR; PG8_WAIT_L(0); PG8_MMA(1, 0, At, B0); PG8_BAR; PG8_SCHED;
            PG8_STAGE(PG8_SB(1, 1), b3 + hstep, voffB);
            PG8_WAIT_V(6); PG8_BAR; PG8_MMA(1, 1, At, B1); PG8_BAR;
            }
        }
        if constexpr (ALIGN_EPI) { if (wr == 0) PG8_BAR; }
        if constexpr (!Epi::AFTER_DRAIN) { E(acc, cur, wr, wc, fr, fq); S.done(cur); }
        if (!has_next) break;
#pragma unroll
        for (int a = 0; a < 2; ++a)
#pragma unroll
            for (int b = 0; b < 2; ++b)
#pragma unroll
                for (int m = 0; m < 4; ++m)
#pragma unroll
                    for (int n = 0; n < 2; ++n) acc[a][b][m][n] = (f32x4){0.f, 0.f, 0.f, 0.f};
        cur = nxt; cA = nA; cB = nB; ++ui;
        if constexpr (ALIGN_EPI) { if (wr == 1) PG8_BAR; }
    }
    PG8_WAIT_V(0);
    if constexpr (!ALIGN_EPI) { if (wr == 0) PG8_BAR; }
    PG8_BAR;
    if constexpr (Epi::AFTER_DRAIN) { E.fused(acc, cur, wr, wc, fr, fq, lds, wid, lane); S.done(cur); }
#undef PG8_SA
#undef PG8_SB
#undef PG8_STAGE
#undef PG8_LDA
#undef PG8_LDB
#undef PG8_MMA
#undef PG8_WAIT_V
#undef PG8_WAIT_L
#undef PG8_BAR
#undef PG8_SCHED
}
}
constexpr int NWAVES = 8;
constexpr int NB = 2, SEQ = 8192, DM = 2048, MTOK = NB * SEQ, DEPTH = 2, HD = 64;
constexpr int NEXP = 32, DEXP = 512, NASSIGN = MTOK * 2;
constexpr int D_IN = 5144;
constexpr int NPROJ = 3840, NVT = 1536, NIN = NPROJ + NVT;
constexpr int P_QA = 0, P_KA = 512, P_QB = 640, P_KBC = 1152, P_VBC = 1280, P_KBS = 1408, P_KBW = 1536, P_QC = 1664, P_KC = 2688, P_GB = 3712;
constexpr int V_C = 0, V_A = 1024, V_BS = 1152, V_BW = 1280;
constexpr int NT_ROW = NPROJ / 256;
constexpr float LN_EPS = 1e-5f, RMS_EPS = 1e-6f, ALPHA = 1.41421356237309515f;
constexpr float LOG2E = 1.44269504088896341f, LN2 = 0.693147180559945309f;
constexpr float SC2 = 0.125f * LOG2E;
constexpr int MAXROWS = 40960;
constexpr float SB_EXIT = -104.0f;

constexpr size_t MiB = 1u << 20;
constexpr size_t WS_CTL = 0, CTL_ZERO_BYTES = 1 * MiB;
constexpr size_t WS_MOD = 1 * MiB;
constexpr size_t WS_SMALL = 2 * MiB;
constexpr size_t WS_LIST = 4 * MiB;
constexpr size_t WS_WCMP = 6 * MiB;
constexpr size_t WS_WIN = 8 * MiB;
constexpr size_t WS_WOUT = 30 * MiB;
constexpr size_t WS_WGU = 38 * MiB;
constexpr size_t WS_WD = 166 * MiB;
constexpr size_t WS_XA = 230 * MiB;
constexpr size_t WS_XB = 358 * MiB;
constexpr size_t WS_HB = 486 * MiB;
constexpr size_t WS_PROJ = 550 * MiB;
constexpr size_t WS_VT = WS_PROJ + (size_t)MTOK * NPROJ * 2;
constexpr size_t WS_XS = WS_PROJ;
constexpr size_t WS_OCAT = 720 * MiB;
constexpr size_t WS_YS = WS_OCAT;
constexpr size_t WS_HID = 848 * MiB;
constexpr size_t WS_END = 888 * MiB;
static_assert(WS_VT + (size_t)NVT * MTOK * 2 <= WS_OCAT && WS_XS + (size_t)MAXROWS * DM * 2 <= WS_OCAT, "proj/vT/xs region");
static_assert(WS_WIN + (size_t)NIN * DM * 2 <= WS_WOUT && WS_WGU + (size_t)NEXP * 1024 * DM * 2 <= WS_WD && WS_WD + (size_t)NEXP * DM * DEXP * 2 <= WS_XA, "weight regions");
constexpr size_t SM_KCMP = 0;
constexpr size_t SM_VCMPT = 256 * 1024;
constexpr size_t SM_GATEW = 512 * 1024;
constexpr size_t SM_ROWINFO = 640 * 1024;
constexpr size_t SM_TILE = 800 * 1024;
constexpr int CW_BAR = 4096;
constexpr int CW_CNT = 16384;

constexpr int RING_OFF = 0, RING_BYTES = 131072;
constexpr int LDSCTL_OFF = RING_BYTES, MISC_OFF = LDSCTL_OFF + 320;
constexpr int LDS_BYTES = 147456;

#define GAS __attribute__((address_space(1)))
#define LAS __attribute__((address_space(3)))
typedef unsigned short bf16;
typedef unsigned v4u __attribute__((ext_vector_type(4)));
typedef unsigned v2u __attribute__((ext_vector_type(2)));
typedef float f32x4 __attribute__((ext_vector_type(4)));
typedef short bf16x8 __attribute__((ext_vector_type(8)));
typedef GAS unsigned gu32;
#define RLX_AGENT __ATOMIC_RELAXED, __HIP_MEMORY_SCOPE_AGENT
#define LDS_WAIT() asm volatile("s_waitcnt lgkmcnt(0)" ::: "memory")
#define VM_WAIT() asm volatile("s_waitcnt vmcnt(0)" ::: "memory")
__device__ __forceinline__ unsigned f2bf(float f) { unsigned u = __builtin_bit_cast(unsigned, f); return (u + 0x7fffu + ((u >> 16) & 1u)) >> 16; }
__device__ __forceinline__ unsigned pk2(float lo, float hi) { return f2bf(lo) | (f2bf(hi) << 16); }
__device__ __forceinline__ float bf2f(unsigned short h) { return __builtin_bit_cast(float, (unsigned)h << 16); }
__device__ __forceinline__ float bflo(unsigned w) { return __builtin_bit_cast(float, w << 16); }
__device__ __forceinline__ float bfhi(unsigned w) { return __builtin_bit_cast(float, w & 0xffff0000u); }
__device__ __forceinline__ float ex2(float x) { return __builtin_amdgcn_exp2f(x); }
__device__ __forceinline__ float lg2(float x) { return __builtin_amdgcn_logf(x); }
__device__ __forceinline__ bf16x8 ldg8(const bf16* p) { return *(const GAS bf16x8*)p; }
__device__ __forceinline__ f32x4 mfma16(bf16x8 a, bf16x8 b, f32x4 c) { return __builtin_amdgcn_mfma_f32_16x16x32_bf16(a, b, c, 0, 0, 0); }
__device__ __forceinline__ bf16x8 pack8(float a0, float a1, float a2, float a3, float a4, float a5, float a6, float a7) {
    v4u w; w.x = pg8::cvt_pk_bf16(a0, a1); w.y = pg8::cvt_pk_bf16(a2, a3); w.z = pg8::cvt_pk_bf16(a4, a5); w.w = pg8::cvt_pk_bf16(a6, a7);
    return __builtin_bit_cast(bf16x8, w);
}
__device__ __forceinline__ float wave_sum(float v) {
#pragma unroll
    for (int o = 1; o < 64; o <<= 1) v += __shfl_xor(v, o);
    return v;
}
#define XB_TMO      128
#define XB_XCNT(j)  (256  + 64 * (j))
#define XB_XSUB(j)  (1280 + 64 * (j))
#define XB_XGEN(j)  (2304 + 64 * (j))
#define XB_TOP      3328
#define XB_TOPGEN   3392
#define XCD_BAR_WORDS 3456
#define XB_SPIN_CAP (1u << 18)

__device__ __forceinline__ unsigned xb_ld(unsigned* p)              { return __hip_atomic_load(p, __ATOMIC_RELAXED, __HIP_MEMORY_SCOPE_AGENT); }
__device__ __forceinline__ unsigned xb_add(unsigned* p, unsigned v) { return __hip_atomic_fetch_add(p, v, __ATOMIC_RELAXED, __HIP_MEMORY_SCOPE_AGENT); }
__device__ __forceinline__ unsigned xb_xcc_id() { return (unsigned)__builtin_amdgcn_s_getreg((3 << 11) | 20) & 0xFu; }
#define XB_SPIN(cond, bar) do { unsigned _sp = 0; while (cond) { __builtin_amdgcn_s_sleep(1); \
    if ((++_sp & 255u) == 0u) { if (xb_ld(&(bar)[XB_TMO])) break; if (_sp > XB_SPIN_CAP) { atomicAdd(&(bar)[XB_TMO], 1u); break; } } } } while (0)

struct XcdBarrier {
    unsigned* bar; unsigned x;
    volatile LAS unsigned* st;
};

__device__ __forceinline__ XcdBarrier xcd_barrier_post(unsigned* bar, volatile LAS unsigned* st) {
    XcdBarrier b; b.bar = bar; b.x = xb_xcc_id(); b.st = st;
    if (threadIdx.x == 0) (void)xb_add(&bar[XB_XCNT(b.x)], 1u);
    return b;
}
__device__ __forceinline__ void xcd_barrier_complete(unsigned* bar, unsigned x, unsigned& nloc, unsigned& nx) {
    const unsigned G = gridDim.x * gridDim.y * gridDim.z;
    unsigned sum, cnt, mine, sp = 0u;
    for (;;) {
        sum = 0u; cnt = 0u; mine = 0u;
#pragma unroll
        for (unsigned j = 0; j < 16; ++j) { const unsigned c = xb_ld(&bar[XB_XCNT(j)]); sum += c; cnt += (c > 0u) ? 1u : 0u; mine = (j == x) ? c : mine; }
        if (sum == G) break;
        __builtin_amdgcn_s_sleep(1);
        if ((++sp & 255u) == 0u) { if (xb_ld(&bar[XB_TMO])) break; if (sp > XB_SPIN_CAP) { atomicAdd(&bar[XB_TMO], 1u); break; } }
    }
    nloc = mine > 0u ? mine : 1u; nx = cnt > 0u ? cnt : 1u;
}

__device__ __forceinline__ void xcd_barrier(const XcdBarrier& b) {
    asm volatile("s_waitcnt vmcnt(0)" ::: "memory");
    __syncthreads();
    if (threadIdx.x == 0) {
        unsigned* bar = b.bar;
        __builtin_amdgcn_s_waitcnt(0);
        unsigned nloc = b.st[0], nx = b.st[1];
        if (nloc == 0u) { xcd_barrier_complete(bar, b.x, nloc, nx); b.st[0] = nloc; b.st[1] = nx; }
        const unsigned old = xb_add(&bar[XB_XSUB(b.x)], 1u);
        const unsigned gen = old / nloc;
        if (old + 1u == (gen + 1u) * nloc) {
            __builtin_amdgcn_fence(__ATOMIC_RELEASE, "agent");
            asm volatile("s_waitcnt vmcnt(0)" ::: "memory");
            const unsigned og = xb_add(&bar[XB_TOP], 1u);
            const unsigned tg = og / nx;
            if (og + 1u == (tg + 1u) * nx) xb_add(&bar[XB_TOPGEN], 1u);
            else XB_SPIN(xb_ld(&bar[XB_TOPGEN]) == tg, bar);
            __builtin_amdgcn_fence(__ATOMIC_ACQUIRE, "agent");
            xb_add(&bar[XB_XGEN(b.x)], 1u);
            asm volatile("s_waitcnt vmcnt(0)" ::: "memory");
        } else {
            XB_SPIN(xb_ld(&bar[XB_XGEN(b.x)]) == gen, bar);
            __builtin_amdgcn_fence(__ATOMIC_ACQUIRE, "agent");
            asm volatile("s_waitcnt vmcnt(0)" ::: "memory");
        }
    }
    __syncthreads();
}
struct Frame {
    LAS unsigned char* lds;
    volatile LAS unsigned* MISC;
    int tid, lane, wave;
    int vcu, G;
};
constexpr int PTR_OFF = LDSCTL_OFF + 1024;
__device__ __forceinline__ unsigned char* tabp(const Frame& F, int i) {
    const unsigned long long v = ((LAS unsigned long long*)(F.lds + PTR_OFF))[i];
    const unsigned lo = __builtin_amdgcn_readfirstlane((unsigned)v), hi = __builtin_amdgcn_readfirstlane((unsigned)(v >> 32));
    return (unsigned char*)(((unsigned long long)hi << 32) | lo);
}
__device__ __forceinline__ const float* inp(const Frame& F, int i) { return (const float*)tabp(F, i); }
__device__ __forceinline__ unsigned char* wsp(const Frame& F) { return tabp(F, 25); }
__device__ __forceinline__ float* outp(const Frame& F) { return (float*)tabp(F, 26); }
__device__ __forceinline__ gu32* ctlp(const Frame& F) { return (gu32*)(tabp(F, 25) + WS_CTL); }
enum { I_X = 0, I_C, I_WADA, I_BADA, I_WIN, I_SINKS, I_PEK, I_W1K, I_W2K, I_PEV, I_W1V, I_W2V, I_MIXG, I_WOUT, I_LN1G, I_LN1B, I_WRG, I_BRG, I_WRE, I_BRE, I_WGATE, I_WUP, I_WDOWN, I_LN2G, I_LN2B };

__device__ __forceinline__ void ada_phase(Frame& F) {
    LAS float* cs = (LAS float*)(F.lds + 73728);
    LAS float* red = (LAS float*)(F.lds + 73728 + 16384);
    const float* c = inp(F, I_C);
    for (int i = F.tid; i < NB * DM; i += NWAVES * 64) { const float v = c[i]; cs[i] = v / (1.0f + __expf(-v)); }
    __syncthreads();
    float* mod = (float*)(wsp(F) + WS_MOD);
    for (int u = F.vcu; u < DEPTH * 96; u += F.G) {
        const int l = u / 96, cb = u % 96, col = cb * 128 + 2 * F.lane;
        const float* W = inp(F, I_WADA) + (size_t)l * DM * (6 * DM) + col;
        float a00 = 0.f, a01 = 0.f, a10 = 0.f, a11 = 0.f;
        const int k0 = F.wave * 256;
#pragma unroll 8
        for (int kk = 0; kk < 256; ++kk) { const int k = k0 + kk; typedef float f32x2_ __attribute__((ext_vector_type(2))); const f32x2_ w = *(const GAS f32x2_*)(W + (size_t)k * (6 * DM));
            const float s0 = cs[k], s1 = cs[DM + k]; a00 += s0 * w.x; a01 += s0 * w.y; a10 += s1 * w.x; a11 += s1 * w.y; }
        red[(F.wave * 2 + 0) * 128 + 2 * F.lane] = a00; red[(F.wave * 2 + 0) * 128 + 2 * F.lane + 1] = a01;
        red[(F.wave * 2 + 1) * 128 + 2 * F.lane] = a10; red[(F.wave * 2 + 1) * 128 + 2 * F.lane + 1] = a11;
        __syncthreads();
        if (F.tid < 256) { const int b = F.tid >> 7, j = F.tid & 127; float s = 0.f;
#pragma unroll
            for (int w = 0; w < 8; ++w) s += red[(w * 2 + b) * 128 + j];
            mod[((size_t)l * NB + b) * (6 * DM) + cb * 128 + j] = s + inp(F, I_BADA)[(size_t)l * 6 * DM + cb * 128 + j]; }
        __syncthreads();
    }
}

__device__ __forceinline__ void tr_item(const float* W, int ldw, int K, bf16* WT, size_t drow0, int rs, int src0, int nvalid, int k0, LAS float* scr, int lane) {
    const int nn = lane & 31;
#pragma unroll 8
    for (int i = 0; i < 32; ++i) { const int kk = 2 * i + (lane >> 5);
        scr[kk * 33 + nn] = (nn < nvalid) ? *(const GAS float*)(W + (size_t)(k0 + kk) * ldw + src0 + nn) : 0.f; }
    LDS_WAIT(); asm volatile("" ::: "memory");
    const int c = lane & 7;
#pragma unroll
    for (int j = 0; j < 4; ++j) { const int n = (lane >> 3) + 8 * j; const LAS float* s = scr + (8 * c) * 33 + n;
        v4u o; o.x = pk2(s[0 * 33], s[1 * 33]); o.y = pk2(s[2 * 33], s[3 * 33]); o.z = pk2(s[4 * 33], s[5 * 33]); o.w = pk2(s[6 * 33], s[7 * 33]);
        *(GAS v4u*)(WT + (drow0 + (size_t)n * rs) * K + k0 + 8 * c) = o; }
    LDS_WAIT(); asm volatile("" ::: "memory");
}
__device__ __forceinline__ void win_src(int n0, int& src0, int& nvalid) {
    nvalid = 32;
    if (n0 < 512) src0 = n0;
    else if (n0 < 640) src0 = 512 + (n0 - 512);
    else if (n0 < 1152) src0 = 768 + (n0 - 640);
    else if (n0 < 1280) src0 = 1280 + (n0 - 1152);
    else if (n0 < 1408) src0 = 1408 + (n0 - 1280);
    else if (n0 < 1536) src0 = 1536 + (n0 - 1408);
    else if (n0 < 1664) src0 = 1792 + (n0 - 1536);
    else if (n0 < 2688) src0 = 2072 + (n0 - 1664);
    else if (n0 < 3712) src0 = 3096 + (n0 - 2688);
    else if (n0 < 3744) { src0 = 2048; nvalid = 24; }
    else if (n0 < 3840) { src0 = 0; nvalid = 0; }
    else if (n0 < 4864) src0 = 4120 + (n0 - 3840);
    else if (n0 < 4992) src0 = 640 + (n0 - 4864);
    else if (n0 < 5120) src0 = 1664 + (n0 - 4992);
    else if (n0 < 5248) src0 = 1920 + (n0 - 5120);
    else { src0 = 0; nvalid = 0; }
}
__device__ __forceinline__ void convert_layer(Frame& F, int l) {
    LAS float* scr = (LAS float*)(F.lds + F.wave * 8704);
    const int gw = F.vcu * NWAVES + F.wave, NGW = F.G * NWAVES;
    constexpr int I_A = 32 * (NIN / 32), I_B = 32 * 64, I_G = NEXP * 512, I_U = NEXP * 512, I_D = NEXP * 512, I_1 = 128, I_2 = 4;
    constexpr int NITEMS = I_A + I_B + I_G + I_U + I_D + 2 * I_1 + 2 * I_2;
    bf16* Win_t = (bf16*)(wsp(F) + WS_WIN); bf16* Wout_t = (bf16*)(wsp(F) + WS_WOUT); bf16* Wgu_t = (bf16*)(wsp(F) + WS_WGU); bf16* Wd_t = (bf16*)(wsp(F) + WS_WD);
    bf16* W1t = (bf16*)(wsp(F) + WS_WCMP); bf16* W2t = (bf16*)(wsp(F) + WS_WCMP + 2 * 128 * 2048 * 2);
    for (int it = gw; it < NITEMS; it += NGW) {
        int r = it;
        if (r < I_A) { const int nblk = NIN / 32, kb = r / nblk, nb = r % nblk; int src0, nv; win_src(nb * 32, src0, nv);
            tr_item(inp(F, I_WIN) + (size_t)l * DM * D_IN, D_IN, DM, Win_t, (size_t)nb * 32, 1, src0, nv, kb * 64, scr, F.lane); continue; } r -= I_A;
        if (r < I_B) { const int kb = r / 64, nb = r % 64;
            tr_item(inp(F, I_WOUT) + (size_t)l * DM * DM, DM, DM, Wout_t, (size_t)nb * 32, 1, nb * 32, 32, kb * 64, scr, F.lane); continue; } r -= I_B;
        if (r < I_G) { const int e = r / 512, q = r % 512, kb = q / 16, nb = q % 16;
            tr_item(inp(F, I_WGATE) + ((size_t)l * NEXP + e) * DM * DEXP, DEXP, DM, Wgu_t, (size_t)e * 1024 + nb * 64, 2, nb * 32, 32, kb * 64, scr, F.lane); continue; } r -= I_G;
        if (r < I_U) { const int e = r / 512, q = r % 512, kb = q / 16, nb = q % 16;
            tr_item(inp(F, I_WUP) + ((size_t)l * NEXP + e) * DM * DEXP, DEXP, DM, Wgu_t, (size_t)e * 1024 + nb * 64 + 1, 2, nb * 32, 32, kb * 64, scr, F.lane); continue; } r -= I_U;
        if (r < I_D) { const int e = r / 512, q = r % 512, kb = q / 64, nb = q % 64;
            tr_item(inp(F, I_WDOWN) + ((size_t)l * NEXP + e) * DEXP * DM, DM, DEXP, Wd_t, (size_t)e * DM + nb * 32, 1, nb * 32, 32, kb * 64, scr, F.lane); continue; } r -= I_D;
        if (r < 2 * I_1) { const int kv = r / I_1, q = r % I_1, kb = q / 4, nb = q % 4;
            tr_item(inp(F, kv ? I_W1V : I_W1K) + (size_t)l * 2048 * 128, 128, 2048, W1t + (size_t)kv * 128 * 2048, (size_t)nb * 32, 1, nb * 32, 32, kb * 64, scr, F.lane); continue; } r -= 2 * I_1;
        { const int kv = r / I_2, q = r % I_2, kb = q / 2, nb = q % 2;
            tr_item(inp(F, kv ? I_W2V : I_W2K) + (size_t)l * 128 * 64, 64, 128, W2t + (size_t)kv * 64 * 128, (size_t)nb * 32, 1, nb * 32, 32, kb * 64, scr, F.lane); }
    }
}

struct Row { f32x4 v[8]; };
__device__ __forceinline__ void row_load(Row& r, const float* p, int lane) {
#pragma unroll
    for (int j = 0; j < 8; ++j) r.v[j] = *((const GAS f32x4*)p + lane + 64 * j);
}
__device__ __forceinline__ void row_store(const Row& r, float* p, int lane) {
#pragma unroll
    for (int j = 0; j < 8; ++j) *((GAS f32x4*)p + lane + 64 * j) = r.v[j];
}
__device__ __forceinline__ void row_store_bf16(const Row& r, bf16* p, int lane) {
#pragma unroll
    for (int j = 0; j < 8; ++j) { v2u w; w.x = pk2(r.v[j].x, r.v[j].y); w.y = pk2(r.v[j].z, r.v[j].w); *((GAS v2u*)p + lane + 64 * j) = w; }
}
__device__ __forceinline__ void row_normalize(Row& r) {
    float s = 0.f;
#pragma unroll
    for (int j = 0; j < 8; ++j) s += (r.v[j].x + r.v[j].y) + (r.v[j].z + r.v[j].w);
    const float mean = wave_sum(s) * (1.0f / DM); float s2 = 0.f;
#pragma unroll
    for (int j = 0; j < 8; ++j) { r.v[j] = r.v[j] - mean; s2 += (r.v[j].x * r.v[j].x + r.v[j].y * r.v[j].y) + (r.v[j].z * r.v[j].z + r.v[j].w * r.v[j].w); }
    const float rstd = 1.0f / sqrtf(wave_sum(s2) * (1.0f / DM) + LN_EPS);
#pragma unroll
    for (int j = 0; j < 8; ++j) r.v[j] = r.v[j] * rstd;
}
__device__ __forceinline__ void row_affine(Row& r, const float* a, float add1, const float* b, int lane) {
#pragma unroll
    for (int j = 0; j < 8; ++j) { const f32x4 av = *((const GAS f32x4*)a + lane + 64 * j) + add1, bv = *((const GAS f32x4*)b + lane + 64 * j); r.v[j] = r.v[j] * av + bv; }
}
__device__ __forceinline__ const float* modp(Frame& F, int l, int b, int which) { return (const float*)(wsp(F) + WS_MOD) + ((size_t)l * NB + b) * (6 * DM) + which * DM; }

__device__ __forceinline__ void ln_in_phase(Frame& F) {
    const int gw = F.vcu * NWAVES + F.wave, NGW = F.G * NWAVES;
    bf16* hb = (bf16*)(wsp(F) + WS_HB);
    for (int m = gw; m < MTOK; m += NGW) { const int b = m / SEQ; Row r; row_load(r, inp(F, I_X) + (size_t)m * DM, F.lane); row_normalize(r);
        row_affine(r, modp(F, 0, b, 1), 1.0f, modp(F, 0, b, 0), F.lane); row_store_bf16(r, hb + (size_t)m * DM, F.lane); }
}

__device__ __forceinline__ void merge_phase(Frame& F, int l) {
    const int gw = F.vcu * NWAVES + F.wave, NGW = F.G * NWAVES;
    const float* oc = (const float*)(wsp(F) + WS_OCAT); bf16* hb = (bf16*)(wsp(F) + WS_HB); const float* mg = inp(F, I_MIXG) + (size_t)l * DM;
    for (int m = gw; m < MTOK; m += NGW) { Row r; row_load(r, oc + (size_t)m * DM, F.lane);
        float sa = 0.f, sb = 0.f, sc = 0.f;
#pragma unroll
        for (int j = 0; j < 8; ++j) { const float q = (r.v[j].x * r.v[j].x + r.v[j].y * r.v[j].y) + (r.v[j].z * r.v[j].z + r.v[j].w * r.v[j].w); if (j < 2) sa += q; else if (j < 4) sb += q; else sc += q; }
        const float ra = 1.0f / sqrtf(wave_sum(sa) * (1.0f / 512.0f) + RMS_EPS), rb = 1.0f / sqrtf(wave_sum(sb) * (1.0f / 512.0f) + RMS_EPS), rc = 1.0f / sqrtf(wave_sum(sc) * (1.0f / 1024.0f) + RMS_EPS);
#pragma unroll
        for (int j = 0; j < 8; ++j) { const float s = j < 2 ? ra : (j < 4 ? rb : rc); const f32x4 g = *((const GAS f32x4*)mg + F.lane + 64 * j); r.v[j] = r.v[j] * s * g; }
        row_store_bf16(r, hb + (size_t)m * DM, F.lane); }
}

__device__ __forceinline__ void post_mixer_phase(Frame& F, int l) {
    const int gw = F.vcu * NWAVES + F.wave, NGW = F.G * NWAVES;
    float* xa = (float*)(wsp(F) + WS_XA); bf16* hb = (bf16*)(wsp(F) + WS_HB);
    const float* wrg = inp(F, I_WRG) + (size_t)l * DM * 4; const float* brg = inp(F, I_BRG) + l * 4;
    const float* wre = inp(F, I_WRE) + (size_t)l * 4 * DM * 8; const float* bre = inp(F, I_BRE) + l * 32;
    unsigned* cnt = (unsigned*)(ctlp(F) + CW_CNT + l * 32); int* list = (int*)(wsp(F) + WS_LIST); float* gatew = (float*)(wsp(F) + WS_SMALL + SM_GATEW);
    for (int m = gw; m < MTOK; m += NGW) { const int b = m / SEQ; Row r; row_load(r, xa + (size_t)m * DM, F.lane); row_normalize(r);
        row_affine(r, inp(F, I_LN1G) + (size_t)l * DM, 0.0f, inp(F, I_LN1B) + (size_t)l * DM, F.lane); row_store(r, xa + (size_t)m * DM, F.lane);
        row_normalize(r); row_affine(r, modp(F, l, b, 4), 1.0f, modp(F, l, b, 3), F.lane); row_store_bf16(r, hb + (size_t)m * DM, F.lane);
        f32x4 lg = (f32x4){0.f, 0.f, 0.f, 0.f};
#pragma unroll
        for (int j = 0; j < 8; ++j) { const GAS f32x4* wp = (const GAS f32x4*)wrg + (size_t)(4 * F.lane + 256 * j);
            lg += wp[0] * r.v[j].x; lg += wp[1] * r.v[j].y; lg += wp[2] * r.v[j].z; lg += wp[3] * r.v[j].w; }
        float g0 = wave_sum(lg.x) + brg[0], g1 = wave_sum(lg.y) + brg[1], g2 = wave_sum(lg.z) + brg[2], g3 = wave_sum(lg.w) + brg[3];
        int gs = 0; float gm = g0; if (g1 > gm) { gm = g1; gs = 1; } if (g2 > gm) { gm = g2; gs = 2; } if (g3 > gm) { gm = g3; gs = 3; }
        const float pgroup = 1.0f / (__expf(g0 - gm) + __expf(g1 - gm) + __expf(g2 - gm) + __expf(g3 - gm));
        gs = __builtin_amdgcn_readfirstlane(gs);
        f32x4 ea = (f32x4){0.f, 0.f, 0.f, 0.f}, eb = (f32x4){0.f, 0.f, 0.f, 0.f};
        const float* wg = wre + (size_t)gs * DM * 8;
#pragma unroll
        for (int j = 0; j < 8; ++j) { const GAS f32x4* wp = (const GAS f32x4*)wg + (size_t)(4 * F.lane + 256 * j) * 2;
            ea += wp[0] * r.v[j].x; eb += wp[1] * r.v[j].x; ea += wp[2] * r.v[j].y; eb += wp[3] * r.v[j].y;
            ea += wp[4] * r.v[j].z; eb += wp[5] * r.v[j].z; ea += wp[6] * r.v[j].w; eb += wp[7] * r.v[j].w; }
        float le[8];
        le[0] = wave_sum(ea.x) + bre[gs * 8 + 0]; le[1] = wave_sum(ea.y) + bre[gs * 8 + 1]; le[2] = wave_sum(ea.z) + bre[gs * 8 + 2]; le[3] = wave_sum(ea.w) + bre[gs * 8 + 3];
        le[4] = wave_sum(eb.x) + bre[gs * 8 + 4]; le[5] = wave_sum(eb.y) + bre[gs * 8 + 5]; le[6] = wave_sum(eb.z) + bre[gs * 8 + 6]; le[7] = wave_sum(eb.w) + bre[gs * 8 + 7];
        int t1 = 0; float m1 = le[0];
#pragma unroll
        for (int i = 1; i < 8; ++i) if (le[i] > m1) { m1 = le[i]; t1 = i; }
        int t2 = -1; float m2 = -3.0e38f;
#pragma unroll
        for (int i = 0; i < 8; ++i) if (i != t1 && le[i] > m2) { m2 = le[i]; t2 = i; }
        const float e2 = __expf(m2 - m1), inv = pgroup / (1.0f + e2);
        if (F.lane == 0) {
            const int x1 = gs * 8 + t1, x2 = gs * 8 + t2;
            const unsigned p1 = __hip_atomic_fetch_add(cnt + x1, 1u, RLX_AGENT); list[(size_t)x1 * MTOK + p1] = m * 2; gatew[m * 2] = inv;
            const unsigned p2 = __hip_atomic_fetch_add(cnt + x2, 1u, RLX_AGENT); list[(size_t)x2 * MTOK + p2] = m * 2 + 1; gatew[m * 2 + 1] = inv * e2;
        }
    }
}

__device__ __forceinline__ void gather_phase(Frame& F, int l) {
    LAS int* tb = (LAS int*)(F.lds + 0);
    const unsigned* cnt = (const unsigned*)(ctlp(F) + CW_CNT + l * 32);
    if (F.tid < 32) tb[F.tid] = (int)__hip_atomic_load(cnt + F.tid, RLX_AGENT);
    __syncthreads();
    if (F.tid == 0) { int row = 0, tile = 0;
        for (int e = 0; e < NEXP; ++e) { tb[32 + e] = row; const int nt = (tb[e] + 255) >> 8; for (int t = 0; t < nt; ++t) tb[64 + tile + t] = e; tile += nt; row += nt * 256; }
        tb[224] = tile; }
    __syncthreads();
    const int ntiles = tb[224];
    int* gt = (int*)(wsp(F) + WS_SMALL + SM_TILE);
    if (blockIdx.x == 0) { if (F.tid < 160) gt[F.tid] = (F.tid < ntiles) ? tb[64 + F.tid] : 0; if (F.tid == 0) gt[200] = ntiles; }
    const int gw = F.vcu * NWAVES + F.wave, NGW = F.G * NWAVES;
    const int* list = (const int*)(wsp(F) + WS_LIST); int* rowinfo = (int*)(wsp(F) + WS_SMALL + SM_ROWINFO);
    const bf16* hb = (const bf16*)(wsp(F) + WS_HB); bf16* xs = (bf16*)(wsp(F) + WS_XS);
    for (int R = gw; R < ntiles * 256; R += NGW) { const int e = tb[64 + (R >> 8)], pos = R - tb[32 + e];
        int aid = -1; if (pos < tb[e]) aid = list[(size_t)e * MTOK + pos];
        GAS v4u* dst = (GAS v4u*)(xs + (size_t)R * DM) + F.lane;
        if (aid >= 0) { const GAS v4u* src = (const GAS v4u*)(hb + (size_t)(aid >> 1) * DM) + F.lane;
#pragma unroll
            for (int j = 0; j < 4; ++j) dst[64 * j] = src[64 * j]; }
        else {
#pragma unroll
            for (int j = 0; j < 4; ++j) dst[64 * j] = (v4u){0u, 0u, 0u, 0u}; }
        if (F.lane == 0) rowinfo[R] = aid; }
    __syncthreads();
}

__device__ __forceinline__ void post_moe_phase(Frame& F, int l, float* dst, bool next_h) {
    const int gw = F.vcu * NWAVES + F.wave, NGW = F.G * NWAVES;
    const float* xa = (const float*)(wsp(F) + WS_XA); const bf16* ys = (const bf16*)(wsp(F) + WS_YS); bf16* hb = (bf16*)(wsp(F) + WS_HB);
    for (int m = gw; m < MTOK; m += NGW) { const int b = m / SEQ; Row r; row_load(r, xa + (size_t)m * DM, F.lane);
        const float* g2 = modp(F, l, b, 5);
#pragma unroll
        for (int j = 0; j < 8; ++j) { const v2u y0 = *((const GAS v2u*)(ys + (size_t)(2 * m) * DM) + F.lane + 64 * j), y1 = *((const GAS v2u*)(ys + (size_t)(2 * m + 1) * DM) + F.lane + 64 * j);
            const f32x4 y = (f32x4){bflo(y0.x) + bflo(y1.x), bfhi(y0.x) + bfhi(y1.x), bflo(y0.y) + bflo(y1.y), bfhi(y0.y) + bfhi(y1.y)};
            const f32x4 gv = *((const GAS f32x4*)g2 + F.lane + 64 * j) + 1.0f; r.v[j] = r.v[j] * ALPHA + gv * y; }
        row_normalize(r); row_affine(r, inp(F, I_LN2G) + (size_t)l * DM, 0.0f, inp(F, I_LN2B) + (size_t)l * DM, F.lane); row_store(r, dst + (size_t)m * DM, F.lane);
        if (next_h) { row_normalize(r); row_affine(r, modp(F, l + 1, b, 1), 1.0f, modp(F, l + 1, b, 0), F.lane); row_store_bf16(r, hb + (size_t)m * DM, F.lane); } }
}
struct Flash { f32x4 O[4][4]; float m[4], l[4]; };

__device__ __forceinline__ void flash_init(Flash& S, float m0, float m1, float m2, float m3) {
#pragma unroll
    for (int db = 0; db < 4; ++db)
#pragma unroll
        for (int qb = 0; qb < 4; ++qb) S.O[db][qb] = (f32x4){0.f, 0.f, 0.f, 0.f};
    S.m[0] = m0; S.m[1] = m1; S.m[2] = m2; S.m[3] = m3; S.l[0] = S.l[1] = S.l[2] = S.l[3] = 0.f;
}
__device__ __forceinline__ void flash_step(Flash& S, const f32x4 (&Sv)[2][4], bf16x8 (&Pf)[4]) {
#pragma unroll
    for (int qb = 0; qb < 4; ++qb) {
        float mx = fmaxf(fmaxf(fmaxf(Sv[0][qb][0], Sv[0][qb][1]), fmaxf(Sv[0][qb][2], Sv[0][qb][3])), fmaxf(fmaxf(Sv[1][qb][0], Sv[1][qb][1]), fmaxf(Sv[1][qb][2], Sv[1][qb][3])));
        mx = fmaxf(mx, __shfl_xor(mx, 16)); mx = fmaxf(mx, __shfl_xor(mx, 32));
        const float mn = fmaxf(S.m[qb], mx), al = ex2(S.m[qb] - mn); S.m[qb] = mn;
        float p[8];
#pragma unroll
        for (int h = 0; h < 2; ++h)
#pragma unroll
            for (int r = 0; r < 4; ++r) p[4 * h + r] = ex2(Sv[h][qb][r] - mn);
        S.l[qb] = S.l[qb] * al + ((p[0] + p[1]) + (p[2] + p[3])) + ((p[4] + p[5]) + (p[6] + p[7]));
#pragma unroll
        for (int db = 0; db < 4; ++db) S.O[db][qb] = S.O[db][qb] * al;
        Pf[qb] = pack8(p[0], p[1], p[2], p[3], p[4], p[5], p[6], p[7]);
    }
}
__device__ __forceinline__ void flash_pv(Flash& S, const bf16* vrow0  , size_t ldv, const bf16x8 (&Pf)[4]) {
#pragma unroll
    for (int db = 0; db < 4; ++db) { const bf16x8 Vf = ldg8(vrow0 + (size_t)(16 * db) * ldv);
#pragma unroll
        for (int qb = 0; qb < 4; ++qb) S.O[db][qb] = mfma16(Vf, Pf[qb], S.O[db][qb]); }
}
__device__ __forceinline__ float flash_inv(const Flash& S, int qb, bool has_sink, float sink2) {
    float lt = S.l[qb]; lt += __shfl_xor(lt, 16); lt += __shfl_xor(lt, 32);
    if (has_sink) lt += ex2(sink2 - S.m[qb]);
    return lt > 0.f ? 1.0f / lt : 0.f;
}
__device__ __forceinline__ float sigmoidf_(float x) { return 1.0f / (1.0f + __expf(-x)); }
__device__ __forceinline__ float slope2_of(int hidx) { return LOG2E * exp2f(-0.5f * (float)(hidx + 1)); }

template <int W, int MODE>
__device__ __forceinline__ void win_unit(Frame& F, int l, int b, int g, int q0) {
    const int lane = F.lane, c = lane & 15, kq = lane >> 4;
    const bf16* proj = (const bf16*)(wsp(F) + WS_PROJ); const bf16* vT = (const bf16*)(wsp(F) + WS_VT); float* ocat = (float*)(wsp(F) + WS_OCAT);
    constexpr int QOFF = MODE == 0 ? P_QA : P_QB, KOFF = MODE == 0 ? P_KA : P_KBW, VROW = MODE == 0 ? V_A : V_BW, OCOL = MODE == 0 ? 0 : 512, HBASE = MODE == 0 ? 0 : 8;
    const size_t tb = (size_t)b * SEQ; const int t = q0 + c;
    const bf16* qrow = proj + (tb + t) * NPROJ;
    bf16x8 Qf[4][2];
#pragma unroll
    for (int qb = 0; qb < 4; ++qb)
#pragma unroll
        for (int ds = 0; ds < 2; ++ds) Qf[qb][ds] = ldg8(qrow + QOFF + (g * 4 + qb) * 64 + ds * 32 + kq * 8);
    float sl2[4], sk2[4];
#pragma unroll
    for (int qb = 0; qb < 4; ++qb) { sl2[qb] = slope2_of(HBASE + g * 4 + qb); sk2[qb] = MODE == 0 ? inp(F, I_SINKS)[l * 8 + g * 4 + qb] * LOG2E : -1.0e30f; }
    Flash S; flash_init(S, sk2[0], sk2[1], sk2[2], sk2[3]);
    int klo = q0 - (W - 1); if (klo < 0) klo = 0; klo &= ~31;
    const int khi = (q0 + 15) & ~31;
    for (int kbase = klo; kbase <= khi; kbase += 32) {
        f32x4 Sv[2][4];
#pragma unroll
        for (int h = 0; h < 2; ++h) { const int key = kbase + 8 * (c >> 2) + 4 * h + (c & 3); const bf16* kr = proj + (tb + key) * NPROJ + KOFF + g * 64 + kq * 8;
            const bf16x8 K0 = ldg8(kr), K1 = ldg8(kr + 32);
#pragma unroll
            for (int qb = 0; qb < 4; ++qb) { f32x4 a = mfma16(K0, Qf[qb][0], (f32x4){0.f, 0.f, 0.f, 0.f}); Sv[h][qb] = mfma16(K1, Qf[qb][1], a); } }
#pragma unroll
        for (int h = 0; h < 2; ++h)
#pragma unroll
            for (int r = 0; r < 4; ++r) { const int dist = t - (kbase + 8 * kq + 4 * h + r); const bool vis = dist >= 0 && dist < W; const float fd = (float)dist;
#pragma unroll
                for (int qb = 0; qb < 4; ++qb) Sv[h][qb][r] = vis ? Sv[h][qb][r] * SC2 - sl2[qb] * fd : -INFINITY; }
        bf16x8 Pf[4]; flash_step(S, Sv, Pf);
        flash_pv(S, vT + (size_t)(VROW + g * 64 + c) * MTOK + tb + kbase + 8 * kq, MTOK, Pf);
    }
#pragma unroll
    for (int qb = 0; qb < 4; ++qb) { float sc = flash_inv(S, qb, MODE == 0, sk2[qb]);
        if (MODE == 1) sc *= sigmoidf_(bf2f(qrow[P_GB + (g * 4 + qb) * 3 + 2]));
        float* op = ocat + (tb + t) * DM + OCOL + (g * 4 + qb) * 64 + 4 * kq;
#pragma unroll
        for (int db = 0; db < 4; ++db) *(GAS f32x4*)(op + 16 * db) = S.O[db][qb] * sc; }
}

__device__ __forceinline__ void sb_unit(Frame& F, int b, int hc, int q0) {
    const int lane = F.lane, c = lane & 15, kq = lane >> 4;
    const bf16* proj = (const bf16*)(wsp(F) + WS_PROJ); const bf16* vT = (const bf16*)(wsp(F) + WS_VT); float* ocat = (float*)(wsp(F) + WS_OCAT);
    const size_t tb = (size_t)b * SEQ;
    bf16x8 Qf[4][2];
#pragma unroll
    for (int qb = 0; qb < 4; ++qb)
#pragma unroll
        for (int ds = 0; ds < 2; ++ds) Qf[qb][ds] = ldg8(proj + (tb + q0 + 16 * qb + c) * NPROJ + P_QC + hc * 64 + ds * 32 + kq * 8);
    f32x4 O[4][4]; float carry[4];
#pragma unroll
    for (int qb = 0; qb < 4; ++qb) { carry[qb] = 0.f;
#pragma unroll
        for (int db = 0; db < 4; ++db) O[db][qb] = (f32x4){0.f, 0.f, 0.f, 0.f}; }
    for (int kbase = q0 + 32; kbase >= 0; kbase -= 32) {
        f32x4 Sv[2][4];
#pragma unroll
        for (int h = 0; h < 2; ++h) { const int key = kbase + 8 * (c >> 2) + 4 * h + (c & 3); const bf16* kr = proj + (tb + key) * NPROJ + P_KC + hc * 64 + kq * 8;
            const bf16x8 K0 = ldg8(kr), K1 = ldg8(kr + 32);
#pragma unroll
            for (int qb = 0; qb < 4; ++qb) { f32x4 a = mfma16(K0, Qf[qb][0], (f32x4){0.f, 0.f, 0.f, 0.f}); Sv[h][qb] = mfma16(K1, Qf[qb][1], a); } }
        bf16x8 Pf[4];
#pragma unroll
        for (int qb = 0; qb < 4; ++qb) { const int t = q0 + 16 * qb + c;
            float L[8], ls[8];
#pragma unroll
            for (int h = 0; h < 2; ++h)
#pragma unroll
                for (int r = 0; r < 4; ++r) { const int j = 4 * h + r; const float z = Sv[h][qb][r] * 0.125f; const bool msk = (kbase + 8 * kq + j) >= t;
                    const float sp = fmaxf(z, 0.f) + LN2 * lg2(1.0f + ex2(-fabsf(z) * LOG2E));
                    L[j] = msk ? 0.f : -sp; ls[j] = msk ? -INFINITY : z - sp; }
            float ex_[8]; float run = 0.f;
#pragma unroll
            for (int j = 7; j >= 0; --j) { ex_[j] = run; run += L[j]; }
            const float t1 = __shfl_xor(run, 16), t2 = __shfl_xor(run, 32), t3 = __shfl_xor(run, 48);
            const float X = ((kq ^ 1) > kq ? t1 : 0.f) + ((kq ^ 2) > kq ? t2 : 0.f) + ((kq ^ 3) > kq ? t3 : 0.f);
            const float base = carry[qb] + X;
            float a[8];
#pragma unroll
            for (int j = 0; j < 8; ++j) a[j] = ex2((ls[j] + base + ex_[j]) * LOG2E);
            carry[qb] += (run + t1) + (t2 + t3);
            Pf[qb] = pack8(a[0], a[1], a[2], a[3], a[4], a[5], a[6], a[7]); }
        const bf16* vr = vT + (size_t)(V_C + hc * 64 + c) * MTOK + tb + kbase + 8 * kq;
#pragma unroll
        for (int db = 0; db < 4; ++db) { const bf16x8 Vf = ldg8(vr + (size_t)(16 * db) * MTOK);
#pragma unroll
            for (int qb = 0; qb < 4; ++qb) O[db][qb] = mfma16(Vf, Pf[qb], O[db][qb]); }
        const bool fin = (carry[0] < SB_EXIT) && (carry[1] < SB_EXIT) && (carry[2] < SB_EXIT) && (carry[3] < SB_EXIT);
        if (__all(fin)) break;
    }
#pragma unroll
    for (int qb = 0; qb < 4; ++qb) { float* op = ocat + (tb + q0 + 16 * qb + c) * DM + 1024 + hc * 64 + 4 * kq;
#pragma unroll
        for (int db = 0; db < 4; ++db) *(GAS f32x4*)(op + 16 * db) = O[db][qb]; }
}

__device__ __forceinline__ float gelu_tanh(float x) { const float u = 0.7978845608028654f * (x + 0.044715f * x * x * x); const float e = __expf(2.0f * u); return 0.5f * x * (2.0f - 2.0f / (e + 1.0f)); }
__device__ __forceinline__ void cmp_mlp_unit(Frame& F, int l, int unit) {
    const int lane = F.lane, c = lane & 15, kq = lane >> 4;
    const int nt = unit & 31, g = (unit >> 5) & 1, b = (unit >> 6) & 1, kv = unit >> 7;
    const bf16* proj = (const bf16*)(wsp(F) + WS_PROJ);
    const bf16* W1t = (const bf16*)(wsp(F) + WS_WCMP) + (size_t)kv * 128 * 2048; const bf16* W2t = (const bf16*)(wsp(F) + WS_WCMP + 2 * 128 * 2048 * 2) + (size_t)kv * 64 * 128;
    const float* pe = inp(F, kv ? I_PEV : I_PEK) + (size_t)l * 32 * 64;
    const int n = nt * 16 + c; const size_t tb = (size_t)b * SEQ; const int xoff = (kv ? P_VBC : P_KBC) + g * 64;
    f32x4 H[4][2];
#pragma unroll
    for (int s = 0; s < 4; ++s) { H[s][0] = (f32x4){0.f, 0.f, 0.f, 0.f}; H[s][1] = (f32x4){0.f, 0.f, 0.f, 0.f}; }
    for (int ks = 0; ks < 64; ++ks) {
        const int lt = ks >> 1, d0 = (ks & 1) * 32 + 8 * kq; int tok = 16 * n + lt; if (tok > SEQ - 1) tok = SEQ - 1;
        const bf16x8 xr = ldg8(proj + (tb + tok) * NPROJ + xoff + d0);
        const f32x4 p0 = *(const GAS f32x4*)(pe + lt * 64 + d0), p1 = *(const GAS f32x4*)(pe + lt * 64 + d0 + 4);
        const bf16x8 Xf = pack8(bf2f((unsigned short)xr[0]) + p0[0], bf2f((unsigned short)xr[1]) + p0[1], bf2f((unsigned short)xr[2]) + p0[2], bf2f((unsigned short)xr[3]) + p0[3],
                                bf2f((unsigned short)xr[4]) + p1[0], bf2f((unsigned short)xr[5]) + p1[1], bf2f((unsigned short)xr[6]) + p1[2], bf2f((unsigned short)xr[7]) + p1[3]);
#pragma unroll
        for (int s = 0; s < 4; ++s)
#pragma unroll
            for (int h = 0; h < 2; ++h) { const int hid = 32 * s + 8 * (c >> 2) + 4 * h + (c & 3);
                H[s][h] = mfma16(ldg8(W1t + (size_t)hid * 2048 + ks * 32 + 8 * kq), Xf, H[s][h]); }
    }
    f32x4 Y[4];
#pragma unroll
    for (int eb = 0; eb < 4; ++eb) Y[eb] = (f32x4){0.f, 0.f, 0.f, 0.f};
#pragma unroll
    for (int s = 0; s < 4; ++s) {
        const bf16x8 Hf = pack8(gelu_tanh(H[s][0][0]), gelu_tanh(H[s][0][1]), gelu_tanh(H[s][0][2]), gelu_tanh(H[s][0][3]), gelu_tanh(H[s][1][0]), gelu_tanh(H[s][1][1]), gelu_tanh(H[s][1][2]), gelu_tanh(H[s][1][3]));
#pragma unroll
        for (int eb = 0; eb < 4; ++eb) Y[eb] = mfma16(ldg8(W2t + (size_t)(16 * eb + c) * 128 + 32 * s + 8 * kq), Hf, Y[eb]);
    }
    const bool valid = n <= 510;
    if (kv == 0) { bf16* kc = (bf16*)(wsp(F) + WS_SMALL + SM_KCMP) + ((size_t)(b * 2 + g) * 512 + n) * 64 + 4 * kq;
#pragma unroll
        for (int eb = 0; eb < 4; ++eb) { v2u w; w.x = valid ? pk2(Y[eb][0], Y[eb][1]) : 0u; w.y = valid ? pk2(Y[eb][2], Y[eb][3]) : 0u; *(GAS v2u*)(kc + 16 * eb) = w; } }
    else { bf16* vc = (bf16*)(wsp(F) + WS_SMALL + SM_VCMPT) + (size_t)(b * 2 + g) * 64 * 512 + n;
#pragma unroll
        for (int eb = 0; eb < 4; ++eb)
#pragma unroll
            for (int r = 0; r < 4; ++r) vc[(size_t)(16 * eb + 4 * kq + r) * 512] = valid ? (bf16)f2bf(Y[eb][r]) : (bf16)0; }
}

constexpr int IMP_STRIDE = 132;
constexpr int A2_WAVE_LDS = 16 * IMP_STRIDE * 4 + 512 + 256;
__device__ __forceinline__ void nsa_unit(Frame& F, int b, int g, int q0) {
    const int lane = F.lane, c = lane & 15, kq = lane >> 4;
    const bf16* proj = (const bf16*)(wsp(F) + WS_PROJ); const bf16* vT = (const bf16*)(wsp(F) + WS_VT); float* ocat = (float*)(wsp(F) + WS_OCAT);
    const bf16* kcmp = (const bf16*)(wsp(F) + WS_SMALL + SM_KCMP) + (size_t)(b * 2 + g) * 512 * 64;
    const bf16* vcmpT = (const bf16*)(wsp(F) + WS_SMALL + SM_VCMPT) + (size_t)(b * 2 + g) * 64 * 512;
    LAS float* imp = (LAS float*)(F.lds + F.wave * A2_WAVE_LDS);
    LAS float* scv = imp + 16 * IMP_STRIDE;
    LAS unsigned* selm = (LAS unsigned*)(scv + 128);
    const size_t tb = (size_t)b * SEQ; const int t = q0 + c;
    const bf16* qrow = proj + (tb + t) * NPROJ;
    bf16x8 Qf[4][2];
#pragma unroll
    for (int qb = 0; qb < 4; ++qb)
#pragma unroll
        for (int ds = 0; ds < 2; ++ds) Qf[qb][ds] = ldg8(qrow + P_QB + (g * 4 + qb) * 64 + ds * 32 + kq * 8);
    float sl2[4];
#pragma unroll
    for (int qb = 0; qb < 4; ++qb) sl2[qb] = slope2_of(8 + g * 4 + qb);
    for (int i = lane; i < 16 * IMP_STRIDE; i += 64) imp[i] = 0.f;
    const int tmax = q0 + 15; const int nmax = tmax >= 31 ? ((tmax - 31) >> 4) : -1;
    Flash S; flash_init(S, -1.0e30f, -1.0e30f, -1.0e30f, -1.0e30f);
    for (int nbase = 0; nbase <= nmax; nbase += 32) {
        f32x4 Sv[2][4];
#pragma unroll
        for (int h = 0; h < 2; ++h) { const int nn = nbase + 8 * (c >> 2) + 4 * h + (c & 3); const bf16* kr = kcmp + (size_t)nn * 64 + kq * 8;
            const bf16x8 K0 = ldg8(kr), K1 = ldg8(kr + 32);
#pragma unroll
            for (int qb = 0; qb < 4; ++qb) { f32x4 a = mfma16(K0, Qf[qb][0], (f32x4){0.f, 0.f, 0.f, 0.f}); Sv[h][qb] = mfma16(K1, Qf[qb][1], a); } }
#pragma unroll
        for (int h = 0; h < 2; ++h)
#pragma unroll
            for (int r = 0; r < 4; ++r) { const int dist = t - 16 * (nbase + 8 * kq + 4 * h + r) - 31; const bool vis = dist >= 0; const float fd = (float)dist;
#pragma unroll
                for (int qb = 0; qb < 4; ++qb) Sv[h][qb][r] = vis ? Sv[h][qb][r] * SC2 - sl2[qb] * fd : -INFINITY; }
        bf16x8 Pf[4]; flash_step(S, Sv, Pf);
        flash_pv(S, vcmpT + (size_t)c * 512 + nbase + 8 * kq, 512, Pf);
    }
    float inv[4];
#pragma unroll
    for (int qb = 0; qb < 4; ++qb) { inv[qb] = flash_inv(S, qb, false, 0.f);
        const float sc = inv[qb] * sigmoidf_(bf2f(qrow[P_GB + (g * 4 + qb) * 3 + 0]));
        float* op = ocat + (tb + t) * DM + 512 + (g * 4 + qb) * 64 + 4 * kq;
#pragma unroll
        for (int db = 0; db < 4; ++db) { const f32x4 old = *(const GAS f32x4*)(op + 16 * db); *(GAS f32x4*)(op + 16 * db) = old + S.O[db][qb] * sc; } }
    LDS_WAIT();
    for (int nbase = 0; nbase <= nmax; nbase += 32) {
        f32x4 Sv[2][4];
#pragma unroll
        for (int h = 0; h < 2; ++h) { const int nn = nbase + 8 * (c >> 2) + 4 * h + (c & 3); const bf16* kr = kcmp + (size_t)nn * 64 + kq * 8;
            const bf16x8 K0 = ldg8(kr), K1 = ldg8(kr + 32);
#pragma unroll
            for (int qb = 0; qb < 4; ++qb) { f32x4 a = mfma16(K0, Qf[qb][0], (f32x4){0.f, 0.f, 0.f, 0.f}); Sv[h][qb] = mfma16(K1, Qf[qb][1], a); } }
        float G[2], Wl[2];
#pragma unroll
        for (int h = 0; h < 2; ++h) { float gs = 0.f, last = 0.f;
#pragma unroll
            for (int r = 0; r < 4; ++r) { const int dist = t - 16 * (nbase + 8 * kq + 4 * h + r) - 31; const bool vis = dist >= 0; const float fd = (float)dist; float pv = 0.f;
#pragma unroll
                for (int qb = 0; qb < 4; ++qb) pv += vis ? ex2(Sv[h][qb][r] * SC2 - sl2[qb] * fd - S.m[qb]) * inv[qb] : 0.f;
                gs += pv; last = pv; }
            G[h] = gs; Wl[h] = last; }
        const int j0 = (nbase >> 2) + 2 * kq;
        LAS float* ip = imp + c * IMP_STRIDE + j0;
        ip[0] += G[0]; LDS_WAIT();
        ip[1] += G[1]; LDS_WAIT();
        ip[1] += Wl[0]; LDS_WAIT();
        ip[2] += Wl[1]; LDS_WAIT();
    }
    unsigned long long ulo = 0ull, uhi = 0ull;
    for (int cq = 0; cq < 16; ++cq) {
        const int tq = q0 + cq, cur = tq >> 6;
        const int ja = lane, jb = lane + 64;
        float va = -1.0f, vb = -1.0f;
        if (ja <= cur) va = (ja == 0 || ja == cur || ja == cur - 1) ? 1.0e4f : imp[cq * IMP_STRIDE + ja];
        if (jb <= cur) vb = (jb == cur || jb == cur - 1) ? 1.0e4f : imp[cq * IMP_STRIDE + jb];
        scv[ja] = va; scv[jb] = vb; LDS_WAIT();
        int ra = 0, rb = 0;
        for (int jj = 0; jj <= cur; ++jj) { const float vj = scv[jj];
            ra += (vj > va || (vj == va && jj < ja)) ? 1 : 0; rb += (vj > vb || (vj == vb && jj < jb)) ? 1 : 0; }
        const unsigned long long mlo = __ballot(ja <= cur && ra < 16), mhi = __ballot(jb <= cur && rb < 16);
        ulo |= mlo; uhi |= mhi;
        if (lane == 0) { selm[cq * 4 + 0] = (unsigned)mlo; selm[cq * 4 + 1] = (unsigned)(mlo >> 32); selm[cq * 4 + 2] = (unsigned)mhi; selm[cq * 4 + 3] = (unsigned)(mhi >> 32); }
        LDS_WAIT();
    }
    const unsigned long long mylo = (unsigned long long)selm[c * 4 + 0] | ((unsigned long long)selm[c * 4 + 1] << 32);
    const unsigned long long myhi = (unsigned long long)selm[c * 4 + 2] | ((unsigned long long)selm[c * 4 + 3] << 32);
    flash_init(S, -1.0e30f, -1.0e30f, -1.0e30f, -1.0e30f);
    for (int j = tmax >> 6; j >= 0; --j) {
        const bool in_u = j < 64 ? ((ulo >> j) & 1ull) != 0ull : ((uhi >> (j - 64)) & 1ull) != 0ull;
        if (!in_u) continue;
        const bool mine = j < 64 ? ((mylo >> j) & 1ull) != 0ull : ((myhi >> (j - 64)) & 1ull) != 0ull;
#pragma unroll 1
        for (int hs = 0; hs < 2; ++hs) { const int kbase = 64 * j + 32 * hs;
            f32x4 Sv[2][4];
#pragma unroll
            for (int h = 0; h < 2; ++h) { const int key = kbase + 8 * (c >> 2) + 4 * h + (c & 3); const bf16* kr = proj + (tb + key) * NPROJ + P_KBS + g * 64 + kq * 8;
                const bf16x8 K0 = ldg8(kr), K1 = ldg8(kr + 32);
#pragma unroll
                for (int qb = 0; qb < 4; ++qb) { f32x4 a = mfma16(K0, Qf[qb][0], (f32x4){0.f, 0.f, 0.f, 0.f}); Sv[h][qb] = mfma16(K1, Qf[qb][1], a); } }
#pragma unroll
            for (int h = 0; h < 2; ++h)
#pragma unroll
                for (int r = 0; r < 4; ++r) { const int dist = t - (kbase + 8 * kq + 4 * h + r); const bool vis = mine && dist >= 0; const float fd = (float)dist;
#pragma unroll
                    for (int qb = 0; qb < 4; ++qb) Sv[h][qb][r] = vis ? Sv[h][qb][r] * SC2 - sl2[qb] * fd : -INFINITY; }
            bf16x8 Pf[4]; flash_step(S, Sv, Pf);
            flash_pv(S, vT + (size_t)(V_BS + g * 64 + c) * MTOK + tb + kbase + 8 * kq, MTOK, Pf); }
    }
#pragma unroll
    for (int qb = 0; qb < 4; ++qb) { const float sc = flash_inv(S, qb, false, 0.f) * sigmoidf_(bf2f(qrow[P_GB + (g * 4 + qb) * 3 + 1]));
        float* op = ocat + (tb + t) * DM + 512 + (g * 4 + qb) * 64 + 4 * kq;
#pragma unroll
        for (int db = 0; db < 4; ++db) { const f32x4 old = *(const GAS f32x4*)(op + 16 * db); *(GAS f32x4*)(op + 16 * db) = old + S.O[db][qb] * sc; } }
    LDS_WAIT();
}

__device__ __forceinline__ void attn1_phase(Frame& F, int l) {
    const int gw = F.vcu * NWAVES + F.wave, NGW = F.G * NWAVES;
    if (F.wave == 0) for (int u = F.vcu; u < 256; u += F.G) cmp_mlp_unit(F, l, u);
    for (int u = gw; u < 2048; u += NGW) win_unit<512, 1>(F, l, u >> 10, (u >> 9) & 1, (u & 511) * 16);
    for (int u = gw; u < 4096; u += NGW) sb_unit(F, u >> 11, (u >> 7) & 15, (u & 127) * 64);
    for (int u = gw; u < 2048; u += NGW) win_unit<128, 0>(F, l, u >> 10, (u >> 9) & 1, (u & 511) * 16);
}
__device__ __forceinline__ void attn2_phase(Frame& F) {
    const int gw = F.vcu * NWAVES + F.wave, NGW = F.G * NWAVES;
    for (int u = gw; u < 2048; u += NGW) nsa_unit(F, u >> 10, (u >> 9) & 1, (u & 511) * 16);
}
#ifndef MK_ONE_LAUNCH
#define MK_ONE_LAUNCH 1
#endif
#ifndef PHASE_MASK
#define PHASE_MASK 0xFFFF
#endif
constexpr int N_PHASES = 2 + 10 * DEPTH;
struct Args { const float* in[25]; float* out; unsigned char* ws; };
#define IN(k) (LO <= (k) && (k) < HI)
#define SEAM(k) do { if constexpr (IN(k) && IN((k) + 1)) xcd_barrier(bar); asm volatile("" : "+v"(F.tid), "+v"(F.lane) :: "memory"); } while (0)
template <int L, int LO, int HI>
__device__ __forceinline__ void layer_phases(Frame& F, const XcdBarrier& bar) {
    constexpr int l = L, pb = 2 + 10 * L;
    if constexpr (IN(pb + 0) && (PHASE_MASK & 4)) {
        pg8::Gemm g{(const pg8::bf16_t*)(wsp(F) + WS_HB), (const pg8::bf16_t*)(wsp(F) + WS_WIN), MTOK, NIN, DM}; pg8::StaticOrder S; S.init(MTOK, NIN, F.G, (int)blockIdx.x);
        pg8::EpiProj E{(pg8::bf16_t*)(wsp(F) + WS_PROJ), (pg8::bf16_t*)(wsp(F) + WS_VT), NPROJ, NT_ROW, MTOK};
        pg8::gemm_phase<pg8::EpiProj, pg8::StaticOrder, true, true>(F.lds + RING_OFF, g, S, E);
    }
    SEAM(pb + 0);
    if constexpr (IN(pb + 1) && (PHASE_MASK & 8)) attn1_phase(F, l);
    SEAM(pb + 1);
    if constexpr (IN(pb + 2) && (PHASE_MASK & 16)) attn2_phase(F);
    SEAM(pb + 2);
    if constexpr (IN(pb + 3) && (PHASE_MASK & 32)) merge_phase(F, l);
    SEAM(pb + 3);
    if constexpr (IN(pb + 4) && (PHASE_MASK & 64)) {
        const float* xin = (l == 0) ? inp(F, I_X) : (const float*)(wsp(F) + WS_XB);
        pg8::Gemm g{(const pg8::bf16_t*)(wsp(F) + WS_HB), (const pg8::bf16_t*)(wsp(F) + WS_WOUT), MTOK, DM, DM}; pg8::StaticOrder S; S.init(MTOK, DM, F.G, (int)blockIdx.x);
        pg8::EpiResid E{xin, (float*)(wsp(F) + WS_XA), (const float*)(wsp(F) + WS_MOD) + (size_t)l * NB * 6 * DM + 2 * DM, 6 * DM, SEQ, DM, ALPHA};
        pg8::gemm_phase<pg8::EpiResid, pg8::StaticOrder, true, true>(F.lds + RING_OFF, g, S, E);
    }
    SEAM(pb + 4);
    if constexpr (IN(pb + 5) && (PHASE_MASK & 128)) post_mixer_phase(F, l);
    SEAM(pb + 5);
    if constexpr (IN(pb + 6) && (PHASE_MASK & 256)) gather_phase(F, l);
    SEAM(pb + 6);
    if constexpr (IN(pb + 7) && (PHASE_MASK & 512)) {
        const int* gt = (const int*)(wsp(F) + WS_SMALL + SM_TILE);
        pg8::Gemm g{(const pg8::bf16_t*)(wsp(F) + WS_XS), (const pg8::bf16_t*)(wsp(F) + WS_WGU), MAXROWS, NEXP * 1024, DM};
        pg8::MoeOrder S{gt[200], 4, F.G, (int)blockIdx.x, gt};
        pg8::EpiSwiGLU E{(pg8::bf16_t*)(wsp(F) + WS_HID), DEXP};
        pg8::gemm_phase<pg8::EpiSwiGLU, pg8::MoeOrder, true, true>(F.lds + RING_OFF, g, S, E);
    }
    SEAM(pb + 7);
    if constexpr (IN(pb + 8) && (PHASE_MASK & 1024)) {
        const int* gt = (const int*)(wsp(F) + WS_SMALL + SM_TILE);
        pg8::Gemm g{(const pg8::bf16_t*)(wsp(F) + WS_HID), (const pg8::bf16_t*)(wsp(F) + WS_WD), MAXROWS, NEXP * DM, DEXP};
        pg8::MoeOrder S{gt[200], 8, F.G, (int)blockIdx.x, gt};
        pg8::EpiDown E{(pg8::bf16_t*)(wsp(F) + WS_YS), DM, (const int*)(wsp(F) + WS_SMALL + SM_ROWINFO), (const float*)(wsp(F) + WS_SMALL + SM_GATEW)};
        pg8::gemm_phase<pg8::EpiDown, pg8::MoeOrder, true, true>(F.lds + RING_OFF, g, S, E);
    }
    SEAM(pb + 8);
    if constexpr (IN(pb + 9) && (PHASE_MASK & 2048)) {
        post_moe_phase(F, l, (l == DEPTH - 1) ? outp(F) : (float*)(wsp(F) + WS_XB), l < DEPTH - 1);
        if (l < DEPTH - 1) convert_layer(F, l + 1);
    }
    SEAM(pb + 9);
}
template <int LO, int HI>
__global__ void __launch_bounds__(NWAVES * 64, 2) fwd_kernel(Args args) {
    extern __shared__ __attribute__((aligned(16))) unsigned char lds[];
    Frame F;
    F.lds = (LAS unsigned char*)lds;
    F.MISC = (volatile LAS unsigned*)(F.lds + MISC_OFF);
    F.tid = threadIdx.x; F.lane = F.tid & 63; F.wave = __builtin_amdgcn_readfirstlane(F.tid >> 6);
    F.G = gridDim.x; { const int bx = blockIdx.x; F.vcu = (F.G % 8 == 0) ? (bx % 8) * (F.G / 8) + bx / 8 : bx; }
    for (int u = F.tid; u < (LDS_BYTES - LDSCTL_OFF) / 4; u += NWAVES * 64) ((LAS unsigned*)(F.lds + LDSCTL_OFF))[u] = 0u;
    __syncthreads();
    if (F.tid < 25) ((LAS unsigned long long*)(F.lds + PTR_OFF))[F.tid] = (unsigned long long)args.in[F.tid];
    if (F.tid == 25) ((LAS unsigned long long*)(F.lds + PTR_OFF))[25] = (unsigned long long)args.ws;
    if (F.tid == 26) ((LAS unsigned long long*)(F.lds + PTR_OFF))[26] = (unsigned long long)args.out;
    __syncthreads();
    XcdBarrier bar; bar.bar = (unsigned*)(ctlp(F) + CW_BAR); bar.x = 0; bar.st = nullptr;
    if constexpr (HI - LO > 1) bar = xcd_barrier_post((unsigned*)(ctlp(F) + CW_BAR), F.MISC + 8);
    if constexpr (IN(0) && (PHASE_MASK & 1)) { ada_phase(F); convert_layer(F, 0); }
    SEAM(0);
    if constexpr (IN(1) && (PHASE_MASK & 2)) ln_in_phase(F);
    SEAM(1);
    layer_phases<0, LO, HI>(F, bar);
    layer_phases<1, LO, HI>(F, bar);
}
#undef IN
#undef SEAM

#if MK_ONE_LAUNCH
#define FWD_MAIN (fwd_kernel<0, N_PHASES>)
static bool set_lds_attr() { return hipFuncSetAttribute((const void*)FWD_MAIN, hipFuncAttributeMaxDynamicSharedMemorySize, LDS_BYTES) == hipSuccess; }
#else
#define FWD_MAIN (fwd_kernel<0, 1>)
template <int... P> static bool set_lds_attr_seq(std::integer_sequence<int, P...>) { bool ok = true; ((ok = ok && hipFuncSetAttribute((const void*)(fwd_kernel<P, P + 1>), hipFuncAttributeMaxDynamicSharedMemorySize, LDS_BYTES) == hipSuccess), ...); return ok; }
static bool set_lds_attr() { return set_lds_attr_seq(std::make_integer_sequence<int, N_PHASES>{}); }
template <int P> static void launch_one(int grid, hipStream_t stream, const Args& a) { hipLaunchKernelGGL((fwd_kernel<P, P + 1>), dim3(grid), dim3(NWAVES * 64), LDS_BYTES, stream, a); }
template <int... P> static void launch_phases(std::integer_sequence<int, P...>, int grid, hipStream_t stream, const Args& a) { (launch_one<P>(grid, stream, a), ...); }
#endif
extern "C" void kernel_launch(void* const* d_in, const int* in_sizes, int n_in, void* d_out, int out_size, void* d_ws, size_t ws_size, hipStream_t stream) {
    static int grid = 0;
    if (grid == 0) {
        if (n_in != 25 || out_size != MTOK * DM || ws_size < WS_END) { fprintf(stderr, "kernel_launch: unexpected problem shape (n_in %d, out %d, ws %zu)\n", n_in, out_size, ws_size); grid = -1; return; }
        int dev = 0, cus = 0, per_cu = 0;
        if (hipGetDevice(&dev) != hipSuccess || hipDeviceGetAttribute(&cus, hipDeviceAttributeMultiprocessorCount, dev) != hipSuccess) { grid = -1; return; }
        if (!set_lds_attr()) { fprintf(stderr, "kernel_launch: hipFuncSetAttribute failed\n"); grid = -1; return; }
        if (hipOccupancyMaxActiveBlocksPerMultiprocessor(&per_cu, (const void*)FWD_MAIN, NWAVES * 64, LDS_BYTES) != hipSuccess || per_cu < 1)
            fprintf(stderr, "kernel_launch: note: occupancy query reports %d workgroups per CU\n", per_cu);
        (void)hipGetLastError();
        grid = cus;
        if (grid > 256) grid = 256;
        grid &= ~7;
    }
    if (grid <= 0) return;
    (void)in_sizes;
    if (hipMemsetAsync((char*)d_ws + WS_CTL, 0, CTL_ZERO_BYTES, stream) != hipSuccess) return;
    Args a{};
    for (int i = 0; i < 25; ++i) a.in[i] = (const float*)d_in[i];
    a.out = (float*)d_out; a.ws = (unsigned char*)d_ws;
#if MK_ONE_LAUNCH
    hipLaunchKernelGGL((fwd_kernel<0, N_PHASES>), dim3(grid), dim3(NWAVES * 64), LDS_BYTES, stream, a);
#else
    launch_phases(std::make_integer_sequence<int, N_PHASES>{}, grid, stream, a);
#endif
}
```

```cpp
#include <hip/hip_runtime.h>
#include <cstdio>
#include <cstdint>
#include <utility>
#define MK_ONE_LAUNCH 1
namespace pg8 {
#define PG8_LAS __attribute__((address_space(3)))
typedef unsigned short bf16_t;
typedef short bf16x8 __attribute__((ext_vector_type(8)));
typedef float f32x4 __attribute__((ext_vector_type(4)));
typedef unsigned u32x4 __attribute__((ext_vector_type(4)));
constexpr int BM = 256, BK = 64, HALF = 128, HTB = HALF * BK * 2  , STAGE_BYTES = 8 * HTB, NXCD = 8, WGM = 8;

__host__ __device__ __forceinline__ int lds_byte(int r, int c) { const int st = (r >> 4) * 2 + (c >> 5), rr = r & 15, cc = c & 31, ob = rr * 64 + cc * 2; return st * 1024 + (ob ^ (((ob >> 9) & 1) << 5)); }
__host__ __device__ __forceinline__ void stage_rc(int b, int& R, int& C) { const int st = b / 1024, sb = b % 1024, swz = sb ^ (((sb >> 9) & 1) << 5); R = (st >> 1) * 16 + swz / 64; C = (st & 1) * 32 + (swz % 64) / 2; }
__host__ __device__ __forceinline__ int perm32(int rho) { const int n = rho >> 4, i = rho & 15; return 8 * (i >> 2) + 4 * n + (i & 3); }

struct Unit { int pm, pn; };
struct Gemm { const bf16_t* A; const bf16_t* Bt; int M, N, K; };

struct StaticOrder {
    int nM, nN, nwg, G, c;
    __host__ __device__ void init(int M, int N, int G_, int c_) { nM = M / BM; nN = N / BM; nwg = nM * nN; G = G_; c = c_; }
    __host__ __device__ bool next(int i, Unit& u) const {
        const long L = (long)i * G + c; if (L >= nwg) return false;
        int wgid = (int)L; { const int q = nwg / NXCD, r = nwg % NXCD, xcd = wgid % NXCD, off = wgid / NXCD; wgid = (xcd < r ? xcd * (q + 1) : r * (q + 1) + (xcd - r) * q) + off; }
        const int nig = WGM * nN, gid = wgid / nig, fm = gid * WGM, gsz = (nM - fm) < WGM ? (nM - fm) : WGM;
        u.pm = fm + ((wgid % nig) % gsz); u.pn = (wgid % nig) / gsz; return true;
    }
    __device__ __forceinline__ void a_ready(const Unit&) const {}
    __device__ __forceinline__ void done(const Unit&) const {}
};
__device__ __forceinline__ unsigned cvt_pk_bf16(float lo, float hi) { unsigned r; asm volatile("s_nop 0\n\tv_cvt_pk_bf16_f32 %0, %1, %2" : "=v"(r) : "v"(lo), "v"(hi));     return r; }
typedef float f32x2 __attribute__((ext_vector_type(2)));
__device__ __forceinline__ unsigned short f2bf_rne(float f) { unsigned u = __builtin_bit_cast(unsigned, f); return (unsigned short)((u + 0x7fffu + ((u >> 16) & 1u)) >> 16); }

struct EpiProj {
    static constexpr bool PERM = true, AFTER_DRAIN = false;
    bf16_t* P; bf16_t* VT; int ldp; int ldvt;
    __device__ __forceinline__ void operator()(const f32x4 (&acc)[2][2][4][2], const Unit& u, int wr, int wc, int fr, int fq) const {
        const int row0 = u.pm * BM + wr * 64 + fr;
#pragma unroll
        for (int bj = 0; bj < 2; ++bj) {
            const int cb = u.pn * BM + bj * HALF;
            if (cb < ldp) {
                bf16_t* colp = P + (size_t)row0 * ldp + cb + wc * 32 + 8 * fq;
#pragma unroll
                for (int ai = 0; ai < 2; ++ai)
#pragma unroll
                    for (int m = 0; m < 4; ++m) { const f32x4 v0 = acc[ai][bj][m][0], v1 = acc[ai][bj][m][1];
                        u32x4 w; w.x = cvt_pk_bf16(v0[0], v0[1]); w.y = cvt_pk_bf16(v0[2], v0[3]); w.z = cvt_pk_bf16(v1[0], v1[1]); w.w = cvt_pk_bf16(v1[2], v1[3]);
                        *(u32x4*)(colp + (size_t)(ai * HALF + m * 16) * ldp) = w; }
            } else {
                const int c0 = cb - ldp + wc * 32 + 8 * fq;
#pragma unroll
                for (int n = 0; n < 2; ++n)
#pragma unroll
                    for (int e = 0; e < 4; ++e) { bf16_t* cp = VT + (size_t)(c0 + n * 4 + e) * ldvt + row0;
#pragma unroll
                        for (int ai = 0; ai < 2; ++ai)
#pragma unroll
                            for (int m = 0; m < 4; ++m) cp[ai * HALF + m * 16] = f2bf_rne(acc[ai][bj][m][n][e]); }
            }
        }
    }
};

struct EpiResid {
    static constexpr bool PERM = false, AFTER_DRAIN = false;
    const float* xin; float* out; const float* gate0; int gate_bstride; int rows_per_batch; int ldc; float alpha;
    __device__ __forceinline__ void operator()(const f32x4 (&acc)[2][2][4][2], const Unit& u, int wr, int wc, int fr, int fq) const {
        const int col0 = u.pn * BM + wc * 32 + 4 * fq;
        const float* gv = gate0 + (size_t)((u.pm * BM) / rows_per_batch) * gate_bstride;
#pragma unroll
        for (int bj = 0; bj < 2; ++bj)
#pragma unroll
            for (int n = 0; n < 2; ++n) { const int c = col0 + bj * HALF + n * 16; const f32x4 g1 = *(const f32x4*)(gv + c) + 1.0f;
#pragma unroll
                for (int ai = 0; ai < 2; ++ai)
#pragma unroll
                    for (int m = 0; m < 4; ++m) { const size_t off = (size_t)(u.pm * BM + ai * HALF + wr * 64 + m * 16 + fr) * ldc + c;
                        const f32x4 xv = *(const f32x4*)(xin + off); *(f32x4*)(out + off) = xv * alpha + g1 * acc[ai][bj][m][n]; } }
    }
};

struct EpiSwiGLU {
    static constexpr bool PERM = true, AFTER_DRAIN = false;
    bf16_t* H; int ldh;
    __device__ __forceinline__ void operator()(const f32x4 (&acc)[2][2][4][2], const Unit& u, int wr, int wc, int fr, int fq) const {
        const int row0 = u.pm * BM + wr * 64 + fr, pnl = u.pn & 3;
        const int j0 = pnl * 128 + wc * 16 + 4 * fq;
#pragma unroll
        for (int ai = 0; ai < 2; ++ai)
#pragma unroll
            for (int m = 0; m < 4; ++m) { bf16_t* rowp = H + (size_t)(row0 + ai * HALF + m * 16) * ldh + j0;
#pragma unroll
                for (int bj = 0; bj < 2; ++bj) { const f32x4 v0 = acc[ai][bj][m][0], v1 = acc[ai][bj][m][1];
                    const float h0 = v0[0] / (1.0f + __expf(-v0[0])) * v0[1], h1 = v0[2] / (1.0f + __expf(-v0[2])) * v0[3];
                    const float h2 = v1[0] / (1.0f + __expf(-v1[0])) * v1[1], h3 = v1[2] / (1.0f + __expf(-v1[2])) * v1[3];
                    typedef unsigned u32x2 __attribute__((ext_vector_type(2)));
                    u32x2 w; w.x = cvt_pk_bf16(h0, h1); w.y = cvt_pk_bf16(h2, h3);
                    *(u32x2*)(rowp + bj * 64) = w; } }
    }
};

struct EpiDown {
    static constexpr bool PERM = true, AFTER_DRAIN = false;
    bf16_t* Y; int ldy; const int* rowinfo; const float* gatew;
    __device__ __forceinline__ void operator()(const f32x4 (&acc)[2][2][4][2], const Unit& u, int wr, int wc, int fr, int fq) const {
        const int row0 = u.pm * BM + wr * 64 + fr, pnl = u.pn & 7;
        const int col0 = pnl * BM + wc * 32 + 8 * fq;
#pragma unroll
        for (int ai = 0; ai < 2; ++ai)
#pragma unroll
            for (int m = 0; m < 4; ++m) { const int aid = rowinfo[row0 + ai * HALF + m * 16];
                if (aid >= 0) { const float gw = gatew[aid]; bf16_t* rowp = Y + (size_t)aid * ldy + col0;
#pragma unroll
                    for (int bj = 0; bj < 2; ++bj) { const f32x4 v0 = acc[ai][bj][m][0] * gw, v1 = acc[ai][bj][m][1] * gw;
                        u32x4 w; w.x = cvt_pk_bf16(v0[0], v0[1]); w.y = cvt_pk_bf16(v0[2], v0[3]); w.z = cvt_pk_bf16(v1[0], v1[1]); w.w = cvt_pk_bf16(v1[2], v1[3]);
                        *(u32x4*)(rowp + bj * HALF) = w; } } }
    }
};

struct MoeOrder {
    int ntiles, NT, G, c; const int* tile_e;
    __device__ __forceinline__ bool next(int i, Unit& u) const {
        const int x = c & 7, ci = c >> 3, per = G >> 3;
        const int q = i * per + ci, rt = x + 8 * (q / NT);
        if (rt >= ntiles) return false;
        u.pm = rt; u.pn = tile_e[rt] * NT + (q % NT); return true;
    }
    __device__ __forceinline__ void a_ready(const Unit&) const {}
    __device__ __forceinline__ void done(const Unit&) const {}
};
template <class Epi, class Sched, bool ALIGN_EPI = false, bool SP2 = false>
__device__ __forceinline__ void gemm_phase(PG8_LAS unsigned char* lds, const Gemm g, const Sched& S, const Epi& E) {
    int tid_ = threadIdx.x; asm volatile("" : "+v"(tid_));
    const int tid = tid_, wid = __builtin_amdgcn_readfirstlane(tid >> 6), lane = tid & 63, wr = wid >> 2, wc = wid & 3, fr = lane & 15, fq = lane >> 4;
    const int K = g.K, nt = K / BK;
    unsigned voffA[2], voffB[2];
#pragma unroll
    for (int i = 0; i < 2; ++i) { int R, C; stage_rc(tid * 16 + i * 8192, R, C); const int Rb = Epi::PERM ? ((R & ~31) + perm32(R & 31)) : R;
        voffA[i] = (unsigned)(R * K + C) * 2u; voffB[i] = (unsigned)(Rb * K + C) * 2u; }
    const size_t kstep = (size_t)(BK * 2);
    const size_t hstep = (size_t)HALF * K * 2;
    const size_t tstep = 2 * hstep;
    const unsigned ldsw = (unsigned)wid * 1024u;
    const int aoff = lds_byte(wr * 64 + fr, fq * 8), boff = lds_byte(wc * 32 + fr, fq * 8);
#define PG8_SA(b, h) (((b) * 2 + (h)) * HTB)
#define PG8_SB(b, h) ((4 + (b) * 2 + (h)) * HTB)
#define PG8_STAGE(bufoff, gbase, voff) do { _Pragma("unroll") for (int _i = 0; _i < 2; ++_i) \
        __builtin_amdgcn_global_load_lds((const unsigned*)((const char*)(gbase) + (voff)[_i]), (PG8_LAS unsigned*)(lds + (bufoff) + ldsw + _i * 8192), 16, 0, 0); } while (0)
#define PG8_LDA(dst, b, h) do { _Pragma("unroll") for (int m = 0; m < 4; ++m) _Pragma("unroll") for (int k = 0; k < 2; ++k) dst[m][k] = *(const PG8_LAS bf16x8*)(lds + PG8_SA(b, h) + aoff + m * 2048 + k * 1024); } while (0)
#define PG8_LDB(dst, b, h) do { _Pragma("unroll") for (int n = 0; n < 2; ++n) _Pragma("unroll") for (int k = 0; k < 2; ++k) dst[n][k] = *(const PG8_LAS bf16x8*)(lds + PG8_SB(b, h) + boff + n * 2048 + k * 1024); } while (0)
#define PG8_MMA(ai, bj, At, Bt) do { __builtin_amdgcn_s_setprio(1); _Pragma("unroll") for (int m = 0; m < 4; ++m) _Pragma("unroll") for (int n = 0; n < 2; ++n) _Pragma("unroll") for (int k = 0; k < 2; ++k) \
        acc[ai][bj][m][n] = __builtin_amdgcn_mfma_f32_16x16x32_bf16(Bt[n][k], At[m][k], acc[ai][bj][m][n], 0, 0, 0); __builtin_amdgcn_s_setprio(0); } while (0)
#define PG8_WAIT_V(n) asm volatile("s_waitcnt vmcnt(" #n ")" ::: "memory")
#define PG8_WAIT_L(n) asm volatile("s_waitcnt lgkmcnt(" #n ")" ::: "memory")
#define PG8_BAR __builtin_amdgcn_s_barrier()
#define PG8_SCHED __builtin_amdgcn_sched_barrier(0)
    Unit cur, nxt; int ui = 0;
    if (!S.next(0, cur)) return;
    f32x4 acc[2][2][4][2];
#pragma unroll
    for (int a = 0; a < 2; ++a)
#pragma unroll
        for (int b = 0; b < 2; ++b)
#pragma unroll
            for (int m = 0; m < 4; ++m)
#pragma unroll
                for (int n = 0; n < 2; ++n) acc[a][b][m][n] = (f32x4){0.f, 0.f, 0.f, 0.f};
    bf16x8 At[4][2], B0[2][2], B1[2][2];
    const char* cA = (const char*)g.A + (size_t)cur.pm * tstep; const char* cB = (const char*)g.Bt + (size_t)cur.pn * tstep;
    S.a_ready(cur);
    if constexpr (SP2) {
        PG8_STAGE(PG8_SB(0, 0), cB, voffB); PG8_STAGE(PG8_SB(0, 1), cB + hstep, voffB); PG8_STAGE(PG8_SA(0, 0), cA, voffA); PG8_STAGE(PG8_SA(0, 1), cA + hstep, voffA);
        if (wr == 1) PG8_BAR;
        PG8_WAIT_V(2); PG8_BAR;
        PG8_STAGE(PG8_SB(1, 0), cB + kstep, voffB); PG8_STAGE(PG8_SA(1, 0), cA + kstep, voffA); PG8_STAGE(PG8_SB(1, 1), cB + hstep + kstep, voffB);
        PG8_WAIT_V(6); PG8_BAR;
    } else {
        PG8_STAGE(PG8_SB(0, 0), cB, voffB); PG8_STAGE(PG8_SA(0, 0), cA, voffA); PG8_STAGE(PG8_SB(0, 1), cB + hstep, voffB); PG8_STAGE(PG8_SA(0, 1), cA + hstep, voffA);
        if (wr == 1) PG8_BAR;
        PG8_WAIT_V(4); PG8_BAR;
        PG8_STAGE(PG8_SB(1, 0), cB + kstep, voffB); PG8_STAGE(PG8_SA(1, 0), cA + kstep, voffA); PG8_STAGE(PG8_SB(1, 1), cB + hstep + kstep, voffB);
        PG8_WAIT_V(6); PG8_BAR;
    }
    for (;;) {
        const bool has_next = S.next(ui + 1, nxt);
        const char* nA = has_next ? (const char*)g.A + (size_t)nxt.pm * tstep : cA; const char* nB = has_next ? (const char*)g.Bt + (size_t)nxt.pn * tstep : cB;
        for (int t = 0; t < nt; t += 2) {
            const bool last = (t == nt - 2);
            const char* a1 = cA + (size_t)(t + 1) * kstep;
            const char* a2 = last ? nA : cA + (size_t)(t + 2) * kstep; const char* b2 = last ? nB : cB + (size_t)(t + 2) * kstep;
            const char* a3 = a2 + kstep; const char* b3 = b2 + kstep;
            if (last && has_next) S.a_ready(nxt);
            if constexpr (SP2) {
            PG8_LDB(B0, 0, 0); PG8_LDB(B1, 0, 1); PG8_SCHED; PG8_LDA(At, 0, 0); PG8_STAGE(PG8_SA(1, 1), a1 + hstep, voffA);
            PG8_WAIT_V(8); PG8_WAIT_L(0); PG8_BAR; PG8_MMA(0, 0, At, B0); PG8_MMA(0, 1, At, B1); PG8_BAR; PG8_SCHED;
            PG8_LDA(At, 0, 1); PG8_STAGE(PG8_SB(0, 0), b2, voffB); PG8_STAGE(PG8_SB(0, 1), b2 + hstep, voffB); PG8_STAGE(PG8_SA(0, 0), a2, voffA);
            PG8_WAIT_V(8); PG8_WAIT_L(0); PG8_BAR; PG8_MMA(1, 0, At, B0); PG8_MMA(1, 1, At, B1); PG8_BAR; PG8_SCHED;
            PG8_LDB(B0, 1, 0); PG8_LDB(B1, 1, 1); PG8_SCHED; PG8_LDA(At, 1, 0); PG8_STAGE(PG8_SA(0, 1), a2 + hstep, voffA);
            PG8_WAIT_V(8); PG8_WAIT_L(0); PG8_BAR; PG8_MMA(0, 0, At, B0); PG8_MMA(0, 1, At, B1); PG8_BAR; PG8_SCHED;
            PG8_LDA(At, 1, 1); PG8_STAGE(PG8_SB(1, 0), b3, voffB); PG8_STAGE(PG8_SB(1, 1), b3 + hstep, voffB); PG8_STAGE(PG8_SA(1, 0), a3, voffA);
            PG8_WAIT_V(8); PG8_WAIT_L(0); PG8_BAR; PG8_MMA(1, 0, At, B0); PG8_MMA(1, 1, At, B1); PG8_BAR; PG8_SCHED;
            } else {
            PG8_LDB(B0, 0, 0); PG8_SCHED; PG8_LDA(At, 0, 0); PG8_STAGE(PG8_SA(1, 1), a1 + hstep, voffA);
            PG8_WAIT_L(8); PG8_BAR; PG8_WAIT_L(0); PG8_MMA(0, 0, At, B0); PG8_BAR; PG8_SCHED;
            PG8_LDB(B1, 0, 1); PG8_STAGE(PG8_SB(0, 0), b2, voffB);
            PG8_BAR; PG8_WAIT_L(0); PG8_MMA(0, 1, At, B1); PG8_BAR;
            PG8_LDA(At, 0, 1); PG8_STAGE(PG8_SA(0, 0), a2, voffA);
            PG8_BAR; PG8_WAIT_L(0); PG8_MMA(1, 0, At, B0); PG8_BAR; PG8_SCHED;
            PG8_STAGE(PG8_SB(0, 1), b2 + hstep, voffB);
            PG8_WAIT_V(6); PG8_BAR; PG8_MMA(1, 1, At, B1); PG8_BAR;
            PG8_LDB(B0, 1, 0); PG8_SCHED; PG8_LDA(At, 1, 0); PG8_STAGE(PG8_SA(0, 1), a2 + hstep, voffA);
            PG8_WAIT_L(8); PG8_BAR; PG8_WAIT_L(0); PG8_MMA(0, 0, At, B0); PG8_BAR; PG8_SCHED;
            PG8_LDB(B1, 1, 1); PG8_STAGE(PG8_SB(1, 0), b3, voffB);
            PG8_BAR; PG8_WAIT_L(0); PG8_MMA(0, 1, At, B1); PG8_BAR;
            PG8_LDA(At, 1, 1); PG8_STAGE(PG8_SA(1, 0), a3, voffA);
            PG8_BAR; PG8_WAIT_L(0); PG8_MMA(1, 0, At, B0); PG8_BAR; PG8_SCHED;
            PG8_STAGE(PG8_SB(1, 1), b3 + hstep, voffB);
            PG8_WAIT_V(6); PG8_BAR; PG8_MMA(1, 1, At, B1); PG8_BAR;
            }
        }
        if constexpr (ALIGN_EPI) { if (wr == 0) PG8_BAR; }
        if constexpr (!Epi::AFTER_DRAIN) { E(acc, cur, wr, wc, fr, fq); S.done(cur); }
        if (!has_next) break;
#pragma unroll
        for (int a = 0; a < 2; ++a)
#pragma unroll
            for (int b = 0; b < 2; ++b)
#pragma unroll
                for (int m = 0; m < 4; ++m)
#pragma unroll
                    for (int n = 0; n < 2; ++n) acc[a][b][m][n] = (f32x4){0.f, 0.f, 0.f, 0.f};
        cur = nxt; cA = nA; cB = nB; ++ui;
        if constexpr (ALIGN_EPI) { if (wr == 1) PG8_BAR; }
    }
    PG8_WAIT_V(0);
    if constexpr (!ALIGN_EPI) { if (wr == 0) PG8_BAR; }
    PG8_BAR;
    if constexpr (Epi::AFTER_DRAIN) { E.fused(acc, cur, wr, wc, fr, fq, lds, wid, lane); S.done(cur); }
#undef PG8_SA
#undef PG8_SB
#undef PG8_STAGE
#undef PG8_LDA
#undef PG8_LDB
#undef PG8_MMA
#undef PG8_WAIT_V
#undef PG8_WAIT_L
#undef PG8_BAR
#undef PG8_SCHED
}
}
constexpr int NWAVES = 8;
constexpr int NB = 2, SEQ = 8192, DM = 2048, MTOK = NB * SEQ, DEPTH = 2, HD = 64;
constexpr int NEXP = 32, DEXP = 512, NASSIGN = MTOK * 2;
constexpr int D_IN = 5144;
constexpr int NPROJ = 3712, NVT = 1408, NIN = NPROJ + NVT;
constexpr int P_QA = 0, P_KA = 512, P_QB = 640, P_KBC = 1152, P_VBC = 1280, P_KBS = 1408, P_KBW = 1536, P_QC = 1664, P_KC = 2688;
constexpr int V_C = 0, V_A = 1024, V_BS = 1152, V_BW = 1280;
constexpr float LN_EPS = 1e-5f, RMS_EPS = 1e-6f, ALPHA = 1.41421356237309515f;
constexpr float LOG2E = 1.44269504088896341f, LN2 = 0.693147180559945309f;
constexpr float SC2 = 0.125f * LOG2E;
constexpr int MAXROWS = 40960;
constexpr float SB_EXIT = -104.0f;

constexpr size_t MiB = 1u << 20;
constexpr size_t WS_CTL = 0, CTL_ZERO_BYTES = 1 * MiB;
constexpr size_t WS_MOD = 1 * MiB;
constexpr size_t WS_SMALL = 2 * MiB;
constexpr size_t WS_LIST = 5 * MiB;
constexpr size_t WS_WCMP = 7 * MiB;
constexpr size_t WS_WIN = 9 * MiB;
constexpr size_t WS_WOUT = 30 * MiB;
constexpr size_t WS_WGU = 38 * MiB;
constexpr size_t WS_WD = 166 * MiB;
constexpr size_t WS_XA = 230 * MiB;
constexpr size_t WS_XB = 358 * MiB;
constexpr size_t WS_HB = 486 * MiB;
constexpr size_t WS_PROJ = 550 * MiB;
constexpr size_t WS_VT = WS_PROJ + (size_t)MTOK * NPROJ * 2;
constexpr size_t WS_XS = WS_PROJ;
constexpr size_t WS_OCAT = 720 * MiB;
constexpr size_t WS_YS = WS_OCAT;
constexpr size_t WS_HID = 848 * MiB;
constexpr size_t WS_END = 888 * MiB;
static_assert(WS_VT + (size_t)NVT * MTOK * 2 <= WS_OCAT && WS_XS + (size_t)MAXROWS * DM * 2 <= WS_OCAT, "proj/vT/xs region");
static_assert(WS_WIN + (size_t)NIN * DM * 2 <= WS_WOUT && WS_WGU + (size_t)NEXP * 1024 * DM * 2 <= WS_WD && WS_WD + (size_t)NEXP * DM * DEXP * 2 <= WS_XA, "weight regions");
constexpr size_t SM_KCMP = 0;
constexpr size_t SM_VCMPT = 256 * 1024;
constexpr size_t SM_GATEW = 512 * 1024;
constexpr size_t SM_ROWINFO = 640 * 1024;
constexpr size_t SM_TILE = 800 * 1024;
constexpr size_t WS_GBUF = WS_SMALL + 1024 * 1024;
constexpr int CW_BAR = 4096;
constexpr int CW_CNT = 16384;

constexpr int RING_OFF = 0, RING_BYTES = 131072;
constexpr int LDSCTL_OFF = 143360, MISC_OFF = LDSCTL_OFF + 320;
constexpr int LDS_BYTES = 147456;

#define GAS __attribute__((address_space(1)))
#define LAS __attribute__((address_space(3)))
typedef unsigned short bf16;
typedef unsigned v4u __attribute__((ext_vector_type(4)));
typedef unsigned v2u __attribute__((ext_vector_type(2)));
typedef float f32x4 __attribute__((ext_vector_type(4)));
typedef short bf16x8 __attribute__((ext_vector_type(8)));
typedef GAS unsigned gu32;
#define RLX_AGENT __ATOMIC_RELAXED, __HIP_MEMORY_SCOPE_AGENT
#define LDS_WAIT() asm volatile("s_waitcnt lgkmcnt(0)" ::: "memory")
#define VM_WAIT() asm volatile("s_waitcnt vmcnt(0)" ::: "memory")
__device__ __forceinline__ unsigned f2bf(float f) { unsigned u = __builtin_bit_cast(unsigned, f); return (u + 0x7fffu + ((u >> 16) & 1u)) >> 16; }
__device__ __forceinline__ unsigned pk2(float lo, float hi) { return f2bf(lo) | (f2bf(hi) << 16); }
__device__ __forceinline__ float bf2f(unsigned short h) { return __builtin_bit_cast(float, (unsigned)h << 16); }
__device__ __forceinline__ float bflo(unsigned w) { return __builtin_bit_cast(float, w << 16); }
__device__ __forceinline__ float bfhi(unsigned w) { return __builtin_bit_cast(float, w & 0xffff0000u); }
__device__ __forceinline__ float ex2(float x) { return __builtin_amdgcn_exp2f(x); }
__device__ __forceinline__ float lg2(float x) { return __builtin_amdgcn_logf(x); }
__device__ __forceinline__ bf16x8 ldg8(const bf16* p) { return *(const GAS bf16x8*)p; }
__device__ __forceinline__ f32x4 mfma16(bf16x8 a, bf16x8 b, f32x4 c) { return __builtin_amdgcn_mfma_f32_16x16x32_bf16(a, b, c, 0, 0, 0); }
__device__ __forceinline__ bf16x8 pack8(float a0, float a1, float a2, float a3, float a4, float a5, float a6, float a7) {
    v4u w; w.x = pg8::cvt_pk_bf16(a0, a1); w.y = pg8::cvt_pk_bf16(a2, a3); w.z = pg8::cvt_pk_bf16(a4, a5); w.w = pg8::cvt_pk_bf16(a6, a7);
    return __builtin_bit_cast(bf16x8, w);
}
__device__ __forceinline__ float wave_sum(float v) {
#pragma unroll
    for (int o = 1; o < 64; o <<= 1) v += __shfl_xor(v, o);
    return v;
}
#define XB_TMO      128
#define XB_XCNT(j)  (256  + 64 * (j))
#define XB_XSUB(j)  (1280 + 64 * (j))
#define XB_XGEN(j)  (2304 + 64 * (j))
#define XB_TOP      3328
#define XB_TOPGEN   3392
#define XCD_BAR_WORDS 3456
#define XB_SPIN_CAP (1u << 18)

__device__ __forceinline__ unsigned xb_ld(unsigned* p)              { return __hip_atomic_load(p, __ATOMIC_RELAXED, __HIP_MEMORY_SCOPE_AGENT); }
__device__ __forceinline__ unsigned xb_add(unsigned* p, unsigned v) { return __hip_atomic_fetch_add(p, v, __ATOMIC_RELAXED, __HIP_MEMORY_SCOPE_AGENT); }
__device__ __forceinline__ unsigned xb_xcc_id() { return (unsigned)__builtin_amdgcn_s_getreg((3 << 11) | 20) & 0xFu; }
#define XB_SPIN(cond, bar) do { unsigned _sp = 0; while (cond) { __builtin_amdgcn_s_sleep(1); \
    if ((++_sp & 255u) == 0u) { if (xb_ld(&(bar)[XB_TMO])) break; if (_sp > XB_SPIN_CAP) { atomicAdd(&(bar)[XB_TMO], 1u); break; } } } } while (0)

struct XcdBarrier {
    unsigned* bar; unsigned x;
    volatile LAS unsigned* st;
};

__device__ __forceinline__ XcdBarrier xcd_barrier_post(unsigned* bar, volatile LAS unsigned* st) {
    XcdBarrier b; b.bar = bar; b.x = xb_xcc_id(); b.st = st;
    if (threadIdx.x == 0) (void)xb_add(&bar[XB_XCNT(b.x)], 1u);
    return b;
}
__device__ __forceinline__ void xcd_barrier_complete(unsigned* bar, unsigned x, unsigned& nloc, unsigned& nx) {
    const unsigned G = gridDim.x * gridDim.y * gridDim.z;
    unsigned sum, cnt, mine, sp = 0u;
    for (;;) {
        sum = 0u; cnt = 0u; mine = 0u;
#pragma unroll
        for (unsigned j = 0; j < 16; ++j) { const unsigned c = xb_ld(&bar[XB_XCNT(j)]); sum += c; cnt += (c > 0u) ? 1u : 0u; mine = (j == x) ? c : mine; }
        if (sum == G) break;
        __builtin_amdgcn_s_sleep(1);
        if ((++sp & 255u) == 0u) { if (xb_ld(&bar[XB_TMO])) break; if (sp > XB_SPIN_CAP) { atomicAdd(&bar[XB_TMO], 1u); break; } }
    }
    nloc = mine > 0u ? mine : 1u; nx = cnt > 0u ? cnt : 1u;
}

__device__ __forceinline__ void xcd_barrier(const XcdBarrier& b) {
    asm volatile("s_waitcnt vmcnt(0)" ::: "memory");
    __syncthreads();
    if (threadIdx.x == 0) {
        unsigned* bar = b.bar;
        __builtin_amdgcn_s_waitcnt(0);
        unsigned nloc = b.st[0], nx = b.st[1];
        if (nloc == 0u) { xcd_barrier_complete(bar, b.x, nloc, nx); b.st[0] = nloc; b.st[1] = nx; }
        const unsigned old = xb_add(&bar[XB_XSUB(b.x)], 1u);
        const unsigned gen = old / nloc;
        if (old + 1u == (gen + 1u) * nloc) {
            __builtin_amdgcn_fence(__ATOMIC_RELEASE, "agent");
            asm volatile("s_waitcnt vmcnt(0)" ::: "memory");
            const unsigned og = xb_add(&bar[XB_TOP], 1u);
            const unsigned tg = og / nx;
            if (og + 1u == (tg + 1u) * nx) xb_add(&bar[XB_TOPGEN], 1u);
            else XB_SPIN(xb_ld(&bar[XB_TOPGEN]) == tg, bar);
            __builtin_amdgcn_fence(__ATOMIC_ACQUIRE, "agent");
            xb_add(&bar[XB_XGEN(b.x)], 1u);
            asm volatile("s_waitcnt vmcnt(0)" ::: "memory");
        } else {
            XB_SPIN(xb_ld(&bar[XB_XGEN(b.x)]) == gen, bar);
            __builtin_amdgcn_fence(__ATOMIC_ACQUIRE, "agent");
            asm volatile("s_waitcnt vmcnt(0)" ::: "memory");
        }
    }
    __syncthreads();
}
struct Frame {
    LAS unsigned char* lds;
    volatile LAS unsigned* MISC;
    int tid, lane, wave;
    int vcu, G;
};
constexpr int PTR_OFF = LDSCTL_OFF + 1024;
__device__ __forceinline__ unsigned char* tabp(const Frame& F, int i) {
    const unsigned long long v = ((LAS unsigned long long*)(F.lds + PTR_OFF))[i];
    const unsigned lo = __builtin_amdgcn_readfirstlane((unsigned)v), hi = __builtin_amdgcn_readfirstlane((unsigned)(v >> 32));
    return (unsigned char*)(((unsigned long long)hi << 32) | lo);
}
__device__ __forceinline__ const float* inp(const Frame& F, int i) { return (const float*)tabp(F, i); }
__device__ __forceinline__ unsigned char* wsp(const Frame& F) { return tabp(F, 25); }
__device__ __forceinline__ float* outp(const Frame& F) { return (float*)tabp(F, 26); }
__device__ __forceinline__ gu32* ctlp(const Frame& F) { return (gu32*)(tabp(F, 25) + WS_CTL); }
enum { I_X = 0, I_C, I_WADA, I_BADA, I_WIN, I_SINKS, I_PEK, I_W1K, I_W2K, I_PEV, I_W1V, I_W2V, I_MIXG, I_WOUT, I_LN1G, I_LN1B, I_WRG, I_BRG, I_WRE, I_BRE, I_WGATE, I_WUP, I_WDOWN, I_LN2G, I_LN2B };

__device__ __forceinline__ void ada_phase(Frame& F) {
    LAS float* cs = (LAS float*)(F.lds + 73728);
    LAS float* red = (LAS float*)(F.lds + 73728 + 16384);
    const float* c = inp(F, I_C);
    for (int i = F.tid; i < NB * DM; i += NWAVES * 64) { const float v = c[i]; cs[i] = v / (1.0f + __expf(-v)); }
    __syncthreads();
    float* mod = (float*)(wsp(F) + WS_MOD);
    for (int u = F.vcu; u < DEPTH * 96; u += F.G) {
        const int l = u / 96, cb = u % 96, col = cb * 128 + 2 * F.lane;
        const float* W = inp(F, I_WADA) + (size_t)l * DM * (6 * DM) + col;
        float a00 = 0.f, a01 = 0.f, a10 = 0.f, a11 = 0.f;
        const int k0 = F.wave * 256;
#pragma unroll 8
        for (int kk = 0; kk < 256; ++kk) { const int k = k0 + kk; typedef float f32x2_ __attribute__((ext_vector_type(2))); const f32x2_ w = *(const GAS f32x2_*)(W + (size_t)k * (6 * DM));
            const float s0 = cs[k], s1 = cs[DM + k]; a00 += s0 * w.x; a01 += s0 * w.y; a10 += s1 * w.x; a11 += s1 * w.y; }
        red[(F.wave * 2 + 0) * 128 + 2 * F.lane] = a00; red[(F.wave * 2 + 0) * 128 + 2 * F.lane + 1] = a01;
        red[(F.wave * 2 + 1) * 128 + 2 * F.lane] = a10; red[(F.wave * 2 + 1) * 128 + 2 * F.lane + 1] = a11;
        __syncthreads();
        if (F.tid < 256) { const int b = F.tid >> 7, j = F.tid & 127; float s = 0.f;
#pragma unroll
            for (int w = 0; w < 8; ++w) s += red[(w * 2 + b) * 128 + j];
            mod[((size_t)l * NB + b) * (6 * DM) + cb * 128 + j] = s + inp(F, I_BADA)[(size_t)l * 6 * DM + cb * 128 + j]; }
        __syncthreads();
    }
}

__device__ __forceinline__ void tr_item(const float* W, int ldw, int K, bf16* WT, size_t drow0, int rs, int src0, int nvalid, int k0, LAS float* scr, int lane) {
    const int nn = lane & 31;
#pragma unroll 8
    for (int i = 0; i < 32; ++i) { const int kk = 2 * i + (lane >> 5);
        scr[kk * 33 + nn] = (nn < nvalid) ? *(const GAS float*)(W + (size_t)(k0 + kk) * ldw + src0 + nn) : 0.f; }
    LDS_WAIT(); asm volatile("" ::: "memory");
    const int c = lane & 7;
#pragma unroll
    for (int j = 0; j < 4; ++j) { const int n = (lane >> 3) + 8 * j; const LAS float* s = scr + (8 * c) * 33 + n;
        v4u o; o.x = pk2(s[0 * 33], s[1 * 33]); o.y = pk2(s[2 * 33], s[3 * 33]); o.z = pk2(s[4 * 33], s[5 * 33]); o.w = pk2(s[6 * 33], s[7 * 33]);
        *(GAS v4u*)(WT + (drow0 + (size_t)n * rs) * K + k0 + 8 * c) = o; }
    LDS_WAIT(); asm volatile("" ::: "memory");
}
__device__ __forceinline__ int win_src(int n0) {
    if (n0 < 512) return n0;
    if (n0 < 640) return 512 + (n0 - 512);
    if (n0 < 1152) return 768 + (n0 - 640);
    if (n0 < 1280) return 1280 + (n0 - 1152);
    if (n0 < 1408) return 1408 + (n0 - 1280);
    if (n0 < 1536) return 1536 + (n0 - 1408);
    if (n0 < 1664) return 1792 + (n0 - 1536);
    if (n0 < 2688) return 2072 + (n0 - 1664);
    if (n0 < 3712) return 3096 + (n0 - 2688);
    if (n0 < 4736) return 4120 + (n0 - 3712);
    if (n0 < 4864) return 640 + (n0 - 4736);
    if (n0 < 4992) return 1664 + (n0 - 4864);
    return 1920 + (n0 - 4992);
}
__device__ __forceinline__ void convert_layer(Frame& F, int l) {
    LAS float* scr = (LAS float*)(F.lds + F.wave * 8704);
    const int gw = F.vcu * NWAVES + F.wave, NGW = F.G * NWAVES;
    constexpr int I_A = 32 * (NIN / 32), I_B = 32 * 64, I_G = NEXP * 512, I_U = NEXP * 512, I_D = NEXP * 512, I_1 = 128, I_2 = 4;
    constexpr int I_GB = 32;
    constexpr int NITEMS = I_A + I_B + I_G + I_U + I_D + 2 * I_1 + 2 * I_2 + I_GB;
    bf16* Win_t = (bf16*)(wsp(F) + WS_WIN); bf16* Wout_t = (bf16*)(wsp(F) + WS_WOUT); bf16* Wgu_t = (bf16*)(wsp(F) + WS_WGU); bf16* Wd_t = (bf16*)(wsp(F) + WS_WD);
    bf16* W1t = (bf16*)(wsp(F) + WS_WCMP); bf16* W2t = (bf16*)(wsp(F) + WS_WCMP + 2 * 128 * 2048 * 2);
    for (int it = gw; it < NITEMS; it += NGW) {
        int r = it;
        if (r < I_A) { const int nblk = NIN / 32, kb = r / nblk, nb = r % nblk;
            tr_item(inp(F, I_WIN) + (size_t)l * DM * D_IN, D_IN, DM, Win_t, (size_t)nb * 32, 1, win_src(nb * 32), 32, kb * 64, scr, F.lane); continue; } r -= I_A;
        if (r < I_B) { const int kb = r / 64, nb = r % 64;
            tr_item(inp(F, I_WOUT) + (size_t)l * DM * DM, DM, DM, Wout_t, (size_t)nb * 32, 1, nb * 32, 32, kb * 64, scr, F.lane); continue; } r -= I_B;
        if (r < I_G) { const int e = r / 512, q = r % 512, kb = q / 16, nb = q % 16;
            tr_item(inp(F, I_WGATE) + ((size_t)l * NEXP + e) * DM * DEXP, DEXP, DM, Wgu_t, (size_t)e * 1024 + nb * 64, 2, nb * 32, 32, kb * 64, scr, F.lane); continue; } r -= I_G;
        if (r < I_U) { const int e = r / 512, q = r % 512, kb = q / 16, nb = q % 16;
            tr_item(inp(F, I_WUP) + ((size_t)l * NEXP + e) * DM * DEXP, DEXP, DM, Wgu_t, (size_t)e * 1024 + nb * 64 + 1, 2, nb * 32, 32, kb * 64, scr, F.lane); continue; } r -= I_U;
        if (r < I_D) { const int e = r / 512, q = r % 512, kb = q / 64, nb = q % 64;
            tr_item(inp(F, I_WDOWN) + ((size_t)l * NEXP + e) * DEXP * DM, DM, DEXP, Wd_t, (size_t)e * DM + nb * 32, 1, nb * 32, 32, kb * 64, scr, F.lane); continue; } r -= I_D;
        if (r < 2 * I_1) { const int kv = r / I_1, q = r % I_1, kb = q / 4, nb = q % 4;
            tr_item(inp(F, kv ? I_W1V : I_W1K) + (size_t)l * 2048 * 128, 128, 2048, W1t + (size_t)kv * 128 * 2048, (size_t)nb * 32, 1, nb * 32, 32, kb * 64, scr, F.lane); continue; } r -= 2 * I_1;
        if (r >= 2 * I_2) { r -= 2 * I_2; tr_item(inp(F, I_WIN) + (size_t)l * DM * D_IN, D_IN, DM, (bf16*)(wsp(F) + WS_WCMP + 1024 * 1024 + 64 * 1024), 0, 1, 2048, 24, r * 64, scr, F.lane); continue; }
        { const int kv = r / I_2, q = r % I_2, kb = q / 2, nb = q % 2;
            tr_item(inp(F, kv ? I_W2V : I_W2K) + (size_t)l * 128 * 64, 64, 128, W2t + (size_t)kv * 64 * 128, (size_t)nb * 32, 1, nb * 32, 32, kb * 64, scr, F.lane); }
    }
    { bf16* Whi = (bf16*)(wsp(F) + WS_WCMP + 1536 * 1024); bf16* Wlo = Whi + 48 * 2048;
      const float* wrg = inp(F, I_WRG) + (size_t)l * DM * 4; const float* wre = inp(F, I_WRE) + (size_t)l * 4 * DM * 8;
      for (int i = gw * 64 + F.lane; i < 48 * 2048; i += NGW * 64) { const int row = i >> 11, k = i & 2047; float v = 0.f;
          if (row < 4) v = wrg[k * 4 + row]; else if (row < 36) { const int g = (row - 4) >> 3, e = (row - 4) & 7; v = wre[((size_t)g * DM + k) * 8 + e]; }
          const unsigned hi = f2bf(v); Whi[i] = (bf16)hi; Wlo[i] = (bf16)f2bf(v - bf2f((unsigned short)hi)); } }
}

struct Row { f32x4 v[8]; };
__device__ __forceinline__ void row_load(Row& r, const float* p, int lane) {
#pragma unroll
    for (int j = 0; j < 8; ++j) r.v[j] = *((const GAS f32x4*)p + lane + 64 * j);
}
__device__ __forceinline__ void row_store(const Row& r, float* p, int lane) {
#pragma unroll
    for (int j = 0; j < 8; ++j) *((GAS f32x4*)p + lane + 64 * j) = r.v[j];
}
__device__ __forceinline__ void row_store_bf16(const Row& r, bf16* p, int lane) {
#pragma unroll
    for (int j = 0; j < 8; ++j) { v2u w; w.x = pk2(r.v[j].x, r.v[j].y); w.y = pk2(r.v[j].z, r.v[j].w); *((GAS v2u*)p + lane + 64 * j) = w; }
}
__device__ __forceinline__ void row_normalize(Row& r) {
    float s = 0.f;
#pragma unroll
    for (int j = 0; j < 8; ++j) s += (r.v[j].x + r.v[j].y) + (r.v[j].z + r.v[j].w);
    const float mean = wave_sum(s) * (1.0f / DM); float s2 = 0.f;
#pragma unroll
    for (int j = 0; j < 8; ++j) { r.v[j] = r.v[j] - mean; s2 += (r.v[j].x * r.v[j].x + r.v[j].y * r.v[j].y) + (r.v[j].z * r.v[j].z + r.v[j].w * r.v[j].w); }
    const float rstd = 1.0f / sqrtf(wave_sum(s2) * (1.0f / DM) + LN_EPS);
#pragma unroll
    for (int j = 0; j < 8; ++j) r.v[j] = r.v[j] * rstd;
}
__device__ __forceinline__ void row_affine(Row& r, const float* a, float add1, const float* b, int lane) {
#pragma unroll
    for (int j = 0; j < 8; ++j) { const f32x4 av = *((const GAS f32x4*)a + lane + 64 * j) + add1, bv = *((const GAS f32x4*)b + lane + 64 * j); r.v[j] = r.v[j] * av + bv; }
}
__device__ __forceinline__ const float* modp(Frame& F, int l, int b, int which) { return (const float*)(wsp(F) + WS_MOD) + ((size_t)l * NB + b) * (6 * DM) + which * DM; }

__device__ __forceinline__ void ln_in_phase(Frame& F) {
    const int gw = F.vcu * NWAVES + F.wave, NGW = F.G * NWAVES;
    bf16* hb = (bf16*)(wsp(F) + WS_HB);
    for (int m = gw; m < MTOK; m += NGW) { const int b = m / SEQ; Row r; row_load(r, inp(F, I_X) + (size_t)m * DM, F.lane); row_normalize(r);
        row_affine(r, modp(F, 0, b, 1), 1.0f, modp(F, 0, b, 0), F.lane); row_store_bf16(r, hb + (size_t)m * DM, F.lane); }
}

__device__ __forceinline__ void merge_phase(Frame& F, int l) {
    const int gw = F.vcu * NWAVES + F.wave, NGW = F.G * NWAVES;
    const float* oc = (const float*)(wsp(F) + WS_OCAT); bf16* hb = (bf16*)(wsp(F) + WS_HB); const float* mg = inp(F, I_MIXG) + (size_t)l * DM;
    for (int m = gw; m < MTOK; m += NGW) { Row r; row_load(r, oc + (size_t)m * DM, F.lane);
        float sa = 0.f, sb = 0.f, sc = 0.f;
#pragma unroll
        for (int j = 0; j < 8; ++j) { const float q = (r.v[j].x * r.v[j].x + r.v[j].y * r.v[j].y) + (r.v[j].z * r.v[j].z + r.v[j].w * r.v[j].w); if (j < 2) sa += q; else if (j < 4) sb += q; else sc += q; }
        const float ra = 1.0f / sqrtf(wave_sum(sa) * (1.0f / 512.0f) + RMS_EPS), rb = 1.0f / sqrtf(wave_sum(sb) * (1.0f / 512.0f) + RMS_EPS), rc = 1.0f / sqrtf(wave_sum(sc) * (1.0f / 1024.0f) + RMS_EPS);
#pragma unroll
        for (int j = 0; j < 8; ++j) { const float s = j < 2 ? ra : (j < 4 ? rb : rc); const f32x4 g = *((const GAS f32x4*)mg + F.lane + 64 * j); r.v[j] = r.v[j] * s * g; }
        row_store_bf16(r, hb + (size_t)m * DM, F.lane); }
}

__device__ __forceinline__ void post_mixer_phase(Frame& F, int l) {
    const int gw = F.vcu * NWAVES + F.wave, NGW = F.G * NWAVES;
    float* xa = (float*)(wsp(F) + WS_XA); bf16* hb = (bf16*)(wsp(F) + WS_HB);
    const float* wrg = inp(F, I_WRG) + (size_t)l * DM * 4; const float* brg = inp(F, I_BRG) + l * 4;
    const float* wre = inp(F, I_WRE) + (size_t)l * 4 * DM * 8; const float* bre = inp(F, I_BRE) + l * 32;
    unsigned* cnt = (unsigned*)(ctlp(F) + CW_CNT + l * 32); int* list = (int*)(wsp(F) + WS_LIST); float* gatew = (float*)(wsp(F) + WS_SMALL + SM_GATEW);
    for (int m = gw; m < MTOK; m += NGW) { const int b = m / SEQ; Row r; row_load(r, xa + (size_t)m * DM, F.lane); row_normalize(r);
        row_affine(r, inp(F, I_LN1G) + (size_t)l * DM, 0.0f, inp(F, I_LN1B) + (size_t)l * DM, F.lane); row_store(r, xa + (size_t)m * DM, F.lane);
        row_normalize(r); row_affine(r, modp(F, l, b, 4), 1.0f, modp(F, l, b, 3), F.lane); row_store_bf16(r, hb + (size_t)m * DM, F.lane);
    }
}

__device__ __forceinline__ void router_phase(Frame& F, int l) {
    if (F.wave >= 4) return;
    const int lane = F.lane, c = lane & 15, kq = lane >> 4;
    const bf16* hb = (const bf16*)(wsp(F) + WS_HB);
    const bf16* Whi = (const bf16*)(wsp(F) + WS_WCMP + 1536 * 1024); const bf16* Wlo = Whi + 48 * 2048;
    const float* brg = inp(F, I_BRG) + l * 4; const float* bre = inp(F, I_BRE) + l * 32;
    unsigned* cnt = (unsigned*)(ctlp(F) + CW_CNT + l * 32); int* list = (int*)(wsp(F) + WS_LIST); float* gatew = (float*)(wsp(F) + WS_SMALL + SM_GATEW);
    LAS float* sl = (LAS float*)(F.lds + F.wave * 4096);
    for (int u = F.wave * F.G + F.vcu; u < MTOK / 16; u += 4 * F.G) {
        const bf16* hrow = hb + (size_t)(u * 16 + c) * DM + 8 * kq;
        const bf16* wh = Whi + (size_t)c * 2048 + 8 * kq; const bf16* wl = Wlo + (size_t)c * 2048 + 8 * kq;
        f32x4 acc[3];
#pragma unroll
        for (int t = 0; t < 3; ++t) acc[t] = (f32x4){0.f, 0.f, 0.f, 0.f};
#pragma unroll 4
        for (int ks = 0; ks < 64; ++ks) { const bf16x8 hf = ldg8(hrow + ks * 32);
#pragma unroll
            for (int t = 0; t < 3; ++t) { acc[t] = mfma16(ldg8(wh + (size_t)t * 16 * 2048 + ks * 32), hf, acc[t]); acc[t] = mfma16(ldg8(wl + (size_t)t * 16 * 2048 + ks * 32), hf, acc[t]); } }
#pragma unroll
        for (int t = 0; t < 3; ++t)
#pragma unroll
            for (int r = 0; r < 4; ++r) sl[c * 49 + 16 * t + 4 * kq + r] = acc[t][r];
        LDS_WAIT();
        if (lane < 16) {
            const LAS float* lr = sl + lane * 49; const int m = u * 16 + lane;
            const float g0 = lr[0] + brg[0], g1 = lr[1] + brg[1], g2 = lr[2] + brg[2], g3 = lr[3] + brg[3];
            int gs = 0; float gm = g0; if (g1 > gm) { gm = g1; gs = 1; } if (g2 > gm) { gm = g2; gs = 2; } if (g3 > gm) { gm = g3; gs = 3; }
            const float pgroup = 1.0f / (__expf(g0 - gm) + __expf(g1 - gm) + __expf(g2 - gm) + __expf(g3 - gm));
            int t1 = 0; float m1 = lr[4 + gs * 8] + bre[gs * 8];
#pragma unroll
            for (int i = 1; i < 8; ++i) { const float v = lr[4 + gs * 8 + i] + bre[gs * 8 + i]; if (v > m1) { m1 = v; t1 = i; } }
            int t2 = -1; float m2 = -3.0e38f;
#pragma unroll
            for (int i = 0; i < 8; ++i) { const float v = lr[4 + gs * 8 + i] + bre[gs * 8 + i]; if (i != t1 && v > m2) { m2 = v; t2 = i; } }
            const float e2 = __expf(m2 - m1), inv = pgroup / (1.0f + e2);
            const int x1 = gs * 8 + t1, x2 = gs * 8 + t2;
            const unsigned p1 = __hip_atomic_fetch_add(cnt + x1, 1u, RLX_AGENT); list[(size_t)x1 * MTOK + p1] = m * 2; gatew[m * 2] = inv;
            const unsigned p2 = __hip_atomic_fetch_add(cnt + x2, 1u, RLX_AGENT); list[(size_t)x2 * MTOK + p2] = m * 2 + 1; gatew[m * 2 + 1] = inv * e2;
        }
        LDS_WAIT();
    }
}

__device__ __forceinline__ void gather_phase(Frame& F, int l) {
    LAS int* tb = (LAS int*)(F.lds + 0);
    const unsigned* cnt = (const unsigned*)(ctlp(F) + CW_CNT + l * 32);
    if (F.tid < 32) tb[F.tid] = (int)__hip_atomic_load(cnt + F.tid, RLX_AGENT);
    __syncthreads();
    if (F.tid == 0) { int row = 0, tile = 0;
        for (int e = 0; e < NEXP; ++e) { tb[32 + e] = row; const int nt = (tb[e] + 255) >> 8; for (int t = 0; t < nt; ++t) tb[64 + tile + t] = e; tile += nt; row += nt * 256; }
        tb[224] = tile; }
    __syncthreads();
    const int ntiles = tb[224];
    int* gt = (int*)(wsp(F) + WS_SMALL + SM_TILE);
    if (blockIdx.x == 0) { if (F.tid < 160) gt[F.tid] = (F.tid < ntiles) ? tb[64 + F.tid] : 0; if (F.tid == 0) gt[200] = ntiles; }
    const int gw = F.vcu * NWAVES + F.wave, NGW = F.G * NWAVES;
    const int* list = (const int*)(wsp(F) + WS_LIST); int* rowinfo = (int*)(wsp(F) + WS_SMALL + SM_ROWINFO);
    const bf16* hb = (const bf16*)(wsp(F) + WS_HB); bf16* xs = (bf16*)(wsp(F) + WS_XS);
    for (int R = gw; R < ntiles * 256; R += NGW) { const int e = tb[64 + (R >> 8)], pos = R - tb[32 + e];
        int aid = -1; if (pos < tb[e]) aid = list[(size_t)e * MTOK + pos];
        GAS v4u* dst = (GAS v4u*)(xs + (size_t)R * DM) + F.lane;
        if (aid >= 0) { const GAS v4u* src = (const GAS v4u*)(hb + (size_t)(aid >> 1) * DM) + F.lane;
#pragma unroll
            for (int j = 0; j < 4; ++j) dst[64 * j] = src[64 * j]; }
        else {
#pragma unroll
            for (int j = 0; j < 4; ++j) dst[64 * j] = (v4u){0u, 0u, 0u, 0u}; }
        if (F.lane == 0) rowinfo[R] = aid; }
    __syncthreads();
}

__device__ __forceinline__ void post_moe_phase(Frame& F, int l, float* dst, bool next_h) {
    const int gw = F.vcu * NWAVES + F.wave, NGW = F.G * NWAVES;
    const float* xa = (const float*)(wsp(F) + WS_XA); const bf16* ys = (const bf16*)(wsp(F) + WS_YS); bf16* hb = (bf16*)(wsp(F) + WS_HB);
    for (int m = gw; m < MTOK; m += NGW) { const int b = m / SEQ; Row r; row_load(r, xa + (size_t)m * DM, F.lane);
        const float* g2 = modp(F, l, b, 5);
#pragma unroll
        for (int j = 0; j < 8; ++j) { const v2u y0 = *((const GAS v2u*)(ys + (size_t)(2 * m) * DM) + F.lane + 64 * j), y1 = *((const GAS v2u*)(ys + (size_t)(2 * m + 1) * DM) + F.lane + 64 * j);
            const f32x4 y = (f32x4){bflo(y0.x) + bflo(y1.x), bfhi(y0.x) + bfhi(y1.x), bflo(y0.y) + bflo(y1.y), bfhi(y0.y) + bfhi(y1.y)};
            const f32x4 gv = *((const GAS f32x4*)g2 + F.lane + 64 * j) + 1.0f; r.v[j] = r.v[j] * ALPHA + gv * y; }
        row_normalize(r); row_affine(r, inp(F, I_LN2G) + (size_t)l * DM, 0.0f, inp(F, I_LN2B) + (size_t)l * DM, F.lane); row_store(r, dst + (size_t)m * DM, F.lane);
        if (next_h) { row_normalize(r); row_affine(r, modp(F, l + 1, b, 1), 1.0f, modp(F, l + 1, b, 0), F.lane); row_store_bf16(r, hb + (size_t)m * DM, F.lane); } }
}
constexpr int IMP_STRIDE = 130;
constexpr int AW_IMP = 0, AW_SCV = 16 * IMP_STRIDE * 4, AW_SEL = AW_SCV + 512, AW_Q = 9216, AW_BYTES = AW_Q + 8192;
static_assert(AW_SEL + 256 <= AW_Q && NWAVES * AW_BYTES <= LDSCTL_OFF, "per-wave LDS slabs");

struct Flash { f32x4 O[4][4]; f32x4 m, l; };
struct KF { bf16x8 K[2][2]; };
struct VF { bf16x8 V[4]; };

__device__ __forceinline__ void load_k(KF& x, const bf16* Kb, size_t ldk, int kbase) {
    const bf16* kp = Kb + (size_t)kbase * ldk;
    x.K[0][0] = ldg8(kp); x.K[0][1] = ldg8(kp + 32); x.K[1][0] = ldg8(kp + 4 * ldk); x.K[1][1] = ldg8(kp + 4 * ldk + 32);
}
__device__ __forceinline__ void load_v(VF& x, const bf16* Vb, size_t ldv, int kbase) {
    const bf16* vp = Vb + kbase;
#pragma unroll
    for (int db = 0; db < 4; ++db) x.V[db] = ldg8(vp + (size_t)(16 * db) * ldv);
}
__device__ __forceinline__ void q_park(LAS bf16x8* Ql, const bf16* q0p, const bf16* q1p, const bf16* q2p, const bf16* q3p, int lane) {
    Ql[0 * 64 + lane] = ldg8(q0p); Ql[1 * 64 + lane] = ldg8(q0p + 32); Ql[2 * 64 + lane] = ldg8(q1p); Ql[3 * 64 + lane] = ldg8(q1p + 32);
    Ql[4 * 64 + lane] = ldg8(q2p); Ql[5 * 64 + lane] = ldg8(q2p + 32); Ql[6 * 64 + lane] = ldg8(q3p); Ql[7 * 64 + lane] = ldg8(q3p + 32);
}
__device__ __forceinline__ void qk_scores(f32x4 (&Sv)[2][4], const KF& x, const LAS bf16x8* Ql, int lane) {
#pragma unroll
    for (int qb = 0; qb < 4; ++qb) { const bf16x8 q0 = Ql[(2 * qb) * 64 + lane], q1 = Ql[(2 * qb + 1) * 64 + lane];
#pragma unroll
        for (int h = 0; h < 2; ++h) { f32x4 a = mfma16(x.K[h][0], q0, (f32x4){0.f, 0.f, 0.f, 0.f}); Sv[h][qb] = mfma16(x.K[h][1], q1, a); } }
}
__device__ __forceinline__ void flash_init(Flash& S, float m0, float m1, float m2, float m3) {
#pragma unroll
    for (int db = 0; db < 4; ++db)
#pragma unroll
        for (int qb = 0; qb < 4; ++qb) S.O[db][qb] = (f32x4){0.f, 0.f, 0.f, 0.f};
    S.m = (f32x4){m0, m1, m2, m3}; S.l = (f32x4){0.f, 0.f, 0.f, 0.f};
}
__device__ __forceinline__ void flash_step(Flash& S, f32x4 (&Sv)[2][4], const VF& x, const f32x4 b0, const f32x4 bj, unsigned vm) {
    float sv[4][8]; float mxv[4]; bool grow = false;
#pragma unroll
    for (int qb = 0; qb < 4; ++qb) {
#pragma unroll
        for (int h = 0; h < 2; ++h)
#pragma unroll
            for (int r = 0; r < 4; ++r) { const int j = 4 * h + r; const float s2 = Sv[h][qb][r] * SC2 + (b0[qb] + bj[qb] * (float)j); sv[qb][j] = ((vm >> j) & 1u) ? s2 : -INFINITY; }
        float mx = fmaxf(fmaxf(fmaxf(sv[qb][0], sv[qb][1]), fmaxf(sv[qb][2], sv[qb][3])), fmaxf(fmaxf(sv[qb][4], sv[qb][5]), fmaxf(sv[qb][6], sv[qb][7])));
        mx = fmaxf(mx, __shfl_xor(mx, 16)); mx = fmaxf(mx, __shfl_xor(mx, 32));
        mxv[qb] = mx; grow = grow | (mx > S.m[qb] + 8.0f);
    }
    if (__any(grow)) {
#pragma unroll
        for (int qb = 0; qb < 4; ++qb) { const float mn = fmaxf(S.m[qb], mxv[qb]), al = ex2(S.m[qb] - mn); S.m[qb] = mn; S.l[qb] = S.l[qb] * al;
#pragma unroll
            for (int db = 0; db < 4; ++db) S.O[db][qb] = S.O[db][qb] * al; }
    }
    bf16x8 Pf[4];
#pragma unroll
    for (int qb = 0; qb < 4; ++qb) {
        float p[8];
#pragma unroll
        for (int j = 0; j < 8; ++j) p[j] = ex2(sv[qb][j] - S.m[qb]);
        S.l[qb] = S.l[qb] + (((p[0] + p[1]) + (p[2] + p[3])) + ((p[4] + p[5]) + (p[6] + p[7])));
        Pf[qb] = pack8(p[0], p[1], p[2], p[3], p[4], p[5], p[6], p[7]);
    }
#pragma unroll
    for (int db = 0; db < 4; ++db)
#pragma unroll
        for (int qb = 0; qb < 4; ++qb) S.O[db][qb] = mfma16(x.V[db], Pf[qb], S.O[db][qb]);
}
__device__ __forceinline__ float flash_inv(const Flash& S, int qb, bool has_sink, float sink2) {
    float lt = S.l[qb]; lt += __shfl_xor(lt, 16); lt += __shfl_xor(lt, 32);
    if (has_sink) lt += ex2(sink2 - S.m[qb]);
    return lt > 0.f ? 1.0f / lt : 0.f;
}
__device__ __forceinline__ float sigmoidf_(float x) { return 1.0f / (1.0f + __expf(-x)); }
__device__ __forceinline__ float slope2_of(int hidx) { return LOG2E * exp2f(-0.5f * (float)(hidx + 1)); }
#define ITER_FENCE() asm volatile("" ::: "memory")

template <int W, int MODE>
__device__ __forceinline__ void win_unit(Frame& F, int l, int b, int g, int q0) {
    const int lane = F.lane, c = lane & 15, kq = lane >> 4;
    const bf16* proj = (const bf16*)(wsp(F) + WS_PROJ); const bf16* vT = (const bf16*)(wsp(F) + WS_VT); float* ocat = (float*)(wsp(F) + WS_OCAT);
    constexpr int QOFF = MODE == 0 ? P_QA : P_QB, KOFF = MODE == 0 ? P_KA : P_KBW, VROW = MODE == 0 ? V_A : V_BW, OCOL = MODE == 0 ? 0 : 512, HBASE = MODE == 0 ? 0 : 8;
    LAS bf16x8* Ql = (LAS bf16x8*)(F.lds + F.wave * AW_BYTES + AW_Q);
    const size_t tb = (size_t)b * SEQ; const int t = q0 + c;
    { const bf16* qp = proj + (tb + t) * NPROJ + QOFF + g * 256 + kq * 8; q_park(Ql, qp, qp + 64, qp + 128, qp + 192, lane); }
    f32x4 sl2, sk2;
#pragma unroll
    for (int qb = 0; qb < 4; ++qb) { sl2[qb] = slope2_of(HBASE + g * 4 + qb); sk2[qb] = MODE == 0 ? inp(F, I_SINKS)[l * 8 + g * 4 + qb] * LOG2E : -1.0e30f; }
    Flash S; flash_init(S, sk2[0], sk2[1], sk2[2], sk2[3]);
    int klo = q0 - (W - 1); if (klo < 0) klo = 0; klo &= ~31;
    const int khi = (q0 + 15) & ~31;
    const bf16* Kb = proj + (tb + 8 * (c >> 2) + (c & 3)) * NPROJ + KOFF + g * 64 + kq * 8;
    const bf16* Vb = vT + (size_t)(VROW + g * 64 + c) * MTOK + tb + 8 * kq;
    KF cur, nxt; load_k(cur, Kb, NPROJ, khi);
    for (int kbase = khi; kbase >= klo; kbase -= 32) {
        ITER_FENCE();
        VF vf; load_v(vf, Vb, MTOK, kbase);
        load_k(nxt, Kb, NPROJ, kbase - 32 >= klo ? kbase - 32 : kbase);
        f32x4 Sv[2][4]; qk_scores(Sv, cur, Ql, lane);
        const int d0 = t - kbase - 8 * kq;
        const f32x4 b0 = sl2 * -(float)d0;
        unsigned vm = 0xffu;
        if (!(kbase + 31 <= q0 && kbase >= q0 + 16 - W)) { vm = 0u;
#pragma unroll
            for (int j = 0; j < 8; ++j) { const int dist = d0 - j; vm |= (dist >= 0 && dist < W) ? (1u << j) : 0u; } }
        flash_step(S, Sv, vf, b0, sl2, vm);
        cur = nxt;
    }
#pragma unroll
    for (int qb = 0; qb < 4; ++qb) { const float sc = flash_inv(S, qb, MODE == 0, sk2[qb]);
        float* op = ocat + (tb + t) * DM + OCOL + (g * 4 + qb) * 64 + 4 * kq;
#pragma unroll
        for (int db = 0; db < 4; ++db) *(GAS f32x4*)(op + 16 * db) = S.O[db][qb] * sc; }
}

constexpr float SB_EXIT_P = 1.0e-37f;
__device__ __forceinline__ void sb_unit(Frame& F, int b, int hc, int q0) {
    const int lane = F.lane, c = lane & 15, kq = lane >> 4;
    const bf16* proj = (const bf16*)(wsp(F) + WS_PROJ); const bf16* vT = (const bf16*)(wsp(F) + WS_VT); float* ocat = (float*)(wsp(F) + WS_OCAT);
    LAS bf16x8* Ql = (LAS bf16x8*)(F.lds + F.wave * AW_BYTES + AW_Q);
    const size_t tb = (size_t)b * SEQ;
    { const bf16* qp = proj + (tb + q0 + c) * NPROJ + P_QC + hc * 64 + kq * 8; q_park(Ql, qp, qp + (size_t)16 * NPROJ, qp + (size_t)32 * NPROJ, qp + (size_t)48 * NPROJ, lane); }
    f32x4 O[4][4]; float carry[4];
#pragma unroll
    for (int qb = 0; qb < 4; ++qb) { carry[qb] = 1.0f;
#pragma unroll
        for (int db = 0; db < 4; ++db) O[db][qb] = (f32x4){0.f, 0.f, 0.f, 0.f}; }
    const bf16* Kb = proj + (tb + 8 * (c >> 2) + (c & 3)) * NPROJ + P_KC + hc * 64 + kq * 8;
    const bf16* Vb = vT + (size_t)(V_C + hc * 64 + c) * MTOK + tb + 8 * kq;
    KF cur, nxt; load_k(cur, Kb, NPROJ, q0 + 32);
    for (int kbase = q0 + 32; kbase >= 0; kbase -= 32) {
        ITER_FENCE();
        VF vf; load_v(vf, Vb, MTOK, kbase);
        load_k(nxt, Kb, NPROJ, kbase >= 32 ? kbase - 32 : kbase);
        f32x4 Sv[2][4]; qk_scores(Sv, cur, Ql, lane);
        const bool diag = kbase + 31 >= q0;
        bf16x8 Pf[4];
#pragma unroll
        for (int qb = 0; qb < 4; ++qb) { const int lim = q0 + 16 * qb + c - kbase - 8 * kq;
            float om[8], sg[8];
#pragma unroll
            for (int h = 0; h < 2; ++h)
#pragma unroll
                for (int r = 0; r < 4; ++r) { const int j = 4 * h + r; const float e = ex2(fminf(Sv[h][qb][r] * SC2, 115.0f)), rr = __builtin_amdgcn_rcpf(1.0f + e);
                    om[j] = rr; sg[j] = e * rr;
                    if (diag) { const bool msk = j >= lim; om[j] = msk ? 1.0f : om[j]; sg[j] = msk ? 0.f : sg[j]; } }
            float ex_[8]; float run = 1.0f;
#pragma unroll
            for (int j = 7; j >= 0; --j) { ex_[j] = run; run *= om[j]; }
            const float t1 = __shfl_xor(run, 16), t2 = __shfl_xor(run, 32), t3 = __shfl_xor(run, 48);
            const float X = ((kq ^ 1) > kq ? t1 : 1.0f) * ((kq ^ 2) > kq ? t2 : 1.0f) * ((kq ^ 3) > kq ? t3 : 1.0f);
            const float base = carry[qb] * X;
            carry[qb] *= (run * t1) * (t2 * t3);
            Pf[qb] = pack8(sg[0] * (base * ex_[0]), sg[1] * (base * ex_[1]), sg[2] * (base * ex_[2]), sg[3] * (base * ex_[3]), sg[4] * (base * ex_[4]), sg[5] * (base * ex_[5]), sg[6] * (base * ex_[6]), sg[7] * (base * ex_[7])); }
#pragma unroll
        for (int db = 0; db < 4; ++db)
#pragma unroll
            for (int qb = 0; qb < 4; ++qb) O[db][qb] = mfma16(vf.V[db], Pf[qb], O[db][qb]);
        const bool fin = (carry[0] < SB_EXIT_P) && (carry[1] < SB_EXIT_P) && (carry[2] < SB_EXIT_P) && (carry[3] < SB_EXIT_P);
        if (__all(fin)) break;
        cur = nxt;
    }
#pragma unroll
    for (int qb = 0; qb < 4; ++qb) { float* op = ocat + (tb + q0 + 16 * qb + c) * DM + 1024 + hc * 64 + 4 * kq;
#pragma unroll
        for (int db = 0; db < 4; ++db) *(GAS f32x4*)(op + 16 * db) = O[db][qb]; }
}

__device__ __forceinline__ void gate_unit(Frame& F, int u) {
    const int lane = F.lane, c = lane & 15, kq = lane >> 4;
    const bf16* hrow = (const bf16*)(wsp(F) + WS_HB) + (size_t)(u * 16 + c) * DM + 8 * kq;
    const bf16* wg = (const bf16*)(wsp(F) + WS_WCMP + 1024 * 1024 + 64 * 1024) + (size_t)c * 2048 + 8 * kq;
    f32x4 a0 = (f32x4){0.f, 0.f, 0.f, 0.f}, a1 = (f32x4){0.f, 0.f, 0.f, 0.f};
#pragma unroll 8
    for (int ks = 0; ks < 64; ++ks) { const bf16x8 hf = ldg8(hrow + ks * 32); a0 = mfma16(ldg8(wg + ks * 32), hf, a0); a1 = mfma16(ldg8(wg + (size_t)16 * 2048 + ks * 32), hf, a1); }
    float* gp = (float*)(wsp(F) + WS_GBUF) + (size_t)(u * 16 + c) * 32 + 4 * kq;
    *(GAS f32x4*)gp = a0; *(GAS f32x4*)(gp + 16) = a1;
}

__device__ __forceinline__ float gelu_tanh(float x) { const float u = 0.7978845608028654f * (x + 0.044715f * x * x * x); const float e = __expf(2.0f * u); return 0.5f * x * (2.0f - 2.0f / (e + 1.0f)); }
__device__ __forceinline__ void cmp_mlp_unit(Frame& F, int l, int unit) {
    const int lane = F.lane, c = lane & 15, kq = lane >> 4;
    const int nt = unit & 31, g = (unit >> 5) & 1, b = (unit >> 6) & 1, kv = unit >> 7;
    const bf16* proj = (const bf16*)(wsp(F) + WS_PROJ);
    const bf16* W1t = (const bf16*)(wsp(F) + WS_WCMP) + (size_t)kv * 128 * 2048; const bf16* W2t = (const bf16*)(wsp(F) + WS_WCMP + 2 * 128 * 2048 * 2) + (size_t)kv * 64 * 128;
    const float* pe = inp(F, kv ? I_PEV : I_PEK) + (size_t)l * 32 * 64;
    const int n = nt * 16 + c; const size_t tb = (size_t)b * SEQ; const int xoff = (kv ? P_VBC : P_KBC) + g * 64;
    LAS f32x4* red = (LAS f32x4*)(F.lds);
    f32x4 H[4][2];
#pragma unroll
    for (int s = 0; s < 4; ++s) { H[s][0] = (f32x4){0.f, 0.f, 0.f, 0.f}; H[s][1] = (f32x4){0.f, 0.f, 0.f, 0.f}; }
#pragma unroll 2
    for (int kk = 0; kk < 8; ++kk) {
        const int ks = F.wave * 8 + kk, lt = ks >> 1, d0 = (ks & 1) * 32 + 8 * kq; int tok = 16 * n + lt; if (tok > SEQ - 1) tok = SEQ - 1;
        const bf16x8 xr = ldg8(proj + (tb + tok) * NPROJ + xoff + d0);
        const f32x4 p0 = *(const GAS f32x4*)(pe + lt * 64 + d0), p1 = *(const GAS f32x4*)(pe + lt * 64 + d0 + 4);
        const bf16x8 Xf = pack8(bf2f((unsigned short)xr[0]) + p0[0], bf2f((unsigned short)xr[1]) + p0[1], bf2f((unsigned short)xr[2]) + p0[2], bf2f((unsigned short)xr[3]) + p0[3],
                                bf2f((unsigned short)xr[4]) + p1[0], bf2f((unsigned short)xr[5]) + p1[1], bf2f((unsigned short)xr[6]) + p1[2], bf2f((unsigned short)xr[7]) + p1[3]);
#pragma unroll
        for (int s = 0; s < 4; ++s)
#pragma unroll
            for (int h = 0; h < 2; ++h) { const int hid = 32 * s + 8 * (c >> 2) + 4 * h + (c & 3);
                H[s][h] = mfma16(ldg8(W1t + (size_t)hid * 2048 + ks * 32 + 8 * kq), Xf, H[s][h]); }
    }
#pragma unroll
    for (int s = 0; s < 4; ++s)
#pragma unroll
        for (int h = 0; h < 2; ++h) red[(F.wave * 8 + s * 2 + h) * 64 + lane] = H[s][h];
    __syncthreads();
    if (F.wave == 0) {
#pragma unroll
        for (int s = 0; s < 4; ++s)
#pragma unroll
            for (int h = 0; h < 2; ++h) { f32x4 a = red[(s * 2 + h) * 64 + lane];
#pragma unroll
                for (int w = 1; w < 8; ++w) a += red[(w * 8 + s * 2 + h) * 64 + lane];
                H[s][h] = a; }
        f32x4 Y[4];
#pragma unroll
        for (int eb = 0; eb < 4; ++eb) Y[eb] = (f32x4){0.f, 0.f, 0.f, 0.f};
#pragma unroll
        for (int s = 0; s < 4; ++s) {
            const bf16x8 Hf = pack8(gelu_tanh(H[s][0][0]), gelu_tanh(H[s][0][1]), gelu_tanh(H[s][0][2]), gelu_tanh(H[s][0][3]), gelu_tanh(H[s][1][0]), gelu_tanh(H[s][1][1]), gelu_tanh(H[s][1][2]), gelu_tanh(H[s][1][3]));
#pragma unroll
            for (int eb = 0; eb < 4; ++eb) Y[eb] = mfma16(ldg8(W2t + (size_t)(16 * eb + c) * 128 + 32 * s + 8 * kq), Hf, Y[eb]);
        }
        const bool valid = n <= 510;
        if (kv == 0) { bf16* kc = (bf16*)(wsp(F) + WS_SMALL + SM_KCMP) + ((size_t)(b * 2 + g) * 512 + n) * 64 + 4 * kq;
#pragma unroll
            for (int eb = 0; eb < 4; ++eb) { v2u w; w.x = valid ? pk2(Y[eb][0], Y[eb][1]) : 0u; w.y = valid ? pk2(Y[eb][2], Y[eb][3]) : 0u; *(GAS v2u*)(kc + 16 * eb) = w; } }
        else { bf16* vc = (bf16*)(wsp(F) + WS_SMALL + SM_VCMPT) + (size_t)(b * 2 + g) * 64 * 512 + n;
#pragma unroll
            for (int eb = 0; eb < 4; ++eb)
#pragma unroll
                for (int r = 0; r < 4; ++r) vc[(size_t)(16 * eb + 4 * kq + r) * 512] = valid ? (bf16)f2bf(Y[eb][r]) : (bf16)0; }
    }
    __syncthreads();
}

__device__ __forceinline__ int next_below(unsigned long long ulo, unsigned long long uhi, int j) {
    if (j > 64) { const unsigned long long m = (j >= 128) ? uhi : (uhi & ((1ull << (j - 64)) - 1ull)); if (m) return 127 - __builtin_clzll(m); j = 64; }
    const unsigned long long m = (j >= 64) ? ulo : (ulo & ((1ull << j) - 1ull));
    return m ? 63 - __builtin_clzll(m) : -1;
}
__device__ __forceinline__ void nsa_unit(Frame& F, int b, int g, int q0) {
    const int lane = F.lane, c = lane & 15, kq = lane >> 4;
    const bf16* proj = (const bf16*)(wsp(F) + WS_PROJ); const bf16* vT = (const bf16*)(wsp(F) + WS_VT); float* ocat = (float*)(wsp(F) + WS_OCAT);
    const bf16* kcmp = (const bf16*)(wsp(F) + WS_SMALL + SM_KCMP) + (size_t)(b * 2 + g) * 512 * 64;
    const bf16* vcmpT = (const bf16*)(wsp(F) + WS_SMALL + SM_VCMPT) + (size_t)(b * 2 + g) * 64 * 512;
    LAS float* imp = (LAS float*)(F.lds + F.wave * AW_BYTES + AW_IMP);
    LAS unsigned* selm = (LAS unsigned*)(F.lds + F.wave * AW_BYTES + AW_SEL);
    LAS bf16x8* Ql = (LAS bf16x8*)(F.lds + F.wave * AW_BYTES + AW_Q);
    const size_t tb = (size_t)b * SEQ; const int t = q0 + c;
    const float* grow = (const float*)(wsp(F) + WS_GBUF) + (tb + t) * 32 + g * 12;
    { const bf16* qp = proj + (tb + t) * NPROJ + P_QB + g * 256 + kq * 8; q_park(Ql, qp, qp + 64, qp + 128, qp + 192, lane); }
    f32x4 sl2;
#pragma unroll
    for (int qb = 0; qb < 4; ++qb) sl2[qb] = slope2_of(8 + g * 4 + qb);
    const f32x4 sl2c = sl2 * 16.0f;
    for (int i = lane; i < 16 * IMP_STRIDE; i += 64) imp[i] = 0.f;
    const int tmax = q0 + 15; const int nmax = tmax >= 31 ? ((tmax - 31) >> 4) : -1; const int ntop = nmax & ~31;
    const bf16* Kc = kcmp + (size_t)(8 * (c >> 2) + (c & 3)) * 64 + kq * 8;
    const bf16* Vc = vcmpT + (size_t)c * 512 + 8 * kq;
    Flash S; flash_init(S, -1.0e30f, -1.0e30f, -1.0e30f, -1.0e30f);
    KF cur, nxt;
    if (nmax >= 0) {
        load_k(cur, Kc, 64, ntop);
        for (int nbase = ntop; nbase >= 0; nbase -= 32) {
            ITER_FENCE();
            VF vf; load_v(vf, Vc, 512, nbase);
            load_k(nxt, Kc, 64, nbase >= 32 ? nbase - 32 : nbase);
            f32x4 Sv[2][4]; qk_scores(Sv, cur, Ql, lane);
            const int d0 = t - 31 - 16 * (nbase + 8 * kq);
            const f32x4 b0 = sl2 * -(float)d0;
            unsigned vm = 0xffu;
            if (!(16 * (nbase + 31) + 31 <= q0)) { vm = 0u;
#pragma unroll
                for (int j = 0; j < 8; ++j) vm |= (d0 - 16 * j >= 0) ? (1u << j) : 0u; }
            flash_step(S, Sv, vf, b0, sl2c, vm);
            cur = nxt;
        }
    }
    f32x4 inv;
#pragma unroll
    for (int qb = 0; qb < 4; ++qb) { inv[qb] = flash_inv(S, qb, false, 0.f);
        const float g0 = sigmoidf_(grow[qb * 3 + 0]), g2 = sigmoidf_(grow[qb * 3 + 2]), sc = inv[qb] * g0;
        float* op = ocat + (tb + t) * DM + 512 + (g * 4 + qb) * 64 + 4 * kq;
#pragma unroll
        for (int db = 0; db < 4; ++db) { const f32x4 old = *(const GAS f32x4*)(op + 16 * db); *(GAS f32x4*)(op + 16 * db) = old * g2 + S.O[db][qb] * sc; } }
    LDS_WAIT();
    for (int nbase = 0; nbase <= nmax; nbase += 32) {
        ITER_FENCE();
        const bf16* kp = Kc + (size_t)nbase * 64;
        KF x; x.K[0][0] = ldg8(kp); x.K[0][1] = ldg8(kp + 32); x.K[1][0] = ldg8(kp + 4 * 64); x.K[1][1] = ldg8(kp + 4 * 64 + 32);
        f32x4 Sv[2][4]; qk_scores(Sv, x, Ql, lane);
        float G[2], Wl[2];
#pragma unroll
        for (int h = 0; h < 2; ++h) { float gs = 0.f, last = 0.f;
#pragma unroll
            for (int r = 0; r < 4; ++r) { const int dist = t - 16 * (nbase + 8 * kq + 4 * h + r) - 31; const bool vis = dist >= 0; const float fd = (float)dist; float pv = 0.f;
#pragma unroll
                for (int qb = 0; qb < 4; ++qb) pv += vis ? ex2(Sv[h][qb][r] * SC2 - sl2[qb] * fd - S.m[qb]) * inv[qb] : 0.f;
                gs += pv; last = pv; }
            G[h] = gs; Wl[h] = last; }
        const int j0 = (nbase >> 2) + 2 * kq;
        LAS float* ip = imp + c * IMP_STRIDE + j0;
        ip[0] += G[0]; LDS_WAIT();
        ip[1] += G[1]; LDS_WAIT();
        ip[1] += Wl[0]; LDS_WAIT();
        ip[2] += Wl[1]; LDS_WAIT();
    }
    unsigned long long ulo = 0ull, uhi = 0ull, ilo = ~0ull, ihi = ~0ull;
    for (int cq = 0; cq < 16; ++cq) {
        const int tq = q0 + cq, cur_ = tq >> 6;
        const int ja = lane, jb = lane + 64;
        const bool oka = ja <= cur_, okb = jb <= cur_;
        unsigned ka = 0u, kb = 0u;
        if (oka) ka = (ja == 0 || ja == cur_ || ja == cur_ - 1) ? 0x461c4000u : __builtin_bit_cast(unsigned, imp[cq * IMP_STRIDE + ja]) + 1u;
        if (okb) kb = (jb == cur_ || jb == cur_ - 1) ? 0x461c4000u : __builtin_bit_cast(unsigned, imp[cq * IMP_STRIDE + jb]) + 1u;
        unsigned long long mlo, mhi;
        if (cur_ < 16) { mlo = __ballot(oka); mhi = 0ull; }
        else {
            unsigned thr = 0u;
#pragma unroll 1
            for (int bit = 30; bit >= 0; --bit) { const unsigned tr = thr | (1u << bit);
                const int cntv = __popcll(__ballot(ka >= tr)) + __popcll(__ballot(kb >= tr)); if (cntv >= 16) thr = tr; }
            mlo = __ballot(ka > thr); mhi = __ballot(kb > thr);
            int need = 16 - (__popcll(mlo) + __popcll(mhi));
            unsigned long long elo = __ballot(ka == thr), ehi = __ballot(kb == thr);
            while (need > 0 && elo) { const unsigned long long bsel = elo & (~elo + 1ull); mlo |= bsel; elo ^= bsel; --need; }
            while (need > 0 && ehi) { const unsigned long long bsel = ehi & (~ehi + 1ull); mhi |= bsel; ehi ^= bsel; --need; }
        }
        ulo |= mlo; uhi |= mhi; ilo &= mlo; ihi &= mhi;
        if (lane == 0) { selm[cq * 4 + 0] = (unsigned)mlo; selm[cq * 4 + 1] = (unsigned)(mlo >> 32); selm[cq * 4 + 2] = (unsigned)mhi; selm[cq * 4 + 3] = (unsigned)(mhi >> 32); }
    }
    LDS_WAIT();
    const unsigned long long mylo = (unsigned long long)selm[c * 4 + 0] | ((unsigned long long)selm[c * 4 + 1] << 32);
    const unsigned long long myhi = (unsigned long long)selm[c * 4 + 2] | ((unsigned long long)selm[c * 4 + 3] << 32);
    flash_init(S, -1.0e30f, -1.0e30f, -1.0e30f, -1.0e30f);
    const bf16* Kb = proj + (tb + 8 * (c >> 2) + (c & 3)) * NPROJ + P_KBS + g * 64 + kq * 8;
    const bf16* Vb = vT + (size_t)(V_BS + g * 64 + c) * MTOK + tb + 8 * kq;
    int j = next_below(ulo, uhi, (tmax >> 6) + 1), hs = 1;
    load_k(cur, Kb, NPROJ, 64 * j + 32);
    while (j >= 0) {
        ITER_FENCE();
        const int kbase = 64 * j + 32 * hs;
        VF vf; load_v(vf, Vb, MTOK, kbase);
        int jn = j, hn = 0; if (hs == 0) { jn = next_below(ulo, uhi, j); hn = 1; }
        load_k(nxt, Kb, NPROJ, jn >= 0 ? 64 * jn + 32 * hn : kbase);
        const bool mine = j < 64 ? ((mylo >> j) & 1ull) != 0ull : ((myhi >> (j - 64)) & 1ull) != 0ull;
        const bool all16 = j < 64 ? ((ilo >> j) & 1ull) != 0ull : ((ihi >> (j - 64)) & 1ull) != 0ull;
        f32x4 Sv[2][4]; qk_scores(Sv, cur, Ql, lane);
        const int d0 = t - kbase - 8 * kq;
        const f32x4 b0 = sl2 * -(float)d0;
        unsigned vm = 0xffu;
        if (!(all16 && kbase + 31 <= q0)) { vm = 0u;
#pragma unroll
            for (int jj = 0; jj < 8; ++jj) vm |= (mine && d0 - jj >= 0) ? (1u << jj) : 0u; }
        flash_step(S, Sv, vf, b0, sl2, vm);
        cur = nxt; j = jn; hs = hn;
    }
#pragma unroll
    for (int qb = 0; qb < 4; ++qb) { const float sc = flash_inv(S, qb, false, 0.f) * sigmoidf_(grow[qb * 3 + 1]);
        float* op = ocat + (tb + t) * DM + 512 + (g * 4 + qb) * 64 + 4 * kq;
#pragma unroll
        for (int db = 0; db < 4; ++db) { const f32x4 old = *(const GAS f32x4*)(op + 16 * db); *(GAS f32x4*)(op + 16 * db) = old + S.O[db][qb] * sc; } }
    LDS_WAIT();
}

__device__ __forceinline__ void attn1_phase(Frame& F, int l) {
    const int gw = F.vcu * NWAVES + F.wave, NGW = F.G * NWAVES;
#ifndef A1U
#define A1U 31
#endif
    if (A1U & 1) for (int u = F.vcu; u < 256; u += F.G) cmp_mlp_unit(F, l, u);
    if (A1U & 2) if (F.wave >= 4) for (int u = (F.wave - 4) * F.G + F.vcu; u < MTOK / 16; u += 4 * F.G) gate_unit(F, u);
    if (A1U & 4) for (int u = gw; u < 2048; u += NGW) win_unit<512, 1>(F, l, u >> 10, (u >> 9) & 1, (u & 511) * 16);
    if (A1U & 8) for (int u = gw; u < 4096; u += NGW) sb_unit(F, u >> 11, (u >> 7) & 15, (u & 127) * 64);
    if (A1U & 16) for (int u = gw; u < 2048; u += NGW) win_unit<128, 0>(F, l, u >> 10, (u >> 9) & 1, (u & 511) * 16);
}
__device__ __forceinline__ void attn2_phase(Frame& F) {
    const int gw = F.vcu * NWAVES + F.wave, NGW = F.G * NWAVES;
    for (int u = gw; u < 2048; u += NGW) nsa_unit(F, u >> 10, (u >> 9) & 1, (u & 511) * 16);
}
#ifndef MK_ONE_LAUNCH
#define MK_ONE_LAUNCH 1
#endif
#ifndef PHASE_MASK
#define PHASE_MASK 0xFFFF
#endif
constexpr int N_PHASES = 2 + 10 * DEPTH;
struct Args { const float* in[25]; float* out; unsigned char* ws; };
#define IN(k) (LO <= (k) && (k) < HI)
#define SEAM(k) do { if constexpr (IN(k) && IN((k) + 1)) xcd_barrier(bar); asm volatile("" : "+v"(F.tid), "+v"(F.lane) :: "memory"); } while (0)
#ifndef DBL_MASK
#define DBL_MASK 0
#endif
#define FENCE() asm volatile("" : "+v"(F.tid), "+v"(F.lane) :: "memory")
#define PHASE(k, bit, ...) do { if constexpr (IN(k) && (PHASE_MASK & (bit))) { __VA_ARGS__ if constexpr ((DBL_MASK & (bit)) != 0) { xcd_barrier(bar); FENCE(); __VA_ARGS__ } } } while (0)
template <int L, int LO, int HI>
__device__ __forceinline__ void layer_phases(Frame& F, const XcdBarrier& bar) {
    constexpr int l = L, pb = 2 + 10 * L;
    PHASE(pb + 0, 4, {
        pg8::Gemm g{(const pg8::bf16_t*)(wsp(F) + WS_HB), (const pg8::bf16_t*)(wsp(F) + WS_WIN), MTOK, NIN, DM}; pg8::StaticOrder S; S.init(MTOK, NIN, F.G, (int)blockIdx.x);
        pg8::EpiProj E{(pg8::bf16_t*)(wsp(F) + WS_PROJ), (pg8::bf16_t*)(wsp(F) + WS_VT), NPROJ, MTOK};
        pg8::gemm_phase<pg8::EpiProj, pg8::StaticOrder, true, true>(F.lds + RING_OFF, g, S, E);
    });
    SEAM(pb + 0);
    PHASE(pb + 1, 8, { attn1_phase(F, l); });
    SEAM(pb + 1);
    PHASE(pb + 2, 16, { attn2_phase(F); });
    if constexpr ((DBL_MASK & 0x10000) != 0) { xcd_barrier(bar); FENCE(); attn1_phase(F, l); xcd_barrier(bar); FENCE(); attn2_phase(F); }
    SEAM(pb + 2);
    PHASE(pb + 3, 32, { merge_phase(F, l); });
    SEAM(pb + 3);
    PHASE(pb + 4, 64, {
        const float* xin = (l == 0) ? inp(F, I_X) : (const float*)(wsp(F) + WS_XB);
        pg8::Gemm g{(const pg8::bf16_t*)(wsp(F) + WS_HB), (const pg8::bf16_t*)(wsp(F) + WS_WOUT), MTOK, DM, DM}; pg8::StaticOrder S; S.init(MTOK, DM, F.G, (int)blockIdx.x);
        pg8::EpiResid E{xin, (float*)(wsp(F) + WS_XA), (const float*)(wsp(F) + WS_MOD) + (size_t)l * NB * 6 * DM + 2 * DM, 6 * DM, SEQ, DM, ALPHA};
        pg8::gemm_phase<pg8::EpiResid, pg8::StaticOrder, true, true>(F.lds + RING_OFF, g, S, E);
    });
    SEAM(pb + 4);
    PHASE(pb + 5, 128, { post_mixer_phase(F, l); });
    if constexpr (IN(pb + 5)) { if constexpr (HI - LO > 1) xcd_barrier(bar); FENCE(); router_phase(F, l); }
    SEAM(pb + 5);
    PHASE(pb + 6, 256, { gather_phase(F, l); });
    SEAM(pb + 6);
    PHASE(pb + 7, 512, {
        const int* gt = (const int*)(wsp(F) + WS_SMALL + SM_TILE);
        pg8::Gemm g{(const pg8::bf16_t*)(wsp(F) + WS_XS), (const pg8::bf16_t*)(wsp(F) + WS_WGU), MAXROWS, NEXP * 1024, DM};
        pg8::MoeOrder S{gt[200], 4, F.G, (int)blockIdx.x, gt};
        pg8::EpiSwiGLU E{(pg8::bf16_t*)(wsp(F) + WS_HID), DEXP};
        pg8::gemm_phase<pg8::EpiSwiGLU, pg8::MoeOrder, true, true>(F.lds + RING_OFF, g, S, E);
    });
    SEAM(pb + 7);
    PHASE(pb + 8, 1024, {
        const int* gt = (const int*)(wsp(F) + WS_SMALL + SM_TILE);
        pg8::Gemm g{(const pg8::bf16_t*)(wsp(F) + WS_HID), (const pg8::bf16_t*)(wsp(F) + WS_WD), MAXROWS, NEXP * DM, DEXP};
        pg8::MoeOrder S{gt[200], 8, F.G, (int)blockIdx.x, gt};
        pg8::EpiDown E{(pg8::bf16_t*)(wsp(F) + WS_YS), DM, (const int*)(wsp(F) + WS_SMALL + SM_ROWINFO), (const float*)(wsp(F) + WS_SMALL + SM_GATEW)};
        pg8::gemm_phase<pg8::EpiDown, pg8::MoeOrder, true, true>(F.lds + RING_OFF, g, S, E);
    });
    SEAM(pb + 8);
    PHASE(pb + 9, 2048, { post_moe_phase(F, l, (l == DEPTH - 1) ? outp(F) : (float*)(wsp(F) + WS_XB), l < DEPTH - 1); });
    PHASE(pb + 9, 4096, { if (l < DEPTH - 1) convert_layer(F, l + 1); });
    SEAM(pb + 9);
}
template <int LO, int HI>
__global__ void __launch_bounds__(NWAVES * 64, 2) fwd_kernel(Args args) {
    extern __shared__ __attribute__((aligned(16))) unsigned char lds[];
    Frame F;
    F.lds = (LAS unsigned char*)lds;
    F.MISC = (volatile LAS unsigned*)(F.lds + MISC_OFF);
    F.tid = threadIdx.x; F.lane = F.tid & 63; F.wave = __builtin_amdgcn_readfirstlane(F.tid >> 6);
    F.G = gridDim.x; { const int bx = blockIdx.x; F.vcu = (F.G % 8 == 0) ? (bx % 8) * (F.G / 8) + bx / 8 : bx; }
    for (int u = F.tid; u < (LDS_BYTES - LDSCTL_OFF) / 4; u += NWAVES * 64) ((LAS unsigned*)(F.lds + LDSCTL_OFF))[u] = 0u;
    __syncthreads();
    if (F.tid < 25) ((LAS unsigned long long*)(F.lds + PTR_OFF))[F.tid] = (unsigned long long)args.in[F.tid];
    if (F.tid == 25) ((LAS unsigned long long*)(F.lds + PTR_OFF))[25] = (unsigned long long)args.ws;
    if (F.tid == 26) ((LAS unsigned long long*)(F.lds + PTR_OFF))[26] = (unsigned long long)args.out;
    __syncthreads();
    XcdBarrier bar; bar.bar = (unsigned*)(ctlp(F) + CW_BAR); bar.x = 0; bar.st = nullptr;
    if constexpr (HI - LO > 1) bar = xcd_barrier_post((unsigned*)(ctlp(F) + CW_BAR), F.MISC + 8);
    PHASE(0, 1, { ada_phase(F); });
    PHASE(0, 4096, { convert_layer(F, 0); });
    SEAM(0);
    PHASE(1, 2, { ln_in_phase(F); });
    SEAM(1);
    layer_phases<0, LO, HI>(F, bar);
    layer_phases<1, LO, HI>(F, bar);
}
#undef IN
#undef SEAM
#undef PHASE

#if MK_ONE_LAUNCH
#define FWD_MAIN (fwd_kernel<0, N_PHASES>)
static bool set_lds_attr() { return hipFuncSetAttribute((const void*)FWD_MAIN, hipFuncAttributeMaxDynamicSharedMemorySize, LDS_BYTES) == hipSuccess; }
#else
#define FWD_MAIN (fwd_kernel<0, 1>)
template <int... P> static bool set_lds_attr_seq(std::integer_sequence<int, P...>) { bool ok = true; ((ok = ok && hipFuncSetAttribute((const void*)(fwd_kernel<P, P + 1>), hipFuncAttributeMaxDynamicSharedMemorySize, LDS_BYTES) == hipSuccess), ...); return ok; }
static bool set_lds_attr() { return set_lds_attr_seq(std::make_integer_sequence<int, N_PHASES>{}); }
template <int P> static void launch_one(int grid, hipStream_t stream, const Args& a) { hipLaunchKernelGGL((fwd_kernel<P, P + 1>), dim3(grid), dim3(NWAVES * 64), LDS_BYTES, stream, a); }
template <int... P> static void launch_phases(std::integer_sequence<int, P...>, int grid, hipStream_t stream, const Args& a) { (launch_one<P>(grid, stream, a), ...); }
#endif
extern "C" void kernel_launch(void* const* d_in, const int* in_sizes, int n_in, void* d_out, int out_size, void* d_ws, size_t ws_size, hipStream_t stream) {
    static int grid = 0;
    if (grid == 0) {
        if (n_in != 25 || out_size != MTOK * DM || ws_size < WS_END) { fprintf(stderr, "kernel_launch: unexpected problem shape (n_in %d, out %d, ws %zu)\n", n_in, out_size, ws_size); grid = -1; return; }
        int dev = 0, cus = 0, per_cu = 0;
        if (hipGetDevice(&dev) != hipSuccess || hipDeviceGetAttribute(&cus, hipDeviceAttributeMultiprocessorCount, dev) != hipSuccess) { grid = -1; return; }
        if (!set_lds_attr()) { fprintf(stderr, "kernel_launch: hipFuncSetAttribute failed\n"); grid = -1; return; }
        if (hipOccupancyMaxActiveBlocksPerMultiprocessor(&per_cu, (const void*)FWD_MAIN, NWAVES * 64, LDS_BYTES) != hipSuccess || per_cu < 1)
            fprintf(stderr, "kernel_launch: note: occupancy query reports %d workgroups per CU\n", per_cu);
        (void)hipGetLastError();
        grid = cus;
        if (grid > 256) grid = 256;
        grid &= ~7;
    }
    if (grid <= 0) return;
    (void)in_sizes;
    if (hipMemsetAsync((char*)d_ws + WS_CTL, 0, CTL_ZERO_BYTES, stream) != hipSuccess) return;
    Args a{};
    for (int i = 0; i < 25; ++i) a.in[i] = (const float*)d_in[i];
    a.out = (float*)d_out; a.ws = (unsigned char*)d_ws;
#if MK_ONE_LAUNCH
    hipLaunchKernelGGL((fwd_kernel<0, N_PHASES>), dim3(grid), dim3(NWAVES * 64), LDS_BYTES, stream, a);
#else
    launch_phases(std::make_integer_sequence<int, N_PHASES>{}, grid, stream, a);
#endif
}
```

```cpp
#include <hip/hip_runtime.h>
#include <cstdio>
#include <cstdint>
#include <utility>
#define MK_ONE_LAUNCH 1
namespace pg8 {
#define PG8_LAS __attribute__((address_space(3)))
#define PG8_LAS_T __attribute__((address_space(3)))
typedef unsigned short bf16_t;
typedef short bf16x8 __attribute__((ext_vector_type(8)));
typedef float f32x4 __attribute__((ext_vector_type(4)));
typedef unsigned u32x4 __attribute__((ext_vector_type(4)));
constexpr int BM = 256, BK = 64, HALF = 128, HTB = HALF * BK * 2  , STAGE_BYTES = 8 * HTB, NXCD = 8, WGM = 8;

__host__ __device__ __forceinline__ int lds_byte(int r, int c) { const int st = (r >> 4) * 2 + (c >> 5), rr = r & 15, cc = c & 31, ob = rr * 64 + cc * 2; return st * 1024 + (ob ^ (((ob >> 9) & 1) << 5)); }
__host__ __device__ __forceinline__ void stage_rc(int b, int& R, int& C) { const int st = b / 1024, sb = b % 1024, swz = sb ^ (((sb >> 9) & 1) << 5); R = (st >> 1) * 16 + swz / 64; C = (st & 1) * 32 + (swz % 64) / 2; }
__host__ __device__ __forceinline__ int perm32(int rho) { const int n = rho >> 4, i = rho & 15; return 8 * (i >> 2) + 4 * n + (i & 3); }

struct Unit { int pm, pn; };
struct Gemm { const bf16_t* A; const bf16_t* Bt; int M, N, K; };

struct StaticOrder {
    int nM, nN, nwg, G, c;
    __host__ __device__ void init(int M, int N, int G_, int c_) { nM = M / BM; nN = N / BM; nwg = nM * nN; G = G_; c = c_; }
    __host__ __device__ bool next(int i, Unit& u) const {
        const long L = (long)i * G + c; if (L >= nwg) return false;
        int wgid = (int)L; { const int q = nwg / NXCD, r = nwg % NXCD, xcd = wgid % NXCD, off = wgid / NXCD; wgid = (xcd < r ? xcd * (q + 1) : r * (q + 1) + (xcd - r) * q) + off; }
        const int nig = WGM * nN, gid = wgid / nig, fm = gid * WGM, gsz = (nM - fm) < WGM ? (nM - fm) : WGM;
        u.pm = fm + ((wgid % nig) % gsz); u.pn = (wgid % nig) / gsz; return true;
    }
    __device__ __forceinline__ void a_ready(const Unit&) const {}
    __device__ __forceinline__ void done(const Unit&) const {}
};
__device__ __forceinline__ unsigned cvt_pk_bf16(float lo, float hi) { unsigned r; asm volatile("s_nop 0\n\tv_cvt_pk_bf16_f32 %0, %1, %2" : "=v"(r) : "v"(lo), "v"(hi));     return r; }
typedef float f32x2 __attribute__((ext_vector_type(2)));
__device__ __forceinline__ unsigned short f2bf_rne(float f) { unsigned u = __builtin_bit_cast(unsigned, f); return (unsigned short)((u + 0x7fffu + ((u >> 16) & 1u)) >> 16); }

struct EpiProj {
    static constexpr bool PERM = true, AFTER_DRAIN = false;
    bf16_t* P; bf16_t* VT; int ldp; int ldvt;
    __device__ __forceinline__ void operator()(const f32x4 (&acc)[2][2][4][2], const Unit& u, int wr, int wc, int fr, int fq) const {
        const int row0 = u.pm * BM + wr * 64 + fr;
#pragma unroll
        for (int bj = 0; bj < 2; ++bj) {
            const int cb = u.pn * BM + bj * HALF;
            if (cb < ldp) {
                bf16_t* colp = P + (size_t)row0 * ldp + cb + wc * 32 + 8 * fq;
#pragma unroll
                for (int ai = 0; ai < 2; ++ai)
#pragma unroll
                    for (int m = 0; m < 4; ++m) { const f32x4 v0 = acc[ai][bj][m][0], v1 = acc[ai][bj][m][1];
                        u32x4 w; w.x = cvt_pk_bf16(v0[0], v0[1]); w.y = cvt_pk_bf16(v0[2], v0[3]); w.z = cvt_pk_bf16(v1[0], v1[1]); w.w = cvt_pk_bf16(v1[2], v1[3]);
                        *(u32x4*)(colp + (size_t)(ai * HALF + m * 16) * ldp) = w; }
            } else {
                const int c0 = cb - ldp + wc * 32 + 8 * fq;
#pragma unroll
                for (int n = 0; n < 2; ++n)
#pragma unroll
                    for (int e = 0; e < 4; ++e) { bf16_t* cp = VT + (size_t)(c0 + n * 4 + e) * ldvt + row0;
#pragma unroll
                        for (int ai = 0; ai < 2; ++ai)
#pragma unroll
                            for (int m = 0; m < 4; ++m) cp[ai * HALF + m * 16] = f2bf_rne(acc[ai][bj][m][n][e]); }
            }
        }
    }
};

template <bool XBF> struct EpiResid {
    static constexpr bool PERM = true, AFTER_DRAIN = false;
    const void* xin; bf16_t* out; const float* gate0; int gate_bstride; int rows_per_batch; int ldc; float alpha;
    __device__ __forceinline__ void operator()(const f32x4 (&acc)[2][2][4][2], const Unit& u, int wr, int wc, int fr, int fq) const {
        const int col0 = u.pn * BM + wc * 32 + 8 * fq;
        const float* gv = gate0 + (size_t)((u.pm * BM) / rows_per_batch) * gate_bstride;
#pragma unroll
        for (int bj = 0; bj < 2; ++bj) { const int c = col0 + bj * HALF; const f32x4 g0 = *(const f32x4*)(gv + c) + 1.0f, g1 = *(const f32x4*)(gv + c + 4) + 1.0f;
#pragma unroll
            for (int ai = 0; ai < 2; ++ai)
#pragma unroll
                for (int m = 0; m < 4; ++m) { const size_t off = (size_t)(u.pm * BM + ai * HALF + wr * 64 + m * 16 + fr) * ldc + c;
                    f32x4 x0, x1;
                    if (XBF) { const u32x4 xw = *(const u32x4*)((const bf16_t*)xin + off);
                        x0 = (f32x4){__builtin_bit_cast(float, xw.x << 16), __builtin_bit_cast(float, xw.x & 0xffff0000u), __builtin_bit_cast(float, xw.y << 16), __builtin_bit_cast(float, xw.y & 0xffff0000u)};
                        x1 = (f32x4){__builtin_bit_cast(float, xw.z << 16), __builtin_bit_cast(float, xw.z & 0xffff0000u), __builtin_bit_cast(float, xw.w << 16), __builtin_bit_cast(float, xw.w & 0xffff0000u)}; }
                    else { x0 = *(const f32x4*)((const float*)xin + off); x1 = *(const f32x4*)((const float*)xin + off + 4); }
                    const f32x4 v0 = x0 * alpha + g0 * acc[ai][bj][m][0], v1 = x1 * alpha + g1 * acc[ai][bj][m][1];
                    u32x4 w; w.x = cvt_pk_bf16(v0[0], v0[1]); w.y = cvt_pk_bf16(v0[2], v0[3]); w.z = cvt_pk_bf16(v1[0], v1[1]); w.w = cvt_pk_bf16(v1[2], v1[3]);
                    *(u32x4*)(out + off) = w; } }
    }
};

struct EpiSwiGLU {
    static constexpr bool PERM = true, AFTER_DRAIN = false;
    bf16_t* H; int ldh;
    __device__ __forceinline__ void operator()(const f32x4 (&acc)[2][2][4][2], const Unit& u, int wr, int wc, int fr, int fq) const {
        const int row0 = u.pm * BM + wr * 64 + fr, pnl = u.pn & 3;
        const int j0 = pnl * 128 + wc * 16 + 4 * fq;
#pragma unroll
        for (int ai = 0; ai < 2; ++ai)
#pragma unroll
            for (int m = 0; m < 4; ++m) { bf16_t* rowp = H + (size_t)(row0 + ai * HALF + m * 16) * ldh + j0;
#pragma unroll
                for (int bj = 0; bj < 2; ++bj) { const f32x4 v0 = acc[ai][bj][m][0], v1 = acc[ai][bj][m][1];
                    const float h0 = v0[0] / (1.0f + __expf(-v0[0])) * v0[1], h1 = v0[2] / (1.0f + __expf(-v0[2])) * v0[3];
                    const float h2 = v1[0] / (1.0f + __expf(-v1[0])) * v1[1], h3 = v1[2] / (1.0f + __expf(-v1[2])) * v1[3];
                    typedef unsigned u32x2 __attribute__((ext_vector_type(2)));
                    u32x2 w; w.x = cvt_pk_bf16(h0, h1); w.y = cvt_pk_bf16(h2, h3);
                    *(u32x2*)(rowp + bj * 64) = w; } }
    }
};

__device__ __forceinline__ int moe_row_aid(const PG8_LAS int* tab, const int* list, int list_stride, int rt, int row_in_tile) {
    const int e = tab[64 + rt], pos = rt * 256 + row_in_tile - tab[32 + e];
    return pos < tab[e] ? list[(size_t)e * list_stride + pos] : -1;
}
struct MoeGather {
    static constexpr bool ON = true;
    const PG8_LAS int* tab; const int* list; int list_stride; unsigned row_bytes, zero_off;
    __device__ __forceinline__ unsigned row_off(const Unit& u, int h, int r) const { const int aid = moe_row_aid(tab, list, list_stride, u.pm, h * HALF + r); return aid >= 0 ? (unsigned)(aid >> 1) * row_bytes : zero_off; }
};

struct EpiDown {
    static constexpr bool PERM = true, AFTER_DRAIN = false;
    bf16_t* Y; int ldy; const PG8_LAS int* tab; const int* list; int list_stride; const float* gatew;
    __device__ __forceinline__ void operator()(const f32x4 (&acc)[2][2][4][2], const Unit& u, int wr, int wc, int fr, int fq) const {
        const int pnl = u.pn & 7;
        const int col0 = pnl * BM + wc * 32 + 8 * fq;
#pragma unroll
        for (int ai = 0; ai < 2; ++ai)
#pragma unroll
            for (int m = 0; m < 4; ++m) { const int aid = moe_row_aid(tab, list, list_stride, u.pm, wr * 64 + fr + ai * HALF + m * 16);
                if (aid >= 0) { const float gw = gatew[aid]; bf16_t* rowp = Y + (size_t)aid * ldy + col0;
#pragma unroll
                    for (int bj = 0; bj < 2; ++bj) { const f32x4 v0 = acc[ai][bj][m][0] * gw, v1 = acc[ai][bj][m][1] * gw;
                        u32x4 w; w.x = cvt_pk_bf16(v0[0], v0[1]); w.y = cvt_pk_bf16(v0[2], v0[3]); w.z = cvt_pk_bf16(v1[0], v1[1]); w.w = cvt_pk_bf16(v1[2], v1[3]);
                        *(u32x4*)(rowp + bj * HALF) = w; } } }
    }
};

struct MoeOrder {
    int NT, G, c; const PG8_LAS int* tab;
    __device__ __forceinline__ bool next(int i, Unit& u) const {
        const int x = c & 7, ci = c >> 3, per = G >> 3;
        const int q = i * per + ci, rt = x + 8 * (q / NT);
        if (rt >= tab[224]) return false;
        u.pm = rt; u.pn = tab[64 + rt] * NT + (q % NT); return true;
    }
    __device__ __forceinline__ void a_ready(const Unit&) const {}
    __device__ __forceinline__ void done(const Unit&) const {}
};
struct NoGather { static constexpr bool ON = false; __device__ __forceinline__ unsigned row_off(const Unit&, int, int) const { return 0u; } };
template <class Epi, class Sched, bool ALIGN_EPI = false, bool SP2 = false, class Gat = NoGather>
__device__ __forceinline__ void gemm_phase(PG8_LAS unsigned char* lds, const Gemm g, const Sched& S, const Epi& E, const Gat& GA = Gat()) {
    static_assert(!Gat::ON || SP2, "the gathered A operand is wired into the SP2 loop only");
    int tid_ = threadIdx.x; asm volatile("" : "+v"(tid_));
    const int tid = tid_, wid = __builtin_amdgcn_readfirstlane(tid >> 6), lane = tid & 63, wr = wid >> 2, wc = wid & 3, fr = lane & 15, fq = lane >> 4;
    const int K = g.K, nt = K / BK;
    unsigned voffA[2], voffB[2];
    int RA[2]; unsigned CA2[2];
#pragma unroll
    for (int i = 0; i < 2; ++i) { int R, C; stage_rc(tid * 16 + i * 8192, R, C); const int Rb = Epi::PERM ? ((R & ~31) + perm32(R & 31)) : R;
        voffA[i] = (unsigned)(R * K + C) * 2u; voffB[i] = (unsigned)(Rb * K + C) * 2u; RA[i] = R; CA2[i] = (unsigned)C * 2u; }
    unsigned gcu[2][2] = {{0u, 0u}, {0u, 0u}}, gnx[2][2] = {{0u, 0u}, {0u, 0u}};
    const size_t kstep = (size_t)(BK * 2);
    const size_t hstep = (size_t)HALF * K * 2;
    const size_t tstep = 2 * hstep;
    const unsigned ldsw = (unsigned)wid * 1024u;
    const int aoff = lds_byte(wr * 64 + fr, fq * 8), boff = lds_byte(wc * 32 + fr, fq * 8);
#define PG8_SA(b, h) (((b) * 2 + (h)) * HTB)
#define PG8_SB(b, h) ((4 + (b) * 2 + (h)) * HTB)
#define PG8_STAGE(bufoff, gbase, voff) do { _Pragma("unroll") for (int _i = 0; _i < 2; ++_i) \
        __builtin_amdgcn_global_load_lds((const unsigned*)((const char*)(gbase) + (voff)[_i]), (PG8_LAS unsigned*)(lds + (bufoff) + ldsw + _i * 8192), 16, 0, 0); } while (0)
#define PG8_STAGE_A(b, h, ptr, isnext) do { if constexpr (Gat::ON) { const bool _nx = (isnext); unsigned _tv[2] = {_nx ? gnx[h][0] : gcu[h][0], _nx ? gnx[h][1] : gcu[h][1]}; PG8_STAGE(PG8_SA(b, h), ptr, _tv); } \
        else { PG8_STAGE(PG8_SA(b, h), (ptr) + (h) * hstep, voffA); } } while (0)
#define PG8_LDA(dst, b, h) do { _Pragma("unroll") for (int m = 0; m < 4; ++m) _Pragma("unroll") for (int k = 0; k < 2; ++k) dst[m][k] = *(const PG8_LAS bf16x8*)(lds + PG8_SA(b, h) + aoff + m * 2048 + k * 1024); } while (0)
#define PG8_LDB(dst, b, h) do { _Pragma("unroll") for (int n = 0; n < 2; ++n) _Pragma("unroll") for (int k = 0; k < 2; ++k) dst[n][k] = *(const PG8_LAS bf16x8*)(lds + PG8_SB(b, h) + boff + n * 2048 + k * 1024); } while (0)
#define PG8_MMA(ai, bj, At, Bt) do { __builtin_amdgcn_s_setprio(1); _Pragma("unroll") for (int m = 0; m < 4; ++m) _Pragma("unroll") for (int n = 0; n < 2; ++n) _Pragma("unroll") for (int k = 0; k < 2; ++k) \
        acc[ai][bj][m][n] = __builtin_amdgcn_mfma_f32_16x16x32_bf16(Bt[n][k], At[m][k], acc[ai][bj][m][n], 0, 0, 0); __builtin_amdgcn_s_setprio(0); } while (0)
#define PG8_WAIT_V(n) asm volatile("s_waitcnt vmcnt(" #n ")" ::: "memory")
#define PG8_WAIT_L(n) asm volatile("s_waitcnt lgkmcnt(" #n ")" ::: "memory")
#define PG8_BAR __builtin_amdgcn_s_barrier()
#define PG8_SCHED __builtin_amdgcn_sched_barrier(0)
    Unit cur, nxt; int ui = 0;
    if (!S.next(0, cur)) return;
    f32x4 acc[2][2][4][2];
#pragma unroll
    for (int a = 0; a < 2; ++a)
#pragma unroll
        for (int b = 0; b < 2; ++b)
#pragma unroll
            for (int m = 0; m < 4; ++m)
#pragma unroll
                for (int n = 0; n < 2; ++n) acc[a][b][m][n] = (f32x4){0.f, 0.f, 0.f, 0.f};
    bf16x8 At[4][2], B0[2][2], B1[2][2];
    const char* cA = (const char*)g.A + (Gat::ON ? (size_t)0 : (size_t)cur.pm * tstep); const char* cB = (const char*)g.Bt + (size_t)cur.pn * tstep;
    if constexpr (Gat::ON) {
#pragma unroll
        for (int h = 0; h < 2; ++h)
#pragma unroll
            for (int i = 0; i < 2; ++i) { gcu[h][i] = GA.row_off(cur, h, RA[i]) + CA2[i]; gnx[h][i] = gcu[h][i]; } }
    S.a_ready(cur);
    if constexpr (SP2) {
        PG8_STAGE(PG8_SB(0, 0), cB, voffB); PG8_STAGE(PG8_SB(0, 1), cB + hstep, voffB); PG8_STAGE_A(0, 0, cA, false); PG8_STAGE_A(0, 1, cA, false);
        if (wr == 1) PG8_BAR;
        PG8_WAIT_V(2); PG8_BAR;
        PG8_STAGE(PG8_SB(1, 0), cB + kstep, voffB); PG8_STAGE_A(1, 0, cA + kstep, false); PG8_STAGE(PG8_SB(1, 1), cB + hstep + kstep, voffB);
        PG8_WAIT_V(6); PG8_BAR;
    } else {
        PG8_STAGE(PG8_SB(0, 0), cB, voffB); PG8_STAGE(PG8_SA(0, 0), cA, voffA); PG8_STAGE(PG8_SB(0, 1), cB + hstep, voffB); PG8_STAGE(PG8_SA(0, 1), cA + hstep, voffA);
        if (wr == 1) PG8_BAR;
        PG8_WAIT_V(4); PG8_BAR;
        PG8_STAGE(PG8_SB(1, 0), cB + kstep, voffB); PG8_STAGE(PG8_SA(1, 0), cA + kstep, voffA); PG8_STAGE(PG8_SB(1, 1), cB + hstep + kstep, voffB);
        PG8_WAIT_V(6); PG8_BAR;
    }
    for (;;) {
        const bool has_next = S.next(ui + 1, nxt);
        const char* nA = (has_next && !Gat::ON) ? (const char*)g.A + (size_t)nxt.pm * tstep : cA; const char* nB = has_next ? (const char*)g.Bt + (size_t)nxt.pn * tstep : cB;
        if constexpr (Gat::ON) { if (has_next) {
#pragma unroll
            for (int h = 0; h < 2; ++h)
#pragma unroll
                for (int i = 0; i < 2; ++i) gnx[h][i] = GA.row_off(nxt, h, RA[i]) + CA2[i]; } }
        for (int t = 0; t < nt; t += 2) {
            const bool last = (t == nt - 2);
            const char* a1 = cA + (size_t)(t + 1) * kstep;
            const char* a2 = last ? nA : cA + (size_t)(t + 2) * kstep; const char* b2 = last ? nB : cB + (size_t)(t + 2) * kstep;
            const char* a3 = a2 + kstep; const char* b3 = b2 + kstep;
            if (last && has_next) S.a_ready(nxt);
            if constexpr (SP2) {
            PG8_LDB(B0, 0, 0); PG8_LDB(B1, 0, 1); PG8_SCHED; PG8_LDA(At, 0, 0); PG8_STAGE_A(1, 1, a1, false);
            PG8_WAIT_V(8); PG8_WAIT_L(0); PG8_BAR; PG8_MMA(0, 0, At, B0); PG8_MMA(0, 1, At, B1); PG8_BAR; PG8_SCHED;
            PG8_LDA(At, 0, 1); PG8_STAGE(PG8_SB(0, 0), b2, voffB); PG8_STAGE(PG8_SB(0, 1), b2 + hstep, voffB); PG8_STAGE_A(0, 0, a2, last);
            PG8_WAIT_V(8); PG8_WAIT_L(0); PG8_BAR; PG8_MMA(1, 0, At, B0); PG8_MMA(1, 1, At, B1); PG8_BAR; PG8_SCHED;
            PG8_LDB(B0, 1, 0); PG8_LDB(B1, 1, 1); PG8_SCHED; PG8_LDA(At, 1, 0); PG8_STAGE_A(0, 1, a2, last);
            PG8_WAIT_V(8); PG8_WAIT_L(0); PG8_BAR; PG8_MMA(0, 0, At, B0); PG8_MMA(0, 1, At, B1); PG8_BAR; PG8_SCHED;
            PG8_LDA(At, 1, 1); PG8_STAGE(PG8_SB(1, 0), b3, voffB); PG8_STAGE(PG8_SB(1, 1), b3 + hstep, voffB); PG8_STAGE_A(1, 0, a3, last);
            PG8_WAIT_V(8); PG8_WAIT_L(0); PG8_BAR; PG8_MMA(1, 0, At, B0); PG8_MMA(1, 1, At, B1); PG8_BAR; PG8_SCHED;
            } else {
            PG8_LDB(B0, 0, 0); PG8_SCHED; PG8_LDA(At, 0, 0); PG8_STAGE(PG8_SA(1, 1), a1 + hstep, voffA);
            PG8_WAIT_L(8); PG8_BAR; PG8_WAIT_L(0); PG8_MMA(0, 0, At, B0); PG8_BAR; PG8_SCHED;
            PG8_LDB(B1, 0, 1); PG8_STAGE(PG8_SB(0, 0), b2, voffB);
            PG8_BAR; PG8_WAIT_L(0); PG8_MMA(0, 1, At, B1); PG8_BAR;
            PG8_LDA(At, 0, 1); PG8_STAGE(PG8_SA(0, 0), a2, voffA);
            PG8_BAR; PG8_WAIT_L(0); PG8_MMA(1, 0, At, B0); PG8_BAR; PG8_SCHED;
            PG8_STAGE(PG8_SB(0, 1), b2 + hstep, voffB);
            PG8_WAIT_V(6); PG8_BAR; PG8_MMA(1, 1, At, B1); PG8_BAR;
            PG8_LDB(B0, 1, 0); PG8_SCHED; PG8_LDA(At, 1, 0); PG8_STAGE(PG8_SA(0, 1), a2 + hstep, voffA);
            PG8_WAIT_L(8); PG8_BAR; PG8_WAIT_L(0); PG8_MMA(0, 0, At, B0); PG8_BAR; PG8_SCHED;
            PG8_LDB(B1, 1, 1); PG8_STAGE(PG8_SB(1, 0), b3, voffB);
            PG8_BAR; PG8_WAIT_L(0); PG8_MMA(0, 1, At, B1); PG8_BAR;
            PG8_LDA(At, 1, 1); PG8_STAGE(PG8_SA(1, 0), a3, voffA);
            PG8_BAR; PG8_WAIT_L(0); PG8_MMA(1, 0, At, B0); PG8_BAR; PG8_SCHED;
            PG8_STAGE(PG8_SB(1, 1), b3 + hstep, voffB);
            PG8_WAIT_V(6); PG8_BAR; PG8_MMA(1, 1, At, B1); PG8_BAR;
            }
        }
        if constexpr (ALIGN_EPI) { if (wr == 0) PG8_BAR; }
        if constexpr (!Epi::AFTER_DRAIN) { E(acc, cur, wr, wc, fr, fq); S.done(cur); }
        if (!has_next) break;
#pragma unroll
        for (int a = 0; a < 2; ++a)
#pragma unroll
            for (int b = 0; b < 2; ++b)
#pragma unroll
                for (int m = 0; m < 4; ++m)
#pragma unroll
                    for (int n = 0; n < 2; ++n) acc[a][b][m][n] = (f32x4){0.f, 0.f, 0.f, 0.f};
        cur = nxt; cA = nA; cB = nB; ++ui;
        if constexpr (Gat::ON) {
#pragma unroll
            for (int h = 0; h < 2; ++h) { gcu[h][0] = gnx[h][0]; gcu[h][1] = gnx[h][1]; } }
        if constexpr (ALIGN_EPI) { if (wr == 1) PG8_BAR; }
    }
    PG8_WAIT_V(0);
    if constexpr (!ALIGN_EPI) { if (wr == 0) PG8_BAR; }
    PG8_BAR;
    if constexpr (Epi::AFTER_DRAIN) { E.fused(acc, cur, wr, wc, fr, fq, lds, wid, lane); S.done(cur); }
#undef PG8_SA
#undef PG8_SB
#undef PG8_STAGE
#undef PG8_STAGE_A
#undef PG8_LDA
#undef PG8_LDB
#undef PG8_MMA
#undef PG8_WAIT_V
#undef PG8_WAIT_L
#undef PG8_BAR
#undef PG8_SCHED
}
}
constexpr int NWAVES = 8;
constexpr int NB = 2, SEQ = 8192, DM = 2048, MTOK = NB * SEQ, DEPTH = 2, HD = 64;
constexpr int NEXP = 32, DEXP = 512, NASSIGN = MTOK * 2;
constexpr int D_IN = 5144;
constexpr int NPROJ = 3712, NVT = 1408, NIN = NPROJ + NVT;
constexpr int P_QA = 0, P_KA = 512, P_QB = 640, P_KBC = 1152, P_VBC = 1280, P_KBS = 1408, P_KBW = 1536, P_QC = 1664, P_KC = 2688;
constexpr int V_C = 0, V_A = 1024, V_BS = 1152, V_BW = 1280;
constexpr float LN_EPS = 1e-5f, RMS_EPS = 1e-6f, ALPHA = 1.41421356237309515f;
constexpr float LOG2E = 1.44269504088896341f, LN2 = 0.693147180559945309f;
constexpr float SC2 = 0.125f * LOG2E;
constexpr int MAXROWS = 40960;
constexpr float SB_EXIT = -104.0f;

constexpr size_t MiB = 1u << 20;
constexpr size_t WS_CTL = 0, CTL_ZERO_BYTES = 1 * MiB;
constexpr size_t WS_MOD = 1 * MiB;
constexpr size_t WS_SMALL = 2 * MiB;
constexpr size_t WS_LIST = 5 * MiB;
constexpr size_t WS_WCMP = 7 * MiB;
constexpr size_t WS_WIN = 9 * MiB;
constexpr size_t WS_WOUT = 30 * MiB;
constexpr size_t WS_WGU = 38 * MiB;
constexpr size_t WS_WD = 166 * MiB;
constexpr size_t WS_XA = 230 * MiB;
constexpr size_t WS_XB = 358 * MiB;
constexpr size_t WS_HB = 486 * MiB;
constexpr size_t WS_PROJ = 550 * MiB;
constexpr size_t WS_VT = WS_PROJ + (size_t)MTOK * NPROJ * 2;
constexpr size_t WS_XS = WS_PROJ;
constexpr size_t WS_OCAT = 720 * MiB;
constexpr size_t WS_YS = WS_OCAT;
constexpr size_t WS_HID = 848 * MiB;
constexpr size_t WS_END = 888 * MiB;
static_assert(WS_VT + (size_t)NVT * MTOK * 2 <= WS_OCAT && WS_XS + (size_t)MAXROWS * DM * 2 <= WS_OCAT, "proj/vT/xs region");
static_assert(WS_WIN + (size_t)NIN * DM * 2 <= WS_WOUT && WS_WGU + (size_t)NEXP * 1024 * DM * 2 <= WS_WD && WS_WD + (size_t)NEXP * DM * DEXP * 2 <= WS_XA, "weight regions");
constexpr size_t SM_KCMP = 0;
constexpr size_t SM_VCMPT = 256 * 1024;
constexpr size_t SM_GATEW = 512 * 1024;
constexpr size_t SM_ROWINFO = 640 * 1024;
constexpr size_t SM_TILE = 800 * 1024;
constexpr size_t WS_GBUF = WS_SMALL + 1024 * 1024;
constexpr int CW_BAR = 4096;
constexpr int CW_CNT = 16384;

constexpr int RING_OFF = 0, RING_BYTES = 131072;
constexpr int TAB_OFF = RING_BYTES;
constexpr int LDSCTL_OFF = 143360, MISC_OFF = LDSCTL_OFF + 320;
constexpr int LDS_BYTES = 147456;

#define GAS __attribute__((address_space(1)))
#define LAS __attribute__((address_space(3)))
typedef unsigned short bf16;
typedef unsigned v4u __attribute__((ext_vector_type(4)));
typedef unsigned v2u __attribute__((ext_vector_type(2)));
typedef float f32x4 __attribute__((ext_vector_type(4)));
typedef short bf16x8 __attribute__((ext_vector_type(8)));
typedef GAS unsigned gu32;
#define RLX_AGENT __ATOMIC_RELAXED, __HIP_MEMORY_SCOPE_AGENT
#define LDS_WAIT() asm volatile("s_waitcnt lgkmcnt(0)" ::: "memory")
#define VM_WAIT() asm volatile("s_waitcnt vmcnt(0)" ::: "memory")
__device__ __forceinline__ unsigned f2bf(float f) { unsigned u = __builtin_bit_cast(unsigned, f); return (u + 0x7fffu + ((u >> 16) & 1u)) >> 16; }
__device__ __forceinline__ unsigned pk2(float lo, float hi) { return f2bf(lo) | (f2bf(hi) << 16); }
__device__ __forceinline__ float bf2f(unsigned short h) { return __builtin_bit_cast(float, (unsigned)h << 16); }
__device__ __forceinline__ float bflo(unsigned w) { return __builtin_bit_cast(float, w << 16); }
__device__ __forceinline__ float bfhi(unsigned w) { return __builtin_bit_cast(float, w & 0xffff0000u); }
__device__ __forceinline__ float ex2(float x) { return __builtin_amdgcn_exp2f(x); }
__device__ __forceinline__ float lg2(float x) { return __builtin_amdgcn_logf(x); }
__device__ __forceinline__ bf16x8 ldg8(const bf16* p) { return *(const GAS bf16x8*)p; }
__device__ __forceinline__ f32x4 mfma16(bf16x8 a, bf16x8 b, f32x4 c) { return __builtin_amdgcn_mfma_f32_16x16x32_bf16(a, b, c, 0, 0, 0); }
__device__ __forceinline__ bf16x8 pack8(float a0, float a1, float a2, float a3, float a4, float a5, float a6, float a7) {
    v4u w; w.x = pg8::cvt_pk_bf16(a0, a1); w.y = pg8::cvt_pk_bf16(a2, a3); w.z = pg8::cvt_pk_bf16(a4, a5); w.w = pg8::cvt_pk_bf16(a6, a7);
    return __builtin_bit_cast(bf16x8, w);
}
__device__ __forceinline__ float wave_sum(float v) {
#pragma unroll
    for (int o = 1; o < 64; o <<= 1) v += __shfl_xor(v, o);
    return v;
}
#define XB_TMO      128
#define XB_XCNT(j)  (256  + 64 * (j))
#define XB_XSUB(j)  (1280 + 64 * (j))
#define XB_XGEN(j)  (2304 + 64 * (j))
#define XB_TOP      3328
#define XB_TOPGEN   3392
#define XCD_BAR_WORDS 3456
#define XB_SPIN_CAP (1u << 18)

__device__ __forceinline__ unsigned xb_ld(unsigned* p)              { return __hip_atomic_load(p, __ATOMIC_RELAXED, __HIP_MEMORY_SCOPE_AGENT); }
__device__ __forceinline__ unsigned xb_add(unsigned* p, unsigned v) { return __hip_atomic_fetch_add(p, v, __ATOMIC_RELAXED, __HIP_MEMORY_SCOPE_AGENT); }
__device__ __forceinline__ unsigned xb_xcc_id() { return (unsigned)__builtin_amdgcn_s_getreg((3 << 11) | 20) & 0xFu; }
#define XB_SPIN(cond, bar) do { unsigned _sp = 0; while (cond) { __builtin_amdgcn_s_sleep(1); \
    if ((++_sp & 255u) == 0u) { if (xb_ld(&(bar)[XB_TMO])) break; if (_sp > XB_SPIN_CAP) { atomicAdd(&(bar)[XB_TMO], 1u); break; } } } } while (0)

struct XcdBarrier {
    unsigned* bar; unsigned x;
    volatile LAS unsigned* st;
};

__device__ __forceinline__ XcdBarrier xcd_barrier_post(unsigned* bar, volatile LAS unsigned* st) {
    XcdBarrier b; b.bar = bar; b.x = xb_xcc_id(); b.st = st;
    if (threadIdx.x == 0) (void)xb_add(&bar[XB_XCNT(b.x)], 1u);
    return b;
}
__device__ __forceinline__ void xcd_barrier_complete(unsigned* bar, unsigned x, unsigned& nloc, unsigned& nx) {
    const unsigned G = gridDim.x * gridDim.y * gridDim.z;
    unsigned sum, cnt, mine, sp = 0u;
    for (;;) {
        sum = 0u; cnt = 0u; mine = 0u;
#pragma unroll
        for (unsigned j = 0; j < 16; ++j) { const unsigned c = xb_ld(&bar[XB_XCNT(j)]); sum += c; cnt += (c > 0u) ? 1u : 0u; mine = (j == x) ? c : mine; }
        if (sum == G) break;
        __builtin_amdgcn_s_sleep(1);
        if ((++sp & 255u) == 0u) { if (xb_ld(&bar[XB_TMO])) break; if (sp > XB_SPIN_CAP) { atomicAdd(&bar[XB_TMO], 1u); break; } }
    }
    nloc = mine > 0u ? mine : 1u; nx = cnt > 0u ? cnt : 1u;
}

__device__ __forceinline__ void xcd_barrier(const XcdBarrier& b) {
    asm volatile("s_waitcnt vmcnt(0)" ::: "memory");
    __syncthreads();
    if (threadIdx.x == 0) {
        unsigned* bar = b.bar;
        __builtin_amdgcn_s_waitcnt(0);
        unsigned nloc = b.st[0], nx = b.st[1];
        if (nloc == 0u) { xcd_barrier_complete(bar, b.x, nloc, nx); b.st[0] = nloc; b.st[1] = nx; }
        const unsigned old = xb_add(&bar[XB_XSUB(b.x)], 1u);
        const unsigned gen = old / nloc;
        if (old + 1u == (gen + 1u) * nloc) {
            __builtin_amdgcn_fence(__ATOMIC_RELEASE, "agent");
            asm volatile("s_waitcnt vmcnt(0)" ::: "memory");
            const unsigned og = xb_add(&bar[XB_TOP], 1u);
            const unsigned tg = og / nx;
            if (og + 1u == (tg + 1u) * nx) xb_add(&bar[XB_TOPGEN], 1u);
            else XB_SPIN(xb_ld(&bar[XB_TOPGEN]) == tg, bar);
            __builtin_amdgcn_fence(__ATOMIC_ACQUIRE, "agent");
            xb_add(&bar[XB_XGEN(b.x)], 1u);
            asm volatile("s_waitcnt vmcnt(0)" ::: "memory");
        } else {
            XB_SPIN(xb_ld(&bar[XB_XGEN(b.x)]) == gen, bar);
            __builtin_amdgcn_fence(__ATOMIC_ACQUIRE, "agent");
            asm volatile("s_waitcnt vmcnt(0)" ::: "memory");
        }
    }
    __syncthreads();
}
struct Frame {
    LAS unsigned char* lds;
    volatile LAS unsigned* MISC;
    int tid, lane, wave;
    int vcu, G;
};
constexpr int PTR_OFF = LDSCTL_OFF + 1024;
__device__ __forceinline__ unsigned char* tabp(const Frame& F, int i) {
    const unsigned long long v = ((LAS unsigned long long*)(F.lds + PTR_OFF))[i];
    const unsigned lo = __builtin_amdgcn_readfirstlane((unsigned)v), hi = __builtin_amdgcn_readfirstlane((unsigned)(v >> 32));
    return (unsigned char*)(((unsigned long long)hi << 32) | lo);
}
__device__ __forceinline__ const float* inp(const Frame& F, int i) { return (const float*)tabp(F, i); }
__device__ __forceinline__ unsigned char* wsp(const Frame& F) { return tabp(F, 25); }
__device__ __forceinline__ float* outp(const Frame& F) { return (float*)tabp(F, 26); }
__device__ __forceinline__ gu32* ctlp(const Frame& F) { return (gu32*)(tabp(F, 25) + WS_CTL); }
enum { I_X = 0, I_C, I_WADA, I_BADA, I_WIN, I_SINKS, I_PEK, I_W1K, I_W2K, I_PEV, I_W1V, I_W2V, I_MIXG, I_WOUT, I_LN1G, I_LN1B, I_WRG, I_BRG, I_WRE, I_BRE, I_WGATE, I_WUP, I_WDOWN, I_LN2G, I_LN2B };

__device__ __forceinline__ void ada_phase(Frame& F) {
    LAS float* cs = (LAS float*)(F.lds + 73728);
    LAS float* red = (LAS float*)(F.lds + 73728 + 16384);
    const float* c = inp(F, I_C);
    for (int i = F.tid; i < NB * DM; i += NWAVES * 64) { const float v = c[i]; cs[i] = v / (1.0f + __expf(-v)); }
    __syncthreads();
    float* mod = (float*)(wsp(F) + WS_MOD);
    for (int u = F.vcu; u < DEPTH * 96; u += F.G) {
        const int l = u / 96, cb = u % 96, col = cb * 128 + 2 * F.lane;
        const float* W = inp(F, I_WADA) + (size_t)l * DM * (6 * DM) + col;
        float a00 = 0.f, a01 = 0.f, a10 = 0.f, a11 = 0.f;
        const int k0 = F.wave * 256;
#pragma unroll 8
        for (int kk = 0; kk < 256; ++kk) { const int k = k0 + kk; typedef float f32x2_ __attribute__((ext_vector_type(2))); const f32x2_ w = *(const GAS f32x2_*)(W + (size_t)k * (6 * DM));
            const float s0 = cs[k], s1 = cs[DM + k]; a00 += s0 * w.x; a01 += s0 * w.y; a10 += s1 * w.x; a11 += s1 * w.y; }
        red[(F.wave * 2 + 0) * 128 + 2 * F.lane] = a00; red[(F.wave * 2 + 0) * 128 + 2 * F.lane + 1] = a01;
        red[(F.wave * 2 + 1) * 128 + 2 * F.lane] = a10; red[(F.wave * 2 + 1) * 128 + 2 * F.lane + 1] = a11;
        __syncthreads();
        if (F.tid < 256) { const int b = F.tid >> 7, j = F.tid & 127; float s = 0.f;
#pragma unroll
            for (int w = 0; w < 8; ++w) s += red[(w * 2 + b) * 128 + j];
            mod[((size_t)l * NB + b) * (6 * DM) + cb * 128 + j] = s + inp(F, I_BADA)[(size_t)l * 6 * DM + cb * 128 + j]; }
        __syncthreads();
    }
}

__device__ __forceinline__ void tr_item(const float* W, int ldw, int K, bf16* WT, size_t drow0, int rs, int src0, int nvalid, int k0, LAS float* scr, int lane) {
    const int nn = lane & 31;
#pragma unroll 8
    for (int i = 0; i < 32; ++i) { const int kk = 2 * i + (lane >> 5);
        scr[kk * 33 + nn] = (nn < nvalid) ? *(const GAS float*)(W + (size_t)(k0 + kk) * ldw + src0 + nn) : 0.f; }
    LDS_WAIT(); asm volatile("" ::: "memory");
    const int c = lane & 7;
#pragma unroll
    for (int j = 0; j < 4; ++j) { const int n = (lane >> 3) + 8 * j; const LAS float* s = scr + (8 * c) * 33 + n;
        v4u o; o.x = pk2(s[0 * 33], s[1 * 33]); o.y = pk2(s[2 * 33], s[3 * 33]); o.z = pk2(s[4 * 33], s[5 * 33]); o.w = pk2(s[6 * 33], s[7 * 33]);
        *(GAS v4u*)(WT + (drow0 + (size_t)n * rs) * K + k0 + 8 * c) = o; }
    LDS_WAIT(); asm volatile("" ::: "memory");
}
__device__ __forceinline__ int win_src(int n0) {
    if (n0 < 512) return n0;
    if (n0 < 640) return 512 + (n0 - 512);
    if (n0 < 1152) return 768 + (n0 - 640);
    if (n0 < 1280) return 1280 + (n0 - 1152);
    if (n0 < 1408) return 1408 + (n0 - 1280);
    if (n0 < 1536) return 1536 + (n0 - 1408);
    if (n0 < 1664) return 1792 + (n0 - 1536);
    if (n0 < 2688) return 2072 + (n0 - 1664);
    if (n0 < 3712) return 3096 + (n0 - 2688);
    if (n0 < 4736) return 4120 + (n0 - 3712);
    if (n0 < 4864) return 640 + (n0 - 4736);
    if (n0 < 4992) return 1664 + (n0 - 4864);
    return 1920 + (n0 - 4992);
}
struct TrDesc { const float* src; bf16* dst; int ldw, K, rs; };
struct TrRegs { f32x4 v[16]; };
__device__ __forceinline__ void tr_load(TrRegs& r, const TrDesc& d) {
#pragma unroll
    for (int i = 0; i < 16; ++i) r.v[i] = *(const GAS f32x4*)(d.src + (size_t)(8 * (i >> 1) + (i & 1)) * d.ldw);
}
__device__ __forceinline__ void tr_store(const TrRegs& r, const TrDesc& d, LAS unsigned* scr, int lane) {
    const int kr = lane >> 4, nc = lane & 15;
#pragma unroll
    for (int i = 0; i < 8; ++i) { const f32x4 a = r.v[2 * i], b = r.v[2 * i + 1]; LAS unsigned* w = scr + (4 * nc) * 36 + 4 * i + kr;
        w[0] = pk2(a[0], b[0]); w[36] = pk2(a[1], b[1]); w[72] = pk2(a[2], b[2]); w[108] = pk2(a[3], b[3]); }
    LDS_WAIT(); asm volatile("" ::: "memory");
#pragma unroll
    for (int j = 0; j < 8; ++j) { const int ch = lane + 64 * j, n = ch >> 3, kc = ch & 7;
        const v4u o = *(const LAS v4u*)(scr + n * 36 + 4 * kc);
        *(GAS v4u*)(d.dst + (size_t)n * d.rs * d.K + 8 * kc) = o; }
    LDS_WAIT(); asm volatile("" ::: "memory");
}
__device__ __forceinline__ TrDesc tr_decode(Frame& F, int l, int it, int lane) {
    constexpr int I_A = 32 * (NIN / 64), I_B = 32 * 32, I_G = NEXP * 256, I_U = NEXP * 256, I_D = NEXP * 256, I_1 = 64, I_2 = 2;
    const float* W; bf16* WT; int ldw, K, rs = 1, src0, k0; size_t drow0;
    int r = it;
    if (r < I_A) { const int nblk = NIN / 64, kb = r / nblk, nb = r % nblk; W = inp(F, I_WIN) + (size_t)l * DM * D_IN; ldw = D_IN; K = DM; WT = (bf16*)(wsp(F) + WS_WIN); drow0 = (size_t)nb * 64; src0 = win_src(nb * 64); k0 = kb * 64; }
    else if ((r -= I_A) < I_B) { const int kb = r / 32, nb = r % 32; W = inp(F, I_WOUT) + (size_t)l * DM * DM; ldw = DM; K = DM; WT = (bf16*)(wsp(F) + WS_WOUT); drow0 = (size_t)nb * 64; src0 = nb * 64; k0 = kb * 64; }
    else if ((r -= I_B) < I_G) { const int e = r / 256, q = r % 256, kb = q / 8, nb = q % 8; W = inp(F, I_WGATE) + ((size_t)l * NEXP + e) * DM * DEXP; ldw = DEXP; K = DM; WT = (bf16*)(wsp(F) + WS_WGU); drow0 = (size_t)e * 1024 + nb * 128; rs = 2; src0 = nb * 64; k0 = kb * 64; }
    else if ((r -= I_G) < I_U) { const int e = r / 256, q = r % 256, kb = q / 8, nb = q % 8; W = inp(F, I_WUP) + ((size_t)l * NEXP + e) * DM * DEXP; ldw = DEXP; K = DM; WT = (bf16*)(wsp(F) + WS_WGU); drow0 = (size_t)e * 1024 + nb * 128 + 1; rs = 2; src0 = nb * 64; k0 = kb * 64; }
    else if ((r -= I_U) < I_D) { const int e = r / 256, q = r % 256, kb = q / 32, nb = q % 32; W = inp(F, I_WDOWN) + ((size_t)l * NEXP + e) * DEXP * DM; ldw = DM; K = DEXP; WT = (bf16*)(wsp(F) + WS_WD); drow0 = (size_t)e * DM + nb * 64; src0 = nb * 64; k0 = kb * 64; }
    else if ((r -= I_D) < 2 * I_1) { const int kv = r / I_1, q = r % I_1, kb = q / 2, nb = q % 2; W = inp(F, kv ? I_W1V : I_W1K) + (size_t)l * 2048 * 128; ldw = 128; K = 2048; WT = (bf16*)(wsp(F) + WS_WCMP) + (size_t)kv * 128 * 2048; drow0 = (size_t)nb * 64; src0 = nb * 64; k0 = kb * 64; }
    else { r -= 2 * I_1; const int kv = r / I_2, kb = r % I_2; W = inp(F, kv ? I_W2V : I_W2K) + (size_t)l * 128 * 64; ldw = 64; K = 128; WT = (bf16*)(wsp(F) + WS_WCMP + 2 * 128 * 2048 * 2) + (size_t)kv * 64 * 128; drow0 = 0; src0 = 0; k0 = kb * 64; }
    TrDesc d; d.src = W + (size_t)(k0 + 2 * (lane >> 4)) * ldw + src0 + 4 * (lane & 15); d.dst = WT + drow0 * K + k0; d.ldw = ldw; d.K = K; d.rs = rs;
    return d;
}
constexpr int CV_SMALL0 = 32 * (NIN / 64) + 32 * 32, CV_GU1 = CV_SMALL0 + 2 * NEXP * 256, CV_DN1 = CV_GU1 + NEXP * 256, CV_END = CV_DN1 + 2 * 64 + 2 * 2;
__device__ __forceinline__ void convert_range(Frame& F, int l, int lo, int hi, LAS unsigned* scr) {
    const int gw = F.vcu * NWAVES + F.wave, NGW = F.G * NWAVES;
    if (lo + gw < hi) {
        TrDesc dc = tr_decode(F, l, lo + gw, F.lane); TrRegs rc; tr_load(rc, dc);
        for (int it = lo + gw; it < hi; it += NGW) {
            const int itn = it + NGW < hi ? it + NGW : it;
            const TrDesc dn = tr_decode(F, l, itn, F.lane); TrRegs rn; tr_load(rn, dn);
            tr_store(rc, dc, scr, F.lane);
            rc = rn; dc = dn;
        }
    }
}
__device__ __forceinline__ void convert_small(Frame& F, int l) {
    LAS unsigned* scr = (LAS unsigned*)(F.lds + F.wave * 9216);
    const int gw = F.vcu * NWAVES + F.wave, NGW = F.G * NWAVES;
    convert_range(F, l, 0, CV_END, scr);
    { LAS float* scrf = (LAS float*)scr;
      for (int it = gw; it < 32; it += NGW) tr_item(inp(F, I_WIN) + (size_t)l * DM * D_IN, D_IN, DM, (bf16*)(wsp(F) + WS_WCMP + 1024 * 1024 + 64 * 1024), 0, 1, 2048, 24, it * 64, scrf, F.lane); }
    { bf16* Whi = (bf16*)(wsp(F) + WS_WCMP + 1536 * 1024); bf16* Wlo = Whi + 48 * 2048;
      const float* wrg = inp(F, I_WRG) + (size_t)l * DM * 4; const float* wre = inp(F, I_WRE) + (size_t)l * 4 * DM * 8;
      for (int i = gw * 64 + F.lane; i < 48 * 2048; i += NGW * 64) { const int row = i >> 11, k = i & 2047; float v = 0.f;
          if (row < 4) v = wrg[k * 4 + row]; else if (row < 36) { const int g = (row - 4) >> 3, e = (row - 4) & 7; v = wre[((size_t)g * DM + k) * 8 + e]; }
          const unsigned hi = f2bf(v); Whi[i] = (bf16)hi; Wlo[i] = (bf16)f2bf(v - bf2f((unsigned short)hi)); } }
}

struct Row { f32x4 v[8]; };
__device__ __forceinline__ void row_load(Row& r, const float* p, int lane) {
#pragma unroll
    for (int j = 0; j < 8; ++j) r.v[j] = *((const GAS f32x4*)p + lane + 64 * j);
}
__device__ __forceinline__ void row_load_bf16(Row& r, const bf16* p, int lane) {
#pragma unroll
    for (int j = 0; j < 8; ++j) { const v2u w = *((const GAS v2u*)p + lane + 64 * j); r.v[j] = (f32x4){bflo(w.x), bfhi(w.x), bflo(w.y), bfhi(w.y)}; }
}
__device__ __forceinline__ void row_store(const Row& r, float* p, int lane) {
#pragma unroll
    for (int j = 0; j < 8; ++j) *((GAS f32x4*)p + lane + 64 * j) = r.v[j];
}
__device__ __forceinline__ void row_store_bf16(const Row& r, bf16* p, int lane) {
#pragma unroll
    for (int j = 0; j < 8; ++j) { v2u w; w.x = pk2(r.v[j].x, r.v[j].y); w.y = pk2(r.v[j].z, r.v[j].w); *((GAS v2u*)p + lane + 64 * j) = w; }
}
__device__ __forceinline__ void row_normalize(Row& r) {
    float s = 0.f;
#pragma unroll
    for (int j = 0; j < 8; ++j) s += (r.v[j].x + r.v[j].y) + (r.v[j].z + r.v[j].w);
    const float mean = wave_sum(s) * (1.0f / DM); float s2 = 0.f;
#pragma unroll
    for (int j = 0; j < 8; ++j) { r.v[j] = r.v[j] - mean; s2 += (r.v[j].x * r.v[j].x + r.v[j].y * r.v[j].y) + (r.v[j].z * r.v[j].z + r.v[j].w * r.v[j].w); }
    const float rstd = 1.0f / sqrtf(wave_sum(s2) * (1.0f / DM) + LN_EPS);
#pragma unroll
    for (int j = 0; j < 8; ++j) r.v[j] = r.v[j] * rstd;
}
__device__ __forceinline__ void row_affine(Row& r, const float* a, float add1, const float* b, int lane) {
#pragma unroll
    for (int j = 0; j < 8; ++j) { const f32x4 av = *((const GAS f32x4*)a + lane + 64 * j) + add1, bv = *((const GAS f32x4*)b + lane + 64 * j); r.v[j] = r.v[j] * av + bv; }
}
__device__ __forceinline__ const float* modp(Frame& F, int l, int b, int which) { return (const float*)(wsp(F) + WS_MOD) + ((size_t)l * NB + b) * (6 * DM) + which * DM; }

__device__ __forceinline__ void ln_in_phase(Frame& F) {
    const int gw = F.vcu * NWAVES + F.wave, NGW = F.G * NWAVES;
    bf16* hb = (bf16*)(wsp(F) + WS_HB);
    for (int m = gw; m < MTOK; m += NGW) { const int b = m / SEQ; Row r; row_load(r, inp(F, I_X) + (size_t)m * DM, F.lane); row_normalize(r);
        row_affine(r, modp(F, 0, b, 1), 1.0f, modp(F, 0, b, 0), F.lane); row_store_bf16(r, hb + (size_t)m * DM, F.lane); }
}

__device__ __forceinline__ void merge_phase(Frame& F, int l) {
    const int gw = F.vcu * NWAVES + F.wave, NGW = F.G * NWAVES;
    const float* oc = (const float*)(wsp(F) + WS_OCAT); bf16* hb = (bf16*)(wsp(F) + WS_HB); const float* mg = inp(F, I_MIXG) + (size_t)l * DM;
    for (int m = gw; m < MTOK; m += NGW) { Row r; row_load(r, oc + (size_t)m * DM, F.lane);
        float sa = 0.f, sb = 0.f, sc = 0.f;
#pragma unroll
        for (int j = 0; j < 8; ++j) { const float q = (r.v[j].x * r.v[j].x + r.v[j].y * r.v[j].y) + (r.v[j].z * r.v[j].z + r.v[j].w * r.v[j].w); if (j < 2) sa += q; else if (j < 4) sb += q; else sc += q; }
        const float ra = 1.0f / sqrtf(wave_sum(sa) * (1.0f / 512.0f) + RMS_EPS), rb = 1.0f / sqrtf(wave_sum(sb) * (1.0f / 512.0f) + RMS_EPS), rc = 1.0f / sqrtf(wave_sum(sc) * (1.0f / 1024.0f) + RMS_EPS);
#pragma unroll
        for (int j = 0; j < 8; ++j) { const float s = j < 2 ? ra : (j < 4 ? rb : rc); const f32x4 g = *((const GAS f32x4*)mg + F.lane + 64 * j); r.v[j] = r.v[j] * s * g; }
        row_store_bf16(r, hb + (size_t)m * DM, F.lane); }
}

__device__ __forceinline__ void post_mixer_phase(Frame& F, int l) {
    const int gw = F.vcu * NWAVES + F.wave, NGW = F.G * NWAVES;
    bf16* xa = (bf16*)(wsp(F) + WS_XA); bf16* hb = (bf16*)(wsp(F) + WS_HB);
    const float* wrg = inp(F, I_WRG) + (size_t)l * DM * 4; const float* brg = inp(F, I_BRG) + l * 4;
    const float* wre = inp(F, I_WRE) + (size_t)l * 4 * DM * 8; const float* bre = inp(F, I_BRE) + l * 32;
    unsigned* cnt = (unsigned*)(ctlp(F) + CW_CNT + l * 32); int* list = (int*)(wsp(F) + WS_LIST); float* gatew = (float*)(wsp(F) + WS_SMALL + SM_GATEW);
    for (int m = gw; m < MTOK; m += NGW) { const int b = m / SEQ; Row r; row_load_bf16(r, xa + (size_t)m * DM, F.lane); row_normalize(r);
        row_affine(r, inp(F, I_LN1G) + (size_t)l * DM, 0.0f, inp(F, I_LN1B) + (size_t)l * DM, F.lane); row_store_bf16(r, xa + (size_t)m * DM, F.lane);
        row_normalize(r); row_affine(r, modp(F, l, b, 4), 1.0f, modp(F, l, b, 3), F.lane); row_store_bf16(r, hb + (size_t)m * DM, F.lane);
    }
}

__device__ __forceinline__ void router_phase(Frame& F, int l) {
    if (F.wave >= 4) return;
    const int lane = F.lane, c = lane & 15, kq = lane >> 4;
    const bf16* hb = (const bf16*)(wsp(F) + WS_HB);
    const bf16* Whi = (const bf16*)(wsp(F) + WS_WCMP + 1536 * 1024); const bf16* Wlo = Whi + 48 * 2048;
    const float* brg = inp(F, I_BRG) + l * 4; const float* bre = inp(F, I_BRE) + l * 32;
    unsigned* cnt = (unsigned*)(ctlp(F) + CW_CNT + l * 32); int* list = (int*)(wsp(F) + WS_LIST); float* gatew = (float*)(wsp(F) + WS_SMALL + SM_GATEW);
    LAS float* sl = (LAS float*)(F.lds + F.wave * 4096);
    for (int u = F.wave * F.G + F.vcu; u < MTOK / 16; u += 4 * F.G) {
        const bf16* hrow = hb + (size_t)(u * 16 + c) * DM + 8 * kq;
        const bf16* wh = Whi + (size_t)c * 2048 + 8 * kq; const bf16* wl = Wlo + (size_t)c * 2048 + 8 * kq;
        f32x4 acc[3];
#pragma unroll
        for (int t = 0; t < 3; ++t) acc[t] = (f32x4){0.f, 0.f, 0.f, 0.f};
#pragma unroll 4
        for (int ks = 0; ks < 64; ++ks) { const bf16x8 hf = ldg8(hrow + ks * 32);
#pragma unroll
            for (int t = 0; t < 3; ++t) { acc[t] = mfma16(ldg8(wh + (size_t)t * 16 * 2048 + ks * 32), hf, acc[t]); acc[t] = mfma16(ldg8(wl + (size_t)t * 16 * 2048 + ks * 32), hf, acc[t]); } }
#pragma unroll
        for (int t = 0; t < 3; ++t)
#pragma unroll
            for (int r = 0; r < 4; ++r) sl[c * 49 + 16 * t + 4 * kq + r] = acc[t][r];
        LDS_WAIT();
        if (lane < 16) {
            const LAS float* lr = sl + lane * 49; const int m = u * 16 + lane;
            const float g0 = lr[0] + brg[0], g1 = lr[1] + brg[1], g2 = lr[2] + brg[2], g3 = lr[3] + brg[3];
            int gs = 0; float gm = g0; if (g1 > gm) { gm = g1; gs = 1; } if (g2 > gm) { gm = g2; gs = 2; } if (g3 > gm) { gm = g3; gs = 3; }
            const float pgroup = 1.0f / (__expf(g0 - gm) + __expf(g1 - gm) + __expf(g2 - gm) + __expf(g3 - gm));
            int t1 = 0; float m1 = lr[4 + gs * 8] + bre[gs * 8];
#pragma unroll
            for (int i = 1; i < 8; ++i) { const float v = lr[4 + gs * 8 + i] + bre[gs * 8 + i]; if (v > m1) { m1 = v; t1 = i; } }
            int t2 = -1; float m2 = -3.0e38f;
#pragma unroll
            for (int i = 0; i < 8; ++i) { const float v = lr[4 + gs * 8 + i] + bre[gs * 8 + i]; if (i != t1 && v > m2) { m2 = v; t2 = i; } }
            const float e2 = __expf(m2 - m1), inv = pgroup / (1.0f + e2);
            const int x1 = gs * 8 + t1, x2 = gs * 8 + t2;
            const unsigned p1 = __hip_atomic_fetch_add(cnt + x1, 1u, RLX_AGENT); list[(size_t)x1 * MTOK + p1] = m * 2; gatew[m * 2] = inv;
            const unsigned p2 = __hip_atomic_fetch_add(cnt + x2, 1u, RLX_AGENT); list[(size_t)x2 * MTOK + p2] = m * 2 + 1; gatew[m * 2 + 1] = inv * e2;
        }
        LDS_WAIT();
    }
}

__device__ __forceinline__ void gather_phase(Frame& F, int l) {
    LAS int* tb = (LAS int*)(F.lds + 0);
    const unsigned* cnt = (const unsigned*)(ctlp(F) + CW_CNT + l * 32);
    if (F.tid < 32) tb[F.tid] = (int)__hip_atomic_load(cnt + F.tid, RLX_AGENT);
    __syncthreads();
    if (F.tid == 0) { int row = 0, tile = 0;
        for (int e = 0; e < NEXP; ++e) { tb[32 + e] = row; const int nt = (tb[e] + 255) >> 8; for (int t = 0; t < nt; ++t) tb[64 + tile + t] = e; tile += nt; row += nt * 256; }
        tb[224] = tile; }
    __syncthreads();
    const int ntiles = tb[224];
    int* gt = (int*)(wsp(F) + WS_SMALL + SM_TILE);
    if (blockIdx.x == 0) { if (F.tid < 160) gt[F.tid] = (F.tid < ntiles) ? tb[64 + F.tid] : 0; if (F.tid == 0) gt[200] = ntiles; }
    const int gw = F.vcu * NWAVES + F.wave, NGW = F.G * NWAVES;
    const int* list = (const int*)(wsp(F) + WS_LIST); int* rowinfo = (int*)(wsp(F) + WS_SMALL + SM_ROWINFO);
    const bf16* hb = (const bf16*)(wsp(F) + WS_HB); bf16* xs = (bf16*)(wsp(F) + WS_XS);
    for (int R = gw; R < ntiles * 256; R += NGW) { const int e = tb[64 + (R >> 8)], pos = R - tb[32 + e];
        int aid = -1; if (pos < tb[e]) aid = list[(size_t)e * MTOK + pos];
        GAS v4u* dst = (GAS v4u*)(xs + (size_t)R * DM) + F.lane;
        if (aid >= 0) { const GAS v4u* src = (const GAS v4u*)(hb + (size_t)(aid >> 1) * DM) + F.lane;
#pragma unroll
            for (int j = 0; j < 4; ++j) dst[64 * j] = src[64 * j]; }
        else {
#pragma unroll
            for (int j = 0; j < 4; ++j) dst[64 * j] = (v4u){0u, 0u, 0u, 0u}; }
        if (F.lane == 0) rowinfo[R] = aid; }
    __syncthreads();
}

__device__ __forceinline__ void moe_tables(Frame& F, int l) {
    LAS int* tb = (LAS int*)(F.lds + TAB_OFF);
    const unsigned* cnt = (const unsigned*)(ctlp(F) + CW_CNT + l * 32);
    __syncthreads();
    if (F.tid < 32) tb[F.tid] = (int)__hip_atomic_load(cnt + F.tid, RLX_AGENT);
    __syncthreads();
    if (F.tid == 0) { int row = 0, tile = 0;
        for (int e = 0; e < NEXP; ++e) { tb[32 + e] = row; const int nt = (tb[e] + 255) >> 8; for (int t = 0; t < nt; ++t) tb[64 + tile + t] = e; tile += nt; row += nt * 256; }
        tb[224] = tile; }
    __syncthreads();
}

__device__ __forceinline__ void post_moe_phase(Frame& F, int l, float* dst_f32, bf16* dst_bf16, bool next_h) {
    const int gw = F.vcu * NWAVES + F.wave, NGW = F.G * NWAVES;
    const bf16* xa = (const bf16*)(wsp(F) + WS_XA); const bf16* ys = (const bf16*)(wsp(F) + WS_YS); bf16* hb = (bf16*)(wsp(F) + WS_HB);
    for (int m = gw; m < MTOK; m += NGW) { const int b = m / SEQ; Row r; row_load_bf16(r, xa + (size_t)m * DM, F.lane);
        const float* g2 = modp(F, l, b, 5);
#pragma unroll
        for (int j = 0; j < 8; ++j) { const v2u y0 = *((const GAS v2u*)(ys + (size_t)(2 * m) * DM) + F.lane + 64 * j), y1 = *((const GAS v2u*)(ys + (size_t)(2 * m + 1) * DM) + F.lane + 64 * j);
            const f32x4 y = (f32x4){bflo(y0.x) + bflo(y1.x), bfhi(y0.x) + bfhi(y1.x), bflo(y0.y) + bflo(y1.y), bfhi(y0.y) + bfhi(y1.y)};
            const f32x4 gv = *((const GAS f32x4*)g2 + F.lane + 64 * j) + 1.0f; r.v[j] = r.v[j] * ALPHA + gv * y; }
        row_normalize(r); row_affine(r, inp(F, I_LN2G) + (size_t)l * DM, 0.0f, inp(F, I_LN2B) + (size_t)l * DM, F.lane); if (dst_f32) row_store(r, dst_f32 + (size_t)m * DM, F.lane); else row_store_bf16(r, dst_bf16 + (size_t)m * DM, F.lane);
        if (next_h) { row_normalize(r); row_affine(r, modp(F, l + 1, b, 1), 1.0f, modp(F, l + 1, b, 0), F.lane); row_store_bf16(r, hb + (size_t)m * DM, F.lane); } }
}
constexpr int IMP_STRIDE = 130;
constexpr int AW_IMP = 0, AW_SCV = 16 * IMP_STRIDE * 4, AW_SEL = AW_SCV + 512, AW_Q = 9216, AW_BYTES = AW_Q + 8192;
static_assert(AW_SEL + 256 <= AW_Q && NWAVES * AW_BYTES <= LDSCTL_OFF, "per-wave LDS slabs");

struct Flash { f32x4 O[4][4]; f32x4 m, l; };
struct KF { bf16x8 K[2][2]; };
struct VF { bf16x8 V[4]; };

__device__ __forceinline__ void load_k(KF& x, const bf16* Kb, size_t ldk, int kbase) {
    const bf16* kp = Kb + (size_t)kbase * ldk;
    x.K[0][0] = ldg8(kp); x.K[0][1] = ldg8(kp + 32); x.K[1][0] = ldg8(kp + 4 * ldk); x.K[1][1] = ldg8(kp + 4 * ldk + 32);
}
__device__ __forceinline__ void load_v(VF& x, const bf16* Vb, size_t ldv, int kbase) {
    const bf16* vp = Vb + kbase;
#pragma unroll
    for (int db = 0; db < 4; ++db) x.V[db] = ldg8(vp + (size_t)(16 * db) * ldv);
}
__device__ __forceinline__ void q_park(LAS bf16x8* Ql, const bf16* q0p, const bf16* q1p, const bf16* q2p, const bf16* q3p, int lane) {
    Ql[0 * 64 + lane] = ldg8(q0p); Ql[1 * 64 + lane] = ldg8(q0p + 32); Ql[2 * 64 + lane] = ldg8(q1p); Ql[3 * 64 + lane] = ldg8(q1p + 32);
    Ql[4 * 64 + lane] = ldg8(q2p); Ql[5 * 64 + lane] = ldg8(q2p + 32); Ql[6 * 64 + lane] = ldg8(q3p); Ql[7 * 64 + lane] = ldg8(q3p + 32);
}
__device__ __forceinline__ void qk_scores(f32x4 (&Sv)[2][4], const KF& x, const LAS bf16x8* Ql, int lane) {
#pragma unroll
    for (int qb = 0; qb < 4; ++qb) { const bf16x8 q0 = Ql[(2 * qb) * 64 + lane], q1 = Ql[(2 * qb + 1) * 64 + lane];
#pragma unroll
        for (int h = 0; h < 2; ++h) { f32x4 a = mfma16(x.K[h][0], q0, (f32x4){0.f, 0.f, 0.f, 0.f}); Sv[h][qb] = mfma16(x.K[h][1], q1, a); } }
}
__device__ __forceinline__ void flash_init(Flash& S, float m0, float m1, float m2, float m3) {
#pragma unroll
    for (int db = 0; db < 4; ++db)
#pragma unroll
        for (int qb = 0; qb < 4; ++qb) S.O[db][qb] = (f32x4){0.f, 0.f, 0.f, 0.f};
    S.m = (f32x4){m0, m1, m2, m3}; S.l = (f32x4){0.f, 0.f, 0.f, 0.f};
}
__device__ __forceinline__ void flash_step(Flash& S, f32x4 (&Sv)[2][4], const VF& x, const f32x4 b0, const f32x4 bj, unsigned vm) {
    float sv[4][8]; float mxv[4]; bool grow = false;
#pragma unroll
    for (int qb = 0; qb < 4; ++qb) {
#pragma unroll
        for (int h = 0; h < 2; ++h)
#pragma unroll
            for (int r = 0; r < 4; ++r) { const int j = 4 * h + r; const float s2 = Sv[h][qb][r] * SC2 + (b0[qb] + bj[qb] * (float)j); sv[qb][j] = ((vm >> j) & 1u) ? s2 : -INFINITY; }
        float mx = fmaxf(fmaxf(fmaxf(sv[qb][0], sv[qb][1]), fmaxf(sv[qb][2], sv[qb][3])), fmaxf(fmaxf(sv[qb][4], sv[qb][5]), fmaxf(sv[qb][6], sv[qb][7])));
        mx = fmaxf(mx, __shfl_xor(mx, 16)); mx = fmaxf(mx, __shfl_xor(mx, 32));
        mxv[qb] = mx; grow = grow | (mx > S.m[qb] + 8.0f);
    }
    if (__any(grow)) {
#pragma unroll
        for (int qb = 0; qb < 4; ++qb) { const float mn = fmaxf(S.m[qb], mxv[qb]), al = ex2(S.m[qb] - mn); S.m[qb] = mn; S.l[qb] = S.l[qb] * al;
#pragma unroll
            for (int db = 0; db < 4; ++db) S.O[db][qb] = S.O[db][qb] * al; }
    }
    bf16x8 Pf[4];
#pragma unroll
    for (int qb = 0; qb < 4; ++qb) {
        float p[8];
#pragma unroll
        for (int j = 0; j < 8; ++j) p[j] = ex2(sv[qb][j] - S.m[qb]);
        S.l[qb] = S.l[qb] + (((p[0] + p[1]) + (p[2] + p[3])) + ((p[4] + p[5]) + (p[6] + p[7])));
        Pf[qb] = pack8(p[0], p[1], p[2], p[3], p[4], p[5], p[6], p[7]);
    }
#pragma unroll
    for (int db = 0; db < 4; ++db)
#pragma unroll
        for (int qb = 0; qb < 4; ++qb) S.O[db][qb] = mfma16(x.V[db], Pf[qb], S.O[db][qb]);
}
__device__ __forceinline__ float flash_inv(const Flash& S, int qb, bool has_sink, float sink2) {
    float lt = S.l[qb]; lt += __shfl_xor(lt, 16); lt += __shfl_xor(lt, 32);
    if (has_sink) lt += ex2(sink2 - S.m[qb]);
    return lt > 0.f ? 1.0f / lt : 0.f;
}
__device__ __forceinline__ float sigmoidf_(float x) { return 1.0f / (1.0f + __expf(-x)); }
__device__ __forceinline__ float slope2_of(int hidx) { return LOG2E * exp2f(-0.5f * (float)(hidx + 1)); }
#define ITER_FENCE() asm volatile("" ::: "memory")

template <int W, int MODE>
__device__ __forceinline__ void win_unit(Frame& F, int l, int b, int g, int q0) {
    const int lane = F.lane, c = lane & 15, kq = lane >> 4;
    const bf16* proj = (const bf16*)(wsp(F) + WS_PROJ); const bf16* vT = (const bf16*)(wsp(F) + WS_VT); float* ocat = (float*)(wsp(F) + WS_OCAT);
    constexpr int QOFF = MODE == 0 ? P_QA : P_QB, KOFF = MODE == 0 ? P_KA : P_KBW, VROW = MODE == 0 ? V_A : V_BW, OCOL = MODE == 0 ? 0 : 512, HBASE = MODE == 0 ? 0 : 8;
    LAS bf16x8* Ql = (LAS bf16x8*)(F.lds + F.wave * AW_BYTES + AW_Q);
    const size_t tb = (size_t)b * SEQ; const int t = q0 + c;
    { const bf16* qp = proj + (tb + t) * NPROJ + QOFF + g * 256 + kq * 8; q_park(Ql, qp, qp + 64, qp + 128, qp + 192, lane); }
    f32x4 sl2, sk2;
#pragma unroll
    for (int qb = 0; qb < 4; ++qb) { sl2[qb] = slope2_of(HBASE + g * 4 + qb); sk2[qb] = MODE == 0 ? inp(F, I_SINKS)[l * 8 + g * 4 + qb] * LOG2E : -1.0e30f; }
    Flash S; flash_init(S, sk2[0], sk2[1], sk2[2], sk2[3]);
    int klo = q0 - (W - 1); if (klo < 0) klo = 0; klo &= ~31;
    const int khi = (q0 + 15) & ~31;
    const bf16* Kb = proj + (tb + 8 * (c >> 2) + (c & 3)) * NPROJ + KOFF + g * 64 + kq * 8;
    const bf16* Vb = vT + (size_t)(VROW + g * 64 + c) * MTOK + tb + 8 * kq;
    KF cur, nxt; load_k(cur, Kb, NPROJ, khi);
    for (int kbase = khi; kbase >= klo; kbase -= 32) {
        ITER_FENCE();
        VF vf; load_v(vf, Vb, MTOK, kbase);
        load_k(nxt, Kb, NPROJ, kbase - 32 >= klo ? kbase - 32 : kbase);
        f32x4 Sv[2][4]; qk_scores(Sv, cur, Ql, lane);
        const int d0 = t - kbase - 8 * kq;
        const f32x4 b0 = sl2 * -(float)d0;
        unsigned vm = 0xffu;
        if (!(kbase + 31 <= q0 && kbase >= q0 + 16 - W)) { vm = 0u;
#pragma unroll
            for (int j = 0; j < 8; ++j) { const int dist = d0 - j; vm |= (dist >= 0 && dist < W) ? (1u << j) : 0u; } }
        flash_step(S, Sv, vf, b0, sl2, vm);
        cur = nxt;
    }
#pragma unroll
    for (int qb = 0; qb < 4; ++qb) { const float sc = flash_inv(S, qb, MODE == 0, sk2[qb]);
        float* op = ocat + (tb + t) * DM + OCOL + (g * 4 + qb) * 64 + 4 * kq;
#pragma unroll
        for (int db = 0; db < 4; ++db) *(GAS f32x4*)(op + 16 * db) = S.O[db][qb] * sc; }
}

constexpr float SB_EXIT_P = 1.0e-37f;
__device__ __forceinline__ void sb_unit(Frame& F, int b, int hc, int q0) {
    const int lane = F.lane, c = lane & 15, kq = lane >> 4;
    const bf16* proj = (const bf16*)(wsp(F) + WS_PROJ); const bf16* vT = (const bf16*)(wsp(F) + WS_VT); float* ocat = (float*)(wsp(F) + WS_OCAT);
    LAS bf16x8* Ql = (LAS bf16x8*)(F.lds + F.wave * AW_BYTES + AW_Q);
    const size_t tb = (size_t)b * SEQ;
    { const bf16* qp = proj + (tb + q0 + c) * NPROJ + P_QC + hc * 64 + kq * 8; q_park(Ql, qp, qp + (size_t)16 * NPROJ, qp + (size_t)32 * NPROJ, qp + (size_t)48 * NPROJ, lane); }
    f32x4 O[4][4]; float carry[4];
#pragma unroll
    for (int qb = 0; qb < 4; ++qb) { carry[qb] = 1.0f;
#pragma unroll
        for (int db = 0; db < 4; ++db) O[db][qb] = (f32x4){0.f, 0.f, 0.f, 0.f}; }
    const bf16* Kb = proj + (tb + 8 * (c >> 2) + (c & 3)) * NPROJ + P_KC + hc * 64 + kq * 8;
    const bf16* Vb = vT + (size_t)(V_C + hc * 64 + c) * MTOK + tb + 8 * kq;
    KF cur, nxt; load_k(cur, Kb, NPROJ, q0 + 32);
    for (int kbase = q0 + 32; kbase >= 0; kbase -= 32) {
        ITER_FENCE();
        VF vf; load_v(vf, Vb, MTOK, kbase);
        load_k(nxt, Kb, NPROJ, kbase >= 32 ? kbase - 32 : kbase);
        f32x4 Sv[2][4]; qk_scores(Sv, cur, Ql, lane);
        const bool diag = kbase + 31 >= q0;
        bf16x8 Pf[4];
#pragma unroll
        for (int qb = 0; qb < 4; ++qb) { const int lim = q0 + 16 * qb + c - kbase - 8 * kq;
            float om[8], sg[8];
#pragma unroll
            for (int h = 0; h < 2; ++h)
#pragma unroll
                for (int r = 0; r < 4; ++r) { const int j = 4 * h + r; const float e = ex2(fminf(Sv[h][qb][r] * SC2, 115.0f)), rr = __builtin_amdgcn_rcpf(1.0f + e);
                    om[j] = rr; sg[j] = e * rr;
                    if (diag) { const bool msk = j >= lim; om[j] = msk ? 1.0f : om[j]; sg[j] = msk ? 0.f : sg[j]; } }
            float ex_[8]; float run = 1.0f;
#pragma unroll
            for (int j = 7; j >= 0; --j) { ex_[j] = run; run *= om[j]; }
            const float t1 = __shfl_xor(run, 16), t2 = __shfl_xor(run, 32), t3 = __shfl_xor(run, 48);
            const float X = ((kq ^ 1) > kq ? t1 : 1.0f) * ((kq ^ 2) > kq ? t2 : 1.0f) * ((kq ^ 3) > kq ? t3 : 1.0f);
            const float base = carry[qb] * X;
            carry[qb] *= (run * t1) * (t2 * t3);
            Pf[qb] = pack8(sg[0] * (base * ex_[0]), sg[1] * (base * ex_[1]), sg[2] * (base * ex_[2]), sg[3] * (base * ex_[3]), sg[4] * (base * ex_[4]), sg[5] * (base * ex_[5]), sg[6] * (base * ex_[6]), sg[7] * (base * ex_[7])); }
#pragma unroll
        for (int db = 0; db < 4; ++db)
#pragma unroll
            for (int qb = 0; qb < 4; ++qb) O[db][qb] = mfma16(vf.V[db], Pf[qb], O[db][qb]);
        const bool fin = (carry[0] < SB_EXIT_P) && (carry[1] < SB_EXIT_P) && (carry[2] < SB_EXIT_P) && (carry[3] < SB_EXIT_P);
        if (__all(fin)) break;
        cur = nxt;
    }
#pragma unroll
    for (int qb = 0; qb < 4; ++qb) { float* op = ocat + (tb + q0 + 16 * qb + c) * DM + 1024 + hc * 64 + 4 * kq;
#pragma unroll
        for (int db = 0; db < 4; ++db) *(GAS f32x4*)(op + 16 * db) = O[db][qb]; }
}

__device__ __forceinline__ void gate_unit(Frame& F, int u) {
    const int lane = F.lane, c = lane & 15, kq = lane >> 4;
    const bf16* hrow = (const bf16*)(wsp(F) + WS_HB) + (size_t)(u * 16 + c) * DM + 8 * kq;
    const bf16* wg = (const bf16*)(wsp(F) + WS_WCMP + 1024 * 1024 + 64 * 1024) + (size_t)c * 2048 + 8 * kq;
    f32x4 a0 = (f32x4){0.f, 0.f, 0.f, 0.f}, a1 = (f32x4){0.f, 0.f, 0.f, 0.f};
#pragma unroll 8
    for (int ks = 0; ks < 64; ++ks) { const bf16x8 hf = ldg8(hrow + ks * 32); a0 = mfma16(ldg8(wg + ks * 32), hf, a0); a1 = mfma16(ldg8(wg + (size_t)16 * 2048 + ks * 32), hf, a1); }
    float* gp = (float*)(wsp(F) + WS_GBUF) + (size_t)(u * 16 + c) * 32 + 4 * kq;
    *(GAS f32x4*)gp = a0; *(GAS f32x4*)(gp + 16) = a1;
}

__device__ __forceinline__ float gelu_tanh(float x) { const float u = 0.7978845608028654f * (x + 0.044715f * x * x * x); const float e = __expf(2.0f * u); return 0.5f * x * (2.0f - 2.0f / (e + 1.0f)); }
__device__ __forceinline__ void cmp_mlp_unit(Frame& F, int l, int unit) {
    const int lane = F.lane, c = lane & 15, kq = lane >> 4;
    const int nt = unit & 31, g = (unit >> 5) & 1, b = (unit >> 6) & 1, kv = unit >> 7;
    const bf16* proj = (const bf16*)(wsp(F) + WS_PROJ);
    const bf16* W1t = (const bf16*)(wsp(F) + WS_WCMP) + (size_t)kv * 128 * 2048; const bf16* W2t = (const bf16*)(wsp(F) + WS_WCMP + 2 * 128 * 2048 * 2) + (size_t)kv * 64 * 128;
    const float* pe = inp(F, kv ? I_PEV : I_PEK) + (size_t)l * 32 * 64;
    const int n = nt * 16 + c; const size_t tb = (size_t)b * SEQ; const int xoff = (kv ? P_VBC : P_KBC) + g * 64;
    LAS f32x4* red = (LAS f32x4*)(F.lds);
    f32x4 H[4][2];
#pragma unroll
    for (int s = 0; s < 4; ++s) { H[s][0] = (f32x4){0.f, 0.f, 0.f, 0.f}; H[s][1] = (f32x4){0.f, 0.f, 0.f, 0.f}; }
#pragma unroll 2
    for (int kk = 0; kk < 8; ++kk) {
        const int ks = F.wave * 8 + kk, lt = ks >> 1, d0 = (ks & 1) * 32 + 8 * kq; int tok = 16 * n + lt; if (tok > SEQ - 1) tok = SEQ - 1;
        const bf16x8 xr = ldg8(proj + (tb + tok) * NPROJ + xoff + d0);
        const f32x4 p0 = *(const GAS f32x4*)(pe + lt * 64 + d0), p1 = *(const GAS f32x4*)(pe + lt * 64 + d0 + 4);
        const bf16x8 Xf = pack8(bf2f((unsigned short)xr[0]) + p0[0], bf2f((unsigned short)xr[1]) + p0[1], bf2f((unsigned short)xr[2]) + p0[2], bf2f((unsigned short)xr[3]) + p0[3],
                                bf2f((unsigned short)xr[4]) + p1[0], bf2f((unsigned short)xr[5]) + p1[1], bf2f((unsigned short)xr[6]) + p1[2], bf2f((unsigned short)xr[7]) + p1[3]);
#pragma unroll
        for (int s = 0; s < 4; ++s)
#pragma unroll
            for (int h = 0; h < 2; ++h) { const int hid = 32 * s + 8 * (c >> 2) + 4 * h + (c & 3);
                H[s][h] = mfma16(ldg8(W1t + (size_t)hid * 2048 + ks * 32 + 8 * kq), Xf, H[s][h]); }
    }
#pragma unroll
    for (int s = 0; s < 4; ++s)
#pragma unroll
        for (int h = 0; h < 2; ++h) red[(F.wave * 8 + s * 2 + h) * 64 + lane] = H[s][h];
    __syncthreads();
    if (F.wave == 0) {
#pragma unroll
        for (int s = 0; s < 4; ++s)
#pragma unroll
            for (int h = 0; h < 2; ++h) { f32x4 a = red[(s * 2 + h) * 64 + lane];
#pragma unroll
                for (int w = 1; w < 8; ++w) a += red[(w * 8 + s * 2 + h) * 64 + lane];
                H[s][h] = a; }
        f32x4 Y[4];
#pragma unroll
        for (int eb = 0; eb < 4; ++eb) Y[eb] = (f32x4){0.f, 0.f, 0.f, 0.f};
#pragma unroll
        for (int s = 0; s < 4; ++s) {
            const bf16x8 Hf = pack8(gelu_tanh(H[s][0][0]), gelu_tanh(H[s][0][1]), gelu_tanh(H[s][0][2]), gelu_tanh(H[s][0][3]), gelu_tanh(H[s][1][0]), gelu_tanh(H[s][1][1]), gelu_tanh(H[s][1][2]), gelu_tanh(H[s][1][3]));
#pragma unroll
            for (int eb = 0; eb < 4; ++eb) Y[eb] = mfma16(ldg8(W2t + (size_t)(16 * eb + c) * 128 + 32 * s + 8 * kq), Hf, Y[eb]);
        }
        const bool valid = n <= 510;
        if (kv == 0) { bf16* kc = (bf16*)(wsp(F) + WS_SMALL + SM_KCMP) + ((size_t)(b * 2 + g) * 512 + n) * 64 + 4 * kq;
#pragma unroll
            for (int eb = 0; eb < 4; ++eb) { v2u w; w.x = valid ? pk2(Y[eb][0], Y[eb][1]) : 0u; w.y = valid ? pk2(Y[eb][2], Y[eb][3]) : 0u; *(GAS v2u*)(kc + 16 * eb) = w; } }
        else { bf16* vc = (bf16*)(wsp(F) + WS_SMALL + SM_VCMPT) + (size_t)(b * 2 + g) * 64 * 512 + n;
#pragma unroll
            for (int eb = 0; eb < 4; ++eb)
#pragma unroll
                for (int r = 0; r < 4; ++r) vc[(size_t)(16 * eb + 4 * kq + r) * 512] = valid ? (bf16)f2bf(Y[eb][r]) : (bf16)0; }
    }
    __syncthreads();
}

__device__ __forceinline__ int next_below(unsigned long long ulo, unsigned long long uhi, int j) {
    if (j > 64) { const unsigned long long m = (j >= 128) ? uhi : (uhi & ((1ull << (j - 64)) - 1ull)); if (m) return 127 - __builtin_clzll(m); j = 64; }
    const unsigned long long m = (j >= 64) ? ulo : (ulo & ((1ull << j) - 1ull));
    return m ? 63 - __builtin_clzll(m) : -1;
}
__device__ __forceinline__ void nsa_unit(Frame& F, int b, int g, int q0) {
    const int lane = F.lane, c = lane & 15, kq = lane >> 4;
    const bf16* proj = (const bf16*)(wsp(F) + WS_PROJ); const bf16* vT = (const bf16*)(wsp(F) + WS_VT); float* ocat = (float*)(wsp(F) + WS_OCAT);
    const bf16* kcmp = (const bf16*)(wsp(F) + WS_SMALL + SM_KCMP) + (size_t)(b * 2 + g) * 512 * 64;
    const bf16* vcmpT = (const bf16*)(wsp(F) + WS_SMALL + SM_VCMPT) + (size_t)(b * 2 + g) * 64 * 512;
    LAS float* imp = (LAS float*)(F.lds + F.wave * AW_BYTES + AW_IMP);
    LAS unsigned* selm = (LAS unsigned*)(F.lds + F.wave * AW_BYTES + AW_SEL);
    LAS bf16x8* Ql = (LAS bf16x8*)(F.lds + F.wave * AW_BYTES + AW_Q);
    const size_t tb = (size_t)b * SEQ; const int t = q0 + c;
    const float* grow = (const float*)(wsp(F) + WS_GBUF) + (tb + t) * 32 + g * 12;
    { const bf16* qp = proj + (tb + t) * NPROJ + P_QB + g * 256 + kq * 8; q_park(Ql, qp, qp + 64, qp + 128, qp + 192, lane); }
    f32x4 sl2;
#pragma unroll
    for (int qb = 0; qb < 4; ++qb) sl2[qb] = slope2_of(8 + g * 4 + qb);
    const f32x4 sl2c = sl2 * 16.0f;
    for (int i = lane; i < 16 * IMP_STRIDE; i += 64) imp[i] = 0.f;
    const int tmax = q0 + 15; const int nmax = tmax >= 31 ? ((tmax - 31) >> 4) : -1; const int ntop = nmax & ~31;
    const bf16* Kc = kcmp + (size_t)(8 * (c >> 2) + (c & 3)) * 64 + kq * 8;
    const bf16* Vc = vcmpT + (size_t)c * 512 + 8 * kq;
    Flash S; flash_init(S, -1.0e30f, -1.0e30f, -1.0e30f, -1.0e30f);
    KF cur, nxt;
    if (nmax >= 0) {
        load_k(cur, Kc, 64, ntop);
        for (int nbase = ntop; nbase >= 0; nbase -= 32) {
            ITER_FENCE();
            VF vf; load_v(vf, Vc, 512, nbase);
            load_k(nxt, Kc, 64, nbase >= 32 ? nbase - 32 : nbase);
            f32x4 Sv[2][4]; qk_scores(Sv, cur, Ql, lane);
            const int d0 = t - 31 - 16 * (nbase + 8 * kq);
            const f32x4 b0 = sl2 * -(float)d0;
            unsigned vm = 0xffu;
            if (!(16 * (nbase + 31) + 31 <= q0)) { vm = 0u;
#pragma unroll
                for (int j = 0; j < 8; ++j) vm |= (d0 - 16 * j >= 0) ? (1u << j) : 0u; }
            flash_step(S, Sv, vf, b0, sl2c, vm);
            cur = nxt;
        }
    }
    f32x4 inv;
#pragma unroll
    for (int qb = 0; qb < 4; ++qb) { inv[qb] = flash_inv(S, qb, false, 0.f);
        const float g0 = sigmoidf_(grow[qb * 3 + 0]), g2 = sigmoidf_(grow[qb * 3 + 2]), sc = inv[qb] * g0;
        float* op = ocat + (tb + t) * DM + 512 + (g * 4 + qb) * 64 + 4 * kq;
#pragma unroll
        for (int db = 0; db < 4; ++db) { const f32x4 old = *(const GAS f32x4*)(op + 16 * db); *(GAS f32x4*)(op + 16 * db) = old * g2 + S.O[db][qb] * sc; } }
    LDS_WAIT();
    for (int nbase = 0; nbase <= nmax; nbase += 32) {
        ITER_FENCE();
        const bf16* kp = Kc + (size_t)nbase * 64;
        KF x; x.K[0][0] = ldg8(kp); x.K[0][1] = ldg8(kp + 32); x.K[1][0] = ldg8(kp + 4 * 64); x.K[1][1] = ldg8(kp + 4 * 64 + 32);
        f32x4 Sv[2][4]; qk_scores(Sv, x, Ql, lane);
        float G[2], Wl[2];
#pragma unroll
        for (int h = 0; h < 2; ++h) { float gs = 0.f, last = 0.f;
#pragma unroll
            for (int r = 0; r < 4; ++r) { const int dist = t - 16 * (nbase + 8 * kq + 4 * h + r) - 31; const bool vis = dist >= 0; const float fd = (float)dist; float pv = 0.f;
#pragma unroll
                for (int qb = 0; qb < 4; ++qb) pv += vis ? ex2(Sv[h][qb][r] * SC2 - sl2[qb] * fd - S.m[qb]) * inv[qb] : 0.f;
                gs += pv; last = pv; }
            G[h] = gs; Wl[h] = last; }
        const int j0 = (nbase >> 2) + 2 * kq;
        LAS float* ip = imp + c * IMP_STRIDE + j0;
        ip[0] += G[0]; LDS_WAIT();
        ip[1] += G[1]; LDS_WAIT();
        ip[1] += Wl[0]; LDS_WAIT();
        ip[2] += Wl[1]; LDS_WAIT();
    }
    unsigned long long ulo = 0ull, uhi = 0ull, ilo = ~0ull, ihi = ~0ull;
    for (int cq = 0; cq < 16; ++cq) {
        const int tq = q0 + cq, cur_ = tq >> 6;
        const int ja = lane, jb = lane + 64;
        const bool oka = ja <= cur_, okb = jb <= cur_;
        unsigned ka = 0u, kb = 0u;
        if (oka) ka = (ja == 0 || ja == cur_ || ja == cur_ - 1) ? 0x461c4000u : __builtin_bit_cast(unsigned, imp[cq * IMP_STRIDE + ja]) + 1u;
        if (okb) kb = (jb == cur_ || jb == cur_ - 1) ? 0x461c4000u : __builtin_bit_cast(unsigned, imp[cq * IMP_STRIDE + jb]) + 1u;
        unsigned long long mlo, mhi;
        if (cur_ < 16) { mlo = __ballot(oka); mhi = 0ull; }
        else {
            unsigned thr = 0u;
#pragma unroll 1
            for (int bit = 30; bit >= 0; --bit) { const unsigned tr = thr | (1u << bit);
                const int cntv = __popcll(__ballot(ka >= tr)) + __popcll(__ballot(kb >= tr)); if (cntv >= 16) thr = tr; }
            mlo = __ballot(ka > thr); mhi = __ballot(kb > thr);
            int need = 16 - (__popcll(mlo) + __popcll(mhi));
            unsigned long long elo = __ballot(ka == thr), ehi = __ballot(kb == thr);
            while (need > 0 && elo) { const unsigned long long bsel = elo & (~elo + 1ull); mlo |= bsel; elo ^= bsel; --need; }
            while (need > 0 && ehi) { const unsigned long long bsel = ehi & (~ehi + 1ull); mhi |= bsel; ehi ^= bsel; --need; }
        }
        ulo |= mlo; uhi |= mhi; ilo &= mlo; ihi &= mhi;
        if (lane == 0) { selm[cq * 4 + 0] = (unsigned)mlo; selm[cq * 4 + 1] = (unsigned)(mlo >> 32); selm[cq * 4 + 2] = (unsigned)mhi; selm[cq * 4 + 3] = (unsigned)(mhi >> 32); }
    }
    LDS_WAIT();
    const unsigned long long mylo = (unsigned long long)selm[c * 4 + 0] | ((unsigned long long)selm[c * 4 + 1] << 32);
    const unsigned long long myhi = (unsigned long long)selm[c * 4 + 2] | ((unsigned long long)selm[c * 4 + 3] << 32);
    flash_init(S, -1.0e30f, -1.0e30f, -1.0e30f, -1.0e30f);
    const bf16* Kb = proj + (tb + 8 * (c >> 2) + (c & 3)) * NPROJ + P_KBS + g * 64 + kq * 8;
    const bf16* Vb = vT + (size_t)(V_BS + g * 64 + c) * MTOK + tb + 8 * kq;
    int j = next_below(ulo, uhi, (tmax >> 6) + 1), hs = 1;
    load_k(cur, Kb, NPROJ, 64 * j + 32);
    while (j >= 0) {
        ITER_FENCE();
        const int kbase = 64 * j + 32 * hs;
        VF vf; load_v(vf, Vb, MTOK, kbase);
        int jn = j, hn = 0; if (hs == 0) { jn = next_below(ulo, uhi, j); hn = 1; }
        load_k(nxt, Kb, NPROJ, jn >= 0 ? 64 * jn + 32 * hn : kbase);
        const bool mine = j < 64 ? ((mylo >> j) & 1ull) != 0ull : ((myhi >> (j - 64)) & 1ull) != 0ull;
        const bool all16 = j < 64 ? ((ilo >> j) & 1ull) != 0ull : ((ihi >> (j - 64)) & 1ull) != 0ull;
        f32x4 Sv[2][4]; qk_scores(Sv, cur, Ql, lane);
        const int d0 = t - kbase - 8 * kq;
        const f32x4 b0 = sl2 * -(float)d0;
        unsigned vm = 0xffu;
        if (!(all16 && kbase + 31 <= q0)) { vm = 0u;
#pragma unroll
            for (int jj = 0; jj < 8; ++jj) vm |= (mine && d0 - jj >= 0) ? (1u << jj) : 0u; }
        flash_step(S, Sv, vf, b0, sl2, vm);
        cur = nxt; j = jn; hs = hn;
    }
#pragma unroll
    for (int qb = 0; qb < 4; ++qb) { const float sc = flash_inv(S, qb, false, 0.f) * sigmoidf_(grow[qb * 3 + 1]);
        float* op = ocat + (tb + t) * DM + 512 + (g * 4 + qb) * 64 + 4 * kq;
#pragma unroll
        for (int db = 0; db < 4; ++db) { const f32x4 old = *(const GAS f32x4*)(op + 16 * db); *(GAS f32x4*)(op + 16 * db) = old + S.O[db][qb] * sc; } }
    LDS_WAIT();
}

__device__ __forceinline__ void attn1_phase(Frame& F, int l) {
    const int gw = F.vcu * NWAVES + F.wave, NGW = F.G * NWAVES;
    for (int u = F.vcu; u < 256; u += F.G) cmp_mlp_unit(F, l, u);
    if (F.wave >= 4) for (int u = (F.wave - 4) * F.G + F.vcu; u < MTOK / 16; u += 4 * F.G) gate_unit(F, u);
    for (int u = gw; u < 2048; u += NGW) win_unit<512, 1>(F, l, u >> 10, (u >> 9) & 1, (u & 511) * 16);
    for (int u = gw; u < 4096; u += NGW) sb_unit(F, u >> 11, (u >> 7) & 15, (u & 127) * 64);
    for (int u = gw; u < 2048; u += NGW) win_unit<128, 0>(F, l, u >> 10, (u >> 9) & 1, (u & 511) * 16);
}
__device__ __forceinline__ void attn2_phase(Frame& F, int l) {
    const int gw = F.vcu * NWAVES + F.wave, NGW = F.G * NWAVES;
    for (int u = gw; u < 2048; u += NGW) nsa_unit(F, u >> 10, (u >> 9) & 1, (u & 511) * 16);
}
#ifndef MK_ONE_LAUNCH
#define MK_ONE_LAUNCH 1
#endif
#ifndef PHASE_MASK
#define PHASE_MASK 0xFFFF
#endif
constexpr int N_PHASES = 2 + 10 * DEPTH;
struct Args { const float* in[25]; float* out; unsigned char* ws; };
#define IN(k) (LO <= (k) && (k) < HI)
#define SEAM(k) do { if constexpr (IN(k) && IN((k) + 1)) xcd_barrier(bar); asm volatile("" : "+v"(F.tid), "+v"(F.lane) :: "memory"); } while (0)
#ifndef DBL_MASK
#define DBL_MASK 0
#endif
#define FENCE() asm volatile("" : "+v"(F.tid), "+v"(F.lane) :: "memory")
#define PHASE(k, bit, ...) do { if constexpr (IN(k) && (PHASE_MASK & (bit))) { __VA_ARGS__ if constexpr ((DBL_MASK & (bit)) != 0) { xcd_barrier(bar); FENCE(); __VA_ARGS__ } } } while (0)
template <int L, int LO, int HI>
__device__ __forceinline__ void layer_phases(Frame& F, const XcdBarrier& bar) {
    constexpr int l = L, pb = 2 + 10 * L;
    PHASE(pb + 0, 4, {
        pg8::Gemm g{(const pg8::bf16_t*)(wsp(F) + WS_HB), (const pg8::bf16_t*)(wsp(F) + WS_WIN), MTOK, NIN, DM}; pg8::StaticOrder S; S.init(MTOK, NIN, F.G, (int)blockIdx.x);
        pg8::EpiProj E{(pg8::bf16_t*)(wsp(F) + WS_PROJ), (pg8::bf16_t*)(wsp(F) + WS_VT), NPROJ, MTOK};
        pg8::gemm_phase<pg8::EpiProj, pg8::StaticOrder, true, true>(F.lds + RING_OFF, g, S, E);
    });
    SEAM(pb + 0);
    PHASE(pb + 1, 8, { attn1_phase(F, l); });
    SEAM(pb + 1);
    PHASE(pb + 2, 16, { attn2_phase(F, l); });
    if constexpr ((DBL_MASK & 0x10000) != 0) { xcd_barrier(bar); FENCE(); attn1_phase(F, l); xcd_barrier(bar); FENCE(); attn2_phase(F, l); }
    SEAM(pb + 2);
    PHASE(pb + 3, 32, { merge_phase(F, l); });
    SEAM(pb + 3);
    PHASE(pb + 4, 64, {
        pg8::Gemm g{(const pg8::bf16_t*)(wsp(F) + WS_HB), (const pg8::bf16_t*)(wsp(F) + WS_WOUT), MTOK, DM, DM}; pg8::StaticOrder S; S.init(MTOK, DM, F.G, (int)blockIdx.x);
        const float* g1p = (const float*)(wsp(F) + WS_MOD) + (size_t)l * NB * 6 * DM + 2 * DM;
        if constexpr (l == 0) { pg8::EpiResid<false> E{(const void*)inp(F, I_X), (pg8::bf16_t*)(wsp(F) + WS_XA), g1p, 6 * DM, SEQ, DM, ALPHA};
            pg8::gemm_phase<pg8::EpiResid<false>, pg8::StaticOrder, true, true>(F.lds + RING_OFF, g, S, E); }
        else { pg8::EpiResid<true> E{(const void*)(wsp(F) + WS_XB), (pg8::bf16_t*)(wsp(F) + WS_XA), g1p, 6 * DM, SEQ, DM, ALPHA};
            pg8::gemm_phase<pg8::EpiResid<true>, pg8::StaticOrder, true, true>(F.lds + RING_OFF, g, S, E); }
    });
    SEAM(pb + 4);
    PHASE(pb + 5, 128, { post_mixer_phase(F, l); });
    if constexpr (IN(pb + 5)) { if constexpr (HI - LO > 1) xcd_barrier(bar); FENCE(); router_phase(F, l); }
    SEAM(pb + 5);
    PHASE(pb + 7, 512, {
        moe_tables(F, l);
        const PG8_LAS_T int* tab = (const PG8_LAS_T int*)(F.lds + TAB_OFF);
        pg8::Gemm g{(const pg8::bf16_t*)(wsp(F) + WS_HB), (const pg8::bf16_t*)(wsp(F) + WS_WGU), MAXROWS, NEXP * 1024, DM};
        pg8::MoeOrder S{4, F.G, (int)blockIdx.x, tab};
        pg8::EpiSwiGLU E{(pg8::bf16_t*)(wsp(F) + WS_HID), DEXP};
        pg8::MoeGather GA{tab, (const int*)(wsp(F) + WS_LIST), MTOK, (unsigned)(DM * 2), 0u};
        pg8::gemm_phase<pg8::EpiSwiGLU, pg8::MoeOrder, true, true, pg8::MoeGather>(F.lds + RING_OFF, g, S, E, GA);
    });
    SEAM(pb + 7);
    PHASE(pb + 8, 1024, {
        moe_tables(F, l);
        const PG8_LAS_T int* tab = (const PG8_LAS_T int*)(F.lds + TAB_OFF);
        pg8::Gemm g{(const pg8::bf16_t*)(wsp(F) + WS_HID), (const pg8::bf16_t*)(wsp(F) + WS_WD), MAXROWS, NEXP * DM, DEXP};
        pg8::MoeOrder S{8, F.G, (int)blockIdx.x, tab};
        pg8::EpiDown E{(pg8::bf16_t*)(wsp(F) + WS_YS), DM, tab, (const int*)(wsp(F) + WS_LIST), MTOK, (const float*)(wsp(F) + WS_SMALL + SM_GATEW)};
        pg8::gemm_phase<pg8::EpiDown, pg8::MoeOrder, true, true>(F.lds + RING_OFF, g, S, E);
    });
    SEAM(pb + 8);
    PHASE(pb + 9, 2048, { post_moe_phase(F, l, (l == DEPTH - 1) ? outp(F) : (float*)nullptr, (bf16*)(wsp(F) + WS_XB), l < DEPTH - 1); });
    PHASE(pb + 9, 4096, { if (l < DEPTH - 1) convert_small(F, l + 1); });
    SEAM(pb + 9);
}
template <int LO, int HI>
__global__ void __launch_bounds__(NWAVES * 64, 2) fwd_kernel(Args args) {
    extern __shared__ __attribute__((aligned(16))) unsigned char lds[];
    Frame F;
    F.lds = (LAS unsigned char*)lds;
    F.MISC = (volatile LAS unsigned*)(F.lds + MISC_OFF);
    F.tid = threadIdx.x; F.lane = F.tid & 63; F.wave = __builtin_amdgcn_readfirstlane(F.tid >> 6);
    F.G = gridDim.x; { const int bx = blockIdx.x; F.vcu = (F.G % 8 == 0) ? (bx % 8) * (F.G / 8) + bx / 8 : bx; }
    for (int u = F.tid; u < (LDS_BYTES - LDSCTL_OFF) / 4; u += NWAVES * 64) ((LAS unsigned*)(F.lds + LDSCTL_OFF))[u] = 0u;
    __syncthreads();
    if (F.tid < 25) ((LAS unsigned long long*)(F.lds + PTR_OFF))[F.tid] = (unsigned long long)args.in[F.tid];
    if (F.tid == 25) ((LAS unsigned long long*)(F.lds + PTR_OFF))[25] = (unsigned long long)args.ws;
    if (F.tid == 26) ((LAS unsigned long long*)(F.lds + PTR_OFF))[26] = (unsigned long long)args.out;
    __syncthreads();
    XcdBarrier bar; bar.bar = (unsigned*)(ctlp(F) + CW_BAR); bar.x = 0; bar.st = nullptr;
    if constexpr (HI - LO > 1) bar = xcd_barrier_post((unsigned*)(ctlp(F) + CW_BAR), F.MISC + 8);
    PHASE(0, 1, { ada_phase(F); });
    PHASE(0, 4096, { __syncthreads(); convert_small(F, 0); });
    SEAM(0);
    PHASE(1, 2, { ln_in_phase(F); });
    SEAM(1);
    layer_phases<0, LO, HI>(F, bar);
    layer_phases<1, LO, HI>(F, bar);
}
#undef IN
#undef SEAM
#undef PHASE

#if MK_ONE_LAUNCH
#define FWD_MAIN (fwd_kernel<0, N_PHASES>)
static bool set_lds_attr() { return hipFuncSetAttribute((const void*)FWD_MAIN, hipFuncAttributeMaxDynamicSharedMemorySize, LDS_BYTES) == hipSuccess; }
#else
#define FWD_MAIN (fwd_kernel<0, 1>)
template <int... P> static bool set_lds_attr_seq(std::integer_sequence<int, P...>) { bool ok = true; ((ok = ok && hipFuncSetAttribute((const void*)(fwd_kernel<P, P + 1>), hipFuncAttributeMaxDynamicSharedMemorySize, LDS_BYTES) == hipSuccess), ...); return ok; }
static bool set_lds_attr() { return set_lds_attr_seq(std::make_integer_sequence<int, N_PHASES>{}); }
template <int P> static void launch_one(int grid, hipStream_t stream, const Args& a) { hipLaunchKernelGGL((fwd_kernel<P, P + 1>), dim3(grid), dim3(NWAVES * 64), LDS_BYTES, stream, a); }
template <int... P> static void launch_phases(std::integer_sequence<int, P...>, int grid, hipStream_t stream, const Args& a) { (launch_one<P>(grid, stream, a), ...); }
#endif
extern "C" void kernel_launch(void* const* d_in, const int* in_sizes, int n_in, void* d_out, int out_size, void* d_ws, size_t ws_size, hipStream_t stream) {
    static int grid = 0;
    if (grid == 0) {
        if (n_in != 25 || out_size != MTOK * DM || ws_size < WS_END) { fprintf(stderr, "kernel_launch: unexpected problem shape (n_in %d, out %d, ws %zu)\n", n_in, out_size, ws_size); grid = -1; return; }
        int dev = 0, cus = 0, per_cu = 0;
        if (hipGetDevice(&dev) != hipSuccess || hipDeviceGetAttribute(&cus, hipDeviceAttributeMultiprocessorCount, dev) != hipSuccess) { grid = -1; return; }
        if (!set_lds_attr()) { fprintf(stderr, "kernel_launch: hipFuncSetAttribute failed\n"); grid = -1; return; }
        if (hipOccupancyMaxActiveBlocksPerMultiprocessor(&per_cu, (const void*)FWD_MAIN, NWAVES * 64, LDS_BYTES) != hipSuccess || per_cu < 1)
            fprintf(stderr, "kernel_launch: note: occupancy query reports %d workgroups per CU\n", per_cu);
        (void)hipGetLastError();
        grid = cus;
        if (grid > 256) grid = 256;
        grid &= ~7;
    }
    if (grid <= 0) return;
    (void)in_sizes;
    if (hipMemsetAsync((char*)d_ws + WS_CTL, 0, CTL_ZERO_BYTES, stream) != hipSuccess) return;
    Args a{};
    for (int i = 0; i < 25; ++i) a.in[i] = (const float*)d_in[i];
    a.out = (float*)d_out; a.ws = (unsigned char*)d_ws;
#if MK_ONE_LAUNCH
    hipLaunchKernelGGL((fwd_kernel<0, N_PHASES>), dim3(grid), dim3(NWAVES * 64), LDS_BYTES, stream, a);
#else
    launch_phases(std::make_integer_sequence<int, N_PHASES>{}, grid, stream, a);
#endif
}
```

```cpp
#include <hip/hip_runtime.h>
#include <cstdio>
#include <cstdint>
#include <utility>
#define MK_ONE_LAUNCH 1
namespace pg8 {
#define PG8_LAS __attribute__((address_space(3)))
#define PG8_LAS_T __attribute__((address_space(3)))
typedef unsigned short bf16_t;
typedef short bf16x8 __attribute__((ext_vector_type(8)));
typedef float f32x4 __attribute__((ext_vector_type(4)));
typedef unsigned u32x4 __attribute__((ext_vector_type(4)));
constexpr int BM = 256, BK = 64, HALF = 128, HTB = HALF * BK * 2  , STAGE_BYTES = 8 * HTB, NXCD = 8, WGM = 8;

__host__ __device__ __forceinline__ int lds_byte(int r, int c) { const int st = (r >> 4) * 2 + (c >> 5), rr = r & 15, cc = c & 31, ob = rr * 64 + cc * 2; return st * 1024 + (ob ^ (((ob >> 9) & 1) << 5)); }
__host__ __device__ __forceinline__ void stage_rc(int b, int& R, int& C) { const int st = b / 1024, sb = b % 1024, swz = sb ^ (((sb >> 9) & 1) << 5); R = (st >> 1) * 16 + swz / 64; C = (st & 1) * 32 + (swz % 64) / 2; }
__host__ __device__ __forceinline__ int perm32(int rho) { const int n = rho >> 4, i = rho & 15; return 8 * (i >> 2) + 4 * n + (i & 3); }

struct Unit { int pm, pn; };
struct Gemm { const bf16_t* A; const bf16_t* Bt; int M, N, K; };

struct StaticOrder {
    int nM, nN, nwg, G, c;
    __host__ __device__ void init(int M, int N, int G_, int c_) { nM = M / BM; nN = N / BM; nwg = nM * nN; G = G_; c = c_; }
    __host__ __device__ bool next(int i, Unit& u) const {
        const long L = (long)i * G + c; if (L >= nwg) return false;
        int wgid = (int)L; { const int q = nwg / NXCD, r = nwg % NXCD, xcd = wgid % NXCD, off = wgid / NXCD; wgid = (xcd < r ? xcd * (q + 1) : r * (q + 1) + (xcd - r) * q) + off; }
        const int nig = WGM * nN, gid = wgid / nig, fm = gid * WGM, gsz = (nM - fm) < WGM ? (nM - fm) : WGM;
        u.pm = fm + ((wgid % nig) % gsz); u.pn = (wgid % nig) / gsz; return true;
    }
    __device__ __forceinline__ void a_ready(const Unit&) const {}
    __device__ __forceinline__ void done(const Unit&) const {}
};
__device__ __forceinline__ unsigned cvt_pk_bf16(float lo, float hi) { unsigned r; asm volatile("s_nop 0\n\tv_cvt_pk_bf16_f32 %0, %1, %2" : "=v"(r) : "v"(lo), "v"(hi));     return r; }
typedef float f32x2 __attribute__((ext_vector_type(2)));
__device__ __forceinline__ unsigned short f2bf_rne(float f) { unsigned u = __builtin_bit_cast(unsigned, f); return (unsigned short)((u + 0x7fffu + ((u >> 16) & 1u)) >> 16); }

struct EpiProj {
    static constexpr bool PERM = true, AFTER_DRAIN = false;
    bf16_t* P; bf16_t* VT; int ldp; int ldvt;
    __device__ __forceinline__ void operator()(const f32x4 (&acc)[2][2][4][2], const Unit& u, int wr, int wc, int fr, int fq) const {
        const int row0 = u.pm * BM + wr * 64 + fr;
#pragma unroll
        for (int bj = 0; bj < 2; ++bj) {
            const int cb = u.pn * BM + bj * HALF;
            if (cb < ldp) {
                bf16_t* colp = P + (size_t)row0 * ldp + cb + wc * 32 + 8 * fq;
#pragma unroll
                for (int ai = 0; ai < 2; ++ai)
#pragma unroll
                    for (int m = 0; m < 4; ++m) { const f32x4 v0 = acc[ai][bj][m][0], v1 = acc[ai][bj][m][1];
                        u32x4 w; w.x = cvt_pk_bf16(v0[0], v0[1]); w.y = cvt_pk_bf16(v0[2], v0[3]); w.z = cvt_pk_bf16(v1[0], v1[1]); w.w = cvt_pk_bf16(v1[2], v1[3]);
                        *(u32x4*)(colp + (size_t)(ai * HALF + m * 16) * ldp) = w; }
            } else {
                const int c0 = cb - ldp + wc * 32 + 8 * fq;
#pragma unroll
                for (int n = 0; n < 2; ++n)
#pragma unroll
                    for (int e = 0; e < 4; ++e) { bf16_t* cp = VT + (size_t)(c0 + n * 4 + e) * ldvt + row0;
#pragma unroll
                        for (int ai = 0; ai < 2; ++ai)
#pragma unroll
                            for (int m = 0; m < 4; ++m) cp[ai * HALF + m * 16] = f2bf_rne(acc[ai][bj][m][n][e]); }
            }
        }
    }
};

template <bool XBF> struct EpiResid {
    static constexpr bool PERM = true, AFTER_DRAIN = false;
    const void* xin; bf16_t* out; const float* gate0; int gate_bstride; int rows_per_batch; int ldc; float alpha;
    __device__ __forceinline__ void operator()(const f32x4 (&acc)[2][2][4][2], const Unit& u, int wr, int wc, int fr, int fq) const {
        const int col0 = u.pn * BM + wc * 32 + 8 * fq;
        const float* gv = gate0 + (size_t)((u.pm * BM) / rows_per_batch) * gate_bstride;
#pragma unroll
        for (int bj = 0; bj < 2; ++bj) { const int c = col0 + bj * HALF; const f32x4 g0 = *(const f32x4*)(gv + c) + 1.0f, g1 = *(const f32x4*)(gv + c + 4) + 1.0f;
#pragma unroll
            for (int ai = 0; ai < 2; ++ai)
#pragma unroll
                for (int m = 0; m < 4; ++m) { const size_t off = (size_t)(u.pm * BM + ai * HALF + wr * 64 + m * 16 + fr) * ldc + c;
                    f32x4 x0, x1;
                    if (XBF) { const u32x4 xw = *(const u32x4*)((const bf16_t*)xin + off);
                        x0 = (f32x4){__builtin_bit_cast(float, xw.x << 16), __builtin_bit_cast(float, xw.x & 0xffff0000u), __builtin_bit_cast(float, xw.y << 16), __builtin_bit_cast(float, xw.y & 0xffff0000u)};
                        x1 = (f32x4){__builtin_bit_cast(float, xw.z << 16), __builtin_bit_cast(float, xw.z & 0xffff0000u), __builtin_bit_cast(float, xw.w << 16), __builtin_bit_cast(float, xw.w & 0xffff0000u)}; }
                    else { x0 = *(const f32x4*)((const float*)xin + off); x1 = *(const f32x4*)((const float*)xin + off + 4); }
                    const f32x4 v0 = x0 * alpha + g0 * acc[ai][bj][m][0], v1 = x1 * alpha + g1 * acc[ai][bj][m][1];
                    u32x4 w; w.x = cvt_pk_bf16(v0[0], v0[1]); w.y = cvt_pk_bf16(v0[2], v0[3]); w.z = cvt_pk_bf16(v1[0], v1[1]); w.w = cvt_pk_bf16(v1[2], v1[3]);
                    *(u32x4*)(out + off) = w; } }
    }
};

struct EpiSwiGLU {
    static constexpr bool PERM = true, AFTER_DRAIN = false;
    bf16_t* H; int ldh;
    __device__ __forceinline__ void operator()(const f32x4 (&acc)[2][2][4][2], const Unit& u, int wr, int wc, int fr, int fq) const {
        const int row0 = u.pm * BM + wr * 64 + fr, pnl = u.pn & 3;
        const int j0 = pnl * 128 + wc * 16 + 4 * fq;
#pragma unroll
        for (int ai = 0; ai < 2; ++ai)
#pragma unroll
            for (int m = 0; m < 4; ++m) { bf16_t* rowp = H + (size_t)(row0 + ai * HALF + m * 16) * ldh + j0;
#pragma unroll
                for (int bj = 0; bj < 2; ++bj) { const f32x4 v0 = acc[ai][bj][m][0], v1 = acc[ai][bj][m][1];
                    const float h0 = v0[0] / (1.0f + __expf(-v0[0])) * v0[1], h1 = v0[2] / (1.0f + __expf(-v0[2])) * v0[3];
                    const float h2 = v1[0] / (1.0f + __expf(-v1[0])) * v1[1], h3 = v1[2] / (1.0f + __expf(-v1[2])) * v1[3];
                    typedef unsigned u32x2 __attribute__((ext_vector_type(2)));
                    u32x2 w; w.x = cvt_pk_bf16(h0, h1); w.y = cvt_pk_bf16(h2, h3);
                    *(u32x2*)(rowp + bj * 64) = w; } }
    }
};

__device__ __forceinline__ int moe_row_aid(const PG8_LAS int* tab, const int* list, int list_stride, int rt, int row_in_tile) {
    const int e = tab[64 + rt], pos = rt * 256 + row_in_tile - tab[32 + e];
    return pos < tab[e] ? list[(size_t)e * list_stride + pos] : -1;
}
struct MoeGather {
    static constexpr bool ON = true;
    const PG8_LAS int* tab; const int* list; int list_stride; unsigned row_bytes, zero_off;
    __device__ __forceinline__ unsigned row_off(const Unit& u, int h, int r) const { const int aid = moe_row_aid(tab, list, list_stride, u.pm, h * HALF + r); return aid >= 0 ? (unsigned)(aid >> 1) * row_bytes : zero_off; }
};

struct EpiDown {
    static constexpr bool PERM = true, AFTER_DRAIN = false;
    bf16_t* Y; int ldy; const PG8_LAS int* tab; const int* list; int list_stride; const float* gatew;
    __device__ __forceinline__ void operator()(const f32x4 (&acc)[2][2][4][2], const Unit& u, int wr, int wc, int fr, int fq) const {
        const int pnl = u.pn & 7;
        const int col0 = pnl * BM + wc * 32 + 8 * fq;
#pragma unroll
        for (int ai = 0; ai < 2; ++ai)
#pragma unroll
            for (int m = 0; m < 4; ++m) { const int aid = moe_row_aid(tab, list, list_stride, u.pm, wr * 64 + fr + ai * HALF + m * 16);
                if (aid >= 0) { const float gw = gatew[aid]; bf16_t* rowp = Y + (size_t)aid * ldy + col0;
#pragma unroll
                    for (int bj = 0; bj < 2; ++bj) { const f32x4 v0 = acc[ai][bj][m][0] * gw, v1 = acc[ai][bj][m][1] * gw;
                        u32x4 w; w.x = cvt_pk_bf16(v0[0], v0[1]); w.y = cvt_pk_bf16(v0[2], v0[3]); w.z = cvt_pk_bf16(v1[0], v1[1]); w.w = cvt_pk_bf16(v1[2], v1[3]);
                        *(u32x4*)(rowp + bj * HALF) = w; } } }
    }
};

struct MoeOrder {
    int NT, G, c; const PG8_LAS int* tab;
    __device__ __forceinline__ bool next(int i, Unit& u) const {
        const int x = c & 7, ci = c >> 3, per = G >> 3;
        const int q = i * per + ci, rt = x + 8 * (q / NT);
        if (rt >= tab[224]) return false;
        u.pm = rt; u.pn = tab[64 + rt] * NT + (q % NT); return true;
    }
    __device__ __forceinline__ void a_ready(const Unit&) const {}
    __device__ __forceinline__ void done(const Unit&) const {}
};
struct NoGather { static constexpr bool ON = false; __device__ __forceinline__ unsigned row_off(const Unit&, int, int) const { return 0u; } };
template <class Epi, class Sched, bool ALIGN_EPI = false, bool SP2 = false, class Gat = NoGather>
__device__ __forceinline__ void gemm_phase(PG8_LAS unsigned char* lds, const Gemm g, const Sched& S, const Epi& E, const Gat& GA = Gat()) {
    static_assert(!Gat::ON || SP2, "the gathered A operand is wired into the SP2 loop only");
    int tid_ = threadIdx.x; asm volatile("" : "+v"(tid_));
    const int tid = tid_, wid = __builtin_amdgcn_readfirstlane(tid >> 6), lane = tid & 63, wr = wid >> 2, wc = wid & 3, fr = lane & 15, fq = lane >> 4;
    const int K = g.K, nt = K / BK;
    unsigned voffA[2], voffB[2];
    int RA[2]; unsigned CA2[2];
#pragma unroll
    for (int i = 0; i < 2; ++i) { int R, C; stage_rc(tid * 16 + i * 8192, R, C); const int Rb = Epi::PERM ? ((R & ~31) + perm32(R & 31)) : R;
        voffA[i] = (unsigned)(R * K + C) * 2u; voffB[i] = (unsigned)(Rb * K + C) * 2u; RA[i] = R; CA2[i] = (unsigned)C * 2u; }
    unsigned gcu[2][2] = {{0u, 0u}, {0u, 0u}}, gnx[2][2] = {{0u, 0u}, {0u, 0u}};
    const size_t kstep = (size_t)(BK * 2);
    const size_t hstep = (size_t)HALF * K * 2;
    const size_t tstep = 2 * hstep;
    const unsigned ldsw = (unsigned)wid * 1024u;
    const int aoff = lds_byte(wr * 64 + fr, fq * 8), boff = lds_byte(wc * 32 + fr, fq * 8);
#define PG8_SA(b, h) (((b) * 2 + (h)) * HTB)
#define PG8_SB(b, h) ((4 + (b) * 2 + (h)) * HTB)
#define PG8_STAGE(bufoff, gbase, voff) do { _Pragma("unroll") for (int _i = 0; _i < 2; ++_i) \
        __builtin_amdgcn_global_load_lds((const unsigned*)((const char*)(gbase) + (voff)[_i]), (PG8_LAS unsigned*)(lds + (bufoff) + ldsw + _i * 8192), 16, 0, 0); } while (0)
#define PG8_STAGE_A(b, h, ptr, isnext) do { if constexpr (Gat::ON) { const bool _nx = (isnext); unsigned _tv[2] = {_nx ? gnx[h][0] : gcu[h][0], _nx ? gnx[h][1] : gcu[h][1]}; PG8_STAGE(PG8_SA(b, h), ptr, _tv); } \
        else { PG8_STAGE(PG8_SA(b, h), (ptr) + (h) * hstep, voffA); } } while (0)
#define PG8_LDA(dst, b, h) do { _Pragma("unroll") for (int m = 0; m < 4; ++m) _Pragma("unroll") for (int k = 0; k < 2; ++k) dst[m][k] = *(const PG8_LAS bf16x8*)(lds + PG8_SA(b, h) + aoff + m * 2048 + k * 1024); } while (0)
#define PG8_LDB(dst, b, h) do { _Pragma("unroll") for (int n = 0; n < 2; ++n) _Pragma("unroll") for (int k = 0; k < 2; ++k) dst[n][k] = *(const PG8_LAS bf16x8*)(lds + PG8_SB(b, h) + boff + n * 2048 + k * 1024); } while (0)
#define PG8_MMA(ai, bj, At, Bt) do { __builtin_amdgcn_s_setprio(1); _Pragma("unroll") for (int m = 0; m < 4; ++m) _Pragma("unroll") for (int n = 0; n < 2; ++n) _Pragma("unroll") for (int k = 0; k < 2; ++k) \
        acc[ai][bj][m][n] = __builtin_amdgcn_mfma_f32_16x16x32_bf16(Bt[n][k], At[m][k], acc[ai][bj][m][n], 0, 0, 0); __builtin_amdgcn_s_setprio(0); } while (0)
#define PG8_WAIT_V(n) asm volatile("s_waitcnt vmcnt(" #n ")" ::: "memory")
#define PG8_WAIT_L(n) asm volatile("s_waitcnt lgkmcnt(" #n ")" ::: "memory")
#define PG8_BAR __builtin_amdgcn_s_barrier()
#define PG8_SCHED __builtin_amdgcn_sched_barrier(0)
    Unit cur, nxt; int ui = 0;
    if (!S.next(0, cur)) return;
    f32x4 acc[2][2][4][2];
#pragma unroll
    for (int a = 0; a < 2; ++a)
#pragma unroll
        for (int b = 0; b < 2; ++b)
#pragma unroll
            for (int m = 0; m < 4; ++m)
#pragma unroll
                for (int n = 0; n < 2; ++n) acc[a][b][m][n] = (f32x4){0.f, 0.f, 0.f, 0.f};
    bf16x8 At[4][2], B0[2][2], B1[2][2];
    const char* cA = (const char*)g.A + (Gat::ON ? (size_t)0 : (size_t)cur.pm * tstep); const char* cB = (const char*)g.Bt + (size_t)cur.pn * tstep;
    if constexpr (Gat::ON) {
#pragma unroll
        for (int h = 0; h < 2; ++h)
#pragma unroll
            for (int i = 0; i < 2; ++i) { gcu[h][i] = GA.row_off(cur, h, RA[i]) + CA2[i]; gnx[h][i] = gcu[h][i]; } }
    S.a_ready(cur);
    if constexpr (SP2) {
        PG8_STAGE(PG8_SB(0, 0), cB, voffB); PG8_STAGE(PG8_SB(0, 1), cB + hstep, voffB); PG8_STAGE_A(0, 0, cA, false); PG8_STAGE_A(0, 1, cA, false);
        if (wr == 1) PG8_BAR;
        PG8_WAIT_V(2); PG8_BAR;
        PG8_STAGE(PG8_SB(1, 0), cB + kstep, voffB); PG8_STAGE_A(1, 0, cA + kstep, false); PG8_STAGE(PG8_SB(1, 1), cB + hstep + kstep, voffB);
        PG8_WAIT_V(6); PG8_BAR;
    } else {
        PG8_STAGE(PG8_SB(0, 0), cB, voffB); PG8_STAGE(PG8_SA(0, 0), cA, voffA); PG8_STAGE(PG8_SB(0, 1), cB + hstep, voffB); PG8_STAGE(PG8_SA(0, 1), cA + hstep, voffA);
        if (wr == 1) PG8_BAR;
        PG8_WAIT_V(4); PG8_BAR;
        PG8_STAGE(PG8_SB(1, 0), cB + kstep, voffB); PG8_STAGE(PG8_SA(1, 0), cA + kstep, voffA); PG8_STAGE(PG8_SB(1, 1), cB + hstep + kstep, voffB);
        PG8_WAIT_V(6); PG8_BAR;
    }
    for (;;) {
        const bool has_next = S.next(ui + 1, nxt);
        const char* nA = (has_next && !Gat::ON) ? (const char*)g.A + (size_t)nxt.pm * tstep : cA; const char* nB = has_next ? (const char*)g.Bt + (size_t)nxt.pn * tstep : cB;
        if constexpr (Gat::ON) { if (has_next) {
#pragma unroll
            for (int h = 0; h < 2; ++h)
#pragma unroll
                for (int i = 0; i < 2; ++i) gnx[h][i] = GA.row_off(nxt, h, RA[i]) + CA2[i]; } }
        for (int t = 0; t < nt; t += 2) {
            const bool last = (t == nt - 2);
            const char* a1 = cA + (size_t)(t + 1) * kstep;
            const char* a2 = last ? nA : cA + (size_t)(t + 2) * kstep; const char* b2 = last ? nB : cB + (size_t)(t + 2) * kstep;
            const char* a3 = a2 + kstep; const char* b3 = b2 + kstep;
            if (last && has_next) S.a_ready(nxt);
            if constexpr (SP2) {
            PG8_LDB(B0, 0, 0); PG8_LDB(B1, 0, 1); PG8_SCHED; PG8_LDA(At, 0, 0); PG8_STAGE_A(1, 1, a1, false);
            PG8_WAIT_V(8); PG8_WAIT_L(0); PG8_BAR; PG8_MMA(0, 0, At, B0); PG8_MMA(0, 1, At, B1); PG8_BAR; PG8_SCHED;
            PG8_LDA(At, 0, 1); PG8_STAGE(PG8_SB(0, 0), b2, voffB); PG8_STAGE(PG8_SB(0, 1), b2 + hstep, voffB); PG8_STAGE_A(0, 0, a2, last);
            PG8_WAIT_V(8); PG8_WAIT_L(0); PG8_BAR; PG8_MMA(1, 0, At, B0); PG8_MMA(1, 1, At, B1); PG8_BAR; PG8_SCHED;
            PG8_LDB(B0, 1, 0); PG8_LDB(B1, 1, 1); PG8_SCHED; PG8_LDA(At, 1, 0); PG8_STAGE_A(0, 1, a2, last);
            PG8_WAIT_V(8); PG8_WAIT_L(0); PG8_BAR; PG8_MMA(0, 0, At, B0); PG8_MMA(0, 1, At, B1); PG8_BAR; PG8_SCHED;
            PG8_LDA(At, 1, 1); PG8_STAGE(PG8_SB(1, 0), b3, voffB); PG8_STAGE(PG8_SB(1, 1), b3 + hstep, voffB); PG8_STAGE_A(1, 0, a3, last);
            PG8_WAIT_V(8); PG8_WAIT_L(0); PG8_BAR; PG8_MMA(1, 0, At, B0); PG8_MMA(1, 1, At, B1); PG8_BAR; PG8_SCHED;
            } else {
            PG8_LDB(B0, 0, 0); PG8_SCHED; PG8_LDA(At, 0, 0); PG8_STAGE(PG8_SA(1, 1), a1 + hstep, voffA);
            PG8_WAIT_L(8); PG8_BAR; PG8_WAIT_L(0); PG8_MMA(0, 0, At, B0); PG8_BAR; PG8_SCHED;
            PG8_LDB(B1, 0, 1); PG8_STAGE(PG8_SB(0, 0), b2, voffB);
            PG8_BAR; PG8_WAIT_L(0); PG8_MMA(0, 1, At, B1); PG8_BAR;
            PG8_LDA(At, 0, 1); PG8_STAGE(PG8_SA(0, 0), a2, voffA);
            PG8_BAR; PG8_WAIT_L(0); PG8_MMA(1, 0, At, B0); PG8_BAR; PG8_SCHED;
            PG8_STAGE(PG8_SB(0, 1), b2 + hstep, voffB);
            PG8_WAIT_V(6); PG8_BAR; PG8_MMA(1, 1, At, B1); PG8_BAR;
            PG8_LDB(B0, 1, 0); PG8_SCHED; PG8_LDA(At, 1, 0); PG8_STAGE(PG8_SA(0, 1), a2 + hstep, voffA);
            PG8_WAIT_L(8); PG8_BAR; PG8_WAIT_L(0); PG8_MMA(0, 0, At, B0); PG8_BAR; PG8_SCHED;
            PG8_LDB(B1, 1, 1); PG8_STAGE(PG8_SB(1, 0), b3, voffB);
            PG8_BAR; PG8_WAIT_L(0); PG8_MMA(0, 1, At, B1); PG8_BAR;
            PG8_LDA(At, 1, 1); PG8_STAGE(PG8_SA(1, 0), a3, voffA);
            PG8_BAR; PG8_WAIT_L(0); PG8_MMA(1, 0, At, B0); PG8_BAR; PG8_SCHED;
            PG8_STAGE(PG8_SB(1, 1), b3 + hstep, voffB);
            PG8_WAIT_V(6); PG8_BAR; PG8_MMA(1, 1, At, B1); PG8_BAR;
            }
        }
        if constexpr (ALIGN_EPI) { if (wr == 0) PG8_BAR; }
        if constexpr (!Epi::AFTER_DRAIN) { E(acc, cur, wr, wc, fr, fq); S.done(cur); }
        if (!has_next) break;
#pragma unroll
        for (int a = 0; a < 2; ++a)
#pragma unroll
            for (int b = 0; b < 2; ++b)
#pragma unroll
                for (int m = 0; m < 4; ++m)
#pragma unroll
                    for (int n = 0; n < 2; ++n) acc[a][b][m][n] = (f32x4){0.f, 0.f, 0.f, 0.f};
        cur = nxt; cA = nA; cB = nB; ++ui;
        if constexpr (Gat::ON) {
#pragma unroll
            for (int h = 0; h < 2; ++h) { gcu[h][0] = gnx[h][0]; gcu[h][1] = gnx[h][1]; } }
        if constexpr (ALIGN_EPI) { if (wr == 1) PG8_BAR; }
    }
    PG8_WAIT_V(0);
    if constexpr (!ALIGN_EPI) { if (wr == 0) PG8_BAR; }
    PG8_BAR;
    if constexpr (Epi::AFTER_DRAIN) { E.fused(acc, cur, wr, wc, fr, fq, lds, wid, lane); S.done(cur); }
#undef PG8_SA
#undef PG8_SB
#undef PG8_STAGE
#undef PG8_STAGE_A
#undef PG8_LDA
#undef PG8_LDB
#undef PG8_MMA
#undef PG8_WAIT_V
#undef PG8_WAIT_L
#undef PG8_BAR
#undef PG8_SCHED
}
}
constexpr int NWAVES = 8;
constexpr int NB = 2, SEQ = 8192, DM = 2048, MTOK = NB * SEQ, DEPTH = 2, HD = 64;
constexpr int NEXP = 32, DEXP = 512, NASSIGN = MTOK * 2;
constexpr int D_IN = 5144;
constexpr int NPROJ = 3712, NVT = 1408, NIN = NPROJ + NVT;
constexpr int P_QA = 0, P_KA = 512, P_QB = 640, P_KBC = 1152, P_VBC = 1280, P_KBS = 1408, P_KBW = 1536, P_QC = 1664, P_KC = 2688;
constexpr int V_C = 0, V_A = 1024, V_BS = 1152, V_BW = 1280;
constexpr float LN_EPS = 1e-5f, RMS_EPS = 1e-6f, ALPHA = 1.41421356237309515f;
constexpr float LOG2E = 1.44269504088896341f, LN2 = 0.693147180559945309f;
constexpr float SC2 = 0.125f * LOG2E;
constexpr int MAXROWS = 40960;
constexpr float SB_EXIT = -104.0f;

constexpr size_t MiB = 1u << 20;
constexpr size_t WS_CTL = 0, CTL_ZERO_BYTES = 1 * MiB;
constexpr size_t WS_MOD = 1 * MiB;
constexpr size_t WS_SMALL = 2 * MiB;
constexpr size_t WS_LIST = 5 * MiB;
constexpr size_t WS_WCMP = 7 * MiB;
constexpr size_t WS_WIN = 9 * MiB;
constexpr size_t WS_WOUT = 30 * MiB;
constexpr size_t WS_WGU = 38 * MiB;
constexpr size_t WS_WD = 166 * MiB;
constexpr size_t WS_XA = 230 * MiB;
constexpr size_t WS_XB = 358 * MiB;
constexpr size_t WS_HB = 486 * MiB;
constexpr size_t WS_PROJ = 550 * MiB;
constexpr size_t WS_VT = WS_PROJ + (size_t)MTOK * NPROJ * 2;
constexpr size_t WS_XS = WS_PROJ;
constexpr size_t WS_OCAT = 720 * MiB;
constexpr size_t WS_YS = WS_OCAT;
constexpr size_t WS_HID = 848 * MiB;
constexpr size_t WS_END = 888 * MiB;
static_assert(WS_VT + (size_t)NVT * MTOK * 2 <= WS_OCAT && WS_XS + (size_t)MAXROWS * DM * 2 <= WS_OCAT, "proj/vT/xs region");
static_assert(WS_WIN + (size_t)NIN * DM * 2 <= WS_WOUT && WS_WGU + (size_t)NEXP * 1024 * DM * 2 <= WS_WD && WS_WD + (size_t)NEXP * DM * DEXP * 2 <= WS_XA, "weight regions");
constexpr size_t SM_KCMP = 0;
constexpr size_t SM_VCMPT = 256 * 1024;
constexpr size_t SM_GATEW = 512 * 1024;
constexpr size_t SM_ROWINFO = 640 * 1024;
constexpr size_t SM_TILE = 800 * 1024;
constexpr size_t WS_GBUF = WS_SMALL + 1024 * 1024;
constexpr int CW_BAR = 4096;
constexpr int CW_CNT = 16384;

constexpr int RING_OFF = 0, RING_BYTES = 131072;
constexpr int TAB_OFF = RING_BYTES;
constexpr int LDSCTL_OFF = 143360, MISC_OFF = LDSCTL_OFF + 320;
constexpr int LDS_BYTES = 147456;

#define GAS __attribute__((address_space(1)))
#define LAS __attribute__((address_space(3)))
typedef unsigned short bf16;
typedef unsigned v4u __attribute__((ext_vector_type(4)));
typedef unsigned v2u __attribute__((ext_vector_type(2)));
typedef float f32x4 __attribute__((ext_vector_type(4)));
typedef short bf16x8 __attribute__((ext_vector_type(8)));
typedef GAS unsigned gu32;
#define RLX_AGENT __ATOMIC_RELAXED, __HIP_MEMORY_SCOPE_AGENT
#define LDS_WAIT() asm volatile("s_waitcnt lgkmcnt(0)" ::: "memory")
#define VM_WAIT() asm volatile("s_waitcnt vmcnt(0)" ::: "memory")
__device__ __forceinline__ unsigned f2bf(float f) { unsigned u = __builtin_bit_cast(unsigned, f); return (u + 0x7fffu + ((u >> 16) & 1u)) >> 16; }
__device__ __forceinline__ unsigned pk2(float lo, float hi) { return f2bf(lo) | (f2bf(hi) << 16); }
__device__ __forceinline__ float bf2f(unsigned short h) { return __builtin_bit_cast(float, (unsigned)h << 16); }
__device__ __forceinline__ float bflo(unsigned w) { return __builtin_bit_cast(float, w << 16); }
__device__ __forceinline__ float bfhi(unsigned w) { return __builtin_bit_cast(float, w & 0xffff0000u); }
__device__ __forceinline__ float ex2(float x) { return __builtin_amdgcn_exp2f(x); }
__device__ __forceinline__ float lg2(float x) { return __builtin_amdgcn_logf(x); }
__device__ __forceinline__ bf16x8 ldg8(const bf16* p) { return *(const GAS bf16x8*)p; }
__device__ __forceinline__ f32x4 mfma16(bf16x8 a, bf16x8 b, f32x4 c) { return __builtin_amdgcn_mfma_f32_16x16x32_bf16(a, b, c, 0, 0, 0); }
__device__ __forceinline__ bf16x8 pack8(float a0, float a1, float a2, float a3, float a4, float a5, float a6, float a7) {
    v4u w; w.x = pg8::cvt_pk_bf16(a0, a1); w.y = pg8::cvt_pk_bf16(a2, a3); w.z = pg8::cvt_pk_bf16(a4, a5); w.w = pg8::cvt_pk_bf16(a6, a7);
    return __builtin_bit_cast(bf16x8, w);
}
__device__ __forceinline__ float wave_sum(float v) {
#pragma unroll
    for (int o = 1; o < 64; o <<= 1) v += __shfl_xor(v, o);
    return v;
}
#define XB_TMO      128
#define XB_XCNT(j)  (256  + 64 * (j))
#define XB_XSUB(j)  (1280 + 64 * (j))
#define XB_XGEN(j)  (2304 + 64 * (j))
#define XB_TOP      3328
#define XB_TOPGEN   3392
#define XCD_BAR_WORDS 3456
#define XB_SPIN_CAP (1u << 18)

__device__ __forceinline__ unsigned xb_ld(unsigned* p)              { return __hip_atomic_load(p, __ATOMIC_RELAXED, __HIP_MEMORY_SCOPE_AGENT); }
__device__ __forceinline__ unsigned xb_add(unsigned* p, unsigned v) { return __hip_atomic_fetch_add(p, v, __ATOMIC_RELAXED, __HIP_MEMORY_SCOPE_AGENT); }
__device__ __forceinline__ unsigned xb_xcc_id() { return (unsigned)__builtin_amdgcn_s_getreg((3 << 11) | 20) & 0xFu; }
#define XB_SPIN(cond, bar) do { unsigned _sp = 0; while (cond) { __builtin_amdgcn_s_sleep(1); \
    if ((++_sp & 255u) == 0u) { if (xb_ld(&(bar)[XB_TMO])) break; if (_sp > XB_SPIN_CAP) { atomicAdd(&(bar)[XB_TMO], 1u); break; } } } } while (0)

struct XcdBarrier {
    unsigned* bar; unsigned x;
    volatile LAS unsigned* st;
};

__device__ __forceinline__ XcdBarrier xcd_barrier_post(unsigned* bar, volatile LAS unsigned* st) {
    XcdBarrier b; b.bar = bar; b.x = xb_xcc_id(); b.st = st;
    if (threadIdx.x == 0) (void)xb_add(&bar[XB_XCNT(b.x)], 1u);
    return b;
}
__device__ __forceinline__ void xcd_barrier_complete(unsigned* bar, unsigned x, unsigned& nloc, unsigned& nx) {
    const unsigned G = gridDim.x * gridDim.y * gridDim.z;
    unsigned sum, cnt, mine, sp = 0u;
    for (;;) {
        sum = 0u; cnt = 0u; mine = 0u;
#pragma unroll
        for (unsigned j = 0; j < 16; ++j) { const unsigned c = xb_ld(&bar[XB_XCNT(j)]); sum += c; cnt += (c > 0u) ? 1u : 0u; mine = (j == x) ? c : mine; }
        if (sum == G) break;
        __builtin_amdgcn_s_sleep(1);
        if ((++sp & 255u) == 0u) { if (xb_ld(&bar[XB_TMO])) break; if (sp > XB_SPIN_CAP) { atomicAdd(&bar[XB_TMO], 1u); break; } }
    }
    nloc = mine > 0u ? mine : 1u; nx = cnt > 0u ? cnt : 1u;
}

__device__ __forceinline__ void xcd_barrier(const XcdBarrier& b) {
    asm volatile("s_waitcnt vmcnt(0)" ::: "memory");
    __syncthreads();
    if (threadIdx.x == 0) {
        unsigned* bar = b.bar;
        __builtin_amdgcn_s_waitcnt(0);
        unsigned nloc = b.st[0], nx = b.st[1];
        if (nloc == 0u) { xcd_barrier_complete(bar, b.x, nloc, nx); b.st[0] = nloc; b.st[1] = nx; }
        const unsigned old = xb_add(&bar[XB_XSUB(b.x)], 1u);
        const unsigned gen = old / nloc;
        if (old + 1u == (gen + 1u) * nloc) {
            __builtin_amdgcn_fence(__ATOMIC_RELEASE, "agent");
            asm volatile("s_waitcnt vmcnt(0)" ::: "memory");
            const unsigned og = xb_add(&bar[XB_TOP], 1u);
            const unsigned tg = og / nx;
            if (og + 1u == (tg + 1u) * nx) xb_add(&bar[XB_TOPGEN], 1u);
            else XB_SPIN(xb_ld(&bar[XB_TOPGEN]) == tg, bar);
            __builtin_amdgcn_fence(__ATOMIC_ACQUIRE, "agent");
            xb_add(&bar[XB_XGEN(b.x)], 1u);
            asm volatile("s_waitcnt vmcnt(0)" ::: "memory");
        } else {
            XB_SPIN(xb_ld(&bar[XB_XGEN(b.x)]) == gen, bar);
            __builtin_amdgcn_fence(__ATOMIC_ACQUIRE, "agent");
            asm volatile("s_waitcnt vmcnt(0)" ::: "memory");
        }
    }
    __syncthreads();
}
struct Frame {
    LAS unsigned char* lds;
    volatile LAS unsigned* MISC;
    int tid, lane, wave;
    int vcu, G;
};
constexpr int PTR_OFF = LDSCTL_OFF + 1024;
__device__ __forceinline__ unsigned char* tabp(const Frame& F, int i) {
    const unsigned long long v = ((LAS unsigned long long*)(F.lds + PTR_OFF))[i];
    const unsigned lo = __builtin_amdgcn_readfirstlane((unsigned)v), hi = __builtin_amdgcn_readfirstlane((unsigned)(v >> 32));
    return (unsigned char*)(((unsigned long long)hi << 32) | lo);
}
__device__ __forceinline__ const float* inp(const Frame& F, int i) { return (const float*)tabp(F, i); }
__device__ __forceinline__ unsigned char* wsp(const Frame& F) { return tabp(F, 25); }
__device__ __forceinline__ float* outp(const Frame& F) { return (float*)tabp(F, 26); }
__device__ __forceinline__ gu32* ctlp(const Frame& F) { return (gu32*)(tabp(F, 25) + WS_CTL); }
enum { I_X = 0, I_C, I_WADA, I_BADA, I_WIN, I_SINKS, I_PEK, I_W1K, I_W2K, I_PEV, I_W1V, I_W2V, I_MIXG, I_WOUT, I_LN1G, I_LN1B, I_WRG, I_BRG, I_WRE, I_BRE, I_WGATE, I_WUP, I_WDOWN, I_LN2G, I_LN2B };

__device__ __forceinline__ void ada_phase(Frame& F) {
    LAS float* cs = (LAS float*)(F.lds + 73728);
    LAS float* red = (LAS float*)(F.lds + 73728 + 16384);
    const float* c = inp(F, I_C);
    for (int i = F.tid; i < NB * DM; i += NWAVES * 64) { const float v = c[i]; cs[i] = v / (1.0f + __expf(-v)); }
    __syncthreads();
    float* mod = (float*)(wsp(F) + WS_MOD);
    for (int u = F.vcu; u < DEPTH * 96; u += F.G) {
        const int l = u / 96, cb = u % 96, col = cb * 128 + 2 * F.lane;
        const float* W = inp(F, I_WADA) + (size_t)l * DM * (6 * DM) + col;
        float a00 = 0.f, a01 = 0.f, a10 = 0.f, a11 = 0.f;
        const int k0 = F.wave * 256;
#pragma unroll 8
        for (int kk = 0; kk < 256; ++kk) { const int k = k0 + kk; typedef float f32x2_ __attribute__((ext_vector_type(2))); const f32x2_ w = *(const GAS f32x2_*)(W + (size_t)k * (6 * DM));
            const float s0 = cs[k], s1 = cs[DM + k]; a00 += s0 * w.x; a01 += s0 * w.y; a10 += s1 * w.x; a11 += s1 * w.y; }
        red[(F.wave * 2 + 0) * 128 + 2 * F.lane] = a00; red[(F.wave * 2 + 0) * 128 + 2 * F.lane + 1] = a01;
        red[(F.wave * 2 + 1) * 128 + 2 * F.lane] = a10; red[(F.wave * 2 + 1) * 128 + 2 * F.lane + 1] = a11;
        __syncthreads();
        if (F.tid < 256) { const int b = F.tid >> 7, j = F.tid & 127; float s = 0.f;
#pragma unroll
            for (int w = 0; w < 8; ++w) s += red[(w * 2 + b) * 128 + j];
            mod[((size_t)l * NB + b) * (6 * DM) + cb * 128 + j] = s + inp(F, I_BADA)[(size_t)l * 6 * DM + cb * 128 + j]; }
        __syncthreads();
    }
}

__device__ __forceinline__ void tr_item(const float* W, int ldw, int K, bf16* WT, size_t drow0, int rs, int src0, int nvalid, int k0, LAS float* scr, int lane) {
    const int nn = lane & 31;
#pragma unroll 8
    for (int i = 0; i < 32; ++i) { const int kk = 2 * i + (lane >> 5);
        scr[kk * 33 + nn] = (nn < nvalid) ? *(const GAS float*)(W + (size_t)(k0 + kk) * ldw + src0 + nn) : 0.f; }
    LDS_WAIT(); asm volatile("" ::: "memory");
    const int c = lane & 7;
#pragma unroll
    for (int j = 0; j < 4; ++j) { const int n = (lane >> 3) + 8 * j; const LAS float* s = scr + (8 * c) * 33 + n;
        v4u o; o.x = pk2(s[0 * 33], s[1 * 33]); o.y = pk2(s[2 * 33], s[3 * 33]); o.z = pk2(s[4 * 33], s[5 * 33]); o.w = pk2(s[6 * 33], s[7 * 33]);
        *(GAS v4u*)(WT + (drow0 + (size_t)n * rs) * K + k0 + 8 * c) = o; }
    LDS_WAIT(); asm volatile("" ::: "memory");
}
__device__ __forceinline__ int win_src(int n0) {
    if (n0 < 512) return n0;
    if (n0 < 640) return 512 + (n0 - 512);
    if (n0 < 1152) return 768 + (n0 - 640);
    if (n0 < 1280) return 1280 + (n0 - 1152);
    if (n0 < 1408) return 1408 + (n0 - 1280);
    if (n0 < 1536) return 1536 + (n0 - 1408);
    if (n0 < 1664) return 1792 + (n0 - 1536);
    if (n0 < 2688) return 2072 + (n0 - 1664);
    if (n0 < 3712) return 3096 + (n0 - 2688);
    if (n0 < 4736) return 4120 + (n0 - 3712);
    if (n0 < 4864) return 640 + (n0 - 4736);
    if (n0 < 4992) return 1664 + (n0 - 4864);
    return 1920 + (n0 - 4992);
}
struct TrDesc { const float* src; bf16* dst; int ldw, K, rs; };
struct TrRegs { f32x4 v[16]; };
__device__ __forceinline__ void tr_load(TrRegs& r, const TrDesc& d) {
#pragma unroll
    for (int i = 0; i < 16; ++i) r.v[i] = *(const GAS f32x4*)(d.src + (size_t)(8 * (i >> 1) + (i & 1)) * d.ldw);
}
__device__ __forceinline__ void tr_store(const TrRegs& r, const TrDesc& d, LAS unsigned* scr, int lane) {
    const int kr = lane >> 4, nc = lane & 15;
#pragma unroll
    for (int i = 0; i < 8; ++i) { const f32x4 a = r.v[2 * i], b = r.v[2 * i + 1]; LAS unsigned* w = scr + (4 * nc) * 36 + 4 * i + kr;
        w[0] = pk2(a[0], b[0]); w[36] = pk2(a[1], b[1]); w[72] = pk2(a[2], b[2]); w[108] = pk2(a[3], b[3]); }
    LDS_WAIT(); asm volatile("" ::: "memory");
#pragma unroll
    for (int j = 0; j < 8; ++j) { const int ch = lane + 64 * j, n = ch >> 3, kc = ch & 7;
        const v4u o = *(const LAS v4u*)(scr + n * 36 + 4 * kc);
        *(GAS v4u*)(d.dst + (size_t)n * d.rs * d.K + 8 * kc) = o; }
    LDS_WAIT(); asm volatile("" ::: "memory");
}
__device__ __forceinline__ TrDesc tr_decode(Frame& F, int l, int it, int lane) {
    constexpr int I_A = 32 * (NIN / 64), I_B = 32 * 32, I_G = NEXP * 256, I_U = NEXP * 256, I_D = NEXP * 256, I_1 = 64, I_2 = 2;
    const float* W; bf16* WT; int ldw, K, rs = 1, src0, k0; size_t drow0;
    int r = it;
    if (r < I_A) { const int nblk = NIN / 64, kb = r / nblk, nb = r % nblk; W = inp(F, I_WIN) + (size_t)l * DM * D_IN; ldw = D_IN; K = DM; WT = (bf16*)(wsp(F) + WS_WIN); drow0 = (size_t)nb * 64; src0 = win_src(nb * 64); k0 = kb * 64; }
    else if ((r -= I_A) < I_B) { const int kb = r / 32, nb = r % 32; W = inp(F, I_WOUT) + (size_t)l * DM * DM; ldw = DM; K = DM; WT = (bf16*)(wsp(F) + WS_WOUT); drow0 = (size_t)nb * 64; src0 = nb * 64; k0 = kb * 64; }
    else if ((r -= I_B) < I_G) { const int e = r / 256, q = r % 256, kb = q / 8, nb = q % 8; W = inp(F, I_WGATE) + ((size_t)l * NEXP + e) * DM * DEXP; ldw = DEXP; K = DM; WT = (bf16*)(wsp(F) + WS_WGU); drow0 = (size_t)e * 1024 + nb * 128; rs = 2; src0 = nb * 64; k0 = kb * 64; }
    else if ((r -= I_G) < I_U) { const int e = r / 256, q = r % 256, kb = q / 8, nb = q % 8; W = inp(F, I_WUP) + ((size_t)l * NEXP + e) * DM * DEXP; ldw = DEXP; K = DM; WT = (bf16*)(wsp(F) + WS_WGU); drow0 = (size_t)e * 1024 + nb * 128 + 1; rs = 2; src0 = nb * 64; k0 = kb * 64; }
    else if ((r -= I_U) < I_D) { const int e = r / 256, q = r % 256, kb = q / 32, nb = q % 32; W = inp(F, I_WDOWN) + ((size_t)l * NEXP + e) * DEXP * DM; ldw = DM; K = DEXP; WT = (bf16*)(wsp(F) + WS_WD); drow0 = (size_t)e * DM + nb * 64; src0 = nb * 64; k0 = kb * 64; }
    else if ((r -= I_D) < 2 * I_1) { const int kv = r / I_1, q = r % I_1, kb = q / 2, nb = q % 2; W = inp(F, kv ? I_W1V : I_W1K) + (size_t)l * 2048 * 128; ldw = 128; K = 2048; WT = (bf16*)(wsp(F) + WS_WCMP) + (size_t)kv * 128 * 2048; drow0 = (size_t)nb * 64; src0 = nb * 64; k0 = kb * 64; }
    else { r -= 2 * I_1; const int kv = r / I_2, kb = r % I_2; W = inp(F, kv ? I_W2V : I_W2K) + (size_t)l * 128 * 64; ldw = 64; K = 128; WT = (bf16*)(wsp(F) + WS_WCMP + 2 * 128 * 2048 * 2) + (size_t)kv * 64 * 128; drow0 = 0; src0 = 0; k0 = kb * 64; }
    TrDesc d; d.src = W + (size_t)(k0 + 2 * (lane >> 4)) * ldw + src0 + 4 * (lane & 15); d.dst = WT + drow0 * K + k0; d.ldw = ldw; d.K = K; d.rs = rs;
    return d;
}
constexpr int CV_SMALL0 = 32 * (NIN / 64) + 32 * 32, CV_GU1 = CV_SMALL0 + 2 * NEXP * 256, CV_DN1 = CV_GU1 + NEXP * 256, CV_END = CV_DN1 + 2 * 64 + 2 * 2;
__device__ __forceinline__ void convert_range(Frame& F, int l, int lo, int hi, LAS unsigned* scr) {
    const int gw = F.vcu * NWAVES + F.wave, NGW = F.G * NWAVES;
    if (lo + gw < hi) {
        TrDesc dc = tr_decode(F, l, lo + gw, F.lane); TrRegs rc; tr_load(rc, dc);
        for (int it = lo + gw; it < hi; it += NGW) {
            const int itn = it + NGW < hi ? it + NGW : it;
            const TrDesc dn = tr_decode(F, l, itn, F.lane); TrRegs rn; tr_load(rn, dn);
            tr_store(rc, dc, scr, F.lane);
            rc = rn; dc = dn;
        }
    }
}
__device__ __forceinline__ void convert_small(Frame& F, int l) {
    LAS unsigned* scr = (LAS unsigned*)(F.lds + F.wave * 9216);
    const int gw = F.vcu * NWAVES + F.wave, NGW = F.G * NWAVES;
    convert_range(F, l, 0, CV_SMALL0, scr);
    convert_range(F, l, CV_DN1, CV_END, scr);
    { LAS float* scrf = (LAS float*)scr;
      for (int it = gw; it < 32; it += NGW) tr_item(inp(F, I_WIN) + (size_t)l * DM * D_IN, D_IN, DM, (bf16*)(wsp(F) + WS_WCMP + 1024 * 1024 + 64 * 1024), 0, 1, 2048, 24, it * 64, scrf, F.lane); }
    { bf16* Whi = (bf16*)(wsp(F) + WS_WCMP + 1536 * 1024); bf16* Wlo = Whi + 48 * 2048;
      const float* wrg = inp(F, I_WRG) + (size_t)l * DM * 4; const float* wre = inp(F, I_WRE) + (size_t)l * 4 * DM * 8;
      for (int i = gw * 64 + F.lane; i < 48 * 2048; i += NGW * 64) { const int row = i >> 11, k = i & 2047; float v = 0.f;
          if (row < 4) v = wrg[k * 4 + row]; else if (row < 36) { const int g = (row - 4) >> 3, e = (row - 4) & 7; v = wre[((size_t)g * DM + k) * 8 + e]; }
          const unsigned hi = f2bf(v); Whi[i] = (bf16)hi; Wlo[i] = (bf16)f2bf(v - bf2f((unsigned short)hi)); } }
}

struct Row { f32x4 v[8]; };
__device__ __forceinline__ void row_load(Row& r, const float* p, int lane) {
#pragma unroll
    for (int j = 0; j < 8; ++j) r.v[j] = *((const GAS f32x4*)p + lane + 64 * j);
}
__device__ __forceinline__ void row_load_bf16(Row& r, const bf16* p, int lane) {
#pragma unroll
    for (int j = 0; j < 8; ++j) { const v2u w = *((const GAS v2u*)p + lane + 64 * j); r.v[j] = (f32x4){bflo(w.x), bfhi(w.x), bflo(w.y), bfhi(w.y)}; }
}
__device__ __forceinline__ void row_store(const Row& r, float* p, int lane) {
#pragma unroll
    for (int j = 0; j < 8; ++j) *((GAS f32x4*)p + lane + 64 * j) = r.v[j];
}
__device__ __forceinline__ void row_store_bf16(const Row& r, bf16* p, int lane) {
#pragma unroll
    for (int j = 0; j < 8; ++j) { v2u w; w.x = pk2(r.v[j].x, r.v[j].y); w.y = pk2(r.v[j].z, r.v[j].w); *((GAS v2u*)p + lane + 64 * j) = w; }
}
__device__ __forceinline__ void row_normalize(Row& r) {
    float s = 0.f;
#pragma unroll
    for (int j = 0; j < 8; ++j) s += (r.v[j].x + r.v[j].y) + (r.v[j].z + r.v[j].w);
    const float mean = wave_sum(s) * (1.0f / DM); float s2 = 0.f;
#pragma unroll
    for (int j = 0; j < 8; ++j) { r.v[j] = r.v[j] - mean; s2 += (r.v[j].x * r.v[j].x + r.v[j].y * r.v[j].y) + (r.v[j].z * r.v[j].z + r.v[j].w * r.v[j].w); }
    const float rstd = 1.0f / sqrtf(wave_sum(s2) * (1.0f / DM) + LN_EPS);
#pragma unroll
    for (int j = 0; j < 8; ++j) r.v[j] = r.v[j] * rstd;
}
__device__ __forceinline__ void row_affine(Row& r, const float* a, float add1, const float* b, int lane) {
#pragma unroll
    for (int j = 0; j < 8; ++j) { const f32x4 av = *((const GAS f32x4*)a + lane + 64 * j) + add1, bv = *((const GAS f32x4*)b + lane + 64 * j); r.v[j] = r.v[j] * av + bv; }
}
__device__ __forceinline__ const float* modp(Frame& F, int l, int b, int which) { return (const float*)(wsp(F) + WS_MOD) + ((size_t)l * NB + b) * (6 * DM) + which * DM; }

__device__ __forceinline__ void ln_in_phase(Frame& F) {
    const int gw = F.vcu * NWAVES + F.wave, NGW = F.G * NWAVES;
    bf16* hb = (bf16*)(wsp(F) + WS_HB);
    for (int m = gw; m < MTOK; m += NGW) { const int b = m / SEQ; Row r; row_load(r, inp(F, I_X) + (size_t)m * DM, F.lane); row_normalize(r);
        row_affine(r, modp(F, 0, b, 1), 1.0f, modp(F, 0, b, 0), F.lane); row_store_bf16(r, hb + (size_t)m * DM, F.lane); }
}

__device__ __forceinline__ void merge_phase(Frame& F, int l) {
    const int gw = F.vcu * NWAVES + F.wave, NGW = F.G * NWAVES;
    const bf16* oc = (const bf16*)(wsp(F) + WS_OCAT); bf16* hb = (bf16*)(wsp(F) + WS_HB); const float* mg = inp(F, I_MIXG) + (size_t)l * DM;
    for (int m = gw; m < MTOK; m += NGW) { Row r; row_load_bf16(r, oc + (size_t)m * DM, F.lane);
        float sa = 0.f, sb = 0.f, sc = 0.f;
#pragma unroll
        for (int j = 0; j < 8; ++j) { const float q = (r.v[j].x * r.v[j].x + r.v[j].y * r.v[j].y) + (r.v[j].z * r.v[j].z + r.v[j].w * r.v[j].w); if (j < 2) sa += q; else if (j < 4) sb += q; else sc += q; }
        const float ra = 1.0f / sqrtf(wave_sum(sa) * (1.0f / 512.0f) + RMS_EPS), rb = 1.0f / sqrtf(wave_sum(sb) * (1.0f / 512.0f) + RMS_EPS), rc = 1.0f / sqrtf(wave_sum(sc) * (1.0f / 1024.0f) + RMS_EPS);
#pragma unroll
        for (int j = 0; j < 8; ++j) { const float s = j < 2 ? ra : (j < 4 ? rb : rc); const f32x4 g = *((const GAS f32x4*)mg + F.lane + 64 * j); r.v[j] = r.v[j] * s * g; }
        row_store_bf16(r, hb + (size_t)m * DM, F.lane); }
}

__device__ __forceinline__ void post_mixer_phase(Frame& F, int l) {
    const int gw = F.vcu * NWAVES + F.wave, NGW = F.G * NWAVES;
    bf16* xa = (bf16*)(wsp(F) + WS_XA); bf16* hb = (bf16*)(wsp(F) + WS_HB);
    const float* wrg = inp(F, I_WRG) + (size_t)l * DM * 4; const float* brg = inp(F, I_BRG) + l * 4;
    const float* wre = inp(F, I_WRE) + (size_t)l * 4 * DM * 8; const float* bre = inp(F, I_BRE) + l * 32;
    unsigned* cnt = (unsigned*)(ctlp(F) + CW_CNT + l * 32); int* list = (int*)(wsp(F) + WS_LIST); float* gatew = (float*)(wsp(F) + WS_SMALL + SM_GATEW);
    for (int m = gw; m < MTOK; m += NGW) { const int b = m / SEQ; Row r; row_load_bf16(r, xa + (size_t)m * DM, F.lane); row_normalize(r);
        row_affine(r, inp(F, I_LN1G) + (size_t)l * DM, 0.0f, inp(F, I_LN1B) + (size_t)l * DM, F.lane); row_store_bf16(r, xa + (size_t)m * DM, F.lane);
        row_normalize(r); row_affine(r, modp(F, l, b, 4), 1.0f, modp(F, l, b, 3), F.lane); row_store_bf16(r, hb + (size_t)m * DM, F.lane);
    }
}

__device__ __forceinline__ void router_phase(Frame& F, int l) {
    if (F.wave >= 4) return;
    const int lane = F.lane, c = lane & 15, kq = lane >> 4;
    const bf16* hb = (const bf16*)(wsp(F) + WS_HB);
    const bf16* Whi = (const bf16*)(wsp(F) + WS_WCMP + 1536 * 1024); const bf16* Wlo = Whi + 48 * 2048;
    const float* brg = inp(F, I_BRG) + l * 4; const float* bre = inp(F, I_BRE) + l * 32;
    unsigned* cnt = (unsigned*)(ctlp(F) + CW_CNT + l * 32); int* list = (int*)(wsp(F) + WS_LIST); float* gatew = (float*)(wsp(F) + WS_SMALL + SM_GATEW);
    LAS float* sl = (LAS float*)(F.lds + F.wave * 4096);
    for (int u = F.wave * F.G + F.vcu; u < MTOK / 16; u += 4 * F.G) {
        const bf16* hrow = hb + (size_t)(u * 16 + c) * DM + 8 * kq;
        const bf16* wh = Whi + (size_t)c * 2048 + 8 * kq; const bf16* wl = Wlo + (size_t)c * 2048 + 8 * kq;
        f32x4 acc[3];
#pragma unroll
        for (int t = 0; t < 3; ++t) acc[t] = (f32x4){0.f, 0.f, 0.f, 0.f};
#pragma unroll 4
        for (int ks = 0; ks < 64; ++ks) { const bf16x8 hf = ldg8(hrow + ks * 32);
#pragma unroll
            for (int t = 0; t < 3; ++t) { acc[t] = mfma16(ldg8(wh + (size_t)t * 16 * 2048 + ks * 32), hf, acc[t]); acc[t] = mfma16(ldg8(wl + (size_t)t * 16 * 2048 + ks * 32), hf, acc[t]); } }
#pragma unroll
        for (int t = 0; t < 3; ++t)
#pragma unroll
            for (int r = 0; r < 4; ++r) sl[c * 49 + 16 * t + 4 * kq + r] = acc[t][r];
        LDS_WAIT();
        if (lane < 16) {
            const LAS float* lr = sl + lane * 49; const int m = u * 16 + lane;
            const float g0 = lr[0] + brg[0], g1 = lr[1] + brg[1], g2 = lr[2] + brg[2], g3 = lr[3] + brg[3];
            int gs = 0; float gm = g0; if (g1 > gm) { gm = g1; gs = 1; } if (g2 > gm) { gm = g2; gs = 2; } if (g3 > gm) { gm = g3; gs = 3; }
            const float pgroup = 1.0f / (__expf(g0 - gm) + __expf(g1 - gm) + __expf(g2 - gm) + __expf(g3 - gm));
            int t1 = 0; float m1 = lr[4 + gs * 8] + bre[gs * 8];
#pragma unroll
            for (int i = 1; i < 8; ++i) { const float v = lr[4 + gs * 8 + i] + bre[gs * 8 + i]; if (v > m1) { m1 = v; t1 = i; } }
            int t2 = -1; float m2 = -3.0e38f;
#pragma unroll
            for (int i = 0; i < 8; ++i) { const float v = lr[4 + gs * 8 + i] + bre[gs * 8 + i]; if (i != t1 && v > m2) { m2 = v; t2 = i; } }
            const float e2 = __expf(m2 - m1), inv = pgroup / (1.0f + e2);
            const int x1 = gs * 8 + t1, x2 = gs * 8 + t2;
            const unsigned p1 = __hip_atomic_fetch_add(cnt + x1, 1u, RLX_AGENT); list[(size_t)x1 * MTOK + p1] = m * 2; gatew[m * 2] = inv;
            const unsigned p2 = __hip_atomic_fetch_add(cnt + x2, 1u, RLX_AGENT); list[(size_t)x2 * MTOK + p2] = m * 2 + 1; gatew[m * 2 + 1] = inv * e2;
        }
        LDS_WAIT();
    }
}

__device__ __forceinline__ void gather_phase(Frame& F, int l) {
    LAS int* tb = (LAS int*)(F.lds + 0);
    const unsigned* cnt = (const unsigned*)(ctlp(F) + CW_CNT + l * 32);
    if (F.tid < 32) tb[F.tid] = (int)__hip_atomic_load(cnt + F.tid, RLX_AGENT);
    __syncthreads();
    if (F.tid == 0) { int row = 0, tile = 0;
        for (int e = 0; e < NEXP; ++e) { tb[32 + e] = row; const int nt = (tb[e] + 255) >> 8; for (int t = 0; t < nt; ++t) tb[64 + tile + t] = e; tile += nt; row += nt * 256; }
        tb[224] = tile; }
    __syncthreads();
    const int ntiles = tb[224];
    int* gt = (int*)(wsp(F) + WS_SMALL + SM_TILE);
    if (blockIdx.x == 0) { if (F.tid < 160) gt[F.tid] = (F.tid < ntiles) ? tb[64 + F.tid] : 0; if (F.tid == 0) gt[200] = ntiles; }
    const int gw = F.vcu * NWAVES + F.wave, NGW = F.G * NWAVES;
    const int* list = (const int*)(wsp(F) + WS_LIST); int* rowinfo = (int*)(wsp(F) + WS_SMALL + SM_ROWINFO);
    const bf16* hb = (const bf16*)(wsp(F) + WS_HB); bf16* xs = (bf16*)(wsp(F) + WS_XS);
    for (int R = gw; R < ntiles * 256; R += NGW) { const int e = tb[64 + (R >> 8)], pos = R - tb[32 + e];
        int aid = -1; if (pos < tb[e]) aid = list[(size_t)e * MTOK + pos];
        GAS v4u* dst = (GAS v4u*)(xs + (size_t)R * DM) + F.lane;
        if (aid >= 0) { const GAS v4u* src = (const GAS v4u*)(hb + (size_t)(aid >> 1) * DM) + F.lane;
#pragma unroll
            for (int j = 0; j < 4; ++j) dst[64 * j] = src[64 * j]; }
        else {
#pragma unroll
            for (int j = 0; j < 4; ++j) dst[64 * j] = (v4u){0u, 0u, 0u, 0u}; }
        if (F.lane == 0) rowinfo[R] = aid; }
    __syncthreads();
}

__device__ __forceinline__ void moe_tables(Frame& F, int l) {
    LAS int* tb = (LAS int*)(F.lds + TAB_OFF);
    const unsigned* cnt = (const unsigned*)(ctlp(F) + CW_CNT + l * 32);
    __syncthreads();
    if (F.tid < 32) tb[F.tid] = (int)__hip_atomic_load(cnt + F.tid, RLX_AGENT);
    __syncthreads();
    if (F.tid == 0) { int row = 0, tile = 0;
        for (int e = 0; e < NEXP; ++e) { tb[32 + e] = row; const int nt = (tb[e] + 255) >> 8; for (int t = 0; t < nt; ++t) tb[64 + tile + t] = e; tile += nt; row += nt * 256; }
        tb[224] = tile; }
    __syncthreads();
}

__device__ __forceinline__ void post_moe_phase(Frame& F, int l, float* dst_f32, bf16* dst_bf16, bool next_h) {
    const int gw = F.vcu * NWAVES + F.wave, NGW = F.G * NWAVES;
    const bf16* xa = (const bf16*)(wsp(F) + WS_XA); const bf16* ys = (const bf16*)(wsp(F) + WS_YS); bf16* hb = (bf16*)(wsp(F) + WS_HB);
    for (int m = gw; m < MTOK; m += NGW) { const int b = m / SEQ; Row r; row_load_bf16(r, xa + (size_t)m * DM, F.lane);
        const float* g2 = modp(F, l, b, 5);
#pragma unroll
        for (int j = 0; j < 8; ++j) { const v2u y0 = *((const GAS v2u*)(ys + (size_t)(2 * m) * DM) + F.lane + 64 * j), y1 = *((const GAS v2u*)(ys + (size_t)(2 * m + 1) * DM) + F.lane + 64 * j);
            const f32x4 y = (f32x4){bflo(y0.x) + bflo(y1.x), bfhi(y0.x) + bfhi(y1.x), bflo(y0.y) + bflo(y1.y), bfhi(y0.y) + bfhi(y1.y)};
            const f32x4 gv = *((const GAS f32x4*)g2 + F.lane + 64 * j) + 1.0f; r.v[j] = r.v[j] * ALPHA + gv * y; }
        row_normalize(r); row_affine(r, inp(F, I_LN2G) + (size_t)l * DM, 0.0f, inp(F, I_LN2B) + (size_t)l * DM, F.lane); if (dst_f32) row_store(r, dst_f32 + (size_t)m * DM, F.lane); else row_store_bf16(r, dst_bf16 + (size_t)m * DM, F.lane);
        if (next_h) { row_normalize(r); row_affine(r, modp(F, l + 1, b, 1), 1.0f, modp(F, l + 1, b, 0), F.lane); row_store_bf16(r, hb + (size_t)m * DM, F.lane); } }
}
constexpr int IMP_STRIDE = 130;
constexpr int AW_IMP = 0, AW_SCV = 16 * IMP_STRIDE * 4, AW_SEL = AW_SCV + 512, AW_Q = 9216, AW_BYTES = AW_Q + 8192;
static_assert(AW_SEL + 256 <= AW_Q && NWAVES * AW_BYTES <= LDSCTL_OFF, "per-wave LDS slabs");

struct Flash { f32x4 O[4][4]; f32x4 m, l; };
struct KF { bf16x8 K[2][2]; };
struct VF { bf16x8 V[4]; };

__device__ __forceinline__ void load_k(KF& x, const bf16* Kb, size_t ldk, int kbase) {
    const bf16* kp = Kb + (size_t)kbase * ldk;
    x.K[0][0] = ldg8(kp); x.K[0][1] = ldg8(kp + 32); x.K[1][0] = ldg8(kp + 4 * ldk); x.K[1][1] = ldg8(kp + 4 * ldk + 32);
}
__device__ __forceinline__ void load_v(VF& x, const bf16* Vb, size_t ldv, int kbase) {
    const bf16* vp = Vb + kbase;
#pragma unroll
    for (int db = 0; db < 4; ++db) x.V[db] = ldg8(vp + (size_t)(16 * db) * ldv);
}
__device__ __forceinline__ void q_park(LAS bf16x8* Ql, const bf16* q0p, const bf16* q1p, const bf16* q2p, const bf16* q3p, int lane) {
    Ql[0 * 64 + lane] = ldg8(q0p); Ql[1 * 64 + lane] = ldg8(q0p + 32); Ql[2 * 64 + lane] = ldg8(q1p); Ql[3 * 64 + lane] = ldg8(q1p + 32);
    Ql[4 * 64 + lane] = ldg8(q2p); Ql[5 * 64 + lane] = ldg8(q2p + 32); Ql[6 * 64 + lane] = ldg8(q3p); Ql[7 * 64 + lane] = ldg8(q3p + 32);
}
__device__ __forceinline__ void qk_scores(f32x4 (&Sv)[2][4], const KF& x, const LAS bf16x8* Ql, int lane) {
#pragma unroll
    for (int qb = 0; qb < 4; ++qb) { const bf16x8 q0 = Ql[(2 * qb) * 64 + lane], q1 = Ql[(2 * qb + 1) * 64 + lane];
#pragma unroll
        for (int h = 0; h < 2; ++h) { f32x4 a = mfma16(x.K[h][0], q0, (f32x4){0.f, 0.f, 0.f, 0.f}); Sv[h][qb] = mfma16(x.K[h][1], q1, a); } }
}
__device__ __forceinline__ void flash_init(Flash& S, float m0, float m1, float m2, float m3) {
#pragma unroll
    for (int db = 0; db < 4; ++db)
#pragma unroll
        for (int qb = 0; qb < 4; ++qb) S.O[db][qb] = (f32x4){0.f, 0.f, 0.f, 0.f};
    S.m = (f32x4){m0, m1, m2, m3}; S.l = (f32x4){0.f, 0.f, 0.f, 0.f};
}
__device__ __forceinline__ void flash_step(Flash& S, f32x4 (&Sv)[2][4], const VF& x, const f32x4 b0, const f32x4 bj, unsigned vm) {
    float sv[4][8]; float mxv[4]; bool grow = false;
#pragma unroll
    for (int qb = 0; qb < 4; ++qb) {
#pragma unroll
        for (int h = 0; h < 2; ++h)
#pragma unroll
            for (int r = 0; r < 4; ++r) { const int j = 4 * h + r; const float s2 = Sv[h][qb][r] * SC2 + (b0[qb] + bj[qb] * (float)j); sv[qb][j] = ((vm >> j) & 1u) ? s2 : -INFINITY; }
        float mx = fmaxf(fmaxf(fmaxf(sv[qb][0], sv[qb][1]), fmaxf(sv[qb][2], sv[qb][3])), fmaxf(fmaxf(sv[qb][4], sv[qb][5]), fmaxf(sv[qb][6], sv[qb][7])));
        mx = fmaxf(mx, __shfl_xor(mx, 16)); mx = fmaxf(mx, __shfl_xor(mx, 32));
        mxv[qb] = mx; grow = grow | (mx > S.m[qb] + 8.0f);
    }
    if (__any(grow)) {
#pragma unroll
        for (int qb = 0; qb < 4; ++qb) { const float mn = fmaxf(S.m[qb], mxv[qb]), al = ex2(S.m[qb] - mn); S.m[qb] = mn; S.l[qb] = S.l[qb] * al;
#pragma unroll
            for (int db = 0; db < 4; ++db) S.O[db][qb] = S.O[db][qb] * al; }
    }
    bf16x8 Pf[4];
#pragma unroll
    for (int qb = 0; qb < 4; ++qb) {
        float p[8];
#pragma unroll
        for (int j = 0; j < 8; ++j) p[j] = ex2(sv[qb][j] - S.m[qb]);
        S.l[qb] = S.l[qb] + (((p[0] + p[1]) + (p[2] + p[3])) + ((p[4] + p[5]) + (p[6] + p[7])));
        Pf[qb] = pack8(p[0], p[1], p[2], p[3], p[4], p[5], p[6], p[7]);
    }
#pragma unroll
    for (int db = 0; db < 4; ++db)
#pragma unroll
        for (int qb = 0; qb < 4; ++qb) S.O[db][qb] = mfma16(x.V[db], Pf[qb], S.O[db][qb]);
}
__device__ __forceinline__ float flash_inv(const Flash& S, int qb, bool has_sink, float sink2) {
    float lt = S.l[qb]; lt += __shfl_xor(lt, 16); lt += __shfl_xor(lt, 32);
    if (has_sink) lt += ex2(sink2 - S.m[qb]);
    return lt > 0.f ? 1.0f / lt : 0.f;
}
__device__ __forceinline__ float sigmoidf_(float x) { return 1.0f / (1.0f + __expf(-x)); }
__device__ __forceinline__ float slope2_of(int hidx) { return LOG2E * exp2f(-0.5f * (float)(hidx + 1)); }
#define ITER_FENCE() asm volatile("" ::: "memory")

template <int W, int MODE>
__device__ __forceinline__ void win_unit(Frame& F, int l, int b, int g, int q0) {
    const int lane = F.lane, c = lane & 15, kq = lane >> 4;
    const bf16* proj = (const bf16*)(wsp(F) + WS_PROJ); const bf16* vT = (const bf16*)(wsp(F) + WS_VT); bf16* ocat = (bf16*)(wsp(F) + WS_OCAT);
    constexpr int QOFF = MODE == 0 ? P_QA : P_QB, KOFF = MODE == 0 ? P_KA : P_KBW, VROW = MODE == 0 ? V_A : V_BW, OCOL = MODE == 0 ? 0 : 512, HBASE = MODE == 0 ? 0 : 8;
    LAS bf16x8* Ql = (LAS bf16x8*)(F.lds + F.wave * AW_BYTES + AW_Q);
    const size_t tb = (size_t)b * SEQ; const int t = q0 + c;
    { const bf16* qp = proj + (tb + t) * NPROJ + QOFF + g * 256 + kq * 8; q_park(Ql, qp, qp + 64, qp + 128, qp + 192, lane); }
    f32x4 sl2, sk2;
#pragma unroll
    for (int qb = 0; qb < 4; ++qb) { sl2[qb] = slope2_of(HBASE + g * 4 + qb); sk2[qb] = MODE == 0 ? inp(F, I_SINKS)[l * 8 + g * 4 + qb] * LOG2E : -1.0e30f; }
    Flash S; flash_init(S, sk2[0], sk2[1], sk2[2], sk2[3]);
    int klo = q0 - (W - 1); if (klo < 0) klo = 0; klo &= ~31;
    const int khi = (q0 + 15) & ~31;
    const bf16* Kb = proj + (tb + 8 * (c >> 2) + (c & 3)) * NPROJ + KOFF + g * 64 + kq * 8;
    const bf16* Vb = vT + (size_t)(VROW + g * 64 + c) * MTOK + tb + 8 * kq;
    KF cur, nxt; load_k(cur, Kb, NPROJ, khi);
    for (int kbase = khi; kbase >= klo; kbase -= 32) {
        ITER_FENCE();
        VF vf; load_v(vf, Vb, MTOK, kbase);
        load_k(nxt, Kb, NPROJ, kbase - 32 >= klo ? kbase - 32 : kbase);
        f32x4 Sv[2][4]; qk_scores(Sv, cur, Ql, lane);
        const int d0 = t - kbase - 8 * kq;
        const f32x4 b0 = sl2 * -(float)d0;
        unsigned vm = 0xffu;
        if (!(kbase + 31 <= q0 && kbase >= q0 + 16 - W)) { vm = 0u;
#pragma unroll
            for (int j = 0; j < 8; ++j) { const int dist = d0 - j; vm |= (dist >= 0 && dist < W) ? (1u << j) : 0u; } }
        flash_step(S, Sv, vf, b0, sl2, vm);
        cur = nxt;
    }
#pragma unroll
    for (int qb = 0; qb < 4; ++qb) { const float sc = flash_inv(S, qb, MODE == 0, sk2[qb]);
        bf16* op = ocat + (tb + t) * DM + OCOL + (g * 4 + qb) * 64 + 4 * kq;
#pragma unroll
        for (int db = 0; db < 4; ++db) { const f32x4 o = S.O[db][qb] * sc; v2u w; w.x = pk2(o[0], o[1]); w.y = pk2(o[2], o[3]); *(GAS v2u*)(op + 16 * db) = w; } }
}

constexpr float SB_EXIT_P = 1.0e-37f;
__device__ __forceinline__ void sb_unit(Frame& F, int b, int hc, int q0) {
    const int lane = F.lane, c = lane & 15, kq = lane >> 4;
    const bf16* proj = (const bf16*)(wsp(F) + WS_PROJ); const bf16* vT = (const bf16*)(wsp(F) + WS_VT); bf16* ocat = (bf16*)(wsp(F) + WS_OCAT);
    LAS bf16x8* Ql = (LAS bf16x8*)(F.lds + F.wave * AW_BYTES + AW_Q);
    const size_t tb = (size_t)b * SEQ;
    { const bf16* qp = proj + (tb + q0 + c) * NPROJ + P_QC + hc * 64 + kq * 8; q_park(Ql, qp, qp + (size_t)16 * NPROJ, qp + (size_t)32 * NPROJ, qp + (size_t)48 * NPROJ, lane); }
    f32x4 O[4][4]; float carry[4];
#pragma unroll
    for (int qb = 0; qb < 4; ++qb) { carry[qb] = 1.0f;
#pragma unroll
        for (int db = 0; db < 4; ++db) O[db][qb] = (f32x4){0.f, 0.f, 0.f, 0.f}; }
    const bf16* Kb = proj + (tb + 8 * (c >> 2) + (c & 3)) * NPROJ + P_KC + hc * 64 + kq * 8;
    const bf16* Vb = vT + (size_t)(V_C + hc * 64 + c) * MTOK + tb + 8 * kq;
    KF cur, nxt; load_k(cur, Kb, NPROJ, q0 + 32);
    for (int kbase = q0 + 32; kbase >= 0; kbase -= 32) {
        ITER_FENCE();
        VF vf; load_v(vf, Vb, MTOK, kbase);
        load_k(nxt, Kb, NPROJ, kbase >= 32 ? kbase - 32 : kbase);
        f32x4 Sv[2][4]; qk_scores(Sv, cur, Ql, lane);
        const bool diag = kbase + 31 >= q0;
        bf16x8 Pf[4];
#pragma unroll
        for (int qb = 0; qb < 4; ++qb) { const int lim = q0 + 16 * qb + c - kbase - 8 * kq;
            float om[8], sg[8];
#pragma unroll
            for (int h = 0; h < 2; ++h)
#pragma unroll
                for (int r = 0; r < 4; ++r) { const int j = 4 * h + r; const float e = ex2(fminf(Sv[h][qb][r] * SC2, 115.0f)), rr = __builtin_amdgcn_rcpf(1.0f + e);
                    om[j] = rr; sg[j] = e * rr;
                    if (diag) { const bool msk = j >= lim; om[j] = msk ? 1.0f : om[j]; sg[j] = msk ? 0.f : sg[j]; } }
            float ex_[8]; float run = 1.0f;
#pragma unroll
            for (int j = 7; j >= 0; --j) { ex_[j] = run; run *= om[j]; }
            const float t1 = __shfl_xor(run, 16), t2 = __shfl_xor(run, 32), t3 = __shfl_xor(run, 48);
            const float X = ((kq ^ 1) > kq ? t1 : 1.0f) * ((kq ^ 2) > kq ? t2 : 1.0f) * ((kq ^ 3) > kq ? t3 : 1.0f);
            const float base = carry[qb] * X;
            carry[qb] *= (run * t1) * (t2 * t3);
            Pf[qb] = pack8(sg[0] * (base * ex_[0]), sg[1] * (base * ex_[1]), sg[2] * (base * ex_[2]), sg[3] * (base * ex_[3]), sg[4] * (base * ex_[4]), sg[5] * (base * ex_[5]), sg[6] * (base * ex_[6]), sg[7] * (base * ex_[7])); }
#pragma unroll
        for (int db = 0; db < 4; ++db)
#pragma unroll
            for (int qb = 0; qb < 4; ++qb) O[db][qb] = mfma16(vf.V[db], Pf[qb], O[db][qb]);
        const bool fin = (carry[0] < SB_EXIT_P) && (carry[1] < SB_EXIT_P) && (carry[2] < SB_EXIT_P) && (carry[3] < SB_EXIT_P);
        if (__all(fin)) break;
        cur = nxt;
    }
#pragma unroll
    for (int qb = 0; qb < 4; ++qb) { bf16* op = ocat + (tb + q0 + 16 * qb + c) * DM + 1024 + hc * 64 + 4 * kq;
#pragma unroll
        for (int db = 0; db < 4; ++db) { const f32x4 o = O[db][qb]; v2u w; w.x = pk2(o[0], o[1]); w.y = pk2(o[2], o[3]); *(GAS v2u*)(op + 16 * db) = w; } }
}

__device__ __forceinline__ void gate_unit(Frame& F, int u) {
    const int lane = F.lane, c = lane & 15, kq = lane >> 4;
    const bf16* hrow = (const bf16*)(wsp(F) + WS_HB) + (size_t)(u * 16 + c) * DM + 8 * kq;
    const bf16* wg = (const bf16*)(wsp(F) + WS_WCMP + 1024 * 1024 + 64 * 1024) + (size_t)c * 2048 + 8 * kq;
    f32x4 a0 = (f32x4){0.f, 0.f, 0.f, 0.f}, a1 = (f32x4){0.f, 0.f, 0.f, 0.f};
#pragma unroll 8
    for (int ks = 0; ks < 64; ++ks) { const bf16x8 hf = ldg8(hrow + ks * 32); a0 = mfma16(ldg8(wg + ks * 32), hf, a0); a1 = mfma16(ldg8(wg + (size_t)16 * 2048 + ks * 32), hf, a1); }
    float* gp = (float*)(wsp(F) + WS_GBUF) + (size_t)(u * 16 + c) * 32 + 4 * kq;
    *(GAS f32x4*)gp = a0; *(GAS f32x4*)(gp + 16) = a1;
}

__device__ __forceinline__ float gelu_tanh(float x) { const float u = 0.7978845608028654f * (x + 0.044715f * x * x * x); const float e = __expf(2.0f * u); return 0.5f * x * (2.0f - 2.0f / (e + 1.0f)); }
__device__ __forceinline__ void cmp_mlp_unit(Frame& F, int l, int unit) {
    const int lane = F.lane, c = lane & 15, kq = lane >> 4;
    const int nt = unit & 31, g = (unit >> 5) & 1, b = (unit >> 6) & 1, kv = unit >> 7;
    const bf16* proj = (const bf16*)(wsp(F) + WS_PROJ);
    const bf16* W1t = (const bf16*)(wsp(F) + WS_WCMP) + (size_t)kv * 128 * 2048; const bf16* W2t = (const bf16*)(wsp(F) + WS_WCMP + 2 * 128 * 2048 * 2) + (size_t)kv * 64 * 128;
    const float* pe = inp(F, kv ? I_PEV : I_PEK) + (size_t)l * 32 * 64;
    const int n = nt * 16 + c; const size_t tb = (size_t)b * SEQ; const int xoff = (kv ? P_VBC : P_KBC) + g * 64;
    LAS f32x4* red = (LAS f32x4*)(F.lds);
    f32x4 H[4][2];
#pragma unroll
    for (int s = 0; s < 4; ++s) { H[s][0] = (f32x4){0.f, 0.f, 0.f, 0.f}; H[s][1] = (f32x4){0.f, 0.f, 0.f, 0.f}; }
#pragma unroll 2
    for (int kk = 0; kk < 8; ++kk) {
        const int ks = F.wave * 8 + kk, lt = ks >> 1, d0 = (ks & 1) * 32 + 8 * kq; int tok = 16 * n + lt; if (tok > SEQ - 1) tok = SEQ - 1;
        const bf16x8 xr = ldg8(proj + (tb + tok) * NPROJ + xoff + d0);
        const f32x4 p0 = *(const GAS f32x4*)(pe + lt * 64 + d0), p1 = *(const GAS f32x4*)(pe + lt * 64 + d0 + 4);
        const bf16x8 Xf = pack8(bf2f((unsigned short)xr[0]) + p0[0], bf2f((unsigned short)xr[1]) + p0[1], bf2f((unsigned short)xr[2]) + p0[2], bf2f((unsigned short)xr[3]) + p0[3],
                                bf2f((unsigned short)xr[4]) + p1[0], bf2f((unsigned short)xr[5]) + p1[1], bf2f((unsigned short)xr[6]) + p1[2], bf2f((unsigned short)xr[7]) + p1[3]);
#pragma unroll
        for (int s = 0; s < 4; ++s)
#pragma unroll
            for (int h = 0; h < 2; ++h) { const int hid = 32 * s + 8 * (c >> 2) + 4 * h + (c & 3);
                H[s][h] = mfma16(ldg8(W1t + (size_t)hid * 2048 + ks * 32 + 8 * kq), Xf, H[s][h]); }
    }
#pragma unroll
    for (int s = 0; s < 4; ++s)
#pragma unroll
        for (int h = 0; h < 2; ++h) red[(F.wave * 8 + s * 2 + h) * 64 + lane] = H[s][h];
    __syncthreads();
    if (F.wave == 0) {
#pragma unroll
        for (int s = 0; s < 4; ++s)
#pragma unroll
            for (int h = 0; h < 2; ++h) { f32x4 a = red[(s * 2 + h) * 64 + lane];
#pragma unroll
                for (int w = 1; w < 8; ++w) a += red[(w * 8 + s * 2 + h) * 64 + lane];
                H[s][h] = a; }
        f32x4 Y[4];
#pragma unroll
        for (int eb = 0; eb < 4; ++eb) Y[eb] = (f32x4){0.f, 0.f, 0.f, 0.f};
#pragma unroll
        for (int s = 0; s < 4; ++s) {
            const bf16x8 Hf = pack8(gelu_tanh(H[s][0][0]), gelu_tanh(H[s][0][1]), gelu_tanh(H[s][0][2]), gelu_tanh(H[s][0][3]), gelu_tanh(H[s][1][0]), gelu_tanh(H[s][1][1]), gelu_tanh(H[s][1][2]), gelu_tanh(H[s][1][3]));
#pragma unroll
            for (int eb = 0; eb < 4; ++eb) Y[eb] = mfma16(ldg8(W2t + (size_t)(16 * eb + c) * 128 + 32 * s + 8 * kq), Hf, Y[eb]);
        }
        const bool valid = n <= 510;
        if (kv == 0) { bf16* kc = (bf16*)(wsp(F) + WS_SMALL + SM_KCMP) + ((size_t)(b * 2 + g) * 512 + n) * 64 + 4 * kq;
#pragma unroll
            for (int eb = 0; eb < 4; ++eb) { v2u w; w.x = valid ? pk2(Y[eb][0], Y[eb][1]) : 0u; w.y = valid ? pk2(Y[eb][2], Y[eb][3]) : 0u; *(GAS v2u*)(kc + 16 * eb) = w; } }
        else { bf16* vc = (bf16*)(wsp(F) + WS_SMALL + SM_VCMPT) + (size_t)(b * 2 + g) * 64 * 512 + n;
#pragma unroll
            for (int eb = 0; eb < 4; ++eb)
#pragma unroll
                for (int r = 0; r < 4; ++r) vc[(size_t)(16 * eb + 4 * kq + r) * 512] = valid ? (bf16)f2bf(Y[eb][r]) : (bf16)0; }
    }
    __syncthreads();
}

__device__ __forceinline__ int next_below(unsigned long long ulo, unsigned long long uhi, int j) {
    if (j > 64) { const unsigned long long m = (j >= 128) ? uhi : (uhi & ((1ull << (j - 64)) - 1ull)); if (m) return 127 - __builtin_clzll(m); j = 64; }
    const unsigned long long m = (j >= 64) ? ulo : (ulo & ((1ull << j) - 1ull));
    return m ? 63 - __builtin_clzll(m) : -1;
}
__device__ __forceinline__ void nsa_unit(Frame& F, int b, int g, int q0) {
    const int lane = F.lane, c = lane & 15, kq = lane >> 4;
    const bf16* proj = (const bf16*)(wsp(F) + WS_PROJ); const bf16* vT = (const bf16*)(wsp(F) + WS_VT); bf16* ocat = (bf16*)(wsp(F) + WS_OCAT);
    const bf16* kcmp = (const bf16*)(wsp(F) + WS_SMALL + SM_KCMP) + (size_t)(b * 2 + g) * 512 * 64;
    const bf16* vcmpT = (const bf16*)(wsp(F) + WS_SMALL + SM_VCMPT) + (size_t)(b * 2 + g) * 64 * 512;
    LAS float* imp = (LAS float*)(F.lds + F.wave * AW_BYTES + AW_IMP);
    LAS unsigned* selm = (LAS unsigned*)(F.lds + F.wave * AW_BYTES + AW_SEL);
    LAS bf16x8* Ql = (LAS bf16x8*)(F.lds + F.wave * AW_BYTES + AW_Q);
    const size_t tb = (size_t)b * SEQ; const int t = q0 + c;
    const float* grow = (const float*)(wsp(F) + WS_GBUF) + (tb + t) * 32 + g * 12;
    { const bf16* qp = proj + (tb + t) * NPROJ + P_QB + g * 256 + kq * 8; q_park(Ql, qp, qp + 64, qp + 128, qp + 192, lane); }
    f32x4 sl2;
#pragma unroll
    for (int qb = 0; qb < 4; ++qb) sl2[qb] = slope2_of(8 + g * 4 + qb);
    const f32x4 sl2c = sl2 * 16.0f;
    for (int i = lane; i < 16 * IMP_STRIDE; i += 64) imp[i] = 0.f;
    const int tmax = q0 + 15; const int nmax = tmax >= 31 ? ((tmax - 31) >> 4) : -1; const int ntop = nmax & ~31;
    const bf16* Kc = kcmp + (size_t)(8 * (c >> 2) + (c & 3)) * 64 + kq * 8;
    const bf16* Vc = vcmpT + (size_t)c * 512 + 8 * kq;
    Flash S; flash_init(S, -1.0e30f, -1.0e30f, -1.0e30f, -1.0e30f);
    KF cur, nxt;
    if (nmax >= 0) {
        load_k(cur, Kc, 64, ntop);
        for (int nbase = ntop; nbase >= 0; nbase -= 32) {
            ITER_FENCE();
            VF vf; load_v(vf, Vc, 512, nbase);
            load_k(nxt, Kc, 64, nbase >= 32 ? nbase - 32 : nbase);
            f32x4 Sv[2][4]; qk_scores(Sv, cur, Ql, lane);
            const int d0 = t - 31 - 16 * (nbase + 8 * kq);
            const f32x4 b0 = sl2 * -(float)d0;
            unsigned vm = 0xffu;
            if (!(16 * (nbase + 31) + 31 <= q0)) { vm = 0u;
#pragma unroll
                for (int j = 0; j < 8; ++j) vm |= (d0 - 16 * j >= 0) ? (1u << j) : 0u; }
            flash_step(S, Sv, vf, b0, sl2c, vm);
            cur = nxt;
        }
    }
    f32x4 inv;
#pragma unroll
    for (int qb = 0; qb < 4; ++qb) { inv[qb] = flash_inv(S, qb, false, 0.f);
        const float g0 = sigmoidf_(grow[qb * 3 + 0]), g2 = sigmoidf_(grow[qb * 3 + 2]), sc = inv[qb] * g0;
        bf16* op = ocat + (tb + t) * DM + 512 + (g * 4 + qb) * 64 + 4 * kq;
#pragma unroll
        for (int db = 0; db < 4; ++db) { const v2u ow = *(const GAS v2u*)(op + 16 * db); const f32x4 old = (f32x4){bflo(ow.x), bfhi(ow.x), bflo(ow.y), bfhi(ow.y)};
            const f32x4 o = old * g2 + S.O[db][qb] * sc; v2u w; w.x = pk2(o[0], o[1]); w.y = pk2(o[2], o[3]); *(GAS v2u*)(op + 16 * db) = w; } }
    LDS_WAIT();
    for (int nbase = 0; nbase <= nmax; nbase += 32) {
        ITER_FENCE();
        const bf16* kp = Kc + (size_t)nbase * 64;
        KF x; x.K[0][0] = ldg8(kp); x.K[0][1] = ldg8(kp + 32); x.K[1][0] = ldg8(kp + 4 * 64); x.K[1][1] = ldg8(kp + 4 * 64 + 32);
        f32x4 Sv[2][4]; qk_scores(Sv, x, Ql, lane);
        float G[2], Wl[2];
#pragma unroll
        for (int h = 0; h < 2; ++h) { float gs = 0.f, last = 0.f;
#pragma unroll
            for (int r = 0; r < 4; ++r) { const int dist = t - 16 * (nbase + 8 * kq + 4 * h + r) - 31; const bool vis = dist >= 0; const float fd = (float)dist; float pv = 0.f;
#pragma unroll
                for (int qb = 0; qb < 4; ++qb) pv += vis ? ex2(Sv[h][qb][r] * SC2 - sl2[qb] * fd - S.m[qb]) * inv[qb] : 0.f;
                gs += pv; last = pv; }
            G[h] = gs; Wl[h] = last; }
        const int j0 = (nbase >> 2) + 2 * kq;
        LAS float* ip = imp + c * IMP_STRIDE + j0;
        ip[0] += G[0]; LDS_WAIT();
        ip[1] += G[1]; LDS_WAIT();
        ip[1] += Wl[0]; LDS_WAIT();
        ip[2] += Wl[1]; LDS_WAIT();
    }
    unsigned long long ulo = 0ull, uhi = 0ull, ilo = ~0ull, ihi = ~0ull;
    for (int cq = 0; cq < 16; ++cq) {
        const int tq = q0 + cq, cur_ = tq >> 6;
        const int ja = lane, jb = lane + 64;
        const bool oka = ja <= cur_, okb = jb <= cur_;
        unsigned ka = 0u, kb = 0u;
        if (oka) ka = (ja == 0 || ja == cur_ || ja == cur_ - 1) ? 0x461c4000u : __builtin_bit_cast(unsigned, imp[cq * IMP_STRIDE + ja]) + 1u;
        if (okb) kb = (jb == cur_ || jb == cur_ - 1) ? 0x461c4000u : __builtin_bit_cast(unsigned, imp[cq * IMP_STRIDE + jb]) + 1u;
        unsigned long long mlo, mhi;
        if (cur_ < 16) { mlo = __ballot(oka); mhi = 0ull; }
        else {
            unsigned thr = 0u;
#pragma unroll 1
            for (int bit = 30; bit >= 0; --bit) { const unsigned tr = thr | (1u << bit);
                const int cntv = __popcll(__ballot(ka >= tr)) + __popcll(__ballot(kb >= tr)); if (cntv >= 16) thr = tr; }
            mlo = __ballot(ka > thr); mhi = __ballot(kb > thr);
            int need = 16 - (__popcll(mlo) + __popcll(mhi));
            unsigned long long elo = __ballot(ka == thr), ehi = __ballot(kb == thr);
            while (need > 0 && elo) { const unsigned long long bsel = elo & (~elo + 1ull); mlo |= bsel; elo ^= bsel; --need; }
            while (need > 0 && ehi) { const unsigned long long bsel = ehi & (~ehi + 1ull); mhi |= bsel; ehi ^= bsel; --need; }
        }
        ulo |= mlo; uhi |= mhi; ilo &= mlo; ihi &= mhi;
        if (lane == 0) { selm[cq * 4 + 0] = (unsigned)mlo; selm[cq * 4 + 1] = (unsigned)(mlo >> 32); selm[cq * 4 + 2] = (unsigned)mhi; selm[cq * 4 + 3] = (unsigned)(mhi >> 32); }
    }
    LDS_WAIT();
    const unsigned long long mylo = (unsigned long long)selm[c * 4 + 0] | ((unsigned long long)selm[c * 4 + 1] << 32);
    const unsigned long long myhi = (unsigned long long)selm[c * 4 + 2] | ((unsigned long long)selm[c * 4 + 3] << 32);
    flash_init(S, -1.0e30f, -1.0e30f, -1.0e30f, -1.0e30f);
    const bf16* Kb = proj + (tb + 8 * (c >> 2) + (c & 3)) * NPROJ + P_KBS + g * 64 + kq * 8;
    const bf16* Vb = vT + (size_t)(V_BS + g * 64 + c) * MTOK + tb + 8 * kq;
    int j = next_below(ulo, uhi, (tmax >> 6) + 1), hs = 1;
    load_k(cur, Kb, NPROJ, 64 * j + 32);
    while (j >= 0) {
        ITER_FENCE();
        const int kbase = 64 * j + 32 * hs;
        VF vf; load_v(vf, Vb, MTOK, kbase);
        int jn = j, hn = 0; if (hs == 0) { jn = next_below(ulo, uhi, j); hn = 1; }
        load_k(nxt, Kb, NPROJ, jn >= 0 ? 64 * jn + 32 * hn : kbase);
        const bool mine = j < 64 ? ((mylo >> j) & 1ull) != 0ull : ((myhi >> (j - 64)) & 1ull) != 0ull;
        const bool all16 = j < 64 ? ((ilo >> j) & 1ull) != 0ull : ((ihi >> (j - 64)) & 1ull) != 0ull;
        f32x4 Sv[2][4]; qk_scores(Sv, cur, Ql, lane);
        const int d0 = t - kbase - 8 * kq;
        const f32x4 b0 = sl2 * -(float)d0;
        unsigned vm = 0xffu;
        if (!(all16 && kbase + 31 <= q0)) { vm = 0u;
#pragma unroll
            for (int jj = 0; jj < 8; ++jj) vm |= (mine && d0 - jj >= 0) ? (1u << jj) : 0u; }
        flash_step(S, Sv, vf, b0, sl2, vm);
        cur = nxt; j = jn; hs = hn;
    }
#pragma unroll
    for (int qb = 0; qb < 4; ++qb) { const float sc = flash_inv(S, qb, false, 0.f) * sigmoidf_(grow[qb * 3 + 1]);
        bf16* op = ocat + (tb + t) * DM + 512 + (g * 4 + qb) * 64 + 4 * kq;
#pragma unroll
        for (int db = 0; db < 4; ++db) { const v2u ow = *(const GAS v2u*)(op + 16 * db); const f32x4 old = (f32x4){bflo(ow.x), bfhi(ow.x), bflo(ow.y), bfhi(ow.y)};
            const f32x4 o = old + S.O[db][qb] * sc; v2u w; w.x = pk2(o[0], o[1]); w.y = pk2(o[2], o[3]); *(GAS v2u*)(op + 16 * db) = w; } }
    LDS_WAIT();
}

__device__ __forceinline__ void attn1_phase(Frame& F, int l) {
    const int gw = F.vcu * NWAVES + F.wave, NGW = F.G * NWAVES;
    LAS unsigned* scr = (LAS unsigned*)(F.lds + F.wave * AW_BYTES);
    for (int u = F.vcu; u < 256; u += F.G) cmp_mlp_unit(F, l, u);
    if (F.wave >= 4) convert_range(F, l, CV_SMALL0, CV_GU1, scr);
    else for (int u = F.wave * F.G + F.vcu; u < MTOK / 16; u += 4 * F.G) gate_unit(F, u);
    for (int u = gw; u < 2048; u += NGW) win_unit<512, 1>(F, l, u >> 10, (u >> 9) & 1, (u & 511) * 16);
    for (int u = gw; u < 4096; u += NGW) sb_unit(F, u >> 11, (u >> 7) & 15, (u & 127) * 64);
    for (int u = gw; u < 2048; u += NGW) win_unit<128, 0>(F, l, u >> 10, (u >> 9) & 1, (u & 511) * 16);
    if (F.wave < 4) convert_range(F, l, CV_SMALL0, CV_GU1, scr);
}
__device__ __forceinline__ void attn2_phase(Frame& F, int l) {
    const int gw = F.vcu * NWAVES + F.wave, NGW = F.G * NWAVES;
    LAS unsigned* scr = (LAS unsigned*)(F.lds + F.wave * AW_BYTES);
    if (F.wave >= 4) convert_range(F, l, CV_GU1, CV_DN1, scr);
    for (int u = gw; u < 2048; u += NGW) nsa_unit(F, u >> 10, (u >> 9) & 1, (u & 511) * 16);
    if (F.wave < 4) convert_range(F, l, CV_GU1, CV_DN1, scr);
}
#ifndef MK_ONE_LAUNCH
#define MK_ONE_LAUNCH 1
#endif
#ifndef PHASE_MASK
#define PHASE_MASK 0xFFFF
#endif
constexpr int N_PHASES = 2 + 10 * DEPTH;
struct Args { const float* in[25]; float* out; unsigned char* ws; };
#define IN(k) (LO <= (k) && (k) < HI)
#define SEAM(k) do { if constexpr (IN(k) && IN((k) + 1)) xcd_barrier(bar); asm volatile("" : "+v"(F.tid), "+v"(F.lane) :: "memory"); } while (0)
#ifndef DBL_MASK
#define DBL_MASK 0
#endif
#define FENCE() asm volatile("" : "+v"(F.tid), "+v"(F.lane) :: "memory")
#define PHASE(k, bit, ...) do { if constexpr (IN(k) && (PHASE_MASK & (bit))) { __VA_ARGS__ if constexpr ((DBL_MASK & (bit)) != 0) { xcd_barrier(bar); FENCE(); __VA_ARGS__ } } } while (0)
template <int L, int LO, int HI>
__device__ __forceinline__ void layer_phases(Frame& F, const XcdBarrier& bar) {
    constexpr int l = L, pb = 2 + 10 * L;
    PHASE(pb + 0, 4, {
        pg8::Gemm g{(const pg8::bf16_t*)(wsp(F) + WS_HB), (const pg8::bf16_t*)(wsp(F) + WS_WIN), MTOK, NIN, DM}; pg8::StaticOrder S; S.init(MTOK, NIN, F.G, (int)blockIdx.x);
        pg8::EpiProj E{(pg8::bf16_t*)(wsp(F) + WS_PROJ), (pg8::bf16_t*)(wsp(F) + WS_VT), NPROJ, MTOK};
        pg8::gemm_phase<pg8::EpiProj, pg8::StaticOrder, true, true>(F.lds + RING_OFF, g, S, E);
    });
    SEAM(pb + 0);
    PHASE(pb + 1, 8, { attn1_phase(F, l); });
    SEAM(pb + 1);
    PHASE(pb + 2, 16, { attn2_phase(F, l); });
    if constexpr ((DBL_MASK & 0x10000) != 0) { xcd_barrier(bar); FENCE(); attn1_phase(F, l); xcd_barrier(bar); FENCE(); attn2_phase(F, l); }
    SEAM(pb + 2);
    PHASE(pb + 3, 32, { merge_phase(F, l); });
    SEAM(pb + 3);
    PHASE(pb + 4, 64, {
        pg8::Gemm g{(const pg8::bf16_t*)(wsp(F) + WS_HB), (const pg8::bf16_t*)(wsp(F) + WS_WOUT), MTOK, DM, DM}; pg8::StaticOrder S; S.init(MTOK, DM, F.G, (int)blockIdx.x);
        const float* g1p = (const float*)(wsp(F) + WS_MOD) + (size_t)l * NB * 6 * DM + 2 * DM;
        if constexpr (l == 0) { pg8::EpiResid<false> E{(const void*)inp(F, I_X), (pg8::bf16_t*)(wsp(F) + WS_XA), g1p, 6 * DM, SEQ, DM, ALPHA};
            pg8::gemm_phase<pg8::EpiResid<false>, pg8::StaticOrder, true, true>(F.lds + RING_OFF, g, S, E); }
        else { pg8::EpiResid<true> E{(const void*)(wsp(F) + WS_XB), (pg8::bf16_t*)(wsp(F) + WS_XA), g1p, 6 * DM, SEQ, DM, ALPHA};
            pg8::gemm_phase<pg8::EpiResid<true>, pg8::StaticOrder, true, true>(F.lds + RING_OFF, g, S, E); }
    });
    SEAM(pb + 4);
    PHASE(pb + 5, 128, { post_mixer_phase(F, l); });
    if constexpr (IN(pb + 5)) { if constexpr (HI - LO > 1) xcd_barrier(bar); FENCE(); router_phase(F, l); }
    SEAM(pb + 5);
    PHASE(pb + 7, 512, {
        moe_tables(F, l);
        const PG8_LAS_T int* tab = (const PG8_LAS_T int*)(F.lds + TAB_OFF);
        pg8::Gemm g{(const pg8::bf16_t*)(wsp(F) + WS_HB), (const pg8::bf16_t*)(wsp(F) + WS_WGU), MAXROWS, NEXP * 1024, DM};
        pg8::MoeOrder S{4, F.G, (int)blockIdx.x, tab};
        pg8::EpiSwiGLU E{(pg8::bf16_t*)(wsp(F) + WS_HID), DEXP};
        pg8::MoeGather GA{tab, (const int*)(wsp(F) + WS_LIST), MTOK, (unsigned)(DM * 2), 0u};
        pg8::gemm_phase<pg8::EpiSwiGLU, pg8::MoeOrder, true, true, pg8::MoeGather>(F.lds + RING_OFF, g, S, E, GA);
    });
    SEAM(pb + 7);
    PHASE(pb + 8, 1024, {
        moe_tables(F, l);
        const PG8_LAS_T int* tab = (const PG8_LAS_T int*)(F.lds + TAB_OFF);
        pg8::Gemm g{(const pg8::bf16_t*)(wsp(F) + WS_HID), (const pg8::bf16_t*)(wsp(F) + WS_WD), MAXROWS, NEXP * DM, DEXP};
        pg8::MoeOrder S{8, F.G, (int)blockIdx.x, tab};
        pg8::EpiDown E{(pg8::bf16_t*)(wsp(F) + WS_YS), DM, tab, (const int*)(wsp(F) + WS_LIST), MTOK, (const float*)(wsp(F) + WS_SMALL + SM_GATEW)};
        pg8::gemm_phase<pg8::EpiDown, pg8::MoeOrder, true, true>(F.lds + RING_OFF, g, S, E);
    });
    SEAM(pb + 8);
    PHASE(pb + 9, 2048, { post_moe_phase(F, l, (l == DEPTH - 1) ? outp(F) : (float*)nullptr, (bf16*)(wsp(F) + WS_XB), l < DEPTH - 1); });
    PHASE(pb + 9, 4096, { if (l < DEPTH - 1) convert_small(F, l + 1); });
    SEAM(pb + 9);
}
template <int LO, int HI>
__global__ void __launch_bounds__(NWAVES * 64, 2) fwd_kernel(Args args) {
    extern __shared__ __attribute__((aligned(16))) unsigned char lds[];
    Frame F;
    F.lds = (LAS unsigned char*)lds;
    F.MISC = (volatile LAS unsigned*)(F.lds + MISC_OFF);
    F.tid = threadIdx.x; F.lane = F.tid & 63; F.wave = __builtin_amdgcn_readfirstlane(F.tid >> 6);
    F.G = gridDim.x; { const int bx = blockIdx.x; F.vcu = (F.G % 8 == 0) ? (bx % 8) * (F.G / 8) + bx / 8 : bx; }
    for (int u = F.tid; u < (LDS_BYTES - LDSCTL_OFF) / 4; u += NWAVES * 64) ((LAS unsigned*)(F.lds + LDSCTL_OFF))[u] = 0u;
    __syncthreads();
    if (F.tid < 25) ((LAS unsigned long long*)(F.lds + PTR_OFF))[F.tid] = (unsigned long long)args.in[F.tid];
    if (F.tid == 25) ((LAS unsigned long long*)(F.lds + PTR_OFF))[25] = (unsigned long long)args.ws;
    if (F.tid == 26) ((LAS unsigned long long*)(F.lds + PTR_OFF))[26] = (unsigned long long)args.out;
    __syncthreads();
    XcdBarrier bar; bar.bar = (unsigned*)(ctlp(F) + CW_BAR); bar.x = 0; bar.st = nullptr;
    if constexpr (HI - LO > 1) bar = xcd_barrier_post((unsigned*)(ctlp(F) + CW_BAR), F.MISC + 8);
    PHASE(0, 1, { ada_phase(F); });
    PHASE(0, 4096, { __syncthreads(); convert_small(F, 0); });
    SEAM(0);
    PHASE(1, 2, { ln_in_phase(F); });
    SEAM(1);
    layer_phases<0, LO, HI>(F, bar);
    layer_phases<1, LO, HI>(F, bar);
}
#undef IN
#undef SEAM
#undef PHASE

#if MK_ONE_LAUNCH
#define FWD_MAIN (fwd_kernel<0, N_PHASES>)
static bool set_lds_attr() { return hipFuncSetAttribute((const void*)FWD_MAIN, hipFuncAttributeMaxDynamicSharedMemorySize, LDS_BYTES) == hipSuccess; }
#else
#define FWD_MAIN (fwd_kernel<0, 1>)
template <int... P> static bool set_lds_attr_seq(std::integer_sequence<int, P...>) { bool ok = true; ((ok = ok && hipFuncSetAttribute((const void*)(fwd_kernel<P, P + 1>), hipFuncAttributeMaxDynamicSharedMemorySize, LDS_BYTES) == hipSuccess), ...); return ok; }
static bool set_lds_attr() { return set_lds_attr_seq(std::make_integer_sequence<int, N_PHASES>{}); }
template <int P> static void launch_one(int grid, hipStream_t stream, const Args& a) { hipLaunchKernelGGL((fwd_kernel<P, P + 1>), dim3(grid), dim3(NWAVES * 64), LDS_BYTES, stream, a); }
template <int... P> static void launch_phases(std::integer_sequence<int, P...>, int grid, hipStream_t stream, const Args& a) { (launch_one<P>(grid, stream, a), ...); }
#endif
extern "C" void kernel_launch(void* const* d_in, const int* in_sizes, int n_in, void* d_out, int out_size, void* d_ws, size_t ws_size, hipStream_t stream) {
    static int grid = 0;
    if (grid == 0) {
        if (n_in != 25 || out_size != MTOK * DM || ws_size < WS_END) { fprintf(stderr, "kernel_launch: unexpected problem shape (n_in %d, out %d, ws %zu)\n", n_in, out_size, ws_size); grid = -1; return; }
        int dev = 0, cus = 0, per_cu = 0;
        if (hipGetDevice(&dev) != hipSuccess || hipDeviceGetAttribute(&cus, hipDeviceAttributeMultiprocessorCount, dev) != hipSuccess) { grid = -1; return; }
        if (!set_lds_attr()) { fprintf(stderr, "kernel_launch: hipFuncSetAttribute failed\n"); grid = -1; return; }
        if (hipOccupancyMaxActiveBlocksPerMultiprocessor(&per_cu, (const void*)FWD_MAIN, NWAVES * 64, LDS_BYTES) != hipSuccess || per_cu < 1)
            fprintf(stderr, "kernel_launch: note: occupancy query reports %d workgroups per CU\n", per_cu);
        (void)hipGetLastError();
        grid = cus;
        if (grid > 256) grid = 256;
        grid &= ~7;
    }
    if (grid <= 0) return;
    (void)in_sizes;
    if (hipMemsetAsync((char*)d_ws + WS_CTL, 0, CTL_ZERO_BYTES, stream) != hipSuccess) return;
    Args a{};
    for (int i = 0; i < 25; ++i) a.in[i] = (const float*)d_in[i];
    a.out = (float*)d_out; a.ws = (unsigned char*)d_ws;
#if MK_ONE_LAUNCH
    hipLaunchKernelGGL((fwd_kernel<0, N_PHASES>), dim3(grid), dim3(NWAVES * 64), LDS_BYTES, stream, a);
#else
    launch_phases(std::make_integer_sequence<int, N_PHASES>{}, grid, stream, a);
#endif
}
```

```cpp
#include <hip/hip_runtime.h>
#include <cstdio>
#include <cstdint>
#include <utility>
#define MK_ONE_LAUNCH 1
namespace pg8 {
#define PG8_LAS __attribute__((address_space(3)))
#define PG8_LAS_T __attribute__((address_space(3)))
typedef unsigned short bf16_t;
typedef short bf16x8 __attribute__((ext_vector_type(8)));
typedef float f32x4 __attribute__((ext_vector_type(4)));
typedef unsigned u32x4 __attribute__((ext_vector_type(4)));
constexpr int BM = 256, BK = 64, HALF = 128, HTB = HALF * BK * 2  , STAGE_BYTES = 8 * HTB, NXCD = 8, WGM = 8;

__host__ __device__ __forceinline__ int lds_byte(int r, int c) { const int st = (r >> 4) * 2 + (c >> 5), rr = r & 15, cc = c & 31, ob = rr * 64 + cc * 2; return st * 1024 + (ob ^ (((ob >> 9) & 1) << 5)); }
__host__ __device__ __forceinline__ void stage_rc(int b, int& R, int& C) { const int st = b / 1024, sb = b % 1024, swz = sb ^ (((sb >> 9) & 1) << 5); R = (st >> 1) * 16 + swz / 64; C = (st & 1) * 32 + (swz % 64) / 2; }
__host__ __device__ __forceinline__ int perm32(int rho) { const int n = rho >> 4, i = rho & 15; return 8 * (i >> 2) + 4 * n + (i & 3); }

struct Unit { int pm, pn; };
struct Gemm { const bf16_t* A; const bf16_t* Bt; int M, N, K; };

struct StaticOrder {
    int nM, nN, nwg, G, c;
    __host__ __device__ void init(int M, int N, int G_, int c_) { nM = M / BM; nN = N / BM; nwg = nM * nN; G = G_; c = c_; }
    __host__ __device__ bool next(int i, Unit& u) const {
        const long L = (long)i * G + c; if (L >= nwg) return false;
        int wgid = (int)L; { const int q = nwg / NXCD, r = nwg % NXCD, xcd = wgid % NXCD, off = wgid / NXCD; wgid = (xcd < r ? xcd * (q + 1) : r * (q + 1) + (xcd - r) * q) + off; }
        const int nig = WGM * nN, gid = wgid / nig, fm = gid * WGM, gsz = (nM - fm) < WGM ? (nM - fm) : WGM;
        u.pm = fm + ((wgid % nig) % gsz); u.pn = (wgid % nig) / gsz; return true;
    }
    __device__ __forceinline__ void a_ready(const Unit&) const {}
    __device__ __forceinline__ void done(const Unit&) const {}
};
__device__ __forceinline__ unsigned cvt_pk_bf16(float lo, float hi) { unsigned r; asm volatile("s_nop 0\n\tv_cvt_pk_bf16_f32 %0, %1, %2\n\ts_nop 1" : "=v"(r) : "v"(lo), "v"(hi));     return r; }
typedef float f32x2 __attribute__((ext_vector_type(2)));
__device__ __forceinline__ unsigned short f2bf_rne(float f) { unsigned u = __builtin_bit_cast(unsigned, f); return (unsigned short)((u + 0x7fffu + ((u >> 16) & 1u)) >> 16); }

struct EpiProj {
    static constexpr bool PERM = true, AFTER_DRAIN = false;
    bf16_t* P; bf16_t* VT; int ldp; int ldvt;
    __device__ __forceinline__ void operator()(const f32x4 (&acc)[2][2][4][2], const Unit& u, int wr, int wc, int fr, int fq) const {
        const int row0 = u.pm * BM + wr * 64 + fr;
#pragma unroll
        for (int bj = 0; bj < 2; ++bj) {
            const int cb = u.pn * BM + bj * HALF;
            if (cb < ldp) {
                bf16_t* colp = P + (size_t)row0 * ldp + cb + wc * 32 + 8 * fq;
#pragma unroll
                for (int ai = 0; ai < 2; ++ai)
#pragma unroll
                    for (int m = 0; m < 4; ++m) { const f32x4 v0 = acc[ai][bj][m][0], v1 = acc[ai][bj][m][1];
                        u32x4 w; w.x = cvt_pk_bf16(v0[0], v0[1]); w.y = cvt_pk_bf16(v0[2], v0[3]); w.z = cvt_pk_bf16(v1[0], v1[1]); w.w = cvt_pk_bf16(v1[2], v1[3]);
                        *(u32x4*)(colp + (size_t)(ai * HALF + m * 16) * ldp) = w; }
            } else {
                const int c0 = cb - ldp + wc * 32 + 8 * fq;
#pragma unroll
                for (int n = 0; n < 2; ++n)
#pragma unroll
                    for (int e = 0; e < 4; ++e) { bf16_t* cp = VT + (size_t)(c0 + n * 4 + e) * ldvt + row0;
#pragma unroll
                        for (int ai = 0; ai < 2; ++ai)
#pragma unroll
                            for (int m = 0; m < 4; ++m) cp[ai * HALF + m * 16] = f2bf_rne(acc[ai][bj][m][n][e]); }
            }
        }
    }
};

template <bool XBF> struct EpiResid {
    static constexpr bool PERM = true, AFTER_DRAIN = false;
    const void* xin; bf16_t* out; const float* gate0; int gate_bstride; int rows_per_batch; int ldc; float alpha;
    __device__ __forceinline__ void operator()(const f32x4 (&acc)[2][2][4][2], const Unit& u, int wr, int wc, int fr, int fq) const {
        const int col0 = u.pn * BM + wc * 32 + 8 * fq;
        const float* gv = gate0 + (size_t)((u.pm * BM) / rows_per_batch) * gate_bstride;
#pragma unroll
        for (int bj = 0; bj < 2; ++bj) { const int c = col0 + bj * HALF; const f32x4 g0 = *(const f32x4*)(gv + c) + 1.0f, g1 = *(const f32x4*)(gv + c + 4) + 1.0f;
#pragma unroll
            for (int ai = 0; ai < 2; ++ai)
#pragma unroll
                for (int m = 0; m < 4; ++m) { const size_t off = (size_t)(u.pm * BM + ai * HALF + wr * 64 + m * 16 + fr) * ldc + c;
                    f32x4 x0, x1;
                    if (XBF) { const u32x4 xw = *(const u32x4*)((const bf16_t*)xin + off);
                        x0 = (f32x4){__builtin_bit_cast(float, xw.x << 16), __builtin_bit_cast(float, xw.x & 0xffff0000u), __builtin_bit_cast(float, xw.y << 16), __builtin_bit_cast(float, xw.y & 0xffff0000u)};
                        x1 = (f32x4){__builtin_bit_cast(float, xw.z << 16), __builtin_bit_cast(float, xw.z & 0xffff0000u), __builtin_bit_cast(float, xw.w << 16), __builtin_bit_cast(float, xw.w & 0xffff0000u)}; }
                    else { x0 = *(const f32x4*)((const float*)xin + off); x1 = *(const f32x4*)((const float*)xin + off + 4); }
                    const f32x4 v0 = x0 * alpha + g0 * acc[ai][bj][m][0], v1 = x1 * alpha + g1 * acc[ai][bj][m][1];
                    u32x4 w; w.x = cvt_pk_bf16(v0[0], v0[1]); w.y = cvt_pk_bf16(v0[2], v0[3]); w.z = cvt_pk_bf16(v1[0], v1[1]); w.w = cvt_pk_bf16(v1[2], v1[3]);
                    *(u32x4*)(out + off) = w; } }
    }
};

struct EpiSwiGLU {
    static constexpr bool PERM = true, AFTER_DRAIN = false;
    bf16_t* H; int ldh;
    __device__ __forceinline__ void operator()(const f32x4 (&acc)[2][2][4][2], const Unit& u, int wr, int wc, int fr, int fq) const {
        const int row0 = u.pm * BM + wr * 64 + fr, pnl = u.pn & 3;
        const int j0 = pnl * 128 + wc * 16 + 4 * fq;
#pragma unroll
        for (int ai = 0; ai < 2; ++ai)
#pragma unroll
            for (int m = 0; m < 4; ++m) { bf16_t* rowp = H + (size_t)(row0 + ai * HALF + m * 16) * ldh + j0;
#pragma unroll
                for (int bj = 0; bj < 2; ++bj) { const f32x4 v0 = acc[ai][bj][m][0], v1 = acc[ai][bj][m][1];
                    const float h0 = v0[0] / (1.0f + __expf(-v0[0])) * v0[1], h1 = v0[2] / (1.0f + __expf(-v0[2])) * v0[3];
                    const float h2 = v1[0] / (1.0f + __expf(-v1[0])) * v1[1], h3 = v1[2] / (1.0f + __expf(-v1[2])) * v1[3];
                    typedef unsigned u32x2 __attribute__((ext_vector_type(2)));
                    u32x2 w; w.x = cvt_pk_bf16(h0, h1); w.y = cvt_pk_bf16(h2, h3);
                    *(u32x2*)(rowp + bj * 64) = w; } }
    }
};

__device__ __forceinline__ int moe_row_aid(const PG8_LAS int* tab, const int* list, int list_stride, int rt, int row_in_tile) {
    const int e = tab[64 + rt], pos = rt * 256 + row_in_tile - tab[32 + e];
    return pos < tab[e] ? list[(size_t)e * list_stride + pos] : -1;
}
struct MoeGather {
    static constexpr bool ON = true;
    const PG8_LAS int* tab; const int* list; int list_stride; unsigned row_bytes, zero_off;
    __device__ __forceinline__ unsigned row_off(const Unit& u, int h, int r) const { const int aid = moe_row_aid(tab, list, list_stride, u.pm, h * HALF + r); return aid >= 0 ? (unsigned)(aid >> 1) * row_bytes : zero_off; }
};

struct EpiDown {
    static constexpr bool PERM = true, AFTER_DRAIN = false;
    bf16_t* Y; int ldy; const PG8_LAS int* tab; const int* list; int list_stride; const float* gatew;
    __device__ __forceinline__ void operator()(const f32x4 (&acc)[2][2][4][2], const Unit& u, int wr, int wc, int fr, int fq) const {
        const int pnl = u.pn & 7;
        const int col0 = pnl * BM + wc * 32 + 8 * fq;
#pragma unroll
        for (int ai = 0; ai < 2; ++ai)
#pragma unroll
            for (int m = 0; m < 4; ++m) { const int aid = moe_row_aid(tab, list, list_stride, u.pm, wr * 64 + fr + ai * HALF + m * 16);
                if (aid >= 0) { const float gw = gatew[aid]; bf16_t* rowp = Y + (size_t)aid * ldy + col0;
#pragma unroll
                    for (int bj = 0; bj < 2; ++bj) { const f32x4 v0 = acc[ai][bj][m][0] * gw, v1 = acc[ai][bj][m][1] * gw;
                        u32x4 w; w.x = cvt_pk_bf16(v0[0], v0[1]); w.y = cvt_pk_bf16(v0[2], v0[3]); w.z = cvt_pk_bf16(v1[0], v1[1]); w.w = cvt_pk_bf16(v1[2], v1[3]);
                        *(u32x4*)(rowp + bj * HALF) = w; } } }
    }
};

struct MoeOrder {
    int NT, G, c; const PG8_LAS int* tab;
    __device__ __forceinline__ bool next(int i, Unit& u) const {
        const int x = c & 7, ci = c >> 3, per = G >> 3;
        const int q = i * per + ci, rt = x + 8 * (q / NT);
        if (rt >= tab[224]) return false;
        u.pm = rt; u.pn = tab[64 + rt] * NT + (q % NT); return true;
    }
    __device__ __forceinline__ void a_ready(const Unit&) const {}
    __device__ __forceinline__ void done(const Unit&) const {}
};
struct NoGather { static constexpr bool ON = false; __device__ __forceinline__ unsigned row_off(const Unit&, int, int) const { return 0u; } };
template <class Epi, class Sched, bool ALIGN_EPI = false, bool SP2 = false, class Gat = NoGather>
__device__ __forceinline__ void gemm_phase(PG8_LAS unsigned char* lds, const Gemm g, const Sched& S, const Epi& E, const Gat& GA = Gat()) {
    static_assert(!Gat::ON || SP2, "the gathered A operand is wired into the SP2 loop only");
    int tid_ = threadIdx.x; asm volatile("" : "+v"(tid_));
    const int tid = tid_, wid = __builtin_amdgcn_readfirstlane(tid >> 6), lane = tid & 63, wr = wid >> 2, wc = wid & 3, fr = lane & 15, fq = lane >> 4;
    const int K = g.K, nt = K / BK;
    unsigned voffA[2], voffB[2];
    int RA[2]; unsigned CA2[2];
#pragma unroll
    for (int i = 0; i < 2; ++i) { int R, C; stage_rc(tid * 16 + i * 8192, R, C); const int Rb = Epi::PERM ? ((R & ~31) + perm32(R & 31)) : R;
        voffA[i] = (unsigned)(R * K + C) * 2u; voffB[i] = (unsigned)(Rb * K + C) * 2u; RA[i] = R; CA2[i] = (unsigned)C * 2u; }
    unsigned gcu[2][2] = {{0u, 0u}, {0u, 0u}}, gnx[2][2] = {{0u, 0u}, {0u, 0u}};
    const size_t kstep = (size_t)(BK * 2);
    const size_t hstep = (size_t)HALF * K * 2;
    const size_t tstep = 2 * hstep;
    const unsigned ldsw = (unsigned)wid * 1024u;
    const int aoff = lds_byte(wr * 64 + fr, fq * 8), boff = lds_byte(wc * 32 + fr, fq * 8);
#define PG8_SA(b, h) (((b) * 2 + (h)) * HTB)
#define PG8_SB(b, h) ((4 + (b) * 2 + (h)) * HTB)
#define PG8_STAGE(bufoff, gbase, voff) do { _Pragma("unroll") for (int _i = 0; _i < 2; ++_i) \
        __builtin_amdgcn_global_load_lds((const unsigned*)((const char*)(gbase) + (voff)[_i]), (PG8_LAS unsigned*)(lds + (bufoff) + ldsw + _i * 8192), 16, 0, 0); } while (0)
#define PG8_STAGE_A(b, h, ptr, isnext) do { if constexpr (Gat::ON) { const bool _nx = (isnext); unsigned _tv[2] = {_nx ? gnx[h][0] : gcu[h][0], _nx ? gnx[h][1] : gcu[h][1]}; PG8_STAGE(PG8_SA(b, h), ptr, _tv); } \
        else { PG8_STAGE(PG8_SA(b, h), (ptr) + (h) * hstep, voffA); } } while (0)
#define PG8_LDA(dst, b, h) do { _Pragma("unroll") for (int m = 0; m < 4; ++m) _Pragma("unroll") for (int k = 0; k < 2; ++k) dst[m][k] = *(const PG8_LAS bf16x8*)(lds + PG8_SA(b, h) + aoff + m * 2048 + k * 1024); } while (0)
#define PG8_LDB(dst, b, h) do { _Pragma("unroll") for (int n = 0; n < 2; ++n) _Pragma("unroll") for (int k = 0; k < 2; ++k) dst[n][k] = *(const PG8_LAS bf16x8*)(lds + PG8_SB(b, h) + boff + n * 2048 + k * 1024); } while (0)
#define PG8_MMA(ai, bj, At, Bt) do { __builtin_amdgcn_s_setprio(1); _Pragma("unroll") for (int m = 0; m < 4; ++m) _Pragma("unroll") for (int n = 0; n < 2; ++n) _Pragma("unroll") for (int k = 0; k < 2; ++k) \
        acc[ai][bj][m][n] = __builtin_amdgcn_mfma_f32_16x16x32_bf16(Bt[n][k], At[m][k], acc[ai][bj][m][n], 0, 0, 0); __builtin_amdgcn_s_setprio(0); } while (0)
#define PG8_WAIT_V(n) asm volatile("s_waitcnt vmcnt(" #n ")" ::: "memory")
#define PG8_WAIT_L(n) asm volatile("s_waitcnt lgkmcnt(" #n ")" ::: "memory")
#define PG8_BAR __builtin_amdgcn_s_barrier()
#define PG8_SCHED __builtin_amdgcn_sched_barrier(0)
    Unit cur, nxt; int ui = 0;
    if (!S.next(0, cur)) return;
    f32x4 acc[2][2][4][2];
#pragma unroll
    for (int a = 0; a < 2; ++a)
#pragma unroll
        for (int b = 0; b < 2; ++b)
#pragma unroll
            for (int m = 0; m < 4; ++m)
#pragma unroll
                for (int n = 0; n < 2; ++n) acc[a][b][m][n] = (f32x4){0.f, 0.f, 0.f, 0.f};
    bf16x8 At[4][2], B0[2][2], B1[2][2];
    const char* cA = (const char*)g.A + (Gat::ON ? (size_t)0 : (size_t)cur.pm * tstep); const char* cB = (const char*)g.Bt + (size_t)cur.pn * tstep;
    if constexpr (Gat::ON) {
#pragma unroll
        for (int h = 0; h < 2; ++h)
#pragma unroll
            for (int i = 0; i < 2; ++i) { gcu[h][i] = GA.row_off(cur, h, RA[i]) + CA2[i]; gnx[h][i] = gcu[h][i]; } }
    S.a_ready(cur);
    if constexpr (SP2) {
        PG8_STAGE(PG8_SB(0, 0), cB, voffB); PG8_STAGE(PG8_SB(0, 1), cB + hstep, voffB); PG8_STAGE_A(0, 0, cA, false); PG8_STAGE_A(0, 1, cA, false);
        if (wr == 1) PG8_BAR;
        PG8_WAIT_V(2); PG8_BAR;
        PG8_STAGE(PG8_SB(1, 0), cB + kstep, voffB); PG8_STAGE_A(1, 0, cA + kstep, false); PG8_STAGE(PG8_SB(1, 1), cB + hstep + kstep, voffB);
        PG8_WAIT_V(6); PG8_BAR;
    } else {
        PG8_STAGE(PG8_SB(0, 0), cB, voffB); PG8_STAGE(PG8_SA(0, 0), cA, voffA); PG8_STAGE(PG8_SB(0, 1), cB + hstep, voffB); PG8_STAGE(PG8_SA(0, 1), cA + hstep, voffA);
        if (wr == 1) PG8_BAR;
        PG8_WAIT_V(4); PG8_BAR;
        PG8_STAGE(PG8_SB(1, 0), cB + kstep, voffB); PG8_STAGE(PG8_SA(1, 0), cA + kstep, voffA); PG8_STAGE(PG8_SB(1, 1), cB + hstep + kstep, voffB);
        PG8_WAIT_V(6); PG8_BAR;
    }
    for (;;) {
        const bool has_next = S.next(ui + 1, nxt);
        const char* nA = (has_next && !Gat::ON) ? (const char*)g.A + (size_t)nxt.pm * tstep : cA; const char* nB = has_next ? (const char*)g.Bt + (size_t)nxt.pn * tstep : cB;
        if constexpr (Gat::ON) { if (has_next) {
#pragma unroll
            for (int h = 0; h < 2; ++h)
#pragma unroll
                for (int i = 0; i < 2; ++i) gnx[h][i] = GA.row_off(nxt, h, RA[i]) + CA2[i]; } }
        for (int t = 0; t < nt; t += 2) {
            const bool last = (t == nt - 2);
            const char* a1 = cA + (size_t)(t + 1) * kstep;
            const char* a2 = last ? nA : cA + (size_t)(t + 2) * kstep; const char* b2 = last ? nB : cB + (size_t)(t + 2) * kstep;
            const char* a3 = a2 + kstep; const char* b3 = b2 + kstep;
            if (last && has_next) S.a_ready(nxt);
            if constexpr (SP2) {
            PG8_LDB(B0, 0, 0); PG8_LDB(B1, 0, 1); PG8_SCHED; PG8_LDA(At, 0, 0); PG8_STAGE_A(1, 1, a1, false);
            PG8_WAIT_V(8); PG8_WAIT_L(0); PG8_BAR; PG8_MMA(0, 0, At, B0); PG8_MMA(0, 1, At, B1); PG8_BAR; PG8_SCHED;
            PG8_LDA(At, 0, 1); PG8_STAGE(PG8_SB(0, 0), b2, voffB); PG8_STAGE(PG8_SB(0, 1), b2 + hstep, voffB); PG8_STAGE_A(0, 0, a2, last);
            PG8_WAIT_V(8); PG8_WAIT_L(0); PG8_BAR; PG8_MMA(1, 0, At, B0); PG8_MMA(1, 1, At, B1); PG8_BAR; PG8_SCHED;
            PG8_LDB(B0, 1, 0); PG8_LDB(B1, 1, 1); PG8_SCHED; PG8_LDA(At, 1, 0); PG8_STAGE_A(0, 1, a2, last);
            PG8_WAIT_V(8); PG8_WAIT_L(0); PG8_BAR; PG8_MMA(0, 0, At, B0); PG8_MMA(0, 1, At, B1); PG8_BAR; PG8_SCHED;
            PG8_LDA(At, 1, 1); PG8_STAGE(PG8_SB(1, 0), b3, voffB); PG8_STAGE(PG8_SB(1, 1), b3 + hstep, voffB); PG8_STAGE_A(1, 0, a3, last);
            PG8_WAIT_V(8); PG8_WAIT_L(0); PG8_BAR; PG8_MMA(1, 0, At, B0); PG8_MMA(1, 1, At, B1); PG8_BAR; PG8_SCHED;
            } else {
            PG8_LDB(B0, 0, 0); PG8_SCHED; PG8_LDA(At, 0, 0); PG8_STAGE(PG8_SA(1, 1), a1 + hstep, voffA);
            PG8_WAIT_L(8); PG8_BAR; PG8_WAIT_L(0); PG8_MMA(0, 0, At, B0); PG8_BAR; PG8_SCHED;
            PG8_LDB(B1, 0, 1); PG8_STAGE(PG8_SB(0, 0), b2, voffB);
            PG8_BAR; PG8_WAIT_L(0); PG8_MMA(0, 1, At, B1); PG8_BAR;
            PG8_LDA(At, 0, 1); PG8_STAGE(PG8_SA(0, 0), a2, voffA);
            PG8_BAR; PG8_WAIT_L(0); PG8_MMA(1, 0, At, B0); PG8_BAR; PG8_SCHED;
            PG8_STAGE(PG8_SB(0, 1), b2 + hstep, voffB);
            PG8_WAIT_V(6); PG8_BAR; PG8_MMA(1, 1, At, B1); PG8_BAR;
            PG8_LDB(B0, 1, 0); PG8_SCHED; PG8_LDA(At, 1, 0); PG8_STAGE(PG8_SA(0, 1), a2 + hstep, voffA);
            PG8_WAIT_L(8); PG8_BAR; PG8_WAIT_L(0); PG8_MMA(0, 0, At, B0); PG8_BAR; PG8_SCHED;
            PG8_LDB(B1, 1, 1); PG8_STAGE(PG8_SB(1, 0), b3, voffB);
            PG8_BAR; PG8_WAIT_L(0); PG8_MMA(0, 1, At, B1); PG8_BAR;
            PG8_LDA(At, 1, 1); PG8_STAGE(PG8_SA(1, 0), a3, voffA);
            PG8_BAR; PG8_WAIT_L(0); PG8_MMA(1, 0, At, B0); PG8_BAR; PG8_SCHED;
            PG8_STAGE(PG8_SB(1, 1), b3 + hstep, voffB);
            PG8_WAIT_V(6); PG8_BAR; PG8_MMA(1, 1, At, B1); PG8_BAR;
            }
        }
        if constexpr (ALIGN_EPI) { if (wr == 0) PG8_BAR; }
        if constexpr (!Epi::AFTER_DRAIN) { E(acc, cur, wr, wc, fr, fq); S.done(cur); }
        if (!has_next) break;
#pragma unroll
        for (int a = 0; a < 2; ++a)
#pragma unroll
            for (int b = 0; b < 2; ++b)
#pragma unroll
                for (int m = 0; m < 4; ++m)
#pragma unroll
                    for (int n = 0; n < 2; ++n) acc[a][b][m][n] = (f32x4){0.f, 0.f, 0.f, 0.f};
        cur = nxt; cA = nA; cB = nB; ++ui;
        if constexpr (Gat::ON) {
#pragma unroll
            for (int h = 0; h < 2; ++h) { gcu[h][0] = gnx[h][0]; gcu[h][1] = gnx[h][1]; } }
        if constexpr (ALIGN_EPI) { if (wr == 1) PG8_BAR; }
    }
    PG8_WAIT_V(0);
    if constexpr (!ALIGN_EPI) { if (wr == 0) PG8_BAR; }
    PG8_BAR;
    if constexpr (Epi::AFTER_DRAIN) { E.fused(acc, cur, wr, wc, fr, fq, lds, wid, lane); S.done(cur); }
#undef PG8_SA
#undef PG8_SB
#undef PG8_STAGE
#undef PG8_STAGE_A
#undef PG8_LDA
#undef PG8_LDB
#undef PG8_MMA
#undef PG8_WAIT_V
#undef PG8_WAIT_L
#undef PG8_BAR
#undef PG8_SCHED
}
}
constexpr int NWAVES = 8;
constexpr int NB = 2, SEQ = 8192, DM = 2048, MTOK = NB * SEQ, DEPTH = 2, HD = 64;
constexpr int NEXP = 32, DEXP = 512, NASSIGN = MTOK * 2;
constexpr int D_IN = 5144;
constexpr int NPROJ = 3712, NVT = 1408, NIN = NPROJ + NVT;
constexpr int P_QA = 0, P_KA = 512, P_QB = 640, P_KBC = 1152, P_VBC = 1280, P_KBS = 1408, P_KBW = 1536, P_QC = 1664, P_KC = 2688;
constexpr int V_C = 0, V_A = 1024, V_BS = 1152, V_BW = 1280;
constexpr float LN_EPS = 1e-5f, RMS_EPS = 1e-6f, ALPHA = 1.41421356237309515f;
constexpr float LOG2E = 1.44269504088896341f, LN2 = 0.693147180559945309f;
constexpr float SC2 = 0.125f * LOG2E;
constexpr int MAXROWS = 40960;
constexpr float SB_EXIT = -104.0f;

constexpr size_t MiB = 1u << 20;
constexpr size_t WS_CTL = 0, CTL_ZERO_BYTES = 1 * MiB;
constexpr size_t WS_MOD = 1 * MiB;
constexpr size_t WS_SMALL = 2 * MiB;
constexpr size_t WS_LIST = 5 * MiB;
constexpr size_t WS_WCMP = 7 * MiB;
constexpr size_t WS_WIN = 9 * MiB;
constexpr size_t WS_WOUT = 30 * MiB;
constexpr size_t WS_WGU = 38 * MiB;
constexpr size_t WS_WD = 166 * MiB;
constexpr size_t WS_XA = 230 * MiB;
constexpr size_t WS_XB = 358 * MiB;
constexpr size_t WS_HB = 486 * MiB;
constexpr size_t WS_PROJ = 550 * MiB;
constexpr size_t WS_VT = WS_PROJ + (size_t)MTOK * NPROJ * 2;
constexpr size_t WS_XS = WS_PROJ;
constexpr size_t WS_OCAT = 720 * MiB;
constexpr size_t WS_YS = WS_OCAT;
constexpr size_t WS_HID = 848 * MiB;
constexpr size_t WS_END = 888 * MiB;
static_assert(WS_VT + (size_t)NVT * MTOK * 2 <= WS_OCAT && WS_XS + (size_t)MAXROWS * DM * 2 <= WS_OCAT, "proj/vT/xs region");
static_assert(WS_WIN + (size_t)NIN * DM * 2 <= WS_WOUT && WS_WGU + (size_t)NEXP * 1024 * DM * 2 <= WS_WD && WS_WD + (size_t)NEXP * DM * DEXP * 2 <= WS_XA, "weight regions");
constexpr size_t SM_KCMP = 0;
constexpr size_t SM_VCMPT = 256 * 1024;
constexpr size_t SM_GATEW = 512 * 1024;
constexpr size_t SM_ROWINFO = 640 * 1024;
constexpr size_t SM_TILE = 800 * 1024;
constexpr size_t WS_GBUF = WS_SMALL + 1024 * 1024;
constexpr int CW_BAR = 4096;
constexpr int CW_CNT = 16384;

constexpr int RING_OFF = 0, RING_BYTES = 131072;
constexpr int TAB_OFF = RING_BYTES;
constexpr int LDSCTL_OFF = 143360, MISC_OFF = LDSCTL_OFF + 320;
constexpr int LDS_BYTES = 147456;

#define GAS __attribute__((address_space(1)))
#define LAS __attribute__((address_space(3)))
typedef unsigned short bf16;
typedef unsigned v4u __attribute__((ext_vector_type(4)));
typedef unsigned v2u __attribute__((ext_vector_type(2)));
typedef float f32x4 __attribute__((ext_vector_type(4)));
typedef short bf16x8 __attribute__((ext_vector_type(8)));
typedef GAS unsigned gu32;
#define RLX_AGENT __ATOMIC_RELAXED, __HIP_MEMORY_SCOPE_AGENT
#define LDS_WAIT() asm volatile("s_waitcnt lgkmcnt(0)" ::: "memory")
#define VM_WAIT() asm volatile("s_waitcnt vmcnt(0)" ::: "memory")
__device__ __forceinline__ unsigned f2bf(float f) { unsigned u = __builtin_bit_cast(unsigned, f); return (u + 0x7fffu + ((u >> 16) & 1u)) >> 16; }
__device__ __forceinline__ unsigned pk2(float lo, float hi) { return f2bf(lo) | (f2bf(hi) << 16); }
__device__ __forceinline__ float bf2f(unsigned short h) { return __builtin_bit_cast(float, (unsigned)h << 16); }
__device__ __forceinline__ float bflo(unsigned w) { return __builtin_bit_cast(float, w << 16); }
__device__ __forceinline__ float bfhi(unsigned w) { return __builtin_bit_cast(float, w & 0xffff0000u); }
__device__ __forceinline__ float ex2(float x) { return __builtin_amdgcn_exp2f(x); }
__device__ __forceinline__ float lg2(float x) { return __builtin_amdgcn_logf(x); }
__device__ __forceinline__ bf16x8 ldg8(const bf16* p) { return *(const GAS bf16x8*)p; }
__device__ __forceinline__ f32x4 mfma16(bf16x8 a, bf16x8 b, f32x4 c) { return __builtin_amdgcn_mfma_f32_16x16x32_bf16(a, b, c, 0, 0, 0); }
__device__ __forceinline__ bf16x8 pack8(float a0, float a1, float a2, float a3, float a4, float a5, float a6, float a7) {
    v4u w; w.x = pg8::cvt_pk_bf16(a0, a1); w.y = pg8::cvt_pk_bf16(a2, a3); w.z = pg8::cvt_pk_bf16(a4, a5); w.w = pg8::cvt_pk_bf16(a6, a7);
    return __builtin_bit_cast(bf16x8, w);
}
__device__ __forceinline__ float wave_sum(float v) {
#pragma unroll
    for (int o = 1; o < 64; o <<= 1) v += __shfl_xor(v, o);
    return v;
}
#define XB_TMO      128
#define XB_XCNT(j)  (256  + 64 * (j))
#define XB_XSUB(j)  (1280 + 64 * (j))
#define XB_XGEN(j)  (2304 + 64 * (j))
#define XB_TOP      3328
#define XB_TOPGEN   3392
#define XCD_BAR_WORDS 3456
#define XB_SPIN_CAP (1u << 18)

__device__ __forceinline__ unsigned xb_ld(unsigned* p)              { return __hip_atomic_load(p, __ATOMIC_RELAXED, __HIP_MEMORY_SCOPE_AGENT); }
__device__ __forceinline__ unsigned xb_add(unsigned* p, unsigned v) { return __hip_atomic_fetch_add(p, v, __ATOMIC_RELAXED, __HIP_MEMORY_SCOPE_AGENT); }
__device__ __forceinline__ unsigned xb_xcc_id() { return (unsigned)__builtin_amdgcn_s_getreg((3 << 11) | 20) & 0xFu; }
#define XB_SPIN(cond, bar) do { unsigned _sp = 0; while (cond) { __builtin_amdgcn_s_sleep(1); \
    if ((++_sp & 255u) == 0u) { if (xb_ld(&(bar)[XB_TMO])) break; if (_sp > XB_SPIN_CAP) { atomicAdd(&(bar)[XB_TMO], 1u); break; } } } } while (0)

struct XcdBarrier {
    unsigned* bar; unsigned x;
    volatile LAS unsigned* st;
};

__device__ __forceinline__ XcdBarrier xcd_barrier_post(unsigned* bar, volatile LAS unsigned* st) {
    XcdBarrier b; b.bar = bar; b.x = xb_xcc_id(); b.st = st;
    if (threadIdx.x == 0) (void)xb_add(&bar[XB_XCNT(b.x)], 1u);
    return b;
}
__device__ __forceinline__ void xcd_barrier_complete(unsigned* bar, unsigned x, unsigned& nloc, unsigned& nx) {
    const unsigned G = gridDim.x * gridDim.y * gridDim.z;
    unsigned sum, cnt, mine, sp = 0u;
    for (;;) {
        sum = 0u; cnt = 0u; mine = 0u;
#pragma unroll
        for (unsigned j = 0; j < 16; ++j) { const unsigned c = xb_ld(&bar[XB_XCNT(j)]); sum += c; cnt += (c > 0u) ? 1u : 0u; mine = (j == x) ? c : mine; }
        if (sum == G) break;
        __builtin_amdgcn_s_sleep(1);
        if ((++sp & 255u) == 0u) { if (xb_ld(&bar[XB_TMO])) break; if (sp > XB_SPIN_CAP) { atomicAdd(&bar[XB_TMO], 1u); break; } }
    }
    nloc = mine > 0u ? mine : 1u; nx = cnt > 0u ? cnt : 1u;
}

__device__ __forceinline__ void xcd_barrier(const XcdBarrier& b) {
    asm volatile("s_waitcnt vmcnt(0)" ::: "memory");
    __syncthreads();
    if (threadIdx.x == 0) {
        unsigned* bar = b.bar;
        __builtin_amdgcn_s_waitcnt(0);
        unsigned nloc = b.st[0], nx = b.st[1];
        if (nloc == 0u) { xcd_barrier_complete(bar, b.x, nloc, nx); b.st[0] = nloc; b.st[1] = nx; }
        const unsigned old = xb_add(&bar[XB_XSUB(b.x)], 1u);
        const unsigned gen = old / nloc;
        if (old + 1u == (gen + 1u) * nloc) {
            __builtin_amdgcn_fence(__ATOMIC_RELEASE, "agent");
            asm volatile("s_waitcnt vmcnt(0)" ::: "memory");
            const unsigned og = xb_add(&bar[XB_TOP], 1u);
            const unsigned tg = og / nx;
            if (og + 1u == (tg + 1u) * nx) xb_add(&bar[XB_TOPGEN], 1u);
            else XB_SPIN(xb_ld(&bar[XB_TOPGEN]) == tg, bar);
            __builtin_amdgcn_fence(__ATOMIC_ACQUIRE, "agent");
            xb_add(&bar[XB_XGEN(b.x)], 1u);
            asm volatile("s_waitcnt vmcnt(0)" ::: "memory");
        } else {
            XB_SPIN(xb_ld(&bar[XB_XGEN(b.x)]) == gen, bar);
            __builtin_amdgcn_fence(__ATOMIC_ACQUIRE, "agent");
            asm volatile("s_waitcnt vmcnt(0)" ::: "memory");
        }
    }
    __syncthreads();
}
struct Frame {
    LAS unsigned char* lds;
    volatile LAS unsigned* MISC;
    int tid, lane, wave;
    int vcu, G;
};
constexpr int PTR_OFF = LDSCTL_OFF + 1024;
__device__ __forceinline__ unsigned char* tabp(const Frame& F, int i) {
    const unsigned long long v = ((LAS unsigned long long*)(F.lds + PTR_OFF))[i];
    const unsigned lo = __builtin_amdgcn_readfirstlane((unsigned)v), hi = __builtin_amdgcn_readfirstlane((unsigned)(v >> 32));
    return (unsigned char*)(((unsigned long long)hi << 32) | lo);
}
__device__ __forceinline__ const float* inp(const Frame& F, int i) { return (const float*)tabp(F, i); }
__device__ __forceinline__ unsigned char* wsp(const Frame& F) { return tabp(F, 25); }
__device__ __forceinline__ float* outp(const Frame& F) { return (float*)tabp(F, 26); }
__device__ __forceinline__ gu32* ctlp(const Frame& F) { return (gu32*)(tabp(F, 25) + WS_CTL); }
enum { I_X = 0, I_C, I_WADA, I_BADA, I_WIN, I_SINKS, I_PEK, I_W1K, I_W2K, I_PEV, I_W1V, I_W2V, I_MIXG, I_WOUT, I_LN1G, I_LN1B, I_WRG, I_BRG, I_WRE, I_BRE, I_WGATE, I_WUP, I_WDOWN, I_LN2G, I_LN2B };

__device__ __forceinline__ void ada_phase(Frame& F) {
    LAS float* cs = (LAS float*)(F.lds + 73728);
    LAS float* red = (LAS float*)(F.lds + 73728 + 16384);
    const float* c = inp(F, I_C);
    for (int i = F.tid; i < NB * DM; i += NWAVES * 64) { const float v = c[i]; cs[i] = v / (1.0f + __expf(-v)); }
    __syncthreads();
    float* mod = (float*)(wsp(F) + WS_MOD);
    for (int u = F.vcu; u < DEPTH * 96; u += F.G) {
        const int l = u / 96, cb = u % 96, col = cb * 128 + 2 * F.lane;
        const float* W = inp(F, I_WADA) + (size_t)l * DM * (6 * DM) + col;
        float a00 = 0.f, a01 = 0.f, a10 = 0.f, a11 = 0.f;
        const int k0 = F.wave * 256;
#pragma unroll 8
        for (int kk = 0; kk < 256; ++kk) { const int k = k0 + kk; typedef float f32x2_ __attribute__((ext_vector_type(2))); const f32x2_ w = *(const GAS f32x2_*)(W + (size_t)k * (6 * DM));
            const float s0 = cs[k], s1 = cs[DM + k]; a00 += s0 * w.x; a01 += s0 * w.y; a10 += s1 * w.x; a11 += s1 * w.y; }
        red[(F.wave * 2 + 0) * 128 + 2 * F.lane] = a00; red[(F.wave * 2 + 0) * 128 + 2 * F.lane + 1] = a01;
        red[(F.wave * 2 + 1) * 128 + 2 * F.lane] = a10; red[(F.wave * 2 + 1) * 128 + 2 * F.lane + 1] = a11;
        __syncthreads();
        if (F.tid < 256) { const int b = F.tid >> 7, j = F.tid & 127; float s = 0.f;
#pragma unroll
            for (int w = 0; w < 8; ++w) s += red[(w * 2 + b) * 128 + j];
            mod[((size_t)l * NB + b) * (6 * DM) + cb * 128 + j] = s + inp(F, I_BADA)[(size_t)l * 6 * DM + cb * 128 + j]; }
        __syncthreads();
    }
}

__device__ __forceinline__ void tr_item(const float* W, int ldw, int K, bf16* WT, size_t drow0, int rs, int src0, int nvalid, int k0, LAS float* scr, int lane) {
    const int nn = lane & 31;
#pragma unroll 8
    for (int i = 0; i < 32; ++i) { const int kk = 2 * i + (lane >> 5);
        scr[kk * 33 + nn] = (nn < nvalid) ? *(const GAS float*)(W + (size_t)(k0 + kk) * ldw + src0 + nn) : 0.f; }
    LDS_WAIT(); asm volatile("" ::: "memory");
    const int c = lane & 7;
#pragma unroll
    for (int j = 0; j < 4; ++j) { const int n = (lane >> 3) + 8 * j; const LAS float* s = scr + (8 * c) * 33 + n;
        v4u o; o.x = pk2(s[0 * 33], s[1 * 33]); o.y = pk2(s[2 * 33], s[3 * 33]); o.z = pk2(s[4 * 33], s[5 * 33]); o.w = pk2(s[6 * 33], s[7 * 33]);
        *(GAS v4u*)(WT + (drow0 + (size_t)n * rs) * K + k0 + 8 * c) = o; }
    LDS_WAIT(); asm volatile("" ::: "memory");
}
__device__ __forceinline__ int win_src(int n0) {
    if (n0 < 512) return n0;
    if (n0 < 640) return 512 + (n0 - 512);
    if (n0 < 1152) return 768 + (n0 - 640);
    if (n0 < 1280) return 1280 + (n0 - 1152);
    if (n0 < 1408) return 1408 + (n0 - 1280);
    if (n0 < 1536) return 1536 + (n0 - 1408);
    if (n0 < 1664) return 1792 + (n0 - 1536);
    if (n0 < 2688) return 2072 + (n0 - 1664);
    if (n0 < 3712) return 3096 + (n0 - 2688);
    if (n0 < 4736) return 4120 + (n0 - 3712);
    if (n0 < 4864) return 640 + (n0 - 4736);
    if (n0 < 4992) return 1664 + (n0 - 4864);
    return 1920 + (n0 - 4992);
}
struct TrDesc { const float* src; bf16* dst; int ldw, K, rs; };
struct TrRegs { f32x4 v[16]; };
__device__ __forceinline__ void tr_load(TrRegs& r, const TrDesc& d) {
#pragma unroll
    for (int i = 0; i < 16; ++i) r.v[i] = *(const GAS f32x4*)(d.src + (size_t)(8 * (i >> 1) + (i & 1)) * d.ldw);
}
__device__ __forceinline__ void tr_store(const TrRegs& r, const TrDesc& d, LAS unsigned* scr, int lane) {
    const int kr = lane >> 4, nc = lane & 15;
#pragma unroll
    for (int i = 0; i < 8; ++i) { const f32x4 a = r.v[2 * i], b = r.v[2 * i + 1]; LAS unsigned* w = scr + (4 * nc) * 36 + 4 * i + kr;
        w[0] = pk2(a[0], b[0]); w[36] = pk2(a[1], b[1]); w[72] = pk2(a[2], b[2]); w[108] = pk2(a[3], b[3]); }
    LDS_WAIT(); asm volatile("" ::: "memory");
#pragma unroll
    for (int j = 0; j < 8; ++j) { const int ch = lane + 64 * j, n = ch >> 3, kc = ch & 7;
        const v4u o = *(const LAS v4u*)(scr + n * 36 + 4 * kc);
        *(GAS v4u*)(d.dst + (size_t)n * d.rs * d.K + 8 * kc) = o; }
    LDS_WAIT(); asm volatile("" ::: "memory");
}
__device__ __forceinline__ TrDesc tr_decode(Frame& F, int l, int it, int lane) {
    constexpr int I_A = 32 * (NIN / 64), I_B = 32 * 32, I_G = NEXP * 256, I_U = NEXP * 256, I_D = NEXP * 256, I_1 = 64, I_2 = 2;
    const float* W; bf16* WT; int ldw, K, rs = 1, src0, k0; size_t drow0;
    int r = it;
    if (r < I_A) { const int nblk = NIN / 64, kb = r / nblk, nb = r % nblk; W = inp(F, I_WIN) + (size_t)l * DM * D_IN; ldw = D_IN; K = DM; WT = (bf16*)(wsp(F) + WS_WIN); drow0 = (size_t)nb * 64; src0 = win_src(nb * 64); k0 = kb * 64; }
    else if ((r -= I_A) < I_B) { const int kb = r / 32, nb = r % 32; W = inp(F, I_WOUT) + (size_t)l * DM * DM; ldw = DM; K = DM; WT = (bf16*)(wsp(F) + WS_WOUT); drow0 = (size_t)nb * 64; src0 = nb * 64; k0 = kb * 64; }
    else if ((r -= I_B) < I_G) { const int e = r / 256, q = r % 256, kb = q / 8, nb = q % 8; W = inp(F, I_WGATE) + ((size_t)l * NEXP + e) * DM * DEXP; ldw = DEXP; K = DM; WT = (bf16*)(wsp(F) + WS_WGU); drow0 = (size_t)e * 1024 + nb * 128; rs = 2; src0 = nb * 64; k0 = kb * 64; }
    else if ((r -= I_G) < I_U) { const int e = r / 256, q = r % 256, kb = q / 8, nb = q % 8; W = inp(F, I_WUP) + ((size_t)l * NEXP + e) * DM * DEXP; ldw = DEXP; K = DM; WT = (bf16*)(wsp(F) + WS_WGU); drow0 = (size_t)e * 1024 + nb * 128 + 1; rs = 2; src0 = nb * 64; k0 = kb * 64; }
    else if ((r -= I_U) < I_D) { const int e = r / 256, q = r % 256, kb = q / 32, nb = q % 32; W = inp(F, I_WDOWN) + ((size_t)l * NEXP + e) * DEXP * DM; ldw = DM; K = DEXP; WT = (bf16*)(wsp(F) + WS_WD); drow0 = (size_t)e * DM + nb * 64; src0 = nb * 64; k0 = kb * 64; }
    else if ((r -= I_D) < 2 * I_1) { const int kv = r / I_1, q = r % I_1, kb = q / 2, nb = q % 2; W = inp(F, kv ? I_W1V : I_W1K) + (size_t)l * 2048 * 128; ldw = 128; K = 2048; WT = (bf16*)(wsp(F) + WS_WCMP) + (size_t)kv * 128 * 2048; drow0 = (size_t)nb * 64; src0 = nb * 64; k0 = kb * 64; }
    else { r -= 2 * I_1; const int kv = r / I_2, kb = r % I_2; W = inp(F, kv ? I_W2V : I_W2K) + (size_t)l * 128 * 64; ldw = 64; K = 128; WT = (bf16*)(wsp(F) + WS_WCMP + 2 * 128 * 2048 * 2) + (size_t)kv * 64 * 128; drow0 = 0; src0 = 0; k0 = kb * 64; }
    TrDesc d; d.src = W + (size_t)(k0 + 2 * (lane >> 4)) * ldw + src0 + 4 * (lane & 15); d.dst = WT + drow0 * K + k0; d.ldw = ldw; d.K = K; d.rs = rs;
    return d;
}
constexpr int CV_SMALL0 = 32 * (NIN / 64) + 32 * 32, CV_GU1 = CV_SMALL0 + 2 * NEXP * 256, CV_DN1 = CV_GU1 + NEXP * 256, CV_END = CV_DN1 + 2 * 64 + 2 * 2;
__device__ __forceinline__ void convert_range(Frame& F, int l, int lo, int hi, LAS unsigned* scr) {
    const int gw = F.vcu * NWAVES + F.wave, NGW = F.G * NWAVES;
    if (lo + gw < hi) {
        TrDesc dc = tr_decode(F, l, lo + gw, F.lane); TrRegs rc; tr_load(rc, dc);
        for (int it = lo + gw; it < hi; it += NGW) {
            const int itn = it + NGW < hi ? it + NGW : it;
            const TrDesc dn = tr_decode(F, l, itn, F.lane); TrRegs rn; tr_load(rn, dn);
            tr_store(rc, dc, scr, F.lane);
            rc = rn; dc = dn;
        }
    }
}
__device__ __forceinline__ void convert_small(Frame& F, int l) {
    LAS unsigned* scr = (LAS unsigned*)(F.lds + F.wave * 9216);
    const int gw = F.vcu * NWAVES + F.wave, NGW = F.G * NWAVES;
    convert_range(F, l, 0, CV_SMALL0, scr);
    convert_range(F, l, CV_DN1, CV_END, scr);
    { LAS float* scrf = (LAS float*)scr;
      for (int it = gw; it < 32; it += NGW) tr_item(inp(F, I_WIN) + (size_t)l * DM * D_IN, D_IN, DM, (bf16*)(wsp(F) + WS_WCMP + 1024 * 1024 + 64 * 1024), 0, 1, 2048, 24, it * 64, scrf, F.lane); }
    { bf16* Whi = (bf16*)(wsp(F) + WS_WCMP + 1536 * 1024); bf16* Wlo = Whi + 48 * 2048;
      const float* wrg = inp(F, I_WRG) + (size_t)l * DM * 4; const float* wre = inp(F, I_WRE) + (size_t)l * 4 * DM * 8;
      for (int i = gw * 64 + F.lane; i < 48 * 2048; i += NGW * 64) { const int row = i >> 11, k = i & 2047; float v = 0.f;
          if (row < 4) v = wrg[k * 4 + row]; else if (row < 36) { const int g = (row - 4) >> 3, e = (row - 4) & 7; v = wre[((size_t)g * DM + k) * 8 + e]; }
          const unsigned hi = f2bf(v); Whi[i] = (bf16)hi; Wlo[i] = (bf16)f2bf(v - bf2f((unsigned short)hi)); } }
}

struct Row { f32x4 v[8]; };
__device__ __forceinline__ void row_load(Row& r, const float* p, int lane) {
#pragma unroll
    for (int j = 0; j < 8; ++j) r.v[j] = *((const GAS f32x4*)p + lane + 64 * j);
}
__device__ __forceinline__ void row_load_bf16(Row& r, const bf16* p, int lane) {
#pragma unroll
    for (int j = 0; j < 8; ++j) { const v2u w = *((const GAS v2u*)p + lane + 64 * j); r.v[j] = (f32x4){bflo(w.x), bfhi(w.x), bflo(w.y), bfhi(w.y)}; }
}
__device__ __forceinline__ void row_store(const Row& r, float* p, int lane) {
#pragma unroll
    for (int j = 0; j < 8; ++j) *((GAS f32x4*)p + lane + 64 * j) = r.v[j];
}
__device__ __forceinline__ void row_store_bf16(const Row& r, bf16* p, int lane) {
#pragma unroll
    for (int j = 0; j < 8; ++j) { v2u w; w.x = pk2(r.v[j].x, r.v[j].y); w.y = pk2(r.v[j].z, r.v[j].w); *((GAS v2u*)p + lane + 64 * j) = w; }
}
__device__ __forceinline__ void row_normalize(Row& r) {
    float s = 0.f;
#pragma unroll
    for (int j = 0; j < 8; ++j) s += (r.v[j].x + r.v[j].y) + (r.v[j].z + r.v[j].w);
    const float mean = wave_sum(s) * (1.0f / DM); float s2 = 0.f;
#pragma unroll
    for (int j = 0; j < 8; ++j) { r.v[j] = r.v[j] - mean; s2 += (r.v[j].x * r.v[j].x + r.v[j].y * r.v[j].y) + (r.v[j].z * r.v[j].z + r.v[j].w * r.v[j].w); }
    const float rstd = 1.0f / sqrtf(wave_sum(s2) * (1.0f / DM) + LN_EPS);
#pragma unroll
    for (int j = 0; j < 8; ++j) r.v[j] = r.v[j] * rstd;
}
__device__ __forceinline__ void row_affine(Row& r, const float* a, float add1, const float* b, int lane) {
#pragma unroll
    for (int j = 0; j < 8; ++j) { const f32x4 av = *((const GAS f32x4*)a + lane + 64 * j) + add1, bv = *((const GAS f32x4*)b + lane + 64 * j); r.v[j] = r.v[j] * av + bv; }
}
__device__ __forceinline__ const float* modp(Frame& F, int l, int b, int which) { return (const float*)(wsp(F) + WS_MOD) + ((size_t)l * NB + b) * (6 * DM) + which * DM; }

__device__ __forceinline__ void ln_in_phase(Frame& F) {
    const int gw = F.vcu * NWAVES + F.wave, NGW = F.G * NWAVES;
    bf16* hb = (bf16*)(wsp(F) + WS_HB);
    for (int m = gw; m < MTOK; m += NGW) { const int b = m / SEQ; Row r; row_load(r, inp(F, I_X) + (size_t)m * DM, F.lane); row_normalize(r);
        row_affine(r, modp(F, 0, b, 1), 1.0f, modp(F, 0, b, 0), F.lane); row_store_bf16(r, hb + (size_t)m * DM, F.lane); }
}

__device__ __forceinline__ void merge_phase(Frame& F, int l) {
    const int gw = F.vcu * NWAVES + F.wave, NGW = F.G * NWAVES;
    const bf16* oc = (const bf16*)(wsp(F) + WS_OCAT); bf16* hb = (bf16*)(wsp(F) + WS_HB); const float* mg = inp(F, I_MIXG) + (size_t)l * DM;
    for (int m = gw; m < MTOK; m += NGW) { Row r; row_load_bf16(r, oc + (size_t)m * DM, F.lane);
        float sa = 0.f, sb = 0.f, sc = 0.f;
#pragma unroll
        for (int j = 0; j < 8; ++j) { const float q = (r.v[j].x * r.v[j].x + r.v[j].y * r.v[j].y) + (r.v[j].z * r.v[j].z + r.v[j].w * r.v[j].w); if (j < 2) sa += q; else if (j < 4) sb += q; else sc += q; }
        const float ra = 1.0f / sqrtf(wave_sum(sa) * (1.0f / 512.0f) + RMS_EPS), rb = 1.0f / sqrtf(wave_sum(sb) * (1.0f / 512.0f) + RMS_EPS), rc = 1.0f / sqrtf(wave_sum(sc) * (1.0f / 1024.0f) + RMS_EPS);
#pragma unroll
        for (int j = 0; j < 8; ++j) { const float s = j < 2 ? ra : (j < 4 ? rb : rc); const f32x4 g = *((const GAS f32x4*)mg + F.lane + 64 * j); r.v[j] = r.v[j] * s * g; }
        row_store_bf16(r, hb + (size_t)m * DM, F.lane); }
}

__device__ __forceinline__ void post_mixer_phase(Frame& F, int l) {
    const int gw = F.vcu * NWAVES + F.wave, NGW = F.G * NWAVES;
    bf16* xa = (bf16*)(wsp(F) + WS_XA); bf16* hb = (bf16*)(wsp(F) + WS_HB);
    const float* wrg = inp(F, I_WRG) + (size_t)l * DM * 4; const float* brg = inp(F, I_BRG) + l * 4;
    const float* wre = inp(F, I_WRE) + (size_t)l * 4 * DM * 8; const float* bre = inp(F, I_BRE) + l * 32;
    unsigned* cnt = (unsigned*)(ctlp(F) + CW_CNT + l * 32); int* list = (int*)(wsp(F) + WS_LIST); float* gatew = (float*)(wsp(F) + WS_SMALL + SM_GATEW);
    for (int m = gw; m < MTOK; m += NGW) { const int b = m / SEQ; Row r; row_load_bf16(r, xa + (size_t)m * DM, F.lane); row_normalize(r);
        row_affine(r, inp(F, I_LN1G) + (size_t)l * DM, 0.0f, inp(F, I_LN1B) + (size_t)l * DM, F.lane); row_store_bf16(r, xa + (size_t)m * DM, F.lane);
        row_normalize(r); row_affine(r, modp(F, l, b, 4), 1.0f, modp(F, l, b, 3), F.lane); row_store_bf16(r, hb + (size_t)m * DM, F.lane);
    }
}

__device__ __forceinline__ void router_phase(Frame& F, int l) {
    if (F.wave >= 4) return;
    const int lane = F.lane, c = lane & 15, kq = lane >> 4;
    const bf16* hb = (const bf16*)(wsp(F) + WS_HB);
    const bf16* Whi = (const bf16*)(wsp(F) + WS_WCMP + 1536 * 1024); const bf16* Wlo = Whi + 48 * 2048;
    const float* brg = inp(F, I_BRG) + l * 4; const float* bre = inp(F, I_BRE) + l * 32;
    unsigned* cnt = (unsigned*)(ctlp(F) + CW_CNT + l * 32); int* list = (int*)(wsp(F) + WS_LIST); float* gatew = (float*)(wsp(F) + WS_SMALL + SM_GATEW);
    LAS float* sl = (LAS float*)(F.lds + F.wave * 4096);
    for (int u = F.wave * F.G + F.vcu; u < MTOK / 16; u += 4 * F.G) {
        const bf16* hrow = hb + (size_t)(u * 16 + c) * DM + 8 * kq;
        const bf16* wh = Whi + (size_t)c * 2048 + 8 * kq; const bf16* wl = Wlo + (size_t)c * 2048 + 8 * kq;
        f32x4 acc[3];
#pragma unroll
        for (int t = 0; t < 3; ++t) acc[t] = (f32x4){0.f, 0.f, 0.f, 0.f};
#pragma unroll 4
        for (int ks = 0; ks < 64; ++ks) { const bf16x8 hf = ldg8(hrow + ks * 32);
#pragma unroll
            for (int t = 0; t < 3; ++t) { acc[t] = mfma16(ldg8(wh + (size_t)t * 16 * 2048 + ks * 32), hf, acc[t]); acc[t] = mfma16(ldg8(wl + (size_t)t * 16 * 2048 + ks * 32), hf, acc[t]); } }
#pragma unroll
        for (int t = 0; t < 3; ++t)
#pragma unroll
            for (int r = 0; r < 4; ++r) sl[c * 49 + 16 * t + 4 * kq + r] = acc[t][r];
        LDS_WAIT();
        if (lane < 16) {
            const LAS float* lr = sl + lane * 49; const int m = u * 16 + lane;
            const float g0 = lr[0] + brg[0], g1 = lr[1] + brg[1], g2 = lr[2] + brg[2], g3 = lr[3] + brg[3];
            int gs = 0; float gm = g0; if (g1 > gm) { gm = g1; gs = 1; } if (g2 > gm) { gm = g2; gs = 2; } if (g3 > gm) { gm = g3; gs = 3; }
            const float pgroup = 1.0f / (__expf(g0 - gm) + __expf(g1 - gm) + __expf(g2 - gm) + __expf(g3 - gm));
            int t1 = 0; float m1 = lr[4 + gs * 8] + bre[gs * 8];
#pragma unroll
            for (int i = 1; i < 8; ++i) { const float v = lr[4 + gs * 8 + i] + bre[gs * 8 + i]; if (v > m1) { m1 = v; t1 = i; } }
            int t2 = -1; float m2 = -3.0e38f;
#pragma unroll
            for (int i = 0; i < 8; ++i) { const float v = lr[4 + gs * 8 + i] + bre[gs * 8 + i]; if (i != t1 && v > m2) { m2 = v; t2 = i; } }
            const float e2 = __expf(m2 - m1), inv = pgroup / (1.0f + e2);
            const int x1 = gs * 8 + t1, x2 = gs * 8 + t2;
            const unsigned p1 = __hip_atomic_fetch_add(cnt + x1, 1u, RLX_AGENT); list[(size_t)x1 * MTOK + p1] = m * 2; gatew[m * 2] = inv;
            const unsigned p2 = __hip_atomic_fetch_add(cnt + x2, 1u, RLX_AGENT); list[(size_t)x2 * MTOK + p2] = m * 2 + 1; gatew[m * 2 + 1] = inv * e2;
        }
        LDS_WAIT();
    }
}

__device__ __forceinline__ void gather_phase(Frame& F, int l) {
    LAS int* tb = (LAS int*)(F.lds + 0);
    const unsigned* cnt = (const unsigned*)(ctlp(F) + CW_CNT + l * 32);
    if (F.tid < 32) tb[F.tid] = (int)__hip_atomic_load(cnt + F.tid, RLX_AGENT);
    __syncthreads();
    if (F.tid == 0) { int row = 0, tile = 0;
        for (int e = 0; e < NEXP; ++e) { tb[32 + e] = row; const int nt = (tb[e] + 255) >> 8; for (int t = 0; t < nt; ++t) tb[64 + tile + t] = e; tile += nt; row += nt * 256; }
        tb[224] = tile; }
    __syncthreads();
    const int ntiles = tb[224];
    int* gt = (int*)(wsp(F) + WS_SMALL + SM_TILE);
    if (blockIdx.x == 0) { if (F.tid < 160) gt[F.tid] = (F.tid < ntiles) ? tb[64 + F.tid] : 0; if (F.tid == 0) gt[200] = ntiles; }
    const int gw = F.vcu * NWAVES + F.wave, NGW = F.G * NWAVES;
    const int* list = (const int*)(wsp(F) + WS_LIST); int* rowinfo = (int*)(wsp(F) + WS_SMALL + SM_ROWINFO);
    const bf16* hb = (const bf16*)(wsp(F) + WS_HB); bf16* xs = (bf16*)(wsp(F) + WS_XS);
    for (int R = gw; R < ntiles * 256; R += NGW) { const int e = tb[64 + (R >> 8)], pos = R - tb[32 + e];
        int aid = -1; if (pos < tb[e]) aid = list[(size_t)e * MTOK + pos];
        GAS v4u* dst = (GAS v4u*)(xs + (size_t)R * DM) + F.lane;
        if (aid >= 0) { const GAS v4u* src = (const GAS v4u*)(hb + (size_t)(aid >> 1) * DM) + F.lane;
#pragma unroll
            for (int j = 0; j < 4; ++j) dst[64 * j] = src[64 * j]; }
        else {
#pragma unroll
            for (int j = 0; j < 4; ++j) dst[64 * j] = (v4u){0u, 0u, 0u, 0u}; }
        if (F.lane == 0) rowinfo[R] = aid; }
    __syncthreads();
}

__device__ __forceinline__ void moe_tables(Frame& F, int l) {
    LAS int* tb = (LAS int*)(F.lds + TAB_OFF);
    const unsigned* cnt = (const unsigned*)(ctlp(F) + CW_CNT + l * 32);
    __syncthreads();
    if (F.tid < 32) tb[F.tid] = (int)__hip_atomic_load(cnt + F.tid, RLX_AGENT);
    __syncthreads();
    if (F.tid == 0) { int row = 0, tile = 0;
        for (int e = 0; e < NEXP; ++e) { tb[32 + e] = row; const int nt = (tb[e] + 255) >> 8; for (int t = 0; t < nt; ++t) tb[64 + tile + t] = e; tile += nt; row += nt * 256; }
        tb[224] = tile; }
    __syncthreads();
}

__device__ __forceinline__ void post_moe_phase(Frame& F, int l, float* dst_f32, bf16* dst_bf16, bool next_h) {
    const int gw = F.vcu * NWAVES + F.wave, NGW = F.G * NWAVES;
    const bf16* xa = (const bf16*)(wsp(F) + WS_XA); const bf16* ys = (const bf16*)(wsp(F) + WS_YS); bf16* hb = (bf16*)(wsp(F) + WS_HB);
    for (int m = gw; m < MTOK; m += NGW) { const int b = m / SEQ; Row r; row_load_bf16(r, xa + (size_t)m * DM, F.lane);
        const float* g2 = modp(F, l, b, 5);
#pragma unroll
        for (int j = 0; j < 8; ++j) { const v2u y0 = *((const GAS v2u*)(ys + (size_t)(2 * m) * DM) + F.lane + 64 * j), y1 = *((const GAS v2u*)(ys + (size_t)(2 * m + 1) * DM) + F.lane + 64 * j);
            const f32x4 y = (f32x4){bflo(y0.x) + bflo(y1.x), bfhi(y0.x) + bfhi(y1.x), bflo(y0.y) + bflo(y1.y), bfhi(y0.y) + bfhi(y1.y)};
            const f32x4 gv = *((const GAS f32x4*)g2 + F.lane + 64 * j) + 1.0f; r.v[j] = r.v[j] * ALPHA + gv * y; }
        row_normalize(r); row_affine(r, inp(F, I_LN2G) + (size_t)l * DM, 0.0f, inp(F, I_LN2B) + (size_t)l * DM, F.lane); if (dst_f32) row_store(r, dst_f32 + (size_t)m * DM, F.lane); else row_store_bf16(r, dst_bf16 + (size_t)m * DM, F.lane);
        if (next_h) { row_normalize(r); row_affine(r, modp(F, l + 1, b, 1), 1.0f, modp(F, l + 1, b, 0), F.lane); row_store_bf16(r, hb + (size_t)m * DM, F.lane); } }
}
constexpr int IMP_STRIDE = 130;
constexpr int AW_IMP = 0, AW_SCV = 16 * IMP_STRIDE * 4, AW_SEL = AW_SCV + 512, AW_Q = 9216, AW_BYTES = AW_Q + 8192;
static_assert(AW_SEL + 256 <= AW_Q && NWAVES * AW_BYTES <= LDSCTL_OFF, "per-wave LDS slabs");

struct Flash { f32x4 O[4][4]; f32x4 m, l; };
struct KF { bf16x8 K[2][2]; };
struct VF { bf16x8 V[4]; };

__device__ __forceinline__ void load_k(KF& x, const bf16* Kb, size_t ldk, int kbase) {
    const bf16* kp = Kb + (size_t)kbase * ldk;
    x.K[0][0] = ldg8(kp); x.K[0][1] = ldg8(kp + 32); x.K[1][0] = ldg8(kp + 4 * ldk); x.K[1][1] = ldg8(kp + 4 * ldk + 32);
}
__device__ __forceinline__ void load_v(VF& x, const bf16* Vb, size_t ldv, int kbase) {
    const bf16* vp = Vb + kbase;
#pragma unroll
    for (int db = 0; db < 4; ++db) x.V[db] = ldg8(vp + (size_t)(16 * db) * ldv);
}
__device__ __forceinline__ void q_park(LAS bf16x8* Ql, const bf16* q0p, const bf16* q1p, const bf16* q2p, const bf16* q3p, int lane) {
    Ql[0 * 64 + lane] = ldg8(q0p); Ql[1 * 64 + lane] = ldg8(q0p + 32); Ql[2 * 64 + lane] = ldg8(q1p); Ql[3 * 64 + lane] = ldg8(q1p + 32);
    Ql[4 * 64 + lane] = ldg8(q2p); Ql[5 * 64 + lane] = ldg8(q2p + 32); Ql[6 * 64 + lane] = ldg8(q3p); Ql[7 * 64 + lane] = ldg8(q3p + 32);
}
__device__ __forceinline__ void qk_scores(f32x4 (&Sv)[2][4], const KF& x, const LAS bf16x8* Ql, int lane) {
#pragma unroll
    for (int qb = 0; qb < 4; ++qb) { const bf16x8 q0 = Ql[(2 * qb) * 64 + lane], q1 = Ql[(2 * qb + 1) * 64 + lane];
#pragma unroll
        for (int h = 0; h < 2; ++h) { f32x4 a = mfma16(x.K[h][0], q0, (f32x4){0.f, 0.f, 0.f, 0.f}); Sv[h][qb] = mfma16(x.K[h][1], q1, a); } }
}
__device__ __forceinline__ void flash_init(Flash& S, float m0, float m1, float m2, float m3) {
#pragma unroll
    for (int db = 0; db < 4; ++db)
#pragma unroll
        for (int qb = 0; qb < 4; ++qb) S.O[db][qb] = (f32x4){0.f, 0.f, 0.f, 0.f};
    S.m = (f32x4){m0, m1, m2, m3}; S.l = (f32x4){0.f, 0.f, 0.f, 0.f};
}
__device__ __forceinline__ void flash_step(Flash& S, f32x4 (&Sv)[2][4], const VF& x, const f32x4 b0, const f32x4 bj, unsigned vm) {
    float sv[4][8]; float mxv[4]; bool grow = false;
#pragma unroll
    for (int qb = 0; qb < 4; ++qb) {
#pragma unroll
        for (int h = 0; h < 2; ++h)
#pragma unroll
            for (int r = 0; r < 4; ++r) { const int j = 4 * h + r; const float s2 = Sv[h][qb][r] * SC2 + (b0[qb] + bj[qb] * (float)j); sv[qb][j] = ((vm >> j) & 1u) ? s2 : -INFINITY; }
        float mx = fmaxf(fmaxf(fmaxf(sv[qb][0], sv[qb][1]), fmaxf(sv[qb][2], sv[qb][3])), fmaxf(fmaxf(sv[qb][4], sv[qb][5]), fmaxf(sv[qb][6], sv[qb][7])));
        mx = fmaxf(mx, __shfl_xor(mx, 16)); mx = fmaxf(mx, __shfl_xor(mx, 32));
        mxv[qb] = mx; grow = grow | (mx > S.m[qb] + 8.0f);
    }
    if (__any(grow)) {
#pragma unroll
        for (int qb = 0; qb < 4; ++qb) { const float mn = fmaxf(S.m[qb], mxv[qb]), al = ex2(S.m[qb] - mn); S.m[qb] = mn; S.l[qb] = S.l[qb] * al;
#pragma unroll
            for (int db = 0; db < 4; ++db) S.O[db][qb] = S.O[db][qb] * al; }
    }
    bf16x8 Pf[4];
#pragma unroll
    for (int qb = 0; qb < 4; ++qb) {
        float p[8];
#pragma unroll
        for (int j = 0; j < 8; ++j) p[j] = ex2(sv[qb][j] - S.m[qb]);
        S.l[qb] = S.l[qb] + (((p[0] + p[1]) + (p[2] + p[3])) + ((p[4] + p[5]) + (p[6] + p[7])));
        Pf[qb] = pack8(p[0], p[1], p[2], p[3], p[4], p[5], p[6], p[7]);
    }
#pragma unroll
    for (int db = 0; db < 4; ++db)
#pragma unroll
        for (int qb = 0; qb < 4; ++qb) S.O[db][qb] = mfma16(x.V[db], Pf[qb], S.O[db][qb]);
}
__device__ __forceinline__ float flash_inv(const Flash& S, int qb, bool has_sink, float sink2) {
    float lt = S.l[qb]; lt += __shfl_xor(lt, 16); lt += __shfl_xor(lt, 32);
    if (has_sink) lt += ex2(sink2 - S.m[qb]);
    return lt > 0.f ? 1.0f / lt : 0.f;
}
__device__ __forceinline__ float sigmoidf_(float x) { return 1.0f / (1.0f + __expf(-x)); }
__device__ __forceinline__ float slope2_of(int hidx) { return LOG2E * exp2f(-0.5f * (float)(hidx + 1)); }
#define ITER_FENCE() asm volatile("" ::: "memory")

template <int W, int MODE>
__device__ __forceinline__ void win_unit(Frame& F, int l, int b, int g, int q0) {
    const int lane = F.lane, c = lane & 15, kq = lane >> 4;
    const bf16* proj = (const bf16*)(wsp(F) + WS_PROJ); const bf16* vT = (const bf16*)(wsp(F) + WS_VT); bf16* ocat = (bf16*)(wsp(F) + WS_OCAT);
    constexpr int QOFF = MODE == 0 ? P_QA : P_QB, KOFF = MODE == 0 ? P_KA : P_KBW, VROW = MODE == 0 ? V_A : V_BW, OCOL = MODE == 0 ? 0 : 512, HBASE = MODE == 0 ? 0 : 8;
    LAS bf16x8* Ql = (LAS bf16x8*)(F.lds + F.wave * AW_BYTES + AW_Q);
    const size_t tb = (size_t)b * SEQ; const int t = q0 + c;
    { const bf16* qp = proj + (tb + t) * NPROJ + QOFF + g * 256 + kq * 8; q_park(Ql, qp, qp + 64, qp + 128, qp + 192, lane); }
    f32x4 sl2, sk2;
#pragma unroll
    for (int qb = 0; qb < 4; ++qb) { sl2[qb] = slope2_of(HBASE + g * 4 + qb); sk2[qb] = MODE == 0 ? inp(F, I_SINKS)[l * 8 + g * 4 + qb] * LOG2E : -1.0e30f; }
    Flash S; flash_init(S, sk2[0], sk2[1], sk2[2], sk2[3]);
    int klo = q0 - (W - 1); if (klo < 0) klo = 0; klo &= ~31;
    const int khi = (q0 + 15) & ~31;
    const bf16* Kb = proj + (tb + 8 * (c >> 2) + (c & 3)) * NPROJ + KOFF + g * 64 + kq * 8;
    const bf16* Vb = vT + (size_t)(VROW + g * 64 + c) * MTOK + tb + 8 * kq;
    KF cur, nxt; load_k(cur, Kb, NPROJ, khi);
    for (int kbase = khi; kbase >= klo; kbase -= 32) {
        ITER_FENCE();
        VF vf; load_v(vf, Vb, MTOK, kbase);
        load_k(nxt, Kb, NPROJ, kbase - 32 >= klo ? kbase - 32 : kbase);
        f32x4 Sv[2][4]; qk_scores(Sv, cur, Ql, lane);
        const int d0 = t - kbase - 8 * kq;
        const f32x4 b0 = sl2 * -(float)d0;
        unsigned vm = 0xffu;
        if (!(kbase + 31 <= q0 && kbase >= q0 + 16 - W)) { vm = 0u;
#pragma unroll
            for (int j = 0; j < 8; ++j) { const int dist = d0 - j; vm |= (dist >= 0 && dist < W) ? (1u << j) : 0u; } }
        flash_step(S, Sv, vf, b0, sl2, vm);
        cur = nxt;
    }
#pragma unroll
    for (int qb = 0; qb < 4; ++qb) { const float sc = flash_inv(S, qb, MODE == 0, sk2[qb]);
        bf16* op = ocat + (tb + t) * DM + OCOL + (g * 4 + qb) * 64 + 4 * kq;
#pragma unroll
        for (int db = 0; db < 4; ++db) { const f32x4 o = S.O[db][qb] * sc; v2u w; w.x = pk2(o[0], o[1]); w.y = pk2(o[2], o[3]); *(GAS v2u*)(op + 16 * db) = w; } }
}

constexpr float SB_EXIT_P = 1.0e-37f;
__device__ __forceinline__ void sb_unit(Frame& F, int b, int hc, int q0) {
    const int lane = F.lane, c = lane & 15, kq = lane >> 4;
    const bf16* proj = (const bf16*)(wsp(F) + WS_PROJ); const bf16* vT = (const bf16*)(wsp(F) + WS_VT); bf16* ocat = (bf16*)(wsp(F) + WS_OCAT);
    LAS bf16x8* Ql = (LAS bf16x8*)(F.lds + F.wave * AW_BYTES + AW_Q);
    const size_t tb = (size_t)b * SEQ;
    { const bf16* qp = proj + (tb + q0 + c) * NPROJ + P_QC + hc * 64 + kq * 8; q_park(Ql, qp, qp + (size_t)16 * NPROJ, qp + (size_t)32 * NPROJ, qp + (size_t)48 * NPROJ, lane); }
    f32x4 O[4][4]; float carry[4];
#pragma unroll
    for (int qb = 0; qb < 4; ++qb) { carry[qb] = 1.0f;
#pragma unroll
        for (int db = 0; db < 4; ++db) O[db][qb] = (f32x4){0.f, 0.f, 0.f, 0.f}; }
    const bf16* Kb = proj + (tb + 8 * (c >> 2) + (c & 3)) * NPROJ + P_KC + hc * 64 + kq * 8;
    const bf16* Vb = vT + (size_t)(V_C + hc * 64 + c) * MTOK + tb + 8 * kq;
    KF cur, nxt; load_k(cur, Kb, NPROJ, q0 + 32);
    for (int kbase = q0 + 32; kbase >= 0; kbase -= 32) {
        ITER_FENCE();
        VF vf; load_v(vf, Vb, MTOK, kbase);
        load_k(nxt, Kb, NPROJ, kbase >= 32 ? kbase - 32 : kbase);
        f32x4 Sv[2][4]; qk_scores(Sv, cur, Ql, lane);
        const bool diag = kbase + 31 >= q0;
        bf16x8 Pf[4];
#pragma unroll
        for (int qb = 0; qb < 4; ++qb) { const int lim = q0 + 16 * qb + c - kbase - 8 * kq;
            float om[8], sg[8];
#pragma unroll
            for (int h = 0; h < 2; ++h)
#pragma unroll
                for (int r = 0; r < 4; ++r) { const int j = 4 * h + r; const float e = ex2(fminf(Sv[h][qb][r] * SC2, 115.0f)), rr = __builtin_amdgcn_rcpf(1.0f + e);
                    om[j] = rr; sg[j] = e * rr;
                    if (diag) { const bool msk = j >= lim; om[j] = msk ? 1.0f : om[j]; sg[j] = msk ? 0.f : sg[j]; } }
            float ex_[8]; float run = 1.0f;
#pragma unroll
            for (int j = 7; j >= 0; --j) { ex_[j] = run; run *= om[j]; }
            const float t1 = __shfl_xor(run, 16), t2 = __shfl_xor(run, 32), t3 = __shfl_xor(run, 48);
            const float X = ((kq ^ 1) > kq ? t1 : 1.0f) * ((kq ^ 2) > kq ? t2 : 1.0f) * ((kq ^ 3) > kq ? t3 : 1.0f);
            const float base = carry[qb] * X;
            carry[qb] *= (run * t1) * (t2 * t3);
            Pf[qb] = pack8(sg[0] * (base * ex_[0]), sg[1] * (base * ex_[1]), sg[2] * (base * ex_[2]), sg[3] * (base * ex_[3]), sg[4] * (base * ex_[4]), sg[5] * (base * ex_[5]), sg[6] * (base * ex_[6]), sg[7] * (base * ex_[7])); }
#pragma unroll
        for (int db = 0; db < 4; ++db)
#pragma unroll
            for (int qb = 0; qb < 4; ++qb) O[db][qb] = mfma16(vf.V[db], Pf[qb], O[db][qb]);
        const bool fin = (carry[0] < SB_EXIT_P) && (carry[1] < SB_EXIT_P) && (carry[2] < SB_EXIT_P) && (carry[3] < SB_EXIT_P);
        if (__all(fin)) break;
        cur = nxt;
    }
#pragma unroll
    for (int qb = 0; qb < 4; ++qb) { bf16* op = ocat + (tb + q0 + 16 * qb + c) * DM + 1024 + hc * 64 + 4 * kq;
#pragma unroll
        for (int db = 0; db < 4; ++db) { const f32x4 o = O[db][qb]; v2u w; w.x = pk2(o[0], o[1]); w.y = pk2(o[2], o[3]); *(GAS v2u*)(op + 16 * db) = w; } }
}

__device__ __forceinline__ void gate_unit(Frame& F, int u) {
    const int lane = F.lane, c = lane & 15, kq = lane >> 4;
    const bf16* hrow = (const bf16*)(wsp(F) + WS_HB) + (size_t)(u * 16 + c) * DM + 8 * kq;
    const bf16* wg = (const bf16*)(wsp(F) + WS_WCMP + 1024 * 1024 + 64 * 1024) + (size_t)c * 2048 + 8 * kq;
    f32x4 a0 = (f32x4){0.f, 0.f, 0.f, 0.f}, a1 = (f32x4){0.f, 0.f, 0.f, 0.f};
#pragma unroll 8
    for (int ks = 0; ks < 64; ++ks) { const bf16x8 hf = ldg8(hrow + ks * 32); a0 = mfma16(ldg8(wg + ks * 32), hf, a0); a1 = mfma16(ldg8(wg + (size_t)16 * 2048 + ks * 32), hf, a1); }
    float* gp = (float*)(wsp(F) + WS_GBUF) + (size_t)(u * 16 + c) * 32 + 4 * kq;
    *(GAS f32x4*)gp = a0; *(GAS f32x4*)(gp + 16) = a1;
}

__device__ __forceinline__ float gelu_tanh(float x) { const float u = 0.7978845608028654f * (x + 0.044715f * x * x * x); const float e = __expf(2.0f * u); return 0.5f * x * (2.0f - 2.0f / (e + 1.0f)); }
__device__ __forceinline__ void cmp_mlp_unit(Frame& F, int l, int unit) {
    const int lane = F.lane, c = lane & 15, kq = lane >> 4;
    const int nt = unit & 31, g = (unit >> 5) & 1, b = (unit >> 6) & 1, kv = unit >> 7;
    const bf16* proj = (const bf16*)(wsp(F) + WS_PROJ);
    const bf16* W1t = (const bf16*)(wsp(F) + WS_WCMP) + (size_t)kv * 128 * 2048; const bf16* W2t = (const bf16*)(wsp(F) + WS_WCMP + 2 * 128 * 2048 * 2) + (size_t)kv * 64 * 128;
    const float* pe = inp(F, kv ? I_PEV : I_PEK) + (size_t)l * 32 * 64;
    const int n = nt * 16 + c; const size_t tb = (size_t)b * SEQ; const int xoff = (kv ? P_VBC : P_KBC) + g * 64;
    LAS f32x4* red = (LAS f32x4*)(F.lds);
    f32x4 H[4][2];
#pragma unroll
    for (int s = 0; s < 4; ++s) { H[s][0] = (f32x4){0.f, 0.f, 0.f, 0.f}; H[s][1] = (f32x4){0.f, 0.f, 0.f, 0.f}; }
#pragma unroll 2
    for (int kk = 0; kk < 8; ++kk) {
        const int ks = F.wave * 8 + kk, lt = ks >> 1, d0 = (ks & 1) * 32 + 8 * kq; int tok = 16 * n + lt; if (tok > SEQ - 1) tok = SEQ - 1;
        const bf16x8 xr = ldg8(proj + (tb + tok) * NPROJ + xoff + d0);
        const f32x4 p0 = *(const GAS f32x4*)(pe + lt * 64 + d0), p1 = *(const GAS f32x4*)(pe + lt * 64 + d0 + 4);
        const bf16x8 Xf = pack8(bf2f((unsigned short)xr[0]) + p0[0], bf2f((unsigned short)xr[1]) + p0[1], bf2f((unsigned short)xr[2]) + p0[2], bf2f((unsigned short)xr[3]) + p0[3],
                                bf2f((unsigned short)xr[4]) + p1[0], bf2f((unsigned short)xr[5]) + p1[1], bf2f((unsigned short)xr[6]) + p1[2], bf2f((unsigned short)xr[7]) + p1[3]);
#pragma unroll
        for (int s = 0; s < 4; ++s)
#pragma unroll
            for (int h = 0; h < 2; ++h) { const int hid = 32 * s + 8 * (c >> 2) + 4 * h + (c & 3);
                H[s][h] = mfma16(ldg8(W1t + (size_t)hid * 2048 + ks * 32 + 8 * kq), Xf, H[s][h]); }
    }
#pragma unroll
    for (int s = 0; s < 4; ++s)
#pragma unroll
        for (int h = 0; h < 2; ++h) red[(F.wave * 8 + s * 2 + h) * 64 + lane] = H[s][h];
    __syncthreads();
    if (F.wave == 0) {
#pragma unroll
        for (int s = 0; s < 4; ++s)
#pragma unroll
            for (int h = 0; h < 2; ++h) { f32x4 a = red[(s * 2 + h) * 64 + lane];
#pragma unroll
                for (int w = 1; w < 8; ++w) a += red[(w * 8 + s * 2 + h) * 64 + lane];
                H[s][h] = a; }
        f32x4 Y[4];
#pragma unroll
        for (int eb = 0; eb < 4; ++eb) Y[eb] = (f32x4){0.f, 0.f, 0.f, 0.f};
#pragma unroll
        for (int s = 0; s < 4; ++s) {
            const bf16x8 Hf = pack8(gelu_tanh(H[s][0][0]), gelu_tanh(H[s][0][1]), gelu_tanh(H[s][0][2]), gelu_tanh(H[s][0][3]), gelu_tanh(H[s][1][0]), gelu_tanh(H[s][1][1]), gelu_tanh(H[s][1][2]), gelu_tanh(H[s][1][3]));
#pragma unroll
            for (int eb = 0; eb < 4; ++eb) Y[eb] = mfma16(ldg8(W2t + (size_t)(16 * eb + c) * 128 + 32 * s + 8 * kq), Hf, Y[eb]);
        }
        const bool valid = n <= 510;
        if (kv == 0) { bf16* kc = (bf16*)(wsp(F) + WS_SMALL + SM_KCMP) + ((size_t)(b * 2 + g) * 512 + n) * 64 + 4 * kq;
#pragma unroll
            for (int eb = 0; eb < 4; ++eb) { v2u w; w.x = valid ? pk2(Y[eb][0], Y[eb][1]) : 0u; w.y = valid ? pk2(Y[eb][2], Y[eb][3]) : 0u; *(GAS v2u*)(kc + 16 * eb) = w; } }
        else { bf16* vc = (bf16*)(wsp(F) + WS_SMALL + SM_VCMPT) + (size_t)(b * 2 + g) * 64 * 512 + n;
#pragma unroll
            for (int eb = 0; eb < 4; ++eb)
#pragma unroll
                for (int r = 0; r < 4; ++r) vc[(size_t)(16 * eb + 4 * kq + r) * 512] = valid ? (bf16)f2bf(Y[eb][r]) : (bf16)0; }
    }
    __syncthreads();
}

__device__ __forceinline__ int next_below(unsigned long long ulo, unsigned long long uhi, int j) {
    if (j > 64) { const unsigned long long m = (j >= 128) ? uhi : (uhi & ((1ull << (j - 64)) - 1ull)); if (m) return 127 - __builtin_clzll(m); j = 64; }
    const unsigned long long m = (j >= 64) ? ulo : (ulo & ((1ull << j) - 1ull));
    return m ? 63 - __builtin_clzll(m) : -1;
}
__device__ __forceinline__ void nsa_unit(Frame& F, int b, int g, int q0) {
    const int lane = F.lane, c = lane & 15, kq = lane >> 4;
    const bf16* proj = (const bf16*)(wsp(F) + WS_PROJ); const bf16* vT = (const bf16*)(wsp(F) + WS_VT); bf16* ocat = (bf16*)(wsp(F) + WS_OCAT);
    const bf16* kcmp = (const bf16*)(wsp(F) + WS_SMALL + SM_KCMP) + (size_t)(b * 2 + g) * 512 * 64;
    const bf16* vcmpT = (const bf16*)(wsp(F) + WS_SMALL + SM_VCMPT) + (size_t)(b * 2 + g) * 64 * 512;
    LAS float* imp = (LAS float*)(F.lds + F.wave * AW_BYTES + AW_IMP);
    LAS unsigned* selm = (LAS unsigned*)(F.lds + F.wave * AW_BYTES + AW_SEL);
    LAS bf16x8* Ql = (LAS bf16x8*)(F.lds + F.wave * AW_BYTES + AW_Q);
    const size_t tb = (size_t)b * SEQ; const int t = q0 + c;
    const float* grow = (const float*)(wsp(F) + WS_GBUF) + (tb + t) * 32 + g * 12;
    { const bf16* qp = proj + (tb + t) * NPROJ + P_QB + g * 256 + kq * 8; q_park(Ql, qp, qp + 64, qp + 128, qp + 192, lane); }
    f32x4 sl2;
#pragma unroll
    for (int qb = 0; qb < 4; ++qb) sl2[qb] = slope2_of(8 + g * 4 + qb);
    const f32x4 sl2c = sl2 * 16.0f;
    for (int i = lane; i < 16 * IMP_STRIDE; i += 64) imp[i] = 0.f;
    const int tmax = q0 + 15; const int nmax = tmax >= 31 ? ((tmax - 31) >> 4) : -1; const int ntop = nmax & ~31;
    const bf16* Kc = kcmp + (size_t)(8 * (c >> 2) + (c & 3)) * 64 + kq * 8;
    const bf16* Vc = vcmpT + (size_t)c * 512 + 8 * kq;
    Flash S; flash_init(S, -1.0e30f, -1.0e30f, -1.0e30f, -1.0e30f);
    KF cur, nxt;
    if (nmax >= 0) {
        load_k(cur, Kc, 64, ntop);
        for (int nbase = ntop; nbase >= 0; nbase -= 32) {
            ITER_FENCE();
            VF vf; load_v(vf, Vc, 512, nbase);
            load_k(nxt, Kc, 64, nbase >= 32 ? nbase - 32 : nbase);
            f32x4 Sv[2][4]; qk_scores(Sv, cur, Ql, lane);
            const int d0 = t - 31 - 16 * (nbase + 8 * kq);
            const f32x4 b0 = sl2 * -(float)d0;
            unsigned vm = 0xffu;
            if (!(16 * (nbase + 31) + 31 <= q0)) { vm = 0u;
#pragma unroll
                for (int j = 0; j < 8; ++j) vm |= (d0 - 16 * j >= 0) ? (1u << j) : 0u; }
            flash_step(S, Sv, vf, b0, sl2c, vm);
            cur = nxt;
        }
    }
    f32x4 inv;
#pragma unroll
    for (int qb = 0; qb < 4; ++qb) { inv[qb] = flash_inv(S, qb, false, 0.f);
        const float g0 = sigmoidf_(grow[qb * 3 + 0]), g2 = sigmoidf_(grow[qb * 3 + 2]), sc = inv[qb] * g0;
        bf16* op = ocat + (tb + t) * DM + 512 + (g * 4 + qb) * 64 + 4 * kq;
#pragma unroll
        for (int db = 0; db < 4; ++db) { const v2u ow = *(const GAS v2u*)(op + 16 * db); const f32x4 old = (f32x4){bflo(ow.x), bfhi(ow.x), bflo(ow.y), bfhi(ow.y)};
            const f32x4 o = old * g2 + S.O[db][qb] * sc; v2u w; w.x = pk2(o[0], o[1]); w.y = pk2(o[2], o[3]); *(GAS v2u*)(op + 16 * db) = w; } }
    LDS_WAIT();
    for (int nbase = 0; nbase <= nmax; nbase += 32) {
        ITER_FENCE();
        const bf16* kp = Kc + (size_t)nbase * 64;
        KF x; x.K[0][0] = ldg8(kp); x.K[0][1] = ldg8(kp + 32); x.K[1][0] = ldg8(kp + 4 * 64); x.K[1][1] = ldg8(kp + 4 * 64 + 32);
        f32x4 Sv[2][4]; qk_scores(Sv, x, Ql, lane);
        float G[2], Wl[2];
#pragma unroll
        for (int h = 0; h < 2; ++h) { float gs = 0.f, last = 0.f;
#pragma unroll
            for (int r = 0; r < 4; ++r) { const int dist = t - 16 * (nbase + 8 * kq + 4 * h + r) - 31; const bool vis = dist >= 0; const float fd = (float)dist; float pv = 0.f;
#pragma unroll
                for (int qb = 0; qb < 4; ++qb) pv += vis ? ex2(Sv[h][qb][r] * SC2 - sl2[qb] * fd - S.m[qb]) * inv[qb] : 0.f;
                gs += pv; last = pv; }
            G[h] = gs; Wl[h] = last; }
        const int j0 = (nbase >> 2) + 2 * kq;
        LAS float* ip = imp + c * IMP_STRIDE + j0;
        ip[0] += G[0]; LDS_WAIT();
        ip[1] += G[1]; LDS_WAIT();
        ip[1] += Wl[0]; LDS_WAIT();
        ip[2] += Wl[1]; LDS_WAIT();
    }
    unsigned long long ulo = 0ull, uhi = 0ull, ilo = ~0ull, ihi = ~0ull;
    for (int cq = 0; cq < 16; ++cq) {
        const int tq = q0 + cq, cur_ = tq >> 6;
        const int ja = lane, jb = lane + 64;
        const bool oka = ja <= cur_, okb = jb <= cur_;
        unsigned ka = 0u, kb = 0u;
        if (oka) ka = (ja == 0 || ja == cur_ || ja == cur_ - 1) ? 0x461c4000u : __builtin_bit_cast(unsigned, imp[cq * IMP_STRIDE + ja]) + 1u;
        if (okb) kb = (jb == cur_ || jb == cur_ - 1) ? 0x461c4000u : __builtin_bit_cast(unsigned, imp[cq * IMP_STRIDE + jb]) + 1u;
        unsigned long long mlo, mhi;
        if (cur_ < 16) { mlo = __ballot(oka); mhi = 0ull; }
        else {
            unsigned thr = 0u;
#pragma unroll 1
            for (int bit = 30; bit >= 0; --bit) { const unsigned tr = thr | (1u << bit);
                const int cntv = __popcll(__ballot(ka >= tr)) + __popcll(__ballot(kb >= tr)); if (cntv >= 16) thr = tr; }
            mlo = __ballot(ka > thr); mhi = __ballot(kb > thr);
            int need = 16 - (__popcll(mlo) + __popcll(mhi));
            unsigned long long elo = __ballot(ka == thr), ehi = __ballot(kb == thr);
            while (need > 0 && elo) { const unsigned long long bsel = elo & (~elo + 1ull); mlo |= bsel; elo ^= bsel; --need; }
            while (need > 0 && ehi) { const unsigned long long bsel = ehi & (~ehi + 1ull); mhi |= bsel; ehi ^= bsel; --need; }
        }
        ulo |= mlo; uhi |= mhi; ilo &= mlo; ihi &= mhi;
        if (lane == 0) { selm[cq * 4 + 0] = (unsigned)mlo; selm[cq * 4 + 1] = (unsigned)(mlo >> 32); selm[cq * 4 + 2] = (unsigned)mhi; selm[cq * 4 + 3] = (unsigned)(mhi >> 32); }
    }
    LDS_WAIT();
    const unsigned long long mylo = (unsigned long long)selm[c * 4 + 0] | ((unsigned long long)selm[c * 4 + 1] << 32);
    const unsigned long long myhi = (unsigned long long)selm[c * 4 + 2] | ((unsigned long long)selm[c * 4 + 3] << 32);
    flash_init(S, -1.0e30f, -1.0e30f, -1.0e30f, -1.0e30f);
    const bf16* Kb = proj + (tb + 8 * (c >> 2) + (c & 3)) * NPROJ + P_KBS + g * 64 + kq * 8;
    const bf16* Vb = vT + (size_t)(V_BS + g * 64 + c) * MTOK + tb + 8 * kq;
    int j = next_below(ulo, uhi, (tmax >> 6) + 1), hs = 1;
    load_k(cur, Kb, NPROJ, 64 * j + 32);
    while (j >= 0) {
        ITER_FENCE();
        const int kbase = 64 * j + 32 * hs;
        VF vf; load_v(vf, Vb, MTOK, kbase);
        int jn = j, hn = 0; if (hs == 0) { jn = next_below(ulo, uhi, j); hn = 1; }
        load_k(nxt, Kb, NPROJ, jn >= 0 ? 64 * jn + 32 * hn : kbase);
        const bool mine = j < 64 ? ((mylo >> j) & 1ull) != 0ull : ((myhi >> (j - 64)) & 1ull) != 0ull;
        const bool all16 = j < 64 ? ((ilo >> j) & 1ull) != 0ull : ((ihi >> (j - 64)) & 1ull) != 0ull;
        f32x4 Sv[2][4]; qk_scores(Sv, cur, Ql, lane);
        const int d0 = t - kbase - 8 * kq;
        const f32x4 b0 = sl2 * -(float)d0;
        unsigned vm = 0xffu;
        if (!(all16 && kbase + 31 <= q0)) { vm = 0u;
#pragma unroll
            for (int jj = 0; jj < 8; ++jj) vm |= (mine && d0 - jj >= 0) ? (1u << jj) : 0u; }
        flash_step(S, Sv, vf, b0, sl2, vm);
        cur = nxt; j = jn; hs = hn;
    }
#pragma unroll
    for (int qb = 0; qb < 4; ++qb) { const float sc = flash_inv(S, qb, false, 0.f) * sigmoidf_(grow[qb * 3 + 1]);
        bf16* op = ocat + (tb + t) * DM + 512 + (g * 4 + qb) * 64 + 4 * kq;
#pragma unroll
        for (int db = 0; db < 4; ++db) { const v2u ow = *(const GAS v2u*)(op + 16 * db); const f32x4 old = (f32x4){bflo(ow.x), bfhi(ow.x), bflo(ow.y), bfhi(ow.y)};
            const f32x4 o = old + S.O[db][qb] * sc; v2u w; w.x = pk2(o[0], o[1]); w.y = pk2(o[2], o[3]); *(GAS v2u*)(op + 16 * db) = w; } }
    LDS_WAIT();
}

__device__ __forceinline__ void attn1_phase(Frame& F, int l) {
    const int gw = F.vcu * NWAVES + F.wave, NGW = F.G * NWAVES;
    LAS unsigned* scr = (LAS unsigned*)(F.lds + F.wave * AW_BYTES);
    for (int u = F.vcu; u < 256; u += F.G) cmp_mlp_unit(F, l, u);
    if (F.wave >= 4) convert_range(F, l, CV_SMALL0, CV_GU1, scr);
    else for (int u = F.wave * F.G + F.vcu; u < MTOK / 16; u += 4 * F.G) gate_unit(F, u);
    for (int u = gw; u < 2048; u += NGW) win_unit<512, 1>(F, l, u >> 10, (u >> 9) & 1, (u & 511) * 16);
    for (int u = gw; u < 4096; u += NGW) sb_unit(F, u >> 11, (u >> 7) & 15, (u & 127) * 64);
    for (int u = gw; u < 2048; u += NGW) win_unit<128, 0>(F, l, u >> 10, (u >> 9) & 1, (u & 511) * 16);
    if (F.wave < 4) convert_range(F, l, CV_SMALL0, CV_GU1, scr);
}
__device__ __forceinline__ void attn2_phase(Frame& F, int l) {
    const int gw = F.vcu * NWAVES + F.wave, NGW = F.G * NWAVES;
    LAS unsigned* scr = (LAS unsigned*)(F.lds + F.wave * AW_BYTES);
    if (F.wave >= 4) convert_range(F, l, CV_GU1, CV_DN1, scr);
    for (int u = gw; u < 2048; u += NGW) nsa_unit(F, u >> 10, (u >> 9) & 1, (u & 511) * 16);
    if (F.wave < 4) convert_range(F, l, CV_GU1, CV_DN1, scr);
}
#ifndef MK_ONE_LAUNCH
#define MK_ONE_LAUNCH 1
#endif
#ifndef PHASE_MASK
#define PHASE_MASK 0xFFFF
#endif
constexpr int N_PHASES = 2 + 10 * DEPTH;
struct Args { const float* in[25]; float* out; unsigned char* ws; };
#define IN(k) (LO <= (k) && (k) < HI)
#define SEAM(k) do { if constexpr (IN(k) && IN((k) + 1)) xcd_barrier(bar); asm volatile("" : "+v"(F.tid), "+v"(F.lane) :: "memory"); } while (0)
#ifndef DBL_MASK
#define DBL_MASK 0
#endif
#define FENCE() asm volatile("" : "+v"(F.tid), "+v"(F.lane) :: "memory")
#define PHASE(k, bit, ...) do { if constexpr (IN(k) && (PHASE_MASK & (bit))) { __VA_ARGS__ if constexpr ((DBL_MASK & (bit)) != 0) { xcd_barrier(bar); FENCE(); __VA_ARGS__ } } } while (0)
template <int L, int LO, int HI>
__device__ __forceinline__ void layer_phases(Frame& F, const XcdBarrier& bar) {
    constexpr int l = L, pb = 2 + 10 * L;
    PHASE(pb + 0, 4, {
        pg8::Gemm g{(const pg8::bf16_t*)(wsp(F) + WS_HB), (const pg8::bf16_t*)(wsp(F) + WS_WIN), MTOK, NIN, DM}; pg8::StaticOrder S; S.init(MTOK, NIN, F.G, (int)blockIdx.x);
        pg8::EpiProj E{(pg8::bf16_t*)(wsp(F) + WS_PROJ), (pg8::bf16_t*)(wsp(F) + WS_VT), NPROJ, MTOK};
        pg8::gemm_phase<pg8::EpiProj, pg8::StaticOrder, true, true>(F.lds + RING_OFF, g, S, E);
    });
    SEAM(pb + 0);
    PHASE(pb + 1, 8, { attn1_phase(F, l); });
    SEAM(pb + 1);
    PHASE(pb + 2, 16, { attn2_phase(F, l); });
    if constexpr ((DBL_MASK & 0x10000) != 0) { xcd_barrier(bar); FENCE(); attn1_phase(F, l); xcd_barrier(bar); FENCE(); attn2_phase(F, l); }
    SEAM(pb + 2);
    PHASE(pb + 3, 32, { merge_phase(F, l); });
    SEAM(pb + 3);
    PHASE(pb + 4, 64, {
        pg8::Gemm g{(const pg8::bf16_t*)(wsp(F) + WS_HB), (const pg8::bf16_t*)(wsp(F) + WS_WOUT), MTOK, DM, DM}; pg8::StaticOrder S; S.init(MTOK, DM, F.G, (int)blockIdx.x);
        const float* g1p = (const float*)(wsp(F) + WS_MOD) + (size_t)l * NB * 6 * DM + 2 * DM;
        if constexpr (l == 0) { pg8::EpiResid<false> E{(const void*)inp(F, I_X), (pg8::bf16_t*)(wsp(F) + WS_XA), g1p, 6 * DM, SEQ, DM, ALPHA};
            pg8::gemm_phase<pg8::EpiResid<false>, pg8::StaticOrder, true, true>(F.lds + RING_OFF, g, S, E); }
        else { pg8::EpiResid<true> E{(const void*)(wsp(F) + WS_XB), (pg8::bf16_t*)(wsp(F) + WS_XA), g1p, 6 * DM, SEQ, DM, ALPHA};
            pg8::gemm_phase<pg8::EpiResid<true>, pg8::StaticOrder, true, true>(F.lds + RING_OFF, g, S, E); }
    });
    SEAM(pb + 4);
    PHASE(pb + 5, 128, { post_mixer_phase(F, l); });
    if constexpr (IN(pb + 5)) { if constexpr (HI - LO > 1) xcd_barrier(bar); FENCE(); router_phase(F, l); }
    SEAM(pb + 5);
    PHASE(pb + 7, 512, {
        moe_tables(F, l);
        const PG8_LAS_T int* tab = (const PG8_LAS_T int*)(F.lds + TAB_OFF);
        pg8::Gemm g{(const pg8::bf16_t*)(wsp(F) + WS_HB), (const pg8::bf16_t*)(wsp(F) + WS_WGU), MAXROWS, NEXP * 1024, DM};
        pg8::MoeOrder S{4, F.G, (int)blockIdx.x, tab};
        pg8::EpiSwiGLU E{(pg8::bf16_t*)(wsp(F) + WS_HID), DEXP};
        pg8::MoeGather GA{tab, (const int*)(wsp(F) + WS_LIST), MTOK, (unsigned)(DM * 2), 0u};
        pg8::gemm_phase<pg8::EpiSwiGLU, pg8::MoeOrder, true, true, pg8::MoeGather>(F.lds + RING_OFF, g, S, E, GA);
    });
    SEAM(pb + 7);
    PHASE(pb + 8, 1024, {
        moe_tables(F, l);
        const PG8_LAS_T int* tab = (const PG8_LAS_T int*)(F.lds + TAB_OFF);
        pg8::Gemm g{(const pg8::bf16_t*)(wsp(F) + WS_HID), (const pg8::bf16_t*)(wsp(F) + WS_WD), MAXROWS, NEXP * DM, DEXP};
        pg8::MoeOrder S{8, F.G, (int)blockIdx.x, tab};
        pg8::EpiDown E{(pg8::bf16_t*)(wsp(F) + WS_YS), DM, tab, (const int*)(wsp(F) + WS_LIST), MTOK, (const float*)(wsp(F) + WS_SMALL + SM_GATEW)};
        pg8::gemm_phase<pg8::EpiDown, pg8::MoeOrder, true, true>(F.lds + RING_OFF, g, S, E);
    });
    SEAM(pb + 8);
    PHASE(pb + 9, 2048, { post_moe_phase(F, l, (l == DEPTH - 1) ? outp(F) : (float*)nullptr, (bf16*)(wsp(F) + WS_XB), l < DEPTH - 1); });
    PHASE(pb + 9, 4096, { if (l < DEPTH - 1) convert_small(F, l + 1); });
    SEAM(pb + 9);
}
template <int LO, int HI>
__global__ void __launch_bounds__(NWAVES * 64, 2) fwd_kernel(Args args) {
    extern __shared__ __attribute__((aligned(16))) unsigned char lds[];
    Frame F;
    F.lds = (LAS unsigned char*)lds;
    F.MISC = (volatile LAS unsigned*)(F.lds + MISC_OFF);
    F.tid = threadIdx.x; F.lane = F.tid & 63; F.wave = __builtin_amdgcn_readfirstlane(F.tid >> 6);
    F.G = gridDim.x; { const int bx = blockIdx.x; F.vcu = (F.G % 8 == 0) ? (bx % 8) * (F.G / 8) + bx / 8 : bx; }
    for (int u = F.tid; u < (LDS_BYTES - LDSCTL_OFF) / 4; u += NWAVES * 64) ((LAS unsigned*)(F.lds + LDSCTL_OFF))[u] = 0u;
    __syncthreads();
    if (F.tid < 25) ((LAS unsigned long long*)(F.lds + PTR_OFF))[F.tid] = (unsigned long long)args.in[F.tid];
    if (F.tid == 25) ((LAS unsigned long long*)(F.lds + PTR_OFF))[25] = (unsigned long long)args.ws;
    if (F.tid == 26) ((LAS unsigned long long*)(F.lds + PTR_OFF))[26] = (unsigned long long)args.out;
    __syncthreads();
    XcdBarrier bar; bar.bar = (unsigned*)(ctlp(F) + CW_BAR); bar.x = 0; bar.st = nullptr;
    if constexpr (HI - LO > 1) bar = xcd_barrier_post((unsigned*)(ctlp(F) + CW_BAR), F.MISC + 8);
    PHASE(0, 1, { ada_phase(F); });
    PHASE(0, 4096, { __syncthreads(); convert_small(F, 0); });
    SEAM(0);
    PHASE(1, 2, { ln_in_phase(F); });
    SEAM(1);
    layer_phases<0, LO, HI>(F, bar);
    layer_phases<1, LO, HI>(F, bar);
}
#undef IN
#undef SEAM
#undef PHASE

#if MK_ONE_LAUNCH
#define FWD_MAIN (fwd_kernel<0, N_PHASES>)
static bool set_lds_attr() { return hipFuncSetAttribute((const void*)FWD_MAIN, hipFuncAttributeMaxDynamicSharedMemorySize, LDS_BYTES) == hipSuccess; }
#else
#define FWD_MAIN (fwd_kernel<0, 1>)
template <int... P> static bool set_lds_attr_seq(std::integer_sequence<int, P...>) { bool ok = true; ((ok = ok && hipFuncSetAttribute((const void*)(fwd_kernel<P, P + 1>), hipFuncAttributeMaxDynamicSharedMemorySize, LDS_BYTES) == hipSuccess), ...); return ok; }
static bool set_lds_attr() { return set_lds_attr_seq(std::make_integer_sequence<int, N_PHASES>{}); }
template <int P> static void launch_one(int grid, hipStream_t stream, const Args& a) { hipLaunchKernelGGL((fwd_kernel<P, P + 1>), dim3(grid), dim3(NWAVES * 64), LDS_BYTES, stream, a); }
template <int... P> static void launch_phases(std::integer_sequence<int, P...>, int grid, hipStream_t stream, const Args& a) { (launch_one<P>(grid, stream, a), ...); }
#endif
extern "C" void kernel_launch(void* const* d_in, const int* in_sizes, int n_in, void* d_out, int out_size, void* d_ws, size_t ws_size, hipStream_t stream) {
    static int grid = 0;
    if (grid == 0) {
        if (n_in != 25 || out_size != MTOK * DM || ws_size < WS_END) { fprintf(stderr, "kernel_launch: unexpected problem shape (n_in %d, out %d, ws %zu)\n", n_in, out_size, ws_size); grid = -1; return; }
        int dev = 0, cus = 0, per_cu = 0;
        if (hipGetDevice(&dev) != hipSuccess || hipDeviceGetAttribute(&cus, hipDeviceAttributeMultiprocessorCount, dev) != hipSuccess) { grid = -1; return; }
        if (!set_lds_attr()) { fprintf(stderr, "kernel_launch: hipFuncSetAttribute failed\n"); grid = -1; return; }
        if (hipOccupancyMaxActiveBlocksPerMultiprocessor(&per_cu, (const void*)FWD_MAIN, NWAVES * 64, LDS_BYTES) != hipSuccess || per_cu < 1)
            fprintf(stderr, "kernel_launch: note: occupancy query reports %d workgroups per CU\n", per_cu);
        (void)hipGetLastError();
        grid = cus;
        if (grid > 256) grid = 256;
        grid &= ~7;
    }
    if (grid <= 0) return;
    (void)in_sizes;
    if (hipMemsetAsync((char*)d_ws + WS_CTL, 0, CTL_ZERO_BYTES, stream) != hipSuccess) return;
    Args a{};
    for (int i = 0; i < 25; ++i) a.in[i] = (const float*)d_in[i];
    a.out = (float*)d_out; a.ws = (unsigned char*)d_ws;
#if MK_ONE_LAUNCH
    hipLaunchKernelGGL((fwd_kernel<0, N_PHASES>), dim3(grid), dim3(NWAVES * 64), LDS_BYTES, stream, a);
#else
    launch_phases(std::make_integer_sequence<int, N_PHASES>{}, grid, stream, a);
#endif
}
```

```cpp
#include <hip/hip_runtime.h>
#include <cstdio>
#include <cstdint>
#include <utility>
#define MK_ONE_LAUNCH 1
namespace pg8 {
#define PG8_LAS __attribute__((address_space(3)))
#define PG8_LAS_T __attribute__((address_space(3)))
typedef unsigned short bf16_t;
typedef short bf16x8 __attribute__((ext_vector_type(8)));
typedef float f32x4 __attribute__((ext_vector_type(4)));
typedef unsigned u32x4 __attribute__((ext_vector_type(4)));
constexpr int BM = 256, BK = 64, HALF = 128, HTB = HALF * BK * 2  , STAGE_BYTES = 8 * HTB, NXCD = 8, WGM = 8;

__host__ __device__ __forceinline__ int lds_byte(int r, int c) { const int st = (r >> 4) * 2 + (c >> 5), rr = r & 15, cc = c & 31, ob = rr * 64 + cc * 2; return st * 1024 + (ob ^ (((ob >> 9) & 1) << 5)); }
__host__ __device__ __forceinline__ void stage_rc(int b, int& R, int& C) { const int st = b / 1024, sb = b % 1024, swz = sb ^ (((sb >> 9) & 1) << 5); R = (st >> 1) * 16 + swz / 64; C = (st & 1) * 32 + (swz % 64) / 2; }
__host__ __device__ __forceinline__ int perm32(int rho) { const int n = rho >> 4, i = rho & 15; return 8 * (i >> 2) + 4 * n + (i & 3); }

struct Unit { int pm, pn; };
struct Gemm { const bf16_t* A; const bf16_t* Bt; int M, N, K; };

struct StaticOrder {
    int nM, nN, nwg, G, c;
    __host__ __device__ void init(int M, int N, int G_, int c_) { nM = M / BM; nN = N / BM; nwg = nM * nN; G = G_; c = c_; }
    __host__ __device__ bool next(int i, Unit& u) const {
        const long L = (long)i * G + c; if (L >= nwg) return false;
        int wgid = (int)L; { const int q = nwg / NXCD, r = nwg % NXCD, xcd = wgid % NXCD, off = wgid / NXCD; wgid = (xcd < r ? xcd * (q + 1) : r * (q + 1) + (xcd - r) * q) + off; }
        const int nig = WGM * nN, gid = wgid / nig, fm = gid * WGM, gsz = (nM - fm) < WGM ? (nM - fm) : WGM;
        u.pm = fm + ((wgid % nig) % gsz); u.pn = (wgid % nig) / gsz; return true;
    }
    __device__ __forceinline__ void a_ready(const Unit&) const {}
    __device__ __forceinline__ void done(const Unit&) const {}
};
__device__ __forceinline__ unsigned cvt_pk_bf16(float lo, float hi) { unsigned r; asm volatile("s_nop 0\n\tv_cvt_pk_bf16_f32 %0, %1, %2\n\ts_nop 1" : "=v"(r) : "v"(lo), "v"(hi));     return r; }
typedef float f32x2 __attribute__((ext_vector_type(2)));
__device__ __forceinline__ unsigned short f2bf_rne(float f) { unsigned u = __builtin_bit_cast(unsigned, f); return (unsigned short)((u + 0x7fffu + ((u >> 16) & 1u)) >> 16); }

struct EpiProj {
    static constexpr bool PERM = true, AFTER_DRAIN = false;
    bf16_t* P; bf16_t* VT; int ldp; int ldvt;
    __device__ __forceinline__ void operator()(const f32x4 (&acc)[2][2][4][2], const Unit& u, int wr, int wc, int fr, int fq) const {
        const int row0 = u.pm * BM + wr * 64 + fr;
#pragma unroll
        for (int bj = 0; bj < 2; ++bj) {
            const int cb = u.pn * BM + bj * HALF;
            if (cb < ldp) {
                bf16_t* colp = P + (size_t)row0 * ldp + cb + wc * 32 + 8 * fq;
#pragma unroll
                for (int ai = 0; ai < 2; ++ai)
#pragma unroll
                    for (int m = 0; m < 4; ++m) { const f32x4 v0 = acc[ai][bj][m][0], v1 = acc[ai][bj][m][1];
                        u32x4 w; w.x = cvt_pk_bf16(v0[0], v0[1]); w.y = cvt_pk_bf16(v0[2], v0[3]); w.z = cvt_pk_bf16(v1[0], v1[1]); w.w = cvt_pk_bf16(v1[2], v1[3]);
                        *(u32x4*)(colp + (size_t)(ai * HALF + m * 16) * ldp) = w; }
            } else {
                const int c0 = cb - ldp + wc * 32 + 8 * fq;
#pragma unroll
                for (int n = 0; n < 2; ++n)
#pragma unroll
                    for (int e = 0; e < 4; ++e) { bf16_t* cp = VT + (size_t)(c0 + n * 4 + e) * ldvt + row0;
#pragma unroll
                        for (int ai = 0; ai < 2; ++ai)
#pragma unroll
                            for (int m = 0; m < 4; ++m) cp[ai * HALF + m * 16] = f2bf_rne(acc[ai][bj][m][n][e]); }
            }
        }
    }
};

template <bool XBF> struct EpiResid {
    static constexpr bool PERM = true, AFTER_DRAIN = false;
    const void* xin; bf16_t* out; const float* gate0; int gate_bstride; int rows_per_batch; int ldc; float alpha;
    __device__ __forceinline__ void operator()(const f32x4 (&acc)[2][2][4][2], const Unit& u, int wr, int wc, int fr, int fq) const {
        const int col0 = u.pn * BM + wc * 32 + 8 * fq;
        const float* gv = gate0 + (size_t)((u.pm * BM) / rows_per_batch) * gate_bstride;
#pragma unroll
        for (int bj = 0; bj < 2; ++bj) { const int c = col0 + bj * HALF; const f32x4 g0 = *(const f32x4*)(gv + c) + 1.0f, g1 = *(const f32x4*)(gv + c + 4) + 1.0f;
#pragma unroll
            for (int ai = 0; ai < 2; ++ai)
#pragma unroll
                for (int m = 0; m < 4; ++m) { const size_t off = (size_t)(u.pm * BM + ai * HALF + wr * 64 + m * 16 + fr) * ldc + c;
                    if (m & 1) asm volatile("" ::: "memory");
                    f32x4 x0, x1;
                    if (XBF) { const u32x4 xw = *(const u32x4*)((const bf16_t*)xin + off);
                        x0 = (f32x4){__builtin_bit_cast(float, xw.x << 16), __builtin_bit_cast(float, xw.x & 0xffff0000u), __builtin_bit_cast(float, xw.y << 16), __builtin_bit_cast(float, xw.y & 0xffff0000u)};
                        x1 = (f32x4){__builtin_bit_cast(float, xw.z << 16), __builtin_bit_cast(float, xw.z & 0xffff0000u), __builtin_bit_cast(float, xw.w << 16), __builtin_bit_cast(float, xw.w & 0xffff0000u)}; }
                    else { x0 = *(const f32x4*)((const float*)xin + off); x1 = *(const f32x4*)((const float*)xin + off + 4); }
                    const f32x4 v0 = x0 * alpha + g0 * acc[ai][bj][m][0], v1 = x1 * alpha + g1 * acc[ai][bj][m][1];
                    u32x4 w; w.x = cvt_pk_bf16(v0[0], v0[1]); w.y = cvt_pk_bf16(v0[2], v0[3]); w.z = cvt_pk_bf16(v1[0], v1[1]); w.w = cvt_pk_bf16(v1[2], v1[3]);
                    *(u32x4*)(out + off) = w; } }
    }
};

struct EpiSwiGLU {
    static constexpr bool PERM = true, AFTER_DRAIN = false;
    bf16_t* H; int ldh;
    __device__ __forceinline__ void operator()(const f32x4 (&acc)[2][2][4][2], const Unit& u, int wr, int wc, int fr, int fq) const {
        const int row0 = u.pm * BM + wr * 64 + fr, pnl = u.pn & 3;
        const int j0 = pnl * 128 + wc * 16 + 4 * fq;
#pragma unroll
        for (int ai = 0; ai < 2; ++ai)
#pragma unroll
            for (int m = 0; m < 4; ++m) { bf16_t* rowp = H + (size_t)(row0 + ai * HALF + m * 16) * ldh + j0;
#pragma unroll
                for (int bj = 0; bj < 2; ++bj) { const f32x4 v0 = acc[ai][bj][m][0], v1 = acc[ai][bj][m][1];
                    const float h0 = v0[0] / (1.0f + __expf(-v0[0])) * v0[1], h1 = v0[2] / (1.0f + __expf(-v0[2])) * v0[3];
                    const float h2 = v1[0] / (1.0f + __expf(-v1[0])) * v1[1], h3 = v1[2] / (1.0f + __expf(-v1[2])) * v1[3];
                    typedef unsigned u32x2 __attribute__((ext_vector_type(2)));
                    u32x2 w; w.x = cvt_pk_bf16(h0, h1); w.y = cvt_pk_bf16(h2, h3);
                    *(u32x2*)(rowp + bj * 64) = w; } }
    }
};

__device__ __forceinline__ int moe_row_aid(const PG8_LAS int* tab, const int* list, int list_stride, int rt, int row_in_tile) {
    const int e = tab[64 + rt], pos = rt * 256 + row_in_tile - tab[32 + e];
    return pos < tab[e] ? list[(size_t)e * list_stride + pos] : -1;
}
struct MoeGather {
    static constexpr bool ON = true;
    const PG8_LAS int* tab; const int* list; int list_stride; unsigned row_bytes, zero_off;
    __device__ __forceinline__ unsigned row_off(const Unit& u, int h, int r) const { const int aid = moe_row_aid(tab, list, list_stride, u.pm, h * HALF + r); return aid >= 0 ? (unsigned)(aid >> 1) * row_bytes : zero_off; }
};

struct EpiDown {
    static constexpr bool PERM = true, AFTER_DRAIN = false;
    bf16_t* Y; int ldy; const PG8_LAS int* tab; const int* list; int list_stride; const float* gatew;
    __device__ __forceinline__ void operator()(const f32x4 (&acc)[2][2][4][2], const Unit& u, int wr, int wc, int fr, int fq) const {
        const int pnl = u.pn & 7;
        const int col0 = pnl * BM + wc * 32 + 8 * fq;
#pragma unroll
        for (int ai = 0; ai < 2; ++ai)
#pragma unroll
            for (int m = 0; m < 4; ++m) { const int aid = moe_row_aid(tab, list, list_stride, u.pm, wr * 64 + fr + ai * HALF + m * 16);
                if (aid >= 0) { const float gw = gatew[aid]; bf16_t* rowp = Y + (size_t)aid * ldy + col0;
#pragma unroll
                    for (int bj = 0; bj < 2; ++bj) { const f32x4 v0 = acc[ai][bj][m][0] * gw, v1 = acc[ai][bj][m][1] * gw;
                        u32x4 w; w.x = cvt_pk_bf16(v0[0], v0[1]); w.y = cvt_pk_bf16(v0[2], v0[3]); w.z = cvt_pk_bf16(v1[0], v1[1]); w.w = cvt_pk_bf16(v1[2], v1[3]);
                        *(u32x4*)(rowp + bj * HALF) = w; } } }
    }
};

struct MoeOrder {
    int NT, G, c; const PG8_LAS int* tab;
    __device__ __forceinline__ bool next(int i, Unit& u) const {
        const int x = c & 7, ci = c >> 3, per = G >> 3;
        const int q = i * per + ci, rt = x + 8 * (q / NT);
        if (rt >= tab[224]) return false;
        u.pm = rt; u.pn = tab[64 + rt] * NT + (q % NT); return true;
    }
    __device__ __forceinline__ void a_ready(const Unit&) const {}
    __device__ __forceinline__ void done(const Unit&) const {}
};

struct GroupScale {
    static constexpr bool ON = true; static constexpr int T1 = 8, T2 = 16;
    const float* ssq; PG8_LAS float* base; float eps;
    __device__ __forceinline__ const PG8_LAS float* tab(int buf) const { return base + buf * 768; }
    __device__ __forceinline__ void announce(const Unit& u, int buf) const {
        const int tid = threadIdx.x, row = tid >> 1, half = tid & 1;
        const f32x4* p = (const f32x4*)(ssq + (size_t)(u.pm * BM + row) * 32 + half * 16);
        const f32x4 a = p[0], b = p[1], c = p[2], d = p[3];
        const float s01 = (a[0] + a[1]) + (a[2] + a[3]) + (b[0] + b[1]) + (b[2] + b[3]), s23 = (c[0] + c[1]) + (c[2] + c[3]) + (d[0] + d[1]) + (d[2] + d[3]);
        const float o01 = __shfl_xor(s01, 1), o23 = __shfl_xor(s23, 1);
        const float sA = half == 0 ? s01 : o01, sB = half == 0 ? s23 : o23, sC = half == 0 ? (o01 + o23) : (s01 + s23);
        const float mA = sA * (1.0f / 512.0f) + eps, mB = sB * (1.0f / 512.0f) + eps, mC = sC * (1.0f / 1024.0f) + eps;
        PG8_LAS float* t = base + buf * 768 + 3 * row;
        if (half == 0) { t[0] = sqrtf(mB / mA); t[1] = sqrtf(mC / mB); }
        else t[2] = 1.0f / sqrtf(mC);
    }
};
struct NoGather { static constexpr bool ON = false; __device__ __forceinline__ unsigned row_off(const Unit&, int, int) const { return 0u; } };
struct NoKScale { static constexpr bool ON = false; static constexpr int T1 = 0, T2 = 0; __device__ __forceinline__ void announce(const Unit&, int) const {} __device__ __forceinline__ const PG8_LAS float* tab(int) const { return nullptr; } };
template <class Epi, class Sched, bool ALIGN_EPI = false, bool SP2 = false, class Gat = NoGather, class KSc = NoKScale>
__device__ __forceinline__ void gemm_phase(PG8_LAS unsigned char* lds, const Gemm g, const Sched& S, const Epi& E, const Gat& GA = Gat(), const KSc& KS = KSc()) {
    static_assert(!Gat::ON || SP2, "the gathered A operand is wired into the SP2 loop only");
    int tid_ = threadIdx.x; asm volatile("" : "+v"(tid_));
    const int tid = tid_, wid = __builtin_amdgcn_readfirstlane(tid >> 6), lane = tid & 63, wr = wid >> 2, wc = wid & 3, fr = lane & 15, fq = lane >> 4;
    const int K = g.K, nt = K / BK;
    unsigned voffA[2], voffB[2];
    int RA[2]; unsigned CA2[2];
#pragma unroll
    for (int i = 0; i < 2; ++i) { int R, C; stage_rc(tid * 16 + i * 8192, R, C); const int Rb = Epi::PERM ? ((R & ~31) + perm32(R & 31)) : R;
        voffA[i] = (unsigned)(R * K + C) * 2u; voffB[i] = (unsigned)(Rb * K + C) * 2u; RA[i] = R; CA2[i] = (unsigned)C * 2u; }
    unsigned gcu[2][2] = {{0u, 0u}, {0u, 0u}}, gnx[2][2] = {{0u, 0u}, {0u, 0u}};
    const size_t kstep = (size_t)(BK * 2);
    const size_t hstep = (size_t)HALF * K * 2;
    const size_t tstep = 2 * hstep;
    const unsigned ldsw = (unsigned)wid * 1024u;
    const int aoff = lds_byte(wr * 64 + fr, fq * 8), boff = lds_byte(wc * 32 + fr, fq * 8);
#define PG8_SA(b, h) (((b) * 2 + (h)) * HTB)
#define PG8_SB(b, h) ((4 + (b) * 2 + (h)) * HTB)
#define PG8_STAGE(bufoff, gbase, voff) do { _Pragma("unroll") for (int _i = 0; _i < 2; ++_i) \
        __builtin_amdgcn_global_load_lds((const unsigned*)((const char*)(gbase) + (voff)[_i]), (PG8_LAS unsigned*)(lds + (bufoff) + ldsw + _i * 8192), 16, 0, 0); } while (0)
#define PG8_STAGE_A(b, h, ptr, isnext) do { if constexpr (Gat::ON) { const bool _nx = (isnext); unsigned _tv[2] = {_nx ? gnx[h][0] : gcu[h][0], _nx ? gnx[h][1] : gcu[h][1]}; PG8_STAGE(PG8_SA(b, h), ptr, _tv); } \
        else { PG8_STAGE(PG8_SA(b, h), (ptr) + (h) * hstep, voffA); } } while (0)
#define PG8_LDA(dst, b, h) do { _Pragma("unroll") for (int m = 0; m < 4; ++m) _Pragma("unroll") for (int k = 0; k < 2; ++k) dst[m][k] = *(const PG8_LAS bf16x8*)(lds + PG8_SA(b, h) + aoff + m * 2048 + k * 1024); } while (0)
#define PG8_LDB(dst, b, h) do { _Pragma("unroll") for (int n = 0; n < 2; ++n) _Pragma("unroll") for (int k = 0; k < 2; ++k) dst[n][k] = *(const PG8_LAS bf16x8*)(lds + PG8_SB(b, h) + boff + n * 2048 + k * 1024); } while (0)
#define PG8_MMA(ai, bj, At, Bt) do { __builtin_amdgcn_s_setprio(1); _Pragma("unroll") for (int m = 0; m < 4; ++m) _Pragma("unroll") for (int n = 0; n < 2; ++n) _Pragma("unroll") for (int k = 0; k < 2; ++k) \
        acc[ai][bj][m][n] = __builtin_amdgcn_mfma_f32_16x16x32_bf16(Bt[n][k], At[m][k], acc[ai][bj][m][n], 0, 0, 0); __builtin_amdgcn_s_setprio(0); } while (0)
#define PG8_WAIT_V(n) asm volatile("s_waitcnt vmcnt(" #n ")" ::: "memory")
#define PG8_WAIT_L(n) asm volatile("s_waitcnt lgkmcnt(" #n ")" ::: "memory")
#define PG8_BAR __builtin_amdgcn_s_barrier()
#define PG8_SCHED __builtin_amdgcn_sched_barrier(0)
    Unit cur, nxt; int ui = 0;
    if (!S.next(0, cur)) return;
    f32x4 acc[2][2][4][2];
#pragma unroll
    for (int a = 0; a < 2; ++a)
#pragma unroll
        for (int b = 0; b < 2; ++b)
#pragma unroll
            for (int m = 0; m < 4; ++m)
#pragma unroll
                for (int n = 0; n < 2; ++n) acc[a][b][m][n] = (f32x4){0.f, 0.f, 0.f, 0.f};
    bf16x8 At[4][2], B0[2][2], B1[2][2];
#define PG8_KSCALE(buf, which) do { const PG8_LAS float* _tb = KS.tab(buf); _Pragma("unroll") for (int _a = 0; _a < 2; ++_a) _Pragma("unroll") for (int _m = 0; _m < 4; ++_m) { \
        const PG8_LAS float* _r = _tb + 3 * (_a * HALF + wr * 64 + _m * 16 + fr); const float _f = _r[which]; \
        _Pragma("unroll") for (int _b = 0; _b < 2; ++_b) _Pragma("unroll") for (int _n = 0; _n < 2; ++_n) acc[_a][_b][_m][_n] = acc[_a][_b][_m][_n] * _f; } } while (0)
    const char* cA = (const char*)g.A + (Gat::ON ? (size_t)0 : (size_t)cur.pm * tstep); const char* cB = (const char*)g.Bt + (size_t)cur.pn * tstep;
    if constexpr (Gat::ON) {
#pragma unroll
        for (int h = 0; h < 2; ++h)
#pragma unroll
            for (int i = 0; i < 2; ++i) { gcu[h][i] = GA.row_off(cur, h, RA[i]) + CA2[i]; gnx[h][i] = gcu[h][i]; } }
    if constexpr (KSc::ON) KS.announce(cur, 0);
    S.a_ready(cur);
    if constexpr (SP2) {
        PG8_STAGE(PG8_SB(0, 0), cB, voffB); PG8_STAGE(PG8_SB(0, 1), cB + hstep, voffB); PG8_STAGE_A(0, 0, cA, false); PG8_STAGE_A(0, 1, cA, false);
        if (wr == 1) PG8_BAR;
        PG8_WAIT_V(2); PG8_BAR;
        PG8_STAGE(PG8_SB(1, 0), cB + kstep, voffB); PG8_STAGE_A(1, 0, cA + kstep, false); PG8_STAGE(PG8_SB(1, 1), cB + hstep + kstep, voffB);
        PG8_WAIT_V(6); PG8_BAR;
    } else {
        PG8_STAGE(PG8_SB(0, 0), cB, voffB); PG8_STAGE(PG8_SA(0, 0), cA, voffA); PG8_STAGE(PG8_SB(0, 1), cB + hstep, voffB); PG8_STAGE(PG8_SA(0, 1), cA + hstep, voffA);
        if (wr == 1) PG8_BAR;
        PG8_WAIT_V(4); PG8_BAR;
        PG8_STAGE(PG8_SB(1, 0), cB + kstep, voffB); PG8_STAGE(PG8_SA(1, 0), cA + kstep, voffA); PG8_STAGE(PG8_SB(1, 1), cB + hstep + kstep, voffB);
        PG8_WAIT_V(6); PG8_BAR;
    }
    for (;;) {
        const bool has_next = S.next(ui + 1, nxt);
        if constexpr (KSc::ON) { if (has_next) KS.announce(nxt, (ui + 1) % 3); }
        const char* nA = (has_next && !Gat::ON) ? (const char*)g.A + (size_t)nxt.pm * tstep : cA; const char* nB = has_next ? (const char*)g.Bt + (size_t)nxt.pn * tstep : cB;
        if constexpr (Gat::ON) { if (has_next) {
#pragma unroll
            for (int h = 0; h < 2; ++h)
#pragma unroll
                for (int i = 0; i < 2; ++i) gnx[h][i] = GA.row_off(nxt, h, RA[i]) + CA2[i]; } }
        int t = 0;
        for (int seg = 0; seg < (KSc::ON ? 3 : 1); ++seg) {
        const int thi = !KSc::ON ? nt : (seg == 0 ? KSc::T1 : (seg == 1 ? KSc::T2 : nt));
        for (; t < thi; t += 2) {
            const bool last = (t == nt - 2);
            const char* a1 = cA + (size_t)(t + 1) * kstep;
            const char* a2 = last ? nA : cA + (size_t)(t + 2) * kstep; const char* b2 = last ? nB : cB + (size_t)(t + 2) * kstep;
            const char* a3 = a2 + kstep; const char* b3 = b2 + kstep;
            if (last && has_next) S.a_ready(nxt);
            if constexpr (SP2) {
            PG8_LDB(B0, 0, 0); PG8_LDB(B1, 0, 1); PG8_SCHED; PG8_LDA(At, 0, 0); PG8_STAGE_A(1, 1, a1, false);
            PG8_WAIT_V(8); PG8_WAIT_L(0); PG8_BAR; PG8_MMA(0, 0, At, B0); PG8_MMA(0, 1, At, B1); PG8_BAR; PG8_SCHED;
            PG8_LDA(At, 0, 1); PG8_STAGE(PG8_SB(0, 0), b2, voffB); PG8_STAGE(PG8_SB(0, 1), b2 + hstep, voffB); PG8_STAGE_A(0, 0, a2, last);
            PG8_WAIT_V(8); PG8_WAIT_L(0); PG8_BAR; PG8_MMA(1, 0, At, B0); PG8_MMA(1, 1, At, B1); PG8_BAR; PG8_SCHED;
            PG8_LDB(B0, 1, 0); PG8_LDB(B1, 1, 1); PG8_SCHED; PG8_LDA(At, 1, 0); PG8_STAGE_A(0, 1, a2, last);
            PG8_WAIT_V(8); PG8_WAIT_L(0); PG8_BAR; PG8_MMA(0, 0, At, B0); PG8_MMA(0, 1, At, B1); PG8_BAR; PG8_SCHED;
            PG8_LDA(At, 1, 1); PG8_STAGE(PG8_SB(1, 0), b3, voffB); PG8_STAGE(PG8_SB(1, 1), b3 + hstep, voffB); PG8_STAGE_A(1, 0, a3, last);
            PG8_WAIT_V(8); PG8_WAIT_L(0); PG8_BAR; PG8_MMA(1, 0, At, B0); PG8_MMA(1, 1, At, B1); PG8_BAR; PG8_SCHED;
            } else {
            PG8_LDB(B0, 0, 0); PG8_SCHED; PG8_LDA(At, 0, 0); PG8_STAGE(PG8_SA(1, 1), a1 + hstep, voffA);
            PG8_WAIT_L(8); PG8_BAR; PG8_WAIT_L(0); PG8_MMA(0, 0, At, B0); PG8_BAR; PG8_SCHED;
            PG8_LDB(B1, 0, 1); PG8_STAGE(PG8_SB(0, 0), b2, voffB);
            PG8_BAR; PG8_WAIT_L(0); PG8_MMA(0, 1, At, B1); PG8_BAR;
            PG8_LDA(At, 0, 1); PG8_STAGE(PG8_SA(0, 0), a2, voffA);
            PG8_BAR; PG8_WAIT_L(0); PG8_MMA(1, 0, At, B0); PG8_BAR; PG8_SCHED;
            PG8_STAGE(PG8_SB(0, 1), b2 + hstep, voffB);
            PG8_WAIT_V(6); PG8_BAR; PG8_MMA(1, 1, At, B1); PG8_BAR;
            PG8_LDB(B0, 1, 0); PG8_SCHED; PG8_LDA(At, 1, 0); PG8_STAGE(PG8_SA(0, 1), a2 + hstep, voffA);
            PG8_WAIT_L(8); PG8_BAR; PG8_WAIT_L(0); PG8_MMA(0, 0, At, B0); PG8_BAR; PG8_SCHED;
            PG8_LDB(B1, 1, 1); PG8_STAGE(PG8_SB(1, 0), b3, voffB);
            PG8_BAR; PG8_WAIT_L(0); PG8_MMA(0, 1, At, B1); PG8_BAR;
            PG8_LDA(At, 1, 1); PG8_STAGE(PG8_SA(1, 0), a3, voffA);
            PG8_BAR; PG8_WAIT_L(0); PG8_MMA(1, 0, At, B0); PG8_BAR; PG8_SCHED;
            PG8_STAGE(PG8_SB(1, 1), b3 + hstep, voffB);
            PG8_WAIT_V(6); PG8_BAR; PG8_MMA(1, 1, At, B1); PG8_BAR;
            }
        }
        if constexpr (KSc::ON) { if (seg < 2) { asm volatile("" ::: "memory"); __builtin_amdgcn_sched_barrier(0); PG8_KSCALE(ui % 3, seg); __builtin_amdgcn_sched_barrier(0); asm volatile("" ::: "memory"); } }
        }
        if constexpr (ALIGN_EPI) { if (wr == 0) PG8_BAR; }
        if constexpr (KSc::ON) { asm volatile("" ::: "memory"); __builtin_amdgcn_sched_barrier(0); PG8_KSCALE(ui % 3, 2); __builtin_amdgcn_sched_barrier(0); }
        if constexpr (!Epi::AFTER_DRAIN) { E(acc, cur, wr, wc, fr, fq); S.done(cur); }
        if (!has_next) break;
#pragma unroll
        for (int a = 0; a < 2; ++a)
#pragma unroll
            for (int b = 0; b < 2; ++b)
#pragma unroll
                for (int m = 0; m < 4; ++m)
#pragma unroll
                    for (int n = 0; n < 2; ++n) acc[a][b][m][n] = (f32x4){0.f, 0.f, 0.f, 0.f};
        cur = nxt; cA = nA; cB = nB; ++ui;
        if constexpr (Gat::ON) {
#pragma unroll
            for (int h = 0; h < 2; ++h) { gcu[h][0] = gnx[h][0]; gcu[h][1] = gnx[h][1]; } }
        if constexpr (ALIGN_EPI) { if (wr == 1) PG8_BAR; }
    }
    PG8_WAIT_V(0);
    if constexpr (!ALIGN_EPI) { if (wr == 0) PG8_BAR; }
    PG8_BAR;
    if constexpr (Epi::AFTER_DRAIN) { E.fused(acc, cur, wr, wc, fr, fq, lds, wid, lane); S.done(cur); }
#undef PG8_SA
#undef PG8_SB
#undef PG8_STAGE
#undef PG8_KSCALE
#undef PG8_STAGE_A
#undef PG8_LDA
#undef PG8_LDB
#undef PG8_MMA
#undef PG8_WAIT_V
#undef PG8_WAIT_L
#undef PG8_BAR
#undef PG8_SCHED
}
}
constexpr int NWAVES = 8;
constexpr int NB = 2, SEQ = 8192, DM = 2048, MTOK = NB * SEQ, DEPTH = 2, HD = 64;
constexpr int NEXP = 32, DEXP = 512, NASSIGN = MTOK * 2;
constexpr int D_IN = 5144;
constexpr int NPROJ = 3712, NVT = 1408, NIN = NPROJ + NVT;
constexpr int P_QA = 0, P_KA = 512, P_QB = 640, P_KBC = 1152, P_VBC = 1280, P_KBS = 1408, P_KBW = 1536, P_QC = 1664, P_KC = 2688;
constexpr int V_C = 0, V_A = 1024, V_BS = 1152, V_BW = 1280;
constexpr float LN_EPS = 1e-5f, RMS_EPS = 1e-6f, ALPHA = 1.41421356237309515f;
constexpr float LOG2E = 1.44269504088896341f, LN2 = 0.693147180559945309f;
constexpr float SC2 = 0.125f * LOG2E;
constexpr int MAXROWS = 40960;
constexpr float SB_EXIT = -104.0f;

constexpr size_t MiB = 1u << 20;
constexpr size_t WS_CTL = 0, CTL_ZERO_BYTES = 1 * MiB;
constexpr size_t WS_MOD = 1 * MiB;
constexpr size_t WS_SMALL = 2 * MiB;
constexpr size_t WS_LIST = 5 * MiB;
constexpr size_t WS_WCMP = 7 * MiB;
constexpr size_t WS_WIN = 9 * MiB;
constexpr size_t WS_WOUT = 30 * MiB;
constexpr size_t WS_WGU = 38 * MiB;
constexpr size_t WS_WD = 166 * MiB;
constexpr size_t WS_XA = 230 * MiB;
constexpr size_t WS_XB = 358 * MiB;
constexpr size_t WS_HB = 486 * MiB;
constexpr size_t WS_PROJ = 550 * MiB;
constexpr size_t WS_VT = WS_PROJ + (size_t)MTOK * NPROJ * 2;
constexpr size_t WS_XS = WS_PROJ;
constexpr size_t WS_OCAT = 720 * MiB;
constexpr size_t WS_YS = WS_OCAT;
constexpr size_t WS_HID = 848 * MiB;
constexpr size_t WS_SSQ = 888 * MiB;
constexpr size_t WS_END = 890 * MiB;
static_assert(WS_VT + (size_t)NVT * MTOK * 2 <= WS_OCAT && WS_XS + (size_t)MAXROWS * DM * 2 <= WS_OCAT, "proj/vT/xs region");
static_assert(WS_WIN + (size_t)NIN * DM * 2 <= WS_WOUT && WS_WGU + (size_t)NEXP * 1024 * DM * 2 <= WS_WD && WS_WD + (size_t)NEXP * DM * DEXP * 2 <= WS_XA, "weight regions");
constexpr size_t SM_KCMP = 0;
constexpr size_t SM_VCMPT = 256 * 1024;
constexpr size_t SM_GATEW = 512 * 1024;
constexpr size_t SM_ROWINFO = 640 * 1024;
constexpr size_t SM_TILE = 800 * 1024;
constexpr size_t WS_GBUF = WS_SMALL + 1024 * 1024;
constexpr int CW_BAR = 4096;
constexpr int CW_CNT = 16384;

constexpr int RING_OFF = 0, RING_BYTES = 131072;
constexpr int TAB_OFF = RING_BYTES;
constexpr int GSC_OFF = RING_BYTES + 1024;
constexpr int LDSCTL_OFF = 143360, MISC_OFF = LDSCTL_OFF + 320;
constexpr int LDS_BYTES = 147456;

#define GAS __attribute__((address_space(1)))
#define LAS __attribute__((address_space(3)))
typedef unsigned short bf16;
typedef unsigned v4u __attribute__((ext_vector_type(4)));
typedef unsigned v2u __attribute__((ext_vector_type(2)));
typedef float f32x4 __attribute__((ext_vector_type(4)));
typedef short bf16x8 __attribute__((ext_vector_type(8)));
typedef GAS unsigned gu32;
#define RLX_AGENT __ATOMIC_RELAXED, __HIP_MEMORY_SCOPE_AGENT
#define LDS_WAIT() asm volatile("s_waitcnt lgkmcnt(0)" ::: "memory")
#define VM_WAIT() asm volatile("s_waitcnt vmcnt(0)" ::: "memory")
__device__ __forceinline__ unsigned f2bf(float f) { unsigned u = __builtin_bit_cast(unsigned, f); return (u + 0x7fffu + ((u >> 16) & 1u)) >> 16; }
__device__ __forceinline__ unsigned pk2(float lo, float hi) { return f2bf(lo) | (f2bf(hi) << 16); }
__device__ __forceinline__ float bf2f(unsigned short h) { return __builtin_bit_cast(float, (unsigned)h << 16); }
__device__ __forceinline__ float bflo(unsigned w) { return __builtin_bit_cast(float, w << 16); }
__device__ __forceinline__ float bfhi(unsigned w) { return __builtin_bit_cast(float, w & 0xffff0000u); }
__device__ __forceinline__ float ex2(float x) { return __builtin_amdgcn_exp2f(x); }
__device__ __forceinline__ float lg2(float x) { return __builtin_amdgcn_logf(x); }
__device__ __forceinline__ bf16x8 ldg8(const bf16* p) { return *(const GAS bf16x8*)p; }
__device__ __forceinline__ f32x4 mfma16(bf16x8 a, bf16x8 b, f32x4 c) { return __builtin_amdgcn_mfma_f32_16x16x32_bf16(a, b, c, 0, 0, 0); }
__device__ __forceinline__ bf16x8 pack8(float a0, float a1, float a2, float a3, float a4, float a5, float a6, float a7) {
    v4u w; w.x = pg8::cvt_pk_bf16(a0, a1); w.y = pg8::cvt_pk_bf16(a2, a3); w.z = pg8::cvt_pk_bf16(a4, a5); w.w = pg8::cvt_pk_bf16(a6, a7);
    return __builtin_bit_cast(bf16x8, w);
}
__device__ __forceinline__ float wave_sum(float v) {
#pragma unroll
    for (int o = 1; o < 64; o <<= 1) v += __shfl_xor(v, o);
    return v;
}
#define XB_TMO      128
#define XB_XCNT(j)  (256  + 64 * (j))
#define XB_XSUB(j)  (1280 + 64 * (j))
#define XB_XGEN(j)  (2304 + 64 * (j))
#define XB_TOP      3328
#define XB_TOPGEN   3392
#define XCD_BAR_WORDS 3456
#define XB_SPIN_CAP (1u << 18)

__device__ __forceinline__ unsigned xb_ld(unsigned* p)              { return __hip_atomic_load(p, __ATOMIC_RELAXED, __HIP_MEMORY_SCOPE_AGENT); }
__device__ __forceinline__ unsigned xb_add(unsigned* p, unsigned v) { return __hip_atomic_fetch_add(p, v, __ATOMIC_RELAXED, __HIP_MEMORY_SCOPE_AGENT); }
__device__ __forceinline__ unsigned xb_xcc_id() { return (unsigned)__builtin_amdgcn_s_getreg((3 << 11) | 20) & 0xFu; }
#define XB_SPIN(cond, bar) do { unsigned _sp = 0; while (cond) { __builtin_amdgcn_s_sleep(1); \
    if ((++_sp & 255u) == 0u) { if (xb_ld(&(bar)[XB_TMO])) break; if (_sp > XB_SPIN_CAP) { atomicAdd(&(bar)[XB_TMO], 1u); break; } } } } while (0)

struct XcdBarrier {
    unsigned* bar; unsigned x;
    volatile LAS unsigned* st;
};

__device__ __forceinline__ XcdBarrier xcd_barrier_post(unsigned* bar, volatile LAS unsigned* st) {
    XcdBarrier b; b.bar = bar; b.x = xb_xcc_id(); b.st = st;
    if (threadIdx.x == 0) (void)xb_add(&bar[XB_XCNT(b.x)], 1u);
    return b;
}
__device__ __forceinline__ void xcd_barrier_complete(unsigned* bar, unsigned x, unsigned& nloc, unsigned& nx) {
    const unsigned G = gridDim.x * gridDim.y * gridDim.z;
    unsigned sum, cnt, mine, sp = 0u;
    for (;;) {
        sum = 0u; cnt = 0u; mine = 0u;
#pragma unroll
        for (unsigned j = 0; j < 16; ++j) { const unsigned c = xb_ld(&bar[XB_XCNT(j)]); sum += c; cnt += (c > 0u) ? 1u : 0u; mine = (j == x) ? c : mine; }
        if (sum == G) break;
        __builtin_amdgcn_s_sleep(1);
        if ((++sp & 255u) == 0u) { if (xb_ld(&bar[XB_TMO])) break; if (sp > XB_SPIN_CAP) { atomicAdd(&bar[XB_TMO], 1u); break; } }
    }
    nloc = mine > 0u ? mine : 1u; nx = cnt > 0u ? cnt : 1u;
}

__device__ __forceinline__ void xcd_barrier(const XcdBarrier& b) {
    asm volatile("s_waitcnt vmcnt(0)" ::: "memory");
    __syncthreads();
    if (threadIdx.x == 0) {
        unsigned* bar = b.bar;
        __builtin_amdgcn_s_waitcnt(0);
        unsigned nloc = b.st[0], nx = b.st[1];
        if (nloc == 0u) { xcd_barrier_complete(bar, b.x, nloc, nx); b.st[0] = nloc; b.st[1] = nx; }
        const unsigned old = xb_add(&bar[XB_XSUB(b.x)], 1u);
        const unsigned gen = old / nloc;
        if (old + 1u == (gen + 1u) * nloc) {
            __builtin_amdgcn_fence(__ATOMIC_RELEASE, "agent");
            asm volatile("s_waitcnt vmcnt(0)" ::: "memory");
            const unsigned og = xb_add(&bar[XB_TOP], 1u);
            const unsigned tg = og / nx;
            if (og + 1u == (tg + 1u) * nx) xb_add(&bar[XB_TOPGEN], 1u);
            else XB_SPIN(xb_ld(&bar[XB_TOPGEN]) == tg, bar);
            __builtin_amdgcn_fence(__ATOMIC_ACQUIRE, "agent");
            xb_add(&bar[XB_XGEN(b.x)], 1u);
            asm volatile("s_waitcnt vmcnt(0)" ::: "memory");
        } else {
            XB_SPIN(xb_ld(&bar[XB_XGEN(b.x)]) == gen, bar);
            __builtin_amdgcn_fence(__ATOMIC_ACQUIRE, "agent");
            asm volatile("s_waitcnt vmcnt(0)" ::: "memory");
        }
    }
    __syncthreads();
}
struct Frame {
    LAS unsigned char* lds;
    volatile LAS unsigned* MISC;
    int tid, lane, wave;
    int vcu, G;
};
constexpr int PTR_OFF = LDSCTL_OFF + 1024;
__device__ __forceinline__ unsigned char* tabp(const Frame& F, int i) {
    const unsigned long long v = ((LAS unsigned long long*)(F.lds + PTR_OFF))[i];
    const unsigned lo = __builtin_amdgcn_readfirstlane((unsigned)v), hi = __builtin_amdgcn_readfirstlane((unsigned)(v >> 32));
    return (unsigned char*)(((unsigned long long)hi << 32) | lo);
}
__device__ __forceinline__ const float* inp(const Frame& F, int i) { return (const float*)tabp(F, i); }
__device__ __forceinline__ unsigned char* wsp(const Frame& F) { return tabp(F, 25); }
__device__ __forceinline__ float* outp(const Frame& F) { return (float*)tabp(F, 26); }
__device__ __forceinline__ gu32* ctlp(const Frame& F) { return (gu32*)(tabp(F, 25) + WS_CTL); }
enum { I_X = 0, I_C, I_WADA, I_BADA, I_WIN, I_SINKS, I_PEK, I_W1K, I_W2K, I_PEV, I_W1V, I_W2V, I_MIXG, I_WOUT, I_LN1G, I_LN1B, I_WRG, I_BRG, I_WRE, I_BRE, I_WGATE, I_WUP, I_WDOWN, I_LN2G, I_LN2B };

__device__ __forceinline__ void ada_phase(Frame& F) {
    LAS float* cs = (LAS float*)(F.lds + 73728);
    LAS float* red = (LAS float*)(F.lds + 73728 + 16384);
    const float* c = inp(F, I_C);
    for (int i = F.tid; i < NB * DM; i += NWAVES * 64) { const float v = c[i]; cs[i] = v / (1.0f + __expf(-v)); }
    __syncthreads();
    float* mod = (float*)(wsp(F) + WS_MOD);
    for (int u = F.vcu; u < DEPTH * 96; u += F.G) {
        const int l = u / 96, cb = u % 96, col = cb * 128 + 2 * F.lane;
        const float* W = inp(F, I_WADA) + (size_t)l * DM * (6 * DM) + col;
        float a00 = 0.f, a01 = 0.f, a10 = 0.f, a11 = 0.f;
        const int k0 = F.wave * 256;
#pragma unroll 8
        for (int kk = 0; kk < 256; ++kk) { const int k = k0 + kk; typedef float f32x2_ __attribute__((ext_vector_type(2))); const f32x2_ w = *(const GAS f32x2_*)(W + (size_t)k * (6 * DM));
            const float s0 = cs[k], s1 = cs[DM + k]; a00 += s0 * w.x; a01 += s0 * w.y; a10 += s1 * w.x; a11 += s1 * w.y; }
        red[(F.wave * 2 + 0) * 128 + 2 * F.lane] = a00; red[(F.wave * 2 + 0) * 128 + 2 * F.lane + 1] = a01;
        red[(F.wave * 2 + 1) * 128 + 2 * F.lane] = a10; red[(F.wave * 2 + 1) * 128 + 2 * F.lane + 1] = a11;
        __syncthreads();
        if (F.tid < 256) { const int b = F.tid >> 7, j = F.tid & 127; float s = 0.f;
#pragma unroll
            for (int w = 0; w < 8; ++w) s += red[(w * 2 + b) * 128 + j];
            mod[((size_t)l * NB + b) * (6 * DM) + cb * 128 + j] = s + inp(F, I_BADA)[(size_t)l * 6 * DM + cb * 128 + j]; }
        __syncthreads();
    }
}

__device__ __forceinline__ void tr_item(const float* W, int ldw, int K, bf16* WT, size_t drow0, int rs, int src0, int nvalid, int k0, LAS float* scr, int lane) {
    const int nn = lane & 31;
#pragma unroll 8
    for (int i = 0; i < 32; ++i) { const int kk = 2 * i + (lane >> 5);
        scr[kk * 33 + nn] = (nn < nvalid) ? *(const GAS float*)(W + (size_t)(k0 + kk) * ldw + src0 + nn) : 0.f; }
    LDS_WAIT(); asm volatile("" ::: "memory");
    const int c = lane & 7;
#pragma unroll
    for (int j = 0; j < 4; ++j) { const int n = (lane >> 3) + 8 * j; const LAS float* s = scr + (8 * c) * 33 + n;
        v4u o; o.x = pk2(s[0 * 33], s[1 * 33]); o.y = pk2(s[2 * 33], s[3 * 33]); o.z = pk2(s[4 * 33], s[5 * 33]); o.w = pk2(s[6 * 33], s[7 * 33]);
        *(GAS v4u*)(WT + (drow0 + (size_t)n * rs) * K + k0 + 8 * c) = o; }
    LDS_WAIT(); asm volatile("" ::: "memory");
}
__device__ __forceinline__ int win_src(int n0) {
    if (n0 < 512) return n0;
    if (n0 < 640) return 512 + (n0 - 512);
    if (n0 < 1152) return 768 + (n0 - 640);
    if (n0 < 1280) return 1280 + (n0 - 1152);
    if (n0 < 1408) return 1408 + (n0 - 1280);
    if (n0 < 1536) return 1536 + (n0 - 1408);
    if (n0 < 1664) return 1792 + (n0 - 1536);
    if (n0 < 2688) return 2072 + (n0 - 1664);
    if (n0 < 3712) return 3096 + (n0 - 2688);
    if (n0 < 4736) return 4120 + (n0 - 3712);
    if (n0 < 4864) return 640 + (n0 - 4736);
    if (n0 < 4992) return 1664 + (n0 - 4864);
    return 1920 + (n0 - 4992);
}
struct TrDesc { const float* src; bf16* dst; int ldw, K, rs; const float* ksc; };
struct TrRegs { f32x4 v[16]; };
__device__ __forceinline__ void tr_load(TrRegs& r, const TrDesc& d) {
#pragma unroll
    for (int i = 0; i < 16; ++i) r.v[i] = *(const GAS f32x4*)(d.src + (size_t)(8 * (i >> 1) + (i & 1)) * d.ldw);
}
__device__ __forceinline__ void tr_store(const TrRegs& r, const TrDesc& d, LAS unsigned* scr, int lane) {
    const int kr = lane >> 4, nc = lane & 15;
#pragma unroll
    for (int i = 0; i < 8; ++i) { f32x4 a = r.v[2 * i], b = r.v[2 * i + 1]; LAS unsigned* w = scr + (4 * nc) * 36 + 4 * i + kr;
        if (d.ksc) { a = a * d.ksc[8 * i]; b = b * d.ksc[8 * i + 1]; }
        w[0] = pk2(a[0], b[0]); w[36] = pk2(a[1], b[1]); w[72] = pk2(a[2], b[2]); w[108] = pk2(a[3], b[3]); }
    LDS_WAIT(); asm volatile("" ::: "memory");
#pragma unroll
    for (int j = 0; j < 8; ++j) { const int ch = lane + 64 * j, n = ch >> 3, kc = ch & 7;
        const v4u o = *(const LAS v4u*)(scr + n * 36 + 4 * kc);
        *(GAS v4u*)(d.dst + (size_t)n * d.rs * d.K + 8 * kc) = o; }
    LDS_WAIT(); asm volatile("" ::: "memory");
}
__device__ __forceinline__ TrDesc tr_decode(Frame& F, int l, int it, int lane) {
    constexpr int I_A = 32 * (NIN / 64), I_B = 32 * 32, I_G = NEXP * 256, I_U = NEXP * 256, I_D = NEXP * 256, I_1 = 64, I_2 = 2;
    const float* W; bf16* WT; int ldw, K, rs = 1, src0, k0; size_t drow0; const float* ksc = nullptr;
    int r = it;
    if (r < I_A) { const int nblk = NIN / 64, kb = r / nblk, nb = r % nblk; W = inp(F, I_WIN) + (size_t)l * DM * D_IN; ldw = D_IN; K = DM; WT = (bf16*)(wsp(F) + WS_WIN); drow0 = (size_t)nb * 64; src0 = win_src(nb * 64); k0 = kb * 64; }
    else if ((r -= I_A) < I_B) { const int kb = r / 32, nb = r % 32; W = inp(F, I_WOUT) + (size_t)l * DM * DM; ldw = DM; K = DM; WT = (bf16*)(wsp(F) + WS_WOUT); drow0 = (size_t)nb * 64; src0 = nb * 64; k0 = kb * 64; ksc = inp(F, I_MIXG) + (size_t)l * DM; }
    else if ((r -= I_B) < I_G) { const int e = r / 256, q = r % 256, kb = q / 8, nb = q % 8; W = inp(F, I_WGATE) + ((size_t)l * NEXP + e) * DM * DEXP; ldw = DEXP; K = DM; WT = (bf16*)(wsp(F) + WS_WGU); drow0 = (size_t)e * 1024 + nb * 128; rs = 2; src0 = nb * 64; k0 = kb * 64; }
    else if ((r -= I_G) < I_U) { const int e = r / 256, q = r % 256, kb = q / 8, nb = q % 8; W = inp(F, I_WUP) + ((size_t)l * NEXP + e) * DM * DEXP; ldw = DEXP; K = DM; WT = (bf16*)(wsp(F) + WS_WGU); drow0 = (size_t)e * 1024 + nb * 128 + 1; rs = 2; src0 = nb * 64; k0 = kb * 64; }
    else if ((r -= I_U) < I_D) { const int e = r / 256, q = r % 256, kb = q / 32, nb = q % 32; W = inp(F, I_WDOWN) + ((size_t)l * NEXP + e) * DEXP * DM; ldw = DM; K = DEXP; WT = (bf16*)(wsp(F) + WS_WD); drow0 = (size_t)e * DM + nb * 64; src0 = nb * 64; k0 = kb * 64; }
    else if ((r -= I_D) < 2 * I_1) { const int kv = r / I_1, q = r % I_1, kb = q / 2, nb = q % 2; W = inp(F, kv ? I_W1V : I_W1K) + (size_t)l * 2048 * 128; ldw = 128; K = 2048; WT = (bf16*)(wsp(F) + WS_WCMP) + (size_t)kv * 128 * 2048; drow0 = (size_t)nb * 64; src0 = nb * 64; k0 = kb * 64; }
    else { r -= 2 * I_1; const int kv = r / I_2, kb = r % I_2; W = inp(F, kv ? I_W2V : I_W2K) + (size_t)l * 128 * 64; ldw = 64; K = 128; WT = (bf16*)(wsp(F) + WS_WCMP + 2 * 128 * 2048 * 2) + (size_t)kv * 64 * 128; drow0 = 0; src0 = 0; k0 = kb * 64; }
    TrDesc d; d.src = W + (size_t)(k0 + 2 * (lane >> 4)) * ldw + src0 + 4 * (lane & 15); d.dst = WT + drow0 * K + k0; d.ldw = ldw; d.K = K; d.rs = rs; d.ksc = ksc ? ksc + k0 + 2 * (lane >> 4) : nullptr;
    return d;
}
constexpr int CV_SMALL0 = 32 * (NIN / 64) + 32 * 32, CV_GU1 = CV_SMALL0 + 2 * NEXP * 256, CV_DN1 = CV_GU1 + NEXP * 256, CV_END = CV_DN1 + 2 * 64 + 2 * 2;
__device__ __forceinline__ void convert_range(Frame& F, int l, int lo, int hi, LAS unsigned* scr) {
    const int gw = F.vcu * NWAVES + F.wave, NGW = F.G * NWAVES;
    if (lo + gw < hi) {
        TrDesc dc = tr_decode(F, l, lo + gw, F.lane); TrRegs rc; tr_load(rc, dc);
        for (int it = lo + gw; it < hi; it += NGW) {
            const int itn = it + NGW < hi ? it + NGW : it;
            const TrDesc dn = tr_decode(F, l, itn, F.lane); TrRegs rn; tr_load(rn, dn);
            tr_store(rc, dc, scr, F.lane);
            rc = rn; dc = dn;
        }
    }
}
__device__ __forceinline__ void convert_small(Frame& F, int l) {
    LAS unsigned* scr = (LAS unsigned*)(F.lds + F.wave * 9216);
    const int gw = F.vcu * NWAVES + F.wave, NGW = F.G * NWAVES;
    convert_range(F, l, 0, CV_SMALL0, scr);
    convert_range(F, l, CV_DN1, CV_END, scr);
    { LAS float* scrf = (LAS float*)scr;
      for (int it = gw; it < 32; it += NGW) tr_item(inp(F, I_WIN) + (size_t)l * DM * D_IN, D_IN, DM, (bf16*)(wsp(F) + WS_WCMP + 1024 * 1024 + 64 * 1024), 0, 1, 2048, 24, it * 64, scrf, F.lane); }
    { bf16* Whi = (bf16*)(wsp(F) + WS_WCMP + 1536 * 1024); bf16* Wlo = Whi + 48 * 2048;
      const float* wrg = inp(F, I_WRG) + (size_t)l * DM * 4; const float* wre = inp(F, I_WRE) + (size_t)l * 4 * DM * 8;
      for (int i = gw * 64 + F.lane; i < 48 * 2048; i += NGW * 64) { const int row = i >> 11, k = i & 2047; float v = 0.f;
          if (row < 4) v = wrg[k * 4 + row]; else if (row < 36) { const int g = (row - 4) >> 3, e = (row - 4) & 7; v = wre[((size_t)g * DM + k) * 8 + e]; }
          const unsigned hi = f2bf(v); Whi[i] = (bf16)hi; Wlo[i] = (bf16)f2bf(v - bf2f((unsigned short)hi)); } }
}

struct Row { f32x4 v[8]; };
__device__ __forceinline__ void row_load(Row& r, const float* p, int lane) {
#pragma unroll
    for (int j = 0; j < 8; ++j) r.v[j] = *((const GAS f32x4*)p + lane + 64 * j);
}
__device__ __forceinline__ void row_load_bf16(Row& r, const bf16* p, int lane) {
#pragma unroll
    for (int j = 0; j < 8; ++j) { const v2u w = *((const GAS v2u*)p + lane + 64 * j); r.v[j] = (f32x4){bflo(w.x), bfhi(w.x), bflo(w.y), bfhi(w.y)}; }
}
struct RawRow { v2u w[8]; };
__device__ __forceinline__ void raw_load(RawRow& r, const bf16* p, int lane) {
#pragma unroll
    for (int j = 0; j < 8; ++j) r.w[j] = *((const GAS v2u*)p + lane + 64 * j);
}
__device__ __forceinline__ void raw_to_row(Row& r, const RawRow& x) {
#pragma unroll
    for (int j = 0; j < 8; ++j) r.v[j] = (f32x4){bflo(x.w[j].x), bfhi(x.w[j].x), bflo(x.w[j].y), bfhi(x.w[j].y)};
}
__device__ __forceinline__ void row_store(const Row& r, float* p, int lane) {
#pragma unroll
    for (int j = 0; j < 8; ++j) *((GAS f32x4*)p + lane + 64 * j) = r.v[j];
}
__device__ __forceinline__ void row_store_bf16(const Row& r, bf16* p, int lane) {
#pragma unroll
    for (int j = 0; j < 8; ++j) { v2u w; w.x = pk2(r.v[j].x, r.v[j].y); w.y = pk2(r.v[j].z, r.v[j].w); *((GAS v2u*)p + lane + 64 * j) = w; }
}
__device__ __forceinline__ void row_normalize(Row& r) {
    float s = 0.f;
#pragma unroll
    for (int j = 0; j < 8; ++j) s += (r.v[j].x + r.v[j].y) + (r.v[j].z + r.v[j].w);
    const float mean = wave_sum(s) * (1.0f / DM); float s2 = 0.f;
#pragma unroll
    for (int j = 0; j < 8; ++j) { r.v[j] = r.v[j] - mean; s2 += (r.v[j].x * r.v[j].x + r.v[j].y * r.v[j].y) + (r.v[j].z * r.v[j].z + r.v[j].w * r.v[j].w); }
    const float rstd = 1.0f / sqrtf(wave_sum(s2) * (1.0f / DM) + LN_EPS);
#pragma unroll
    for (int j = 0; j < 8; ++j) r.v[j] = r.v[j] * rstd;
}
__device__ __forceinline__ void row_affine(Row& r, const float* a, float add1, const float* b, int lane) {
#pragma unroll
    for (int j = 0; j < 8; ++j) { const f32x4 av = *((const GAS f32x4*)a + lane + 64 * j) + add1, bv = *((const GAS f32x4*)b + lane + 64 * j); r.v[j] = r.v[j] * av + bv; }
}
__device__ __forceinline__ const float* modp(Frame& F, int l, int b, int which) { return (const float*)(wsp(F) + WS_MOD) + ((size_t)l * NB + b) * (6 * DM) + which * DM; }

__device__ __forceinline__ void ln_in_phase(Frame& F) {
    const int gw = F.vcu * NWAVES + F.wave, NGW = F.G * NWAVES;
    bf16* hb = (bf16*)(wsp(F) + WS_HB);
    Row nx; row_load(nx, inp(F, I_X) + (size_t)gw * DM, F.lane);
    for (int m = gw; m < MTOK; m += NGW) { const int b = m / SEQ; Row r = nx; row_load(nx, inp(F, I_X) + (size_t)(m + NGW < MTOK ? m + NGW : m) * DM, F.lane); row_normalize(r);
        row_affine(r, modp(F, 0, b, 1), 1.0f, modp(F, 0, b, 0), F.lane); row_store_bf16(r, hb + (size_t)m * DM, F.lane); }
}

__device__ __forceinline__ void merge_phase(Frame& F, int l) {
    const int gw = F.vcu * NWAVES + F.wave, NGW = F.G * NWAVES;
    const bf16* oc = (const bf16*)(wsp(F) + WS_OCAT); bf16* hb = (bf16*)(wsp(F) + WS_HB); const float* mg = inp(F, I_MIXG) + (size_t)l * DM;
    for (int m = gw; m < MTOK; m += NGW) { Row r; row_load_bf16(r, oc + (size_t)m * DM, F.lane);
        float sa = 0.f, sb = 0.f, sc = 0.f;
#pragma unroll
        for (int j = 0; j < 8; ++j) { const float q = (r.v[j].x * r.v[j].x + r.v[j].y * r.v[j].y) + (r.v[j].z * r.v[j].z + r.v[j].w * r.v[j].w); if (j < 2) sa += q; else if (j < 4) sb += q; else sc += q; }
        const float ra = 1.0f / sqrtf(wave_sum(sa) * (1.0f / 512.0f) + RMS_EPS), rb = 1.0f / sqrtf(wave_sum(sb) * (1.0f / 512.0f) + RMS_EPS), rc = 1.0f / sqrtf(wave_sum(sc) * (1.0f / 1024.0f) + RMS_EPS);
#pragma unroll
        for (int j = 0; j < 8; ++j) { const float s = j < 2 ? ra : (j < 4 ? rb : rc); const f32x4 g = *((const GAS f32x4*)mg + F.lane + 64 * j); r.v[j] = r.v[j] * s * g; }
        row_store_bf16(r, hb + (size_t)m * DM, F.lane); }
}

__device__ __forceinline__ void post_mixer_phase(Frame& F, int l) {
    const int gw = F.vcu * NWAVES + F.wave, NGW = F.G * NWAVES;
    bf16* xa = (bf16*)(wsp(F) + WS_XA); bf16* hb = (bf16*)(wsp(F) + WS_HB);
    const float* wrg = inp(F, I_WRG) + (size_t)l * DM * 4; const float* brg = inp(F, I_BRG) + l * 4;
    const float* wre = inp(F, I_WRE) + (size_t)l * 4 * DM * 8; const float* bre = inp(F, I_BRE) + l * 32;
    unsigned* cnt = (unsigned*)(ctlp(F) + CW_CNT + l * 32); int* list = (int*)(wsp(F) + WS_LIST); float* gatew = (float*)(wsp(F) + WS_SMALL + SM_GATEW);
    RawRow nx; raw_load(nx, xa + (size_t)gw * DM, F.lane);
    for (int m = gw; m < MTOK; m += NGW) { const int b = m / SEQ; Row r; raw_to_row(r, nx); raw_load(nx, xa + (size_t)(m + NGW < MTOK ? m + NGW : m) * DM, F.lane); row_normalize(r);
        row_affine(r, inp(F, I_LN1G) + (size_t)l * DM, 0.0f, inp(F, I_LN1B) + (size_t)l * DM, F.lane); row_store_bf16(r, xa + (size_t)m * DM, F.lane);
        row_normalize(r); row_affine(r, modp(F, l, b, 4), 1.0f, modp(F, l, b, 3), F.lane); row_store_bf16(r, hb + (size_t)m * DM, F.lane);
    }
}

__device__ __forceinline__ void router_phase(Frame& F, int l) {
    const int lane = F.lane, c = lane & 15, kq = lane >> 4, w4 = F.wave & 3, kh = F.wave >> 2;
    const bf16* hb = (const bf16*)(wsp(F) + WS_HB);
    const bf16* Whi = (const bf16*)(wsp(F) + WS_WCMP + 1536 * 1024); const bf16* Wlo = Whi + 48 * 2048;
    const float* brg = inp(F, I_BRG) + l * 4; const float* bre = inp(F, I_BRE) + l * 32;
    unsigned* cnt = (unsigned*)(ctlp(F) + CW_CNT + l * 32); int* list = (int*)(wsp(F) + WS_LIST); float* gatew = (float*)(wsp(F) + WS_SMALL + SM_GATEW);
    LAS float* sl = (LAS float*)(F.lds + w4 * 4096);
    LAS f32x4* part = (LAS f32x4*)(F.lds + 16384 + w4 * 3072);
    for (int u0 = F.vcu; u0 < MTOK / 16; u0 += 4 * F.G) {
        const int u = u0 + w4 * F.G; const bool live = u < MTOK / 16;
        f32x4 acc[3];
#pragma unroll
        for (int t = 0; t < 3; ++t) acc[t] = (f32x4){0.f, 0.f, 0.f, 0.f};
        if (live) {
            const bf16* hrow = hb + (size_t)(u * 16 + c) * DM + 8 * kq + kh * 1024;
            const bf16* wh = Whi + (size_t)c * 2048 + 8 * kq + kh * 1024; const bf16* wl = Wlo + (size_t)c * 2048 + 8 * kq + kh * 1024;
#pragma unroll 4
            for (int ks = 0; ks < 32; ++ks) { const bf16x8 hf = ldg8(hrow + ks * 32);
#pragma unroll
                for (int t = 0; t < 3; ++t) { acc[t] = mfma16(ldg8(wh + (size_t)t * 16 * 2048 + ks * 32), hf, acc[t]); acc[t] = mfma16(ldg8(wl + (size_t)t * 16 * 2048 + ks * 32), hf, acc[t]); } }
            if (kh == 1) {
#pragma unroll
                for (int t = 0; t < 3; ++t) part[t * 64 + lane] = acc[t]; }
        }
        __syncthreads();
        if (live && kh == 0) {
#pragma unroll
            for (int t = 0; t < 3; ++t) { acc[t] += part[t * 64 + lane];
#pragma unroll
                for (int r = 0; r < 4; ++r) sl[c * 49 + 16 * t + 4 * kq + r] = acc[t][r]; }
            LDS_WAIT();
            if (lane < 16) {
                const LAS float* lr = sl + lane * 49; const int m = u * 16 + lane;
                const float g0 = lr[0] + brg[0], g1 = lr[1] + brg[1], g2 = lr[2] + brg[2], g3 = lr[3] + brg[3];
                int gs = 0; float gm = g0; if (g1 > gm) { gm = g1; gs = 1; } if (g2 > gm) { gm = g2; gs = 2; } if (g3 > gm) { gm = g3; gs = 3; }
                const float pgroup = 1.0f / (__expf(g0 - gm) + __expf(g1 - gm) + __expf(g2 - gm) + __expf(g3 - gm));
                int t1 = 0; float m1 = lr[4 + gs * 8] + bre[gs * 8];
#pragma unroll
                for (int i = 1; i < 8; ++i) { const float v = lr[4 + gs * 8 + i] + bre[gs * 8 + i]; if (v > m1) { m1 = v; t1 = i; } }
                int t2 = -1; float m2 = -3.0e38f;
#pragma unroll
                for (int i = 0; i < 8; ++i) { const float v = lr[4 + gs * 8 + i] + bre[gs * 8 + i]; if (i != t1 && v > m2) { m2 = v; t2 = i; } }
                const float e2 = __expf(m2 - m1), inv = pgroup / (1.0f + e2);
                const int x1 = gs * 8 + t1, x2 = gs * 8 + t2;
                const unsigned p1 = __hip_atomic_fetch_add(cnt + x1, 1u, RLX_AGENT); list[(size_t)x1 * MTOK + p1] = m * 2; gatew[m * 2] = inv;
                const unsigned p2 = __hip_atomic_fetch_add(cnt + x2, 1u, RLX_AGENT); list[(size_t)x2 * MTOK + p2] = m * 2 + 1; gatew[m * 2 + 1] = inv * e2;
            }
        }
        __syncthreads();
    }
}

__device__ __forceinline__ void gather_phase(Frame& F, int l) {
    LAS int* tb = (LAS int*)(F.lds + 0);
    const unsigned* cnt = (const unsigned*)(ctlp(F) + CW_CNT + l * 32);
    if (F.tid < 32) tb[F.tid] = (int)__hip_atomic_load(cnt + F.tid, RLX_AGENT);
    __syncthreads();
    if (F.tid == 0) { int row = 0, tile = 0;
        for (int e = 0; e < NEXP; ++e) { tb[32 + e] = row; const int nt = (tb[e] + 255) >> 8; for (int t = 0; t < nt; ++t) tb[64 + tile + t] = e; tile += nt; row += nt * 256; }
        tb[224] = tile; }
    __syncthreads();
    const int ntiles = tb[224];
    int* gt = (int*)(wsp(F) + WS_SMALL + SM_TILE);
    if (blockIdx.x == 0) { if (F.tid < 160) gt[F.tid] = (F.tid < ntiles) ? tb[64 + F.tid] : 0; if (F.tid == 0) gt[200] = ntiles; }
    const int gw = F.vcu * NWAVES + F.wave, NGW = F.G * NWAVES;
    const int* list = (const int*)(wsp(F) + WS_LIST); int* rowinfo = (int*)(wsp(F) + WS_SMALL + SM_ROWINFO);
    const bf16* hb = (const bf16*)(wsp(F) + WS_HB); bf16* xs = (bf16*)(wsp(F) + WS_XS);
    for (int R = gw; R < ntiles * 256; R += NGW) { const int e = tb[64 + (R >> 8)], pos = R - tb[32 + e];
        int aid = -1; if (pos < tb[e]) aid = list[(size_t)e * MTOK + pos];
        GAS v4u* dst = (GAS v4u*)(xs + (size_t)R * DM) + F.lane;
        if (aid >= 0) { const GAS v4u* src = (const GAS v4u*)(hb + (size_t)(aid >> 1) * DM) + F.lane;
#pragma unroll
            for (int j = 0; j < 4; ++j) dst[64 * j] = src[64 * j]; }
        else {
#pragma unroll
            for (int j = 0; j < 4; ++j) dst[64 * j] = (v4u){0u, 0u, 0u, 0u}; }
        if (F.lane == 0) rowinfo[R] = aid; }
    __syncthreads();
}

__device__ __forceinline__ void moe_tables(Frame& F, int l) {
    LAS int* tb = (LAS int*)(F.lds + TAB_OFF);
    const unsigned* cnt = (const unsigned*)(ctlp(F) + CW_CNT + l * 32);
    __syncthreads();
    if (F.tid < 32) tb[F.tid] = (int)__hip_atomic_load(cnt + F.tid, RLX_AGENT);
    __syncthreads();
    if (F.tid == 0) { int row = 0, tile = 0;
        for (int e = 0; e < NEXP; ++e) { tb[32 + e] = row; const int nt = (tb[e] + 255) >> 8; for (int t = 0; t < nt; ++t) tb[64 + tile + t] = e; tile += nt; row += nt * 256; }
        tb[224] = tile; }
    __syncthreads();
}

__device__ __forceinline__ void post_moe_phase(Frame& F, int l, float* dst_f32, bf16* dst_bf16, bool next_h) {
    const int gw = F.vcu * NWAVES + F.wave, NGW = F.G * NWAVES;
    const bf16* xa = (const bf16*)(wsp(F) + WS_XA); const bf16* ys = (const bf16*)(wsp(F) + WS_YS); bf16* hb = (bf16*)(wsp(F) + WS_HB);
    RawRow nx, ny0, ny1; raw_load(nx, xa + (size_t)gw * DM, F.lane); raw_load(ny0, ys + (size_t)(2 * gw) * DM, F.lane); raw_load(ny1, ys + (size_t)(2 * gw + 1) * DM, F.lane);
    for (int m = gw; m < MTOK; m += NGW) { const int b = m / SEQ; Row r; raw_to_row(r, nx); const RawRow cy0 = ny0, cy1 = ny1;
        { const int mn = m + NGW < MTOK ? m + NGW : m; raw_load(nx, xa + (size_t)mn * DM, F.lane); raw_load(ny0, ys + (size_t)(2 * mn) * DM, F.lane); raw_load(ny1, ys + (size_t)(2 * mn + 1) * DM, F.lane); }
        const float* g2 = modp(F, l, b, 5);
#pragma unroll
        for (int j = 0; j < 8; ++j) { const v2u y0 = cy0.w[j], y1 = cy1.w[j];
            const f32x4 y = (f32x4){bflo(y0.x) + bflo(y1.x), bfhi(y0.x) + bfhi(y1.x), bflo(y0.y) + bflo(y1.y), bfhi(y0.y) + bfhi(y1.y)};
            const f32x4 gv = *((const GAS f32x4*)g2 + F.lane + 64 * j) + 1.0f; r.v[j] = r.v[j] * ALPHA + gv * y; }
        row_normalize(r); row_affine(r, inp(F, I_LN2G) + (size_t)l * DM, 0.0f, inp(F, I_LN2B) + (size_t)l * DM, F.lane); if (dst_f32) row_store(r, dst_f32 + (size_t)m * DM, F.lane); else row_store_bf16(r, dst_bf16 + (size_t)m * DM, F.lane);
        if (next_h) { row_normalize(r); row_affine(r, modp(F, l + 1, b, 1), 1.0f, modp(F, l + 1, b, 0), F.lane); row_store_bf16(r, hb + (size_t)m * DM, F.lane); } }
}
constexpr int IMP_STRIDE = 130;
constexpr int AW_IMP = 0, AW_SCV = 16 * IMP_STRIDE * 4, AW_SEL = AW_SCV + 512, AW_Q = 9216, AW_BYTES = AW_Q + 8192;
static_assert(AW_SEL + 256 <= AW_Q && NWAVES * AW_BYTES <= LDSCTL_OFF, "per-wave LDS slabs");

struct Flash { f32x4 O[4][4]; f32x4 m, l; };
struct KF { bf16x8 K[2][2]; };
struct VF { bf16x8 V[4]; };

__device__ __forceinline__ void load_k(KF& x, const bf16* Kb, size_t ldk, int kbase) {
    const bf16* kp = Kb + (size_t)kbase * ldk;
    x.K[0][0] = ldg8(kp); x.K[0][1] = ldg8(kp + 32); x.K[1][0] = ldg8(kp + 4 * ldk); x.K[1][1] = ldg8(kp + 4 * ldk + 32);
}
__device__ __forceinline__ void load_v(VF& x, const bf16* Vb, size_t ldv, int kbase) {
    const bf16* vp = Vb + kbase;
#pragma unroll
    for (int db = 0; db < 4; ++db) x.V[db] = ldg8(vp + (size_t)(16 * db) * ldv);
}
__device__ __forceinline__ void q_park(LAS bf16x8* Ql, const bf16* q0p, const bf16* q1p, const bf16* q2p, const bf16* q3p, int lane) {
    Ql[0 * 64 + lane] = ldg8(q0p); Ql[1 * 64 + lane] = ldg8(q0p + 32); Ql[2 * 64 + lane] = ldg8(q1p); Ql[3 * 64 + lane] = ldg8(q1p + 32);
    Ql[4 * 64 + lane] = ldg8(q2p); Ql[5 * 64 + lane] = ldg8(q2p + 32); Ql[6 * 64 + lane] = ldg8(q3p); Ql[7 * 64 + lane] = ldg8(q3p + 32);
}
__device__ __forceinline__ void qk_scores(f32x4 (&Sv)[2][4], const KF& x, const LAS bf16x8* Ql, int lane) {
#pragma unroll
    for (int qb = 0; qb < 4; ++qb) { const bf16x8 q0 = Ql[(2 * qb) * 64 + lane], q1 = Ql[(2 * qb + 1) * 64 + lane];
#pragma unroll
        for (int h = 0; h < 2; ++h) { f32x4 a = mfma16(x.K[h][0], q0, (f32x4){0.f, 0.f, 0.f, 0.f}); Sv[h][qb] = mfma16(x.K[h][1], q1, a); } }
}
__device__ __forceinline__ void flash_init(Flash& S, float m0, float m1, float m2, float m3) {
#pragma unroll
    for (int db = 0; db < 4; ++db)
#pragma unroll
        for (int qb = 0; qb < 4; ++qb) S.O[db][qb] = (f32x4){0.f, 0.f, 0.f, 0.f};
    S.m = (f32x4){m0, m1, m2, m3}; S.l = (f32x4){0.f, 0.f, 0.f, 0.f};
}
__device__ __forceinline__ void flash_step(Flash& S, f32x4 (&Sv)[2][4], const VF& x, const f32x4 b0, const f32x4 bj, unsigned vm) {
    float sv[4][8]; float mxv[4]; bool grow = false;
#pragma unroll
    for (int qb = 0; qb < 4; ++qb) {
#pragma unroll
        for (int h = 0; h < 2; ++h)
#pragma unroll
            for (int r = 0; r < 4; ++r) { const int j = 4 * h + r; const float s2 = Sv[h][qb][r] * SC2 + (b0[qb] + bj[qb] * (float)j); sv[qb][j] = ((vm >> j) & 1u) ? s2 : -INFINITY; }
        float mx = fmaxf(fmaxf(fmaxf(sv[qb][0], sv[qb][1]), fmaxf(sv[qb][2], sv[qb][3])), fmaxf(fmaxf(sv[qb][4], sv[qb][5]), fmaxf(sv[qb][6], sv[qb][7])));
        mx = fmaxf(mx, __shfl_xor(mx, 16)); mx = fmaxf(mx, __shfl_xor(mx, 32));
        mxv[qb] = mx; grow = grow | (mx > S.m[qb] + 8.0f);
    }
    if (__any(grow)) {
#pragma unroll
        for (int qb = 0; qb < 4; ++qb) { const float mn = fmaxf(S.m[qb], mxv[qb]), al = ex2(S.m[qb] - mn); S.m[qb] = mn; S.l[qb] = S.l[qb] * al;
#pragma unroll
            for (int db = 0; db < 4; ++db) S.O[db][qb] = S.O[db][qb] * al; }
    }
    bf16x8 Pf[4];
#pragma unroll
    for (int qb = 0; qb < 4; ++qb) {
        float p[8];
#pragma unroll
        for (int j = 0; j < 8; ++j) p[j] = ex2(sv[qb][j] - S.m[qb]);
        S.l[qb] = S.l[qb] + (((p[0] + p[1]) + (p[2] + p[3])) + ((p[4] + p[5]) + (p[6] + p[7])));
        Pf[qb] = pack8(p[0], p[1], p[2], p[3], p[4], p[5], p[6], p[7]);
    }
#pragma unroll
    for (int db = 0; db < 4; ++db)
#pragma unroll
        for (int qb = 0; qb < 4; ++qb) S.O[db][qb] = mfma16(x.V[db], Pf[qb], S.O[db][qb]);
}
__device__ __forceinline__ float flash_inv(const Flash& S, int qb, bool has_sink, float sink2) {
    float lt = S.l[qb]; lt += __shfl_xor(lt, 16); lt += __shfl_xor(lt, 32);
    if (has_sink) lt += ex2(sink2 - S.m[qb]);
    return lt > 0.f ? 1.0f / lt : 0.f;
}
__device__ __forceinline__ float sigmoidf_(float x) { return 1.0f / (1.0f + __expf(-x)); }
__device__ __forceinline__ float slope2_of(int hidx) { return LOG2E * exp2f(-0.5f * (float)(hidx + 1)); }
#define ITER_FENCE() asm volatile("" ::: "memory")

template <int W, int MODE>
__device__ __forceinline__ void win_unit(Frame& F, int l, int b, int g, int q0) {
    const int lane = F.lane, c = lane & 15, kq = lane >> 4;
    const bf16* proj = (const bf16*)(wsp(F) + WS_PROJ); const bf16* vT = (const bf16*)(wsp(F) + WS_VT); bf16* ocat = (bf16*)(wsp(F) + WS_OCAT);
    constexpr int QOFF = MODE == 0 ? P_QA : P_QB, KOFF = MODE == 0 ? P_KA : P_KBW, VROW = MODE == 0 ? V_A : V_BW, OCOL = MODE == 0 ? 0 : 512, HBASE = MODE == 0 ? 0 : 8;
    LAS bf16x8* Ql = (LAS bf16x8*)(F.lds + F.wave * AW_BYTES + AW_Q);
    const size_t tb = (size_t)b * SEQ; const int t = q0 + c;
    { const bf16* qp = proj + (tb + t) * NPROJ + QOFF + g * 256 + kq * 8; q_park(Ql, qp, qp + 64, qp + 128, qp + 192, lane); }
    f32x4 sl2, sk2;
#pragma unroll
    for (int qb = 0; qb < 4; ++qb) { sl2[qb] = slope2_of(HBASE + g * 4 + qb); sk2[qb] = MODE == 0 ? inp(F, I_SINKS)[l * 8 + g * 4 + qb] * LOG2E : -1.0e30f; }
    Flash S; flash_init(S, sk2[0], sk2[1], sk2[2], sk2[3]);
    int klo = q0 - (W - 1); if (klo < 0) klo = 0; klo &= ~31;
    const int khi = (q0 + 15) & ~31;
    const bf16* Kb = proj + (tb + 8 * (c >> 2) + (c & 3)) * NPROJ + KOFF + g * 64 + kq * 8;
    const bf16* Vb = vT + (size_t)(VROW + g * 64 + c) * MTOK + tb + 8 * kq;
    KF cur, nxt; load_k(cur, Kb, NPROJ, khi);
    for (int kbase = khi; kbase >= klo; kbase -= 32) {
        ITER_FENCE();
        VF vf; load_v(vf, Vb, MTOK, kbase);
        load_k(nxt, Kb, NPROJ, kbase - 32 >= klo ? kbase - 32 : kbase);
        f32x4 Sv[2][4]; qk_scores(Sv, cur, Ql, lane);
        const int d0 = t - kbase - 8 * kq;
        const f32x4 b0 = sl2 * -(float)d0;
        unsigned vm = 0xffu;
        if (!(kbase + 31 <= q0 && kbase >= q0 + 16 - W)) { vm = 0u;
#pragma unroll
            for (int j = 0; j < 8; ++j) { const int dist = d0 - j; vm |= (dist >= 0 && dist < W) ? (1u << j) : 0u; } }
        flash_step(S, Sv, vf, b0, sl2, vm);
        cur = nxt;
    }
#pragma unroll
    for (int qb = 0; qb < 4; ++qb) { const float sc = flash_inv(S, qb, MODE == 0, sk2[qb]);
        bf16* op = ocat + (tb + t) * DM + OCOL + (g * 4 + qb) * 64 + 4 * kq; float q2 = 0.f;
#pragma unroll
        for (int db = 0; db < 4; ++db) { const f32x4 o = S.O[db][qb] * sc; v2u w; w.x = pk2(o[0], o[1]); w.y = pk2(o[2], o[3]); *(GAS v2u*)(op + 16 * db) = w;
            q2 += (bflo(w.x) * bflo(w.x) + bfhi(w.x) * bfhi(w.x)) + (bflo(w.y) * bflo(w.y) + bfhi(w.y) * bfhi(w.y)); }
        if (MODE == 0) { q2 += __shfl_xor(q2, 16); q2 += __shfl_xor(q2, 32); if (kq == 0) ((float*)(wsp(F) + WS_SSQ))[(tb + t) * 32 + g * 4 + qb] = q2; } }
}

constexpr float SB_EXIT_P = 1.0e-37f;
__device__ __forceinline__ void sb_unit(Frame& F, int b, int hc, int q0) {
    const int lane = F.lane, c = lane & 15, kq = lane >> 4;
    const bf16* proj = (const bf16*)(wsp(F) + WS_PROJ); const bf16* vT = (const bf16*)(wsp(F) + WS_VT); bf16* ocat = (bf16*)(wsp(F) + WS_OCAT);
    LAS bf16x8* Ql = (LAS bf16x8*)(F.lds + F.wave * AW_BYTES + AW_Q);
    const size_t tb = (size_t)b * SEQ;
    { const bf16* qp = proj + (tb + q0 + c) * NPROJ + P_QC + hc * 64 + kq * 8; q_park(Ql, qp, qp + (size_t)16 * NPROJ, qp + (size_t)32 * NPROJ, qp + (size_t)48 * NPROJ, lane); }
    f32x4 O[4][4]; float carry[4];
#pragma unroll
    for (int qb = 0; qb < 4; ++qb) { carry[qb] = 1.0f;
#pragma unroll
        for (int db = 0; db < 4; ++db) O[db][qb] = (f32x4){0.f, 0.f, 0.f, 0.f}; }
    const bf16* Kb = proj + (tb + 8 * (c >> 2) + (c & 3)) * NPROJ + P_KC + hc * 64 + kq * 8;
    const bf16* Vb = vT + (size_t)(V_C + hc * 64 + c) * MTOK + tb + 8 * kq;
    KF cur, nxt; load_k(cur, Kb, NPROJ, q0 + 32);
    for (int kbase = q0 + 32; kbase >= 0; kbase -= 32) {
        ITER_FENCE();
        VF vf; load_v(vf, Vb, MTOK, kbase);
        load_k(nxt, Kb, NPROJ, kbase >= 32 ? kbase - 32 : kbase);
        f32x4 Sv[2][4]; qk_scores(Sv, cur, Ql, lane);
        const bool diag = kbase + 31 >= q0;
        bf16x8 Pf[4];
#pragma unroll
        for (int qb = 0; qb < 4; ++qb) { const int lim = q0 + 16 * qb + c - kbase - 8 * kq;
            float om[8], sg[8];
#pragma unroll
            for (int h = 0; h < 2; ++h)
#pragma unroll
                for (int r = 0; r < 4; ++r) { const int j = 4 * h + r; const float e = ex2(fminf(Sv[h][qb][r] * SC2, 115.0f)), rr = __builtin_amdgcn_rcpf(1.0f + e);
                    om[j] = rr; sg[j] = e * rr;
                    if (diag) { const bool msk = j >= lim; om[j] = msk ? 1.0f : om[j]; sg[j] = msk ? 0.f : sg[j]; } }
            float ex_[8]; float run = 1.0f;
#pragma unroll
            for (int j = 7; j >= 0; --j) { ex_[j] = run; run *= om[j]; }
            const float t1 = __shfl_xor(run, 16), t2 = __shfl_xor(run, 32), t3 = __shfl_xor(run, 48);
            const float X = ((kq ^ 1) > kq ? t1 : 1.0f) * ((kq ^ 2) > kq ? t2 : 1.0f) * ((kq ^ 3) > kq ? t3 : 1.0f);
            const float base = carry[qb] * X;
            carry[qb] *= (run * t1) * (t2 * t3);
            Pf[qb] = pack8(sg[0] * (base * ex_[0]), sg[1] * (base * ex_[1]), sg[2] * (base * ex_[2]), sg[3] * (base * ex_[3]), sg[4] * (base * ex_[4]), sg[5] * (base * ex_[5]), sg[6] * (base * ex_[6]), sg[7] * (base * ex_[7])); }
#pragma unroll
        for (int db = 0; db < 4; ++db)
#pragma unroll
            for (int qb = 0; qb < 4; ++qb) O[db][qb] = mfma16(vf.V[db], Pf[qb], O[db][qb]);
        const bool fin = (carry[0] < SB_EXIT_P) && (carry[1] < SB_EXIT_P) && (carry[2] < SB_EXIT_P) && (carry[3] < SB_EXIT_P);
        if (__all(fin)) break;
        cur = nxt;
    }
#pragma unroll
    for (int qb = 0; qb < 4; ++qb) { bf16* op = ocat + (tb + q0 + 16 * qb + c) * DM + 1024 + hc * 64 + 4 * kq;
        float q2 = 0.f;
#pragma unroll
        for (int db = 0; db < 4; ++db) { const f32x4 o = O[db][qb]; v2u w; w.x = pk2(o[0], o[1]); w.y = pk2(o[2], o[3]); *(GAS v2u*)(op + 16 * db) = w;
            q2 += (bflo(w.x) * bflo(w.x) + bfhi(w.x) * bfhi(w.x)) + (bflo(w.y) * bflo(w.y) + bfhi(w.y) * bfhi(w.y)); }
        q2 += __shfl_xor(q2, 16); q2 += __shfl_xor(q2, 32); if (kq == 0) ((float*)(wsp(F) + WS_SSQ))[(tb + q0 + 16 * qb + c) * 32 + 16 + hc] = q2; }
}

__device__ __forceinline__ void gate_unit(Frame& F, int u) {
    const int lane = F.lane, c = lane & 15, kq = lane >> 4;
    const bf16* hrow = (const bf16*)(wsp(F) + WS_HB) + (size_t)(u * 16 + c) * DM + 8 * kq;
    const bf16* wg = (const bf16*)(wsp(F) + WS_WCMP + 1024 * 1024 + 64 * 1024) + (size_t)c * 2048 + 8 * kq;
    f32x4 a0 = (f32x4){0.f, 0.f, 0.f, 0.f}, a1 = (f32x4){0.f, 0.f, 0.f, 0.f};
#pragma unroll 8
    for (int ks = 0; ks < 64; ++ks) { const bf16x8 hf = ldg8(hrow + ks * 32); a0 = mfma16(ldg8(wg + ks * 32), hf, a0); a1 = mfma16(ldg8(wg + (size_t)16 * 2048 + ks * 32), hf, a1); }
    float* gp = (float*)(wsp(F) + WS_GBUF) + (size_t)(u * 16 + c) * 32 + 4 * kq;
    *(GAS f32x4*)gp = a0; *(GAS f32x4*)(gp + 16) = a1;
}

__device__ __forceinline__ float gelu_tanh(float x) { const float u = 0.7978845608028654f * (x + 0.044715f * x * x * x); const float e = __expf(2.0f * u); return 0.5f * x * (2.0f - 2.0f / (e + 1.0f)); }
__device__ __forceinline__ void cmp_mlp_unit(Frame& F, int l, int unit) {
    const int lane = F.lane, c = lane & 15, kq = lane >> 4;
    const int nt = unit & 31, g = (unit >> 5) & 1, b = (unit >> 6) & 1, kv = unit >> 7;
    const bf16* proj = (const bf16*)(wsp(F) + WS_PROJ);
    const bf16* W1t = (const bf16*)(wsp(F) + WS_WCMP) + (size_t)kv * 128 * 2048; const bf16* W2t = (const bf16*)(wsp(F) + WS_WCMP + 2 * 128 * 2048 * 2) + (size_t)kv * 64 * 128;
    const float* pe = inp(F, kv ? I_PEV : I_PEK) + (size_t)l * 32 * 64;
    const int n = nt * 16 + c; const size_t tb = (size_t)b * SEQ; const int xoff = (kv ? P_VBC : P_KBC) + g * 64;
    LAS f32x4* red = (LAS f32x4*)(F.lds);
    f32x4 H[4][2];
#pragma unroll
    for (int s = 0; s < 4; ++s) { H[s][0] = (f32x4){0.f, 0.f, 0.f, 0.f}; H[s][1] = (f32x4){0.f, 0.f, 0.f, 0.f}; }
#pragma unroll 2
    for (int kk = 0; kk < 8; ++kk) {
        const int ks = F.wave * 8 + kk, lt = ks >> 1, d0 = (ks & 1) * 32 + 8 * kq; int tok = 16 * n + lt; if (tok > SEQ - 1) tok = SEQ - 1;
        const bf16x8 xr = ldg8(proj + (tb + tok) * NPROJ + xoff + d0);
        const f32x4 p0 = *(const GAS f32x4*)(pe + lt * 64 + d0), p1 = *(const GAS f32x4*)(pe + lt * 64 + d0 + 4);
        const bf16x8 Xf = pack8(bf2f((unsigned short)xr[0]) + p0[0], bf2f((unsigned short)xr[1]) + p0[1], bf2f((unsigned short)xr[2]) + p0[2], bf2f((unsigned short)xr[3]) + p0[3],
                                bf2f((unsigned short)xr[4]) + p1[0], bf2f((unsigned short)xr[5]) + p1[1], bf2f((unsigned short)xr[6]) + p1[2], bf2f((unsigned short)xr[7]) + p1[3]);
#pragma unroll
        for (int s = 0; s < 4; ++s)
#pragma unroll
            for (int h = 0; h < 2; ++h) { const int hid = 32 * s + 8 * (c >> 2) + 4 * h + (c & 3);
                H[s][h] = mfma16(ldg8(W1t + (size_t)hid * 2048 + ks * 32 + 8 * kq), Xf, H[s][h]); }
    }
#pragma unroll
    for (int s = 0; s < 4; ++s)
#pragma unroll
        for (int h = 0; h < 2; ++h) red[(F.wave * 8 + s * 2 + h) * 64 + lane] = H[s][h];
    __syncthreads();
    if (F.wave == 0) {
#pragma unroll
        for (int s = 0; s < 4; ++s)
#pragma unroll
            for (int h = 0; h < 2; ++h) { f32x4 a = red[(s * 2 + h) * 64 + lane];
#pragma unroll
                for (int w = 1; w < 8; ++w) a += red[(w * 8 + s * 2 + h) * 64 + lane];
                H[s][h] = a; }
        f32x4 Y[4];
#pragma unroll
        for (int eb = 0; eb < 4; ++eb) Y[eb] = (f32x4){0.f, 0.f, 0.f, 0.f};
#pragma unroll
        for (int s = 0; s < 4; ++s) {
            const bf16x8 Hf = pack8(gelu_tanh(H[s][0][0]), gelu_tanh(H[s][0][1]), gelu_tanh(H[s][0][2]), gelu_tanh(H[s][0][3]), gelu_tanh(H[s][1][0]), gelu_tanh(H[s][1][1]), gelu_tanh(H[s][1][2]), gelu_tanh(H[s][1][3]));
#pragma unroll
            for (int eb = 0; eb < 4; ++eb) Y[eb] = mfma16(ldg8(W2t + (size_t)(16 * eb + c) * 128 + 32 * s + 8 * kq), Hf, Y[eb]);
        }
        const bool valid = n <= 510;
        if (kv == 0) { bf16* kc = (bf16*)(wsp(F) + WS_SMALL + SM_KCMP) + ((size_t)(b * 2 + g) * 512 + n) * 64 + 4 * kq;
#pragma unroll
            for (int eb = 0; eb < 4; ++eb) { v2u w; w.x = valid ? pk2(Y[eb][0], Y[eb][1]) : 0u; w.y = valid ? pk2(Y[eb][2], Y[eb][3]) : 0u; *(GAS v2u*)(kc + 16 * eb) = w; } }
        else { bf16* vc = (bf16*)(wsp(F) + WS_SMALL + SM_VCMPT) + (size_t)(b * 2 + g) * 64 * 512 + n;
#pragma unroll
            for (int eb = 0; eb < 4; ++eb)
#pragma unroll
                for (int r = 0; r < 4; ++r) vc[(size_t)(16 * eb + 4 * kq + r) * 512] = valid ? (bf16)f2bf(Y[eb][r]) : (bf16)0; }
    }
    __syncthreads();
}

__device__ __forceinline__ int next_below(unsigned long long ulo, unsigned long long uhi, int j) {
    if (j > 64) { const unsigned long long m = (j >= 128) ? uhi : (uhi & ((1ull << (j - 64)) - 1ull)); if (m) return 127 - __builtin_clzll(m); j = 64; }
    const unsigned long long m = (j >= 64) ? ulo : (ulo & ((1ull << j) - 1ull));
    return m ? 63 - __builtin_clzll(m) : -1;
}
__device__ __forceinline__ void nsa_unit(Frame& F, int b, int g, int q0) {
    const int lane = F.lane, c = lane & 15, kq = lane >> 4;
    const bf16* proj = (const bf16*)(wsp(F) + WS_PROJ); const bf16* vT = (const bf16*)(wsp(F) + WS_VT); bf16* ocat = (bf16*)(wsp(F) + WS_OCAT);
    const bf16* kcmp = (const bf16*)(wsp(F) + WS_SMALL + SM_KCMP) + (size_t)(b * 2 + g) * 512 * 64;
    const bf16* vcmpT = (const bf16*)(wsp(F) + WS_SMALL + SM_VCMPT) + (size_t)(b * 2 + g) * 64 * 512;
    LAS float* imp = (LAS float*)(F.lds + F.wave * AW_BYTES + AW_IMP);
    LAS unsigned* selm = (LAS unsigned*)(F.lds + F.wave * AW_BYTES + AW_SEL);
    LAS bf16x8* Ql = (LAS bf16x8*)(F.lds + F.wave * AW_BYTES + AW_Q);
    const size_t tb = (size_t)b * SEQ; const int t = q0 + c;
    const float* grow = (const float*)(wsp(F) + WS_GBUF) + (tb + t) * 32 + g * 12;
    { const bf16* qp = proj + (tb + t) * NPROJ + P_QB + g * 256 + kq * 8; q_park(Ql, qp, qp + 64, qp + 128, qp + 192, lane); }
    f32x4 sl2;
#pragma unroll
    for (int qb = 0; qb < 4; ++qb) sl2[qb] = slope2_of(8 + g * 4 + qb);
    const f32x4 sl2c = sl2 * 16.0f;
    for (int i = lane; i < 16 * IMP_STRIDE; i += 64) imp[i] = 0.f;
    const int tmax = q0 + 15; const int nmax = tmax >= 31 ? ((tmax - 31) >> 4) : -1; const int ntop = nmax & ~31;
    const bf16* Kc = kcmp + (size_t)(8 * (c >> 2) + (c & 3)) * 64 + kq * 8;
    const bf16* Vc = vcmpT + (size_t)c * 512 + 8 * kq;
    Flash S; flash_init(S, -1.0e30f, -1.0e30f, -1.0e30f, -1.0e30f);
    KF cur, nxt;
    if (nmax >= 0) {
        load_k(cur, Kc, 64, ntop);
        for (int nbase = ntop; nbase >= 0; nbase -= 32) {
            ITER_FENCE();
            VF vf; load_v(vf, Vc, 512, nbase);
            load_k(nxt, Kc, 64, nbase >= 32 ? nbase - 32 : nbase);
            f32x4 Sv[2][4]; qk_scores(Sv, cur, Ql, lane);
            const int d0 = t - 31 - 16 * (nbase + 8 * kq);
            const f32x4 b0 = sl2 * -(float)d0;
            unsigned vm = 0xffu;
            if (!(16 * (nbase + 31) + 31 <= q0)) { vm = 0u;
#pragma unroll
                for (int j = 0; j < 8; ++j) vm |= (d0 - 16 * j >= 0) ? (1u << j) : 0u; }
            flash_step(S, Sv, vf, b0, sl2c, vm);
            cur = nxt;
        }
    }
    f32x4 inv;
#pragma unroll
    for (int qb = 0; qb < 4; ++qb) { inv[qb] = flash_inv(S, qb, false, 0.f);
        const float g0 = sigmoidf_(grow[qb * 3 + 0]), g2 = sigmoidf_(grow[qb * 3 + 2]), sc = inv[qb] * g0;
        bf16* op = ocat + (tb + t) * DM + 512 + (g * 4 + qb) * 64 + 4 * kq;
#pragma unroll
        for (int db = 0; db < 4; ++db) { const v2u ow = *(const GAS v2u*)(op + 16 * db); const f32x4 old = (f32x4){bflo(ow.x), bfhi(ow.x), bflo(ow.y), bfhi(ow.y)};
            const f32x4 o = old * g2 + S.O[db][qb] * sc; v2u w; w.x = pk2(o[0], o[1]); w.y = pk2(o[2], o[3]); *(GAS v2u*)(op + 16 * db) = w; } }
    LDS_WAIT();
    for (int nbase = 0; nbase <= nmax; nbase += 32) {
        ITER_FENCE();
        const bf16* kp = Kc + (size_t)nbase * 64;
        KF x; x.K[0][0] = ldg8(kp); x.K[0][1] = ldg8(kp + 32); x.K[1][0] = ldg8(kp + 4 * 64); x.K[1][1] = ldg8(kp + 4 * 64 + 32);
        f32x4 Sv[2][4]; qk_scores(Sv, x, Ql, lane);
        float G[2], Wl[2];
#pragma unroll
        for (int h = 0; h < 2; ++h) { float gs = 0.f, last = 0.f;
#pragma unroll
            for (int r = 0; r < 4; ++r) { const int dist = t - 16 * (nbase + 8 * kq + 4 * h + r) - 31; const bool vis = dist >= 0; const float fd = (float)dist; float pv = 0.f;
#pragma unroll
                for (int qb = 0; qb < 4; ++qb) pv += vis ? ex2(Sv[h][qb][r] * SC2 - sl2[qb] * fd - S.m[qb]) * inv[qb] : 0.f;
                gs += pv; last = pv; }
            G[h] = gs; Wl[h] = last; }
        const int j0 = (nbase >> 2) + 2 * kq;
        LAS float* ip = imp + c * IMP_STRIDE + j0;
        ip[0] += G[0]; LDS_WAIT();
        ip[1] += G[1]; LDS_WAIT();
        ip[1] += Wl[0]; LDS_WAIT();
        ip[2] += Wl[1]; LDS_WAIT();
    }
    unsigned long long ulo = 0ull, uhi = 0ull, ilo = ~0ull, ihi = ~0ull;
    for (int cq = 0; cq < 16; ++cq) {
        const int tq = q0 + cq, cur_ = tq >> 6;
        const int ja = lane, jb = lane + 64;
        const bool oka = ja <= cur_, okb = jb <= cur_;
        unsigned ka = 0u, kb = 0u;
        if (oka) ka = (ja == 0 || ja == cur_ || ja == cur_ - 1) ? 0x461c4000u : __builtin_bit_cast(unsigned, imp[cq * IMP_STRIDE + ja]) + 1u;
        if (okb) kb = (jb == cur_ || jb == cur_ - 1) ? 0x461c4000u : __builtin_bit_cast(unsigned, imp[cq * IMP_STRIDE + jb]) + 1u;
        unsigned long long mlo, mhi;
        if (cur_ < 16) { mlo = __ballot(oka); mhi = 0ull; }
        else {
            unsigned thr = 0u;
#pragma unroll 1
            for (int bit = 30; bit >= 0; --bit) { const unsigned tr = thr | (1u << bit);
                const int cntv = __popcll(__ballot(ka >= tr)) + __popcll(__ballot(kb >= tr)); if (cntv >= 16) thr = tr; }
            mlo = __ballot(ka > thr); mhi = __ballot(kb > thr);
            int need = 16 - (__popcll(mlo) + __popcll(mhi));
            unsigned long long elo = __ballot(ka == thr), ehi = __ballot(kb == thr);
            while (need > 0 && elo) { const unsigned long long bsel = elo & (~elo + 1ull); mlo |= bsel; elo ^= bsel; --need; }
            while (need > 0 && ehi) { const unsigned long long bsel = ehi & (~ehi + 1ull); mhi |= bsel; ehi ^= bsel; --need; }
        }
        ulo |= mlo; uhi |= mhi; ilo &= mlo; ihi &= mhi;
        if (lane == 0) { selm[cq * 4 + 0] = (unsigned)mlo; selm[cq * 4 + 1] = (unsigned)(mlo >> 32); selm[cq * 4 + 2] = (unsigned)mhi; selm[cq * 4 + 3] = (unsigned)(mhi >> 32); }
    }
    LDS_WAIT();
    const unsigned long long mylo = (unsigned long long)selm[c * 4 + 0] | ((unsigned long long)selm[c * 4 + 1] << 32);
    const unsigned long long myhi = (unsigned long long)selm[c * 4 + 2] | ((unsigned long long)selm[c * 4 + 3] << 32);
    flash_init(S, -1.0e30f, -1.0e30f, -1.0e30f, -1.0e30f);
    const bf16* Kb = proj + (tb + 8 * (c >> 2) + (c & 3)) * NPROJ + P_KBS + g * 64 + kq * 8;
    const bf16* Vb = vT + (size_t)(V_BS + g * 64 + c) * MTOK + tb + 8 * kq;
    int j = next_below(ulo, uhi, (tmax >> 6) + 1), hs = 1;
    load_k(cur, Kb, NPROJ, 64 * j + 32);
    while (j >= 0) {
        ITER_FENCE();
        const int kbase = 64 * j + 32 * hs;
        VF vf; load_v(vf, Vb, MTOK, kbase);
        int jn = j, hn = 0; if (hs == 0) { jn = next_below(ulo, uhi, j); hn = 1; }
        load_k(nxt, Kb, NPROJ, jn >= 0 ? 64 * jn + 32 * hn : kbase);
        const bool mine = j < 64 ? ((mylo >> j) & 1ull) != 0ull : ((myhi >> (j - 64)) & 1ull) != 0ull;
        const bool all16 = j < 64 ? ((ilo >> j) & 1ull) != 0ull : ((ihi >> (j - 64)) & 1ull) != 0ull;
        f32x4 Sv[2][4]; qk_scores(Sv, cur, Ql, lane);
        const int d0 = t - kbase - 8 * kq;
        const f32x4 b0 = sl2 * -(float)d0;
        unsigned vm = 0xffu;
        if (!(all16 && kbase + 31 <= q0)) { vm = 0u;
#pragma unroll
            for (int jj = 0; jj < 8; ++jj) vm |= (mine && d0 - jj >= 0) ? (1u << jj) : 0u; }
        flash_step(S, Sv, vf, b0, sl2, vm);
        cur = nxt; j = jn; hs = hn;
    }
#pragma unroll
    for (int qb = 0; qb < 4; ++qb) { const float sc = flash_inv(S, qb, false, 0.f) * sigmoidf_(grow[qb * 3 + 1]);
        bf16* op = ocat + (tb + t) * DM + 512 + (g * 4 + qb) * 64 + 4 * kq; float q2 = 0.f;
#pragma unroll
        for (int db = 0; db < 4; ++db) { const v2u ow = *(const GAS v2u*)(op + 16 * db); const f32x4 old = (f32x4){bflo(ow.x), bfhi(ow.x), bflo(ow.y), bfhi(ow.y)};
            const f32x4 o = old + S.O[db][qb] * sc; v2u w; w.x = pk2(o[0], o[1]); w.y = pk2(o[2], o[3]); *(GAS v2u*)(op + 16 * db) = w;
            q2 += (bflo(w.x) * bflo(w.x) + bfhi(w.x) * bfhi(w.x)) + (bflo(w.y) * bflo(w.y) + bfhi(w.y) * bfhi(w.y)); }
        q2 += __shfl_xor(q2, 16); q2 += __shfl_xor(q2, 32); if (kq == 0) ((float*)(wsp(F) + WS_SSQ))[(tb + t) * 32 + 8 + g * 4 + qb] = q2; }
    LDS_WAIT();
}

__device__ __forceinline__ void attn1_phase(Frame& F, int l) {
    const int gw = F.vcu * NWAVES + F.wave, NGW = F.G * NWAVES;
    LAS unsigned* scr = (LAS unsigned*)(F.lds + F.wave * AW_BYTES);
    for (int u = F.vcu; u < 256; u += F.G) cmp_mlp_unit(F, l, u);
    if (F.wave >= 4) convert_range(F, l, CV_SMALL0, CV_GU1, scr);
    else for (int u = F.wave * F.G + F.vcu; u < MTOK / 16; u += 4 * F.G) gate_unit(F, u);
    for (int u = gw; u < 2048; u += NGW) win_unit<512, 1>(F, l, u >> 10, (u >> 9) & 1, (u & 511) * 16);
    for (int u = gw; u < 4096; u += NGW) sb_unit(F, u >> 11, (u >> 7) & 15, (u & 127) * 64);
    for (int u = gw; u < 2048; u += NGW) win_unit<128, 0>(F, l, u >> 10, (u >> 9) & 1, (u & 511) * 16);
    if (F.wave < 4) convert_range(F, l, CV_SMALL0, CV_GU1, scr);
}
__device__ __forceinline__ void attn2_phase(Frame& F, int l) {
    const int gw = F.vcu * NWAVES + F.wave, NGW = F.G * NWAVES;
    LAS unsigned* scr = (LAS unsigned*)(F.lds + F.wave * AW_BYTES);
    if (F.wave >= 4) convert_range(F, l, CV_GU1, CV_DN1, scr);
    for (int u = gw; u < 2048; u += NGW) nsa_unit(F, u >> 10, (u >> 9) & 1, (u & 511) * 16);
    if (F.wave < 4) convert_range(F, l, CV_GU1, CV_DN1, scr);
}
#ifndef MK_ONE_LAUNCH
#define MK_ONE_LAUNCH 1
#endif
#ifndef PHASE_MASK
#define PHASE_MASK 0xFFFF
#endif
constexpr int N_PHASES = 2 + 10 * DEPTH;
struct Args { const float* in[25]; float* out; unsigned char* ws; };
#define IN(k) (LO <= (k) && (k) < HI)
#define SEAM(k) do { if constexpr (IN(k) && IN((k) + 1)) xcd_barrier(bar); asm volatile("" : "+v"(F.tid), "+v"(F.lane) :: "memory"); } while (0)
#ifndef DBL_MASK
#define DBL_MASK 0
#endif
#define FENCE() asm volatile("" : "+v"(F.tid), "+v"(F.lane) :: "memory")
#define PHASE(k, bit, ...) do { if constexpr (IN(k) && (PHASE_MASK & (bit))) { __VA_ARGS__ if constexpr ((DBL_MASK & (bit)) != 0) { xcd_barrier(bar); FENCE(); __VA_ARGS__ } } } while (0)
template <int L, int LO, int HI>
__device__ __forceinline__ void layer_phases(Frame& F, const XcdBarrier& bar) {
    constexpr int l = L, pb = 2 + 10 * L;
    PHASE(pb + 0, 4, {
        pg8::Gemm g{(const pg8::bf16_t*)(wsp(F) + WS_HB), (const pg8::bf16_t*)(wsp(F) + WS_WIN), MTOK, NIN, DM}; pg8::StaticOrder S; S.init(MTOK, NIN, F.G, (int)blockIdx.x);
        pg8::EpiProj E{(pg8::bf16_t*)(wsp(F) + WS_PROJ), (pg8::bf16_t*)(wsp(F) + WS_VT), NPROJ, MTOK};
        pg8::gemm_phase<pg8::EpiProj, pg8::StaticOrder, true, true>(F.lds + RING_OFF, g, S, E);
    });
    SEAM(pb + 0);
    PHASE(pb + 1, 8, { attn1_phase(F, l); });
    SEAM(pb + 1);
    PHASE(pb + 2, 16, { attn2_phase(F, l); });
    if constexpr ((DBL_MASK & 0x10000) != 0) { xcd_barrier(bar); FENCE(); attn1_phase(F, l); xcd_barrier(bar); FENCE(); attn2_phase(F, l); }
    SEAM(pb + 2);
    PHASE(pb + 4, 64, {
        pg8::Gemm g{(const pg8::bf16_t*)(wsp(F) + WS_OCAT), (const pg8::bf16_t*)(wsp(F) + WS_WOUT), MTOK, DM, DM}; pg8::StaticOrder S; S.init(MTOK, DM, F.G, (int)blockIdx.x);
        pg8::GroupScale KS{(const float*)(wsp(F) + WS_SSQ), (PG8_LAS float*)(F.lds + GSC_OFF), RMS_EPS};
        const float* g1p = (const float*)(wsp(F) + WS_MOD) + (size_t)l * NB * 6 * DM + 2 * DM;
        if constexpr (l == 0) { pg8::EpiResid<false> E{(const void*)inp(F, I_X), (pg8::bf16_t*)(wsp(F) + WS_XA), g1p, 6 * DM, SEQ, DM, ALPHA};
            pg8::gemm_phase<pg8::EpiResid<false>, pg8::StaticOrder, true, true, pg8::NoGather, pg8::GroupScale>(F.lds + RING_OFF, g, S, E, pg8::NoGather(), KS); }
        else { pg8::EpiResid<true> E{(const void*)(wsp(F) + WS_XB), (pg8::bf16_t*)(wsp(F) + WS_XA), g1p, 6 * DM, SEQ, DM, ALPHA};
            pg8::gemm_phase<pg8::EpiResid<true>, pg8::StaticOrder, true, true, pg8::NoGather, pg8::GroupScale>(F.lds + RING_OFF, g, S, E, pg8::NoGather(), KS); }
    });
    SEAM(pb + 4);
    PHASE(pb + 5, 128, { post_mixer_phase(F, l); });
    if constexpr (IN(pb + 5)) { if constexpr (HI - LO > 1) xcd_barrier(bar); FENCE(); router_phase(F, l); }
    SEAM(pb + 5);
    PHASE(pb + 7, 512, {
        moe_tables(F, l);
        const PG8_LAS_T int* tab = (const PG8_LAS_T int*)(F.lds + TAB_OFF);
        pg8::Gemm g{(const pg8::bf16_t*)(wsp(F) + WS_HB), (const pg8::bf16_t*)(wsp(F) + WS_WGU), MAXROWS, NEXP * 1024, DM};
        pg8::MoeOrder S{4, F.G, (int)blockIdx.x, tab};
        pg8::EpiSwiGLU E{(pg8::bf16_t*)(wsp(F) + WS_HID), DEXP};
        pg8::MoeGather GA{tab, (const int*)(wsp(F) + WS_LIST), MTOK, (unsigned)(DM * 2), 0u};
        pg8::gemm_phase<pg8::EpiSwiGLU, pg8::MoeOrder, true, true, pg8::MoeGather>(F.lds + RING_OFF, g, S, E, GA);
    });
    SEAM(pb + 7);
    PHASE(pb + 8, 1024, {
        moe_tables(F, l);
        const PG8_LAS_T int* tab = (const PG8_LAS_T int*)(F.lds + TAB_OFF);
        pg8::Gemm g{(const pg8::bf16_t*)(wsp(F) + WS_HID), (const pg8::bf16_t*)(wsp(F) + WS_WD), MAXROWS, NEXP * DM, DEXP};
        pg8::MoeOrder S{8, F.G, (int)blockIdx.x, tab};
        pg8::EpiDown E{(pg8::bf16_t*)(wsp(F) + WS_YS), DM, tab, (const int*)(wsp(F) + WS_LIST), MTOK, (const float*)(wsp(F) + WS_SMALL + SM_GATEW)};
        pg8::gemm_phase<pg8::EpiDown, pg8::MoeOrder, true, true>(F.lds + RING_OFF, g, S, E);
    });
    SEAM(pb + 8);
    PHASE(pb + 9, 2048, { post_moe_phase(F, l, (l == DEPTH - 1) ? outp(F) : (float*)nullptr, (bf16*)(wsp(F) + WS_XB), l < DEPTH - 1); });
    PHASE(pb + 9, 4096, { if (l < DEPTH - 1) convert_small(F, l + 1); });
    SEAM(pb + 9);
}
template <int LO, int HI>
__global__ void __launch_bounds__(NWAVES * 64, 2) fwd_kernel(Args args) {
    extern __shared__ __attribute__((aligned(16))) unsigned char lds[];
    Frame F;
    F.lds = (LAS unsigned char*)lds;
    F.MISC = (volatile LAS unsigned*)(F.lds + MISC_OFF);
    F.tid = threadIdx.x; F.lane = F.tid & 63; F.wave = __builtin_amdgcn_readfirstlane(F.tid >> 6);
    F.G = gridDim.x; { const int bx = blockIdx.x; F.vcu = (F.G % 8 == 0) ? (bx % 8) * (F.G / 8) + bx / 8 : bx; }
    for (int u = F.tid; u < (LDS_BYTES - LDSCTL_OFF) / 4; u += NWAVES * 64) ((LAS unsigned*)(F.lds + LDSCTL_OFF))[u] = 0u;
    __syncthreads();
    if (F.tid < 25) ((LAS unsigned long long*)(F.lds + PTR_OFF))[F.tid] = (unsigned long long)args.in[F.tid];
    if (F.tid == 25) ((LAS unsigned long long*)(F.lds + PTR_OFF))[25] = (unsigned long long)args.ws;
    if (F.tid == 26) ((LAS unsigned long long*)(F.lds + PTR_OFF))[26] = (unsigned long long)args.out;
    __syncthreads();
    XcdBarrier bar; bar.bar = (unsigned*)(ctlp(F) + CW_BAR); bar.x = 0; bar.st = nullptr;
    if constexpr (HI - LO > 1) bar = xcd_barrier_post((unsigned*)(ctlp(F) + CW_BAR), F.MISC + 8);
    PHASE(0, 1, { ada_phase(F); });
    PHASE(0, 4096, { __syncthreads(); convert_small(F, 0); });
    SEAM(0);
    PHASE(1, 2, { ln_in_phase(F); });
    SEAM(1);
    layer_phases<0, LO, HI>(F, bar);
    layer_phases<1, LO, HI>(F, bar);
}
#undef IN
#undef SEAM
#undef PHASE

#if MK_ONE_LAUNCH
#define FWD_MAIN (fwd_kernel<0, N_PHASES>)
static bool set_lds_attr() { return hipFuncSetAttribute((const void*)FWD_MAIN, hipFuncAttributeMaxDynamicSharedMemorySize, LDS_BYTES) == hipSuccess; }
#else
#define FWD_MAIN (fwd_kernel<0, 1>)
template <int... P> static bool set_lds_attr_seq(std::integer_sequence<int, P...>) { bool ok = true; ((ok = ok && hipFuncSetAttribute((const void*)(fwd_kernel<P, P + 1>), hipFuncAttributeMaxDynamicSharedMemorySize, LDS_BYTES) == hipSuccess), ...); return ok; }
static bool set_lds_attr() { return set_lds_attr_seq(std::make_integer_sequence<int, N_PHASES>{}); }
template <int P> static void launch_one(int grid, hipStream_t stream, const Args& a) { hipLaunchKernelGGL((fwd_kernel<P, P + 1>), dim3(grid), dim3(NWAVES * 64), LDS_BYTES, stream, a); }
template <int... P> static void launch_phases(std::integer_sequence<int, P...>, int grid, hipStream_t stream, const Args& a) { (launch_one<P>(grid, stream, a), ...); }
#endif
extern "C" void kernel_launch(void* const* d_in, const int* in_sizes, int n_in, void* d_out, int out_size, void* d_ws, size_t ws_size, hipStream_t stream) {
    static int grid = 0;
    if (grid == 0) {
        if (n_in != 25 || out_size != MTOK * DM || ws_size < WS_END) { fprintf(stderr, "kernel_launch: unexpected problem shape (n_in %d, out %d, ws %zu)\n", n_in, out_size, ws_size); grid = -1; return; }
        int dev = 0, cus = 0, per_cu = 0;
        if (hipGetDevice(&dev) != hipSuccess || hipDeviceGetAttribute(&cus, hipDeviceAttributeMultiprocessorCount, dev) != hipSuccess) { grid = -1; return; }
        if (!set_lds_attr()) { fprintf(stderr, "kernel_launch: hipFuncSetAttribute failed\n"); grid = -1; return; }
        if (hipOccupancyMaxActiveBlocksPerMultiprocessor(&per_cu, (const void*)FWD_MAIN, NWAVES * 64, LDS_BYTES) != hipSuccess || per_cu < 1)
            fprintf(stderr, "kernel_launch: note: occupancy query reports %d workgroups per CU\n", per_cu);
        (void)hipGetLastError();
        grid = cus;
        if (grid > 256) grid = 256;
        grid &= ~7;
    }
    if (grid <= 0) return;
    (void)in_sizes;
    if (hipMemsetAsync((char*)d_ws + WS_CTL, 0, CTL_ZERO_BYTES, stream) != hipSuccess) return;
    Args a{};
    for (int i = 0; i < 25; ++i) a.in[i] = (const float*)d_in[i];
    a.out = (float*)d_out; a.ws = (unsigned char*)d_ws;
#if MK_ONE_LAUNCH
    hipLaunchKernelGGL((fwd_kernel<0, N_PHASES>), dim3(grid), dim3(NWAVES * 64), LDS_BYTES, stream, a);
#else
    launch_phases(std::make_integer_sequence<int, N_PHASES>{}, grid, stream, a);
#endif
}
```

```cpp
#include <hip/hip_runtime.h>
#include <cstdio>
#include <cstdint>
#include <utility>
#define MK_ONE_LAUNCH 1
namespace pg8 {
#define PG8_LAS __attribute__((address_space(3)))
#define PG8_LAS_T __attribute__((address_space(3)))
typedef unsigned short bf16_t;
typedef short bf16x8 __attribute__((ext_vector_type(8)));
typedef float f32x4 __attribute__((ext_vector_type(4)));
typedef unsigned u32x4 __attribute__((ext_vector_type(4)));
constexpr int BM = 256, BK = 64, HALF = 128, HTB = HALF * BK * 2  , STAGE_BYTES = 8 * HTB, NXCD = 8, WGM = 8;

__host__ __device__ __forceinline__ int lds_byte(int r, int c) { const int st = (r >> 4) * 2 + (c >> 5), rr = r & 15, cc = c & 31, ob = rr * 64 + cc * 2; return st * 1024 + (ob ^ (((ob >> 9) & 1) << 5)); }
__host__ __device__ __forceinline__ void stage_rc(int b, int& R, int& C) { const int st = b / 1024, sb = b % 1024, swz = sb ^ (((sb >> 9) & 1) << 5); R = (st >> 1) * 16 + swz / 64; C = (st & 1) * 32 + (swz % 64) / 2; }
__host__ __device__ __forceinline__ int perm32(int rho) { const int n = rho >> 4, i = rho & 15; return 8 * (i >> 2) + 4 * n + (i & 3); }

struct Unit { int pm, pn; };
struct Gemm { const bf16_t* A; const bf16_t* Bt; int M, N, K; };

struct StaticOrder {
    int nM, nN, nwg, G, c;
    __host__ __device__ void init(int M, int N, int G_, int c_) { nM = M / BM; nN = N / BM; nwg = nM * nN; G = G_; c = c_; }
    __host__ __device__ bool next(int i, Unit& u) const {
        const long L = (long)i * G + c; if (L >= nwg) return false;
        int wgid = (int)L; { const int q = nwg / NXCD, r = nwg % NXCD, xcd = wgid % NXCD, off = wgid / NXCD; wgid = (xcd < r ? xcd * (q + 1) : r * (q + 1) + (xcd - r) * q) + off; }
        const int nig = WGM * nN, gid = wgid / nig, fm = gid * WGM, gsz = (nM - fm) < WGM ? (nM - fm) : WGM;
        u.pm = fm + ((wgid % nig) % gsz); u.pn = (wgid % nig) / gsz; return true;
    }
    __device__ __forceinline__ void a_ready(const Unit&) const {}
    __device__ __forceinline__ void done(const Unit&) const {}
};
__device__ __forceinline__ unsigned cvt_pk_bf16(float lo, float hi) { unsigned r; asm volatile("s_nop 0\n\tv_cvt_pk_bf16_f32 %0, %1, %2\n\ts_nop 1" : "=v"(r) : "v"(lo), "v"(hi));     return r; }
typedef float f32x2 __attribute__((ext_vector_type(2)));
__device__ __forceinline__ unsigned short f2bf_rne(float f) { unsigned u = __builtin_bit_cast(unsigned, f); return (unsigned short)((u + 0x7fffu + ((u >> 16) & 1u)) >> 16); }

struct EpiProj {
    static constexpr bool PERM = true, AFTER_DRAIN = false;
    bf16_t* P; bf16_t* VT; int ldp; int ldvt;
    __device__ __forceinline__ void operator()(const f32x4 (&acc)[2][2][4][2], const Unit& u, int wr, int wc, int fr, int fq) const {
        const int row0 = u.pm * BM + wr * 64 + fr;
#pragma unroll
        for (int bj = 0; bj < 2; ++bj) {
            const int cb = u.pn * BM + bj * HALF;
            if (cb < ldp) {
                bf16_t* colp = P + (size_t)row0 * ldp + cb + wc * 32 + 8 * fq;
#pragma unroll
                for (int ai = 0; ai < 2; ++ai)
#pragma unroll
                    for (int m = 0; m < 4; ++m) { const f32x4 v0 = acc[ai][bj][m][0], v1 = acc[ai][bj][m][1];
                        u32x4 w; w.x = cvt_pk_bf16(v0[0], v0[1]); w.y = cvt_pk_bf16(v0[2], v0[3]); w.z = cvt_pk_bf16(v1[0], v1[1]); w.w = cvt_pk_bf16(v1[2], v1[3]);
                        *(u32x4*)(colp + (size_t)(ai * HALF + m * 16) * ldp) = w; }
            } else {
                const int c0 = cb - ldp + wc * 32 + 8 * fq;
#pragma unroll
                for (int n = 0; n < 2; ++n)
#pragma unroll
                    for (int e = 0; e < 4; ++e) { bf16_t* cp = VT + (size_t)(c0 + n * 4 + e) * ldvt + row0;
#pragma unroll
                        for (int ai = 0; ai < 2; ++ai)
#pragma unroll
                            for (int m = 0; m < 4; ++m) cp[ai * HALF + m * 16] = f2bf_rne(acc[ai][bj][m][n][e]); }
            }
        }
    }
};

template <bool XBF> struct EpiResid {
    static constexpr bool PERM = true, AFTER_DRAIN = false;
    const void* xin; bf16_t* out; const float* gate0; int gate_bstride; int rows_per_batch; int ldc; float alpha;
    __device__ __forceinline__ void operator()(const f32x4 (&acc)[2][2][4][2], const Unit& u, int wr, int wc, int fr, int fq) const {
        const int col0 = u.pn * BM + wc * 32 + 8 * fq;
        const float* gv = gate0 + (size_t)((u.pm * BM) / rows_per_batch) * gate_bstride;
#pragma unroll
        for (int bj = 0; bj < 2; ++bj) { const int c = col0 + bj * HALF; const f32x4 g0 = *(const f32x4*)(gv + c) + 1.0f, g1 = *(const f32x4*)(gv + c + 4) + 1.0f;
#pragma unroll
            for (int ai = 0; ai < 2; ++ai)
#pragma unroll
                for (int m = 0; m < 4; ++m) { const size_t off = (size_t)(u.pm * BM + ai * HALF + wr * 64 + m * 16 + fr) * ldc + c;
                    if (m & 1) asm volatile("" ::: "memory");
                    f32x4 x0, x1;
                    if (XBF) { const u32x4 xw = *(const u32x4*)((const bf16_t*)xin + off);
                        x0 = (f32x4){__builtin_bit_cast(float, xw.x << 16), __builtin_bit_cast(float, xw.x & 0xffff0000u), __builtin_bit_cast(float, xw.y << 16), __builtin_bit_cast(float, xw.y & 0xffff0000u)};
                        x1 = (f32x4){__builtin_bit_cast(float, xw.z << 16), __builtin_bit_cast(float, xw.z & 0xffff0000u), __builtin_bit_cast(float, xw.w << 16), __builtin_bit_cast(float, xw.w & 0xffff0000u)}; }
                    else { x0 = *(const f32x4*)((const float*)xin + off); x1 = *(const f32x4*)((const float*)xin + off + 4); }
                    const f32x4 v0 = x0 * alpha + g0 * acc[ai][bj][m][0], v1 = x1 * alpha + g1 * acc[ai][bj][m][1];
                    u32x4 w; w.x = cvt_pk_bf16(v0[0], v0[1]); w.y = cvt_pk_bf16(v0[2], v0[3]); w.z = cvt_pk_bf16(v1[0], v1[1]); w.w = cvt_pk_bf16(v1[2], v1[3]);
                    *(u32x4*)(out + off) = w; } }
    }
};

struct EpiSwiGLU {
    static constexpr bool PERM = true, AFTER_DRAIN = false;
    bf16_t* H; int ldh;
    __device__ __forceinline__ void operator()(const f32x4 (&acc)[2][2][4][2], const Unit& u, int wr, int wc, int fr, int fq) const {
        const int row0 = u.pm * BM + wr * 64 + fr, pnl = u.pn & 3;
        const int j0 = pnl * 128 + wc * 16 + 4 * fq;
#pragma unroll
        for (int ai = 0; ai < 2; ++ai)
#pragma unroll
            for (int m = 0; m < 4; ++m) { bf16_t* rowp = H + (size_t)(row0 + ai * HALF + m * 16) * ldh + j0;
#pragma unroll
                for (int bj = 0; bj < 2; ++bj) { const f32x4 v0 = acc[ai][bj][m][0], v1 = acc[ai][bj][m][1];
                    const float h0 = v0[0] / (1.0f + __expf(-v0[0])) * v0[1], h1 = v0[2] / (1.0f + __expf(-v0[2])) * v0[3];
                    const float h2 = v1[0] / (1.0f + __expf(-v1[0])) * v1[1], h3 = v1[2] / (1.0f + __expf(-v1[2])) * v1[3];
                    typedef unsigned u32x2 __attribute__((ext_vector_type(2)));
                    u32x2 w; w.x = cvt_pk_bf16(h0, h1); w.y = cvt_pk_bf16(h2, h3);
                    *(u32x2*)(rowp + bj * 64) = w; } }
    }
};

__device__ __forceinline__ int moe_row_aid(const PG8_LAS int* tab, const int* list, int list_stride, int rt, int row_in_tile) {
    const int e = tab[64 + rt], pos = rt * 256 + row_in_tile - tab[32 + e];
    return pos < tab[e] ? list[(size_t)e * list_stride + pos] : -1;
}
struct MoeGather {
    static constexpr bool ON = true;
    const PG8_LAS int* tab; const int* list; int list_stride; unsigned row_bytes, zero_off;
    __device__ __forceinline__ unsigned row_off(const Unit& u, int h, int r) const { const int aid = moe_row_aid(tab, list, list_stride, u.pm, h * HALF + r); return aid >= 0 ? (unsigned)(aid >> 1) * row_bytes : zero_off; }
};

struct EpiDown {
    static constexpr bool PERM = true, AFTER_DRAIN = false;
    bf16_t* Y; int ldy; const PG8_LAS int* tab; const int* list; int list_stride; const float* gatew;
    __device__ __forceinline__ void operator()(const f32x4 (&acc)[2][2][4][2], const Unit& u, int wr, int wc, int fr, int fq) const {
        const int pnl = u.pn & 7;
        const int col0 = pnl * BM + wc * 32 + 8 * fq;
#pragma unroll
        for (int ai = 0; ai < 2; ++ai)
#pragma unroll
            for (int m = 0; m < 4; ++m) { const int aid = moe_row_aid(tab, list, list_stride, u.pm, wr * 64 + fr + ai * HALF + m * 16);
                if (aid >= 0) { const float gw = gatew[aid]; bf16_t* rowp = Y + (size_t)aid * ldy + col0;
#pragma unroll
                    for (int bj = 0; bj < 2; ++bj) { const f32x4 v0 = acc[ai][bj][m][0] * gw, v1 = acc[ai][bj][m][1] * gw;
                        u32x4 w; w.x = cvt_pk_bf16(v0[0], v0[1]); w.y = cvt_pk_bf16(v0[2], v0[3]); w.z = cvt_pk_bf16(v1[0], v1[1]); w.w = cvt_pk_bf16(v1[2], v1[3]);
                        *(u32x4*)(rowp + bj * HALF) = w; } } }
    }
};

struct MoeOrder {
    int NT, G, c; const PG8_LAS int* tab;
    __device__ __forceinline__ bool next(int i, Unit& u) const {
        const int x = c & 7, ci = c >> 3, per = G >> 3;
        const int q = i * per + ci, rt = x + 8 * (q / NT);
        if (rt >= tab[224]) return false;
        u.pm = rt; u.pn = tab[64 + rt] * NT + (q % NT); return true;
    }
    __device__ __forceinline__ void a_ready(const Unit&) const {}
    __device__ __forceinline__ void done(const Unit&) const {}
};

struct GroupScale {
    static constexpr bool ON = true; static constexpr int T1 = 8, T2 = 16;
    const float* ssq; PG8_LAS float* base; float eps;
    __device__ __forceinline__ const PG8_LAS float* tab(int buf) const { return base + buf * 768; }
    __device__ __forceinline__ void announce(const Unit& u, int buf) const {
        const int tid = threadIdx.x, row = tid >> 1, half = tid & 1;
        const f32x4* p = (const f32x4*)(ssq + (size_t)(u.pm * BM + row) * 32 + half * 16);
        const f32x4 a = p[0], b = p[1], c = p[2], d = p[3];
        const float s01 = (a[0] + a[1]) + (a[2] + a[3]) + (b[0] + b[1]) + (b[2] + b[3]), s23 = (c[0] + c[1]) + (c[2] + c[3]) + (d[0] + d[1]) + (d[2] + d[3]);
        const float o01 = __shfl_xor(s01, 1), o23 = __shfl_xor(s23, 1);
        const float sA = half == 0 ? s01 : o01, sB = half == 0 ? s23 : o23, sC = half == 0 ? (o01 + o23) : (s01 + s23);
        const float mA = sA * (1.0f / 512.0f) + eps, mB = sB * (1.0f / 512.0f) + eps, mC = sC * (1.0f / 1024.0f) + eps;
        PG8_LAS float* t = base + buf * 768 + 3 * row;
        if (half == 0) { t[0] = sqrtf(mB / mA); t[1] = sqrtf(mC / mB); }
        else t[2] = 1.0f / sqrtf(mC);
    }
};
struct NoGather { static constexpr bool ON = false; __device__ __forceinline__ unsigned row_off(const Unit&, int, int) const { return 0u; } };
struct NoKScale { static constexpr bool ON = false; static constexpr int T1 = 0, T2 = 0; __device__ __forceinline__ void announce(const Unit&, int) const {} __device__ __forceinline__ const PG8_LAS float* tab(int) const { return nullptr; } };
template <class Epi, class Sched, bool ALIGN_EPI = false, bool SP2 = false, class Gat = NoGather, class KSc = NoKScale>
__device__ __forceinline__ void gemm_phase(PG8_LAS unsigned char* lds, const Gemm g, const Sched& S, const Epi& E, const Gat& GA = Gat(), const KSc& KS = KSc()) {
    static_assert(!Gat::ON || SP2, "the gathered A operand is wired into the SP2 loop only");
    int tid_ = threadIdx.x; asm volatile("" : "+v"(tid_));
    const int tid = tid_, wid = __builtin_amdgcn_readfirstlane(tid >> 6), lane = tid & 63, wr = wid >> 2, wc = wid & 3, fr = lane & 15, fq = lane >> 4;
    const int K = g.K, nt = K / BK;
    unsigned voffA[2], voffB[2];
    int RA[2]; unsigned CA2[2];
#pragma unroll
    for (int i = 0; i < 2; ++i) { int R, C; stage_rc(tid * 16 + i * 8192, R, C); const int Rb = Epi::PERM ? ((R & ~31) + perm32(R & 31)) : R;
        voffA[i] = (unsigned)(R * K + C) * 2u; voffB[i] = (unsigned)(Rb * K + C) * 2u; RA[i] = R; CA2[i] = (unsigned)C * 2u; }
    unsigned gcu[2][2] = {{0u, 0u}, {0u, 0u}}, gnx[2][2] = {{0u, 0u}, {0u, 0u}};
    const size_t kstep = (size_t)(BK * 2);
    const size_t hstep = (size_t)HALF * K * 2;
    const size_t tstep = 2 * hstep;
    const unsigned ldsw = (unsigned)wid * 1024u;
    const int aoff = lds_byte(wr * 64 + fr, fq * 8), boff = lds_byte(wc * 32 + fr, fq * 8);
#define PG8_SA(b, h) (((b) * 2 + (h)) * HTB)
#define PG8_SB(b, h) ((4 + (b) * 2 + (h)) * HTB)
#define PG8_STAGE(bufoff, gbase, voff) do { _Pragma("unroll") for (int _i = 0; _i < 2; ++_i) \
        __builtin_amdgcn_global_load_lds((const unsigned*)((const char*)(gbase) + (voff)[_i]), (PG8_LAS unsigned*)(lds + (bufoff) + ldsw + _i * 8192), 16, 0, 0); } while (0)
#define PG8_STAGE_A(b, h, ptr, isnext) do { if constexpr (Gat::ON) { const bool _nx = (isnext); unsigned _tv[2] = {_nx ? gnx[h][0] : gcu[h][0], _nx ? gnx[h][1] : gcu[h][1]}; PG8_STAGE(PG8_SA(b, h), ptr, _tv); } \
        else { PG8_STAGE(PG8_SA(b, h), (ptr) + (h) * hstep, voffA); } } while (0)
#define PG8_LDA(dst, b, h) do { _Pragma("unroll") for (int m = 0; m < 4; ++m) _Pragma("unroll") for (int k = 0; k < 2; ++k) dst[m][k] = *(const PG8_LAS bf16x8*)(lds + PG8_SA(b, h) + aoff + m * 2048 + k * 1024); } while (0)
#define PG8_LDB(dst, b, h) do { _Pragma("unroll") for (int n = 0; n < 2; ++n) _Pragma("unroll") for (int k = 0; k < 2; ++k) dst[n][k] = *(const PG8_LAS bf16x8*)(lds + PG8_SB(b, h) + boff + n * 2048 + k * 1024); } while (0)
#define PG8_MMA(ai, bj, At, Bt) do { __builtin_amdgcn_s_setprio(1); _Pragma("unroll") for (int m = 0; m < 4; ++m) _Pragma("unroll") for (int n = 0; n < 2; ++n) _Pragma("unroll") for (int k = 0; k < 2; ++k) \
        acc[ai][bj][m][n] = __builtin_amdgcn_mfma_f32_16x16x32_bf16(Bt[n][k], At[m][k], acc[ai][bj][m][n], 0, 0, 0); __builtin_amdgcn_s_setprio(0); } while (0)
#define PG8_WAIT_V(n) asm volatile("s_waitcnt vmcnt(" #n ")" ::: "memory")
#define PG8_WAIT_L(n) asm volatile("s_waitcnt lgkmcnt(" #n ")" ::: "memory")
#define PG8_BAR __builtin_amdgcn_s_barrier()
#define PG8_SCHED __builtin_amdgcn_sched_barrier(0)
    Unit cur, nxt; int ui = 0;
    if (!S.next(0, cur)) return;
    f32x4 acc[2][2][4][2];
#pragma unroll
    for (int a = 0; a < 2; ++a)
#pragma unroll
        for (int b = 0; b < 2; ++b)
#pragma unroll
            for (int m = 0; m < 4; ++m)
#pragma unroll
                for (int n = 0; n < 2; ++n) acc[a][b][m][n] = (f32x4){0.f, 0.f, 0.f, 0.f};
    bf16x8 At[4][2], B0[2][2], B1[2][2];
#define PG8_KSCALE(buf, which) do { const PG8_LAS float* _tb = KS.tab(buf); _Pragma("unroll") for (int _a = 0; _a < 2; ++_a) _Pragma("unroll") for (int _m = 0; _m < 4; ++_m) { \
        const PG8_LAS float* _r = _tb + 3 * (_a * HALF + wr * 64 + _m * 16 + fr); const float _f = _r[which]; \
        _Pragma("unroll") for (int _b = 0; _b < 2; ++_b) _Pragma("unroll") for (int _n = 0; _n < 2; ++_n) acc[_a][_b][_m][_n] = acc[_a][_b][_m][_n] * _f; } } while (0)
    const char* cA = (const char*)g.A + (Gat::ON ? (size_t)0 : (size_t)cur.pm * tstep); const char* cB = (const char*)g.Bt + (size_t)cur.pn * tstep;
    if constexpr (Gat::ON) {
#pragma unroll
        for (int h = 0; h < 2; ++h)
#pragma unroll
            for (int i = 0; i < 2; ++i) { gcu[h][i] = GA.row_off(cur, h, RA[i]) + CA2[i]; gnx[h][i] = gcu[h][i]; } }
    if constexpr (KSc::ON) KS.announce(cur, 0);
    S.a_ready(cur);
    if constexpr (SP2) {
        PG8_STAGE(PG8_SB(0, 0), cB, voffB); PG8_STAGE(PG8_SB(0, 1), cB + hstep, voffB); PG8_STAGE_A(0, 0, cA, false); PG8_STAGE_A(0, 1, cA, false);
        if (wr == 1) PG8_BAR;
        PG8_WAIT_V(2); PG8_BAR;
        PG8_STAGE(PG8_SB(1, 0), cB + kstep, voffB); PG8_STAGE_A(1, 0, cA + kstep, false); PG8_STAGE(PG8_SB(1, 1), cB + hstep + kstep, voffB);
        PG8_WAIT_V(6); PG8_BAR;
    } else {
        PG8_STAGE(PG8_SB(0, 0), cB, voffB); PG8_STAGE(PG8_SA(0, 0), cA, voffA); PG8_STAGE(PG8_SB(0, 1), cB + hstep, voffB); PG8_STAGE(PG8_SA(0, 1), cA + hstep, voffA);
        if (wr == 1) PG8_BAR;
        PG8_WAIT_V(4); PG8_BAR;
        PG8_STAGE(PG8_SB(1, 0), cB + kstep, voffB); PG8_STAGE(PG8_SA(1, 0), cA + kstep, voffA); PG8_STAGE(PG8_SB(1, 1), cB + hstep + kstep, voffB);
        PG8_WAIT_V(6); PG8_BAR;
    }
    for (;;) {
        const bool has_next = S.next(ui + 1, nxt);
        if constexpr (KSc::ON) { if (has_next) KS.announce(nxt, (ui + 1) % 3); }
        const char* nA = (has_next && !Gat::ON) ? (const char*)g.A + (size_t)nxt.pm * tstep : cA; const char* nB = has_next ? (const char*)g.Bt + (size_t)nxt.pn * tstep : cB;
        if constexpr (Gat::ON) { if (has_next) {
#pragma unroll
            for (int h = 0; h < 2; ++h)
#pragma unroll
                for (int i = 0; i < 2; ++i) gnx[h][i] = GA.row_off(nxt, h, RA[i]) + CA2[i]; } }
        int t = 0;
        for (int seg = 0; seg < (KSc::ON ? 3 : 1); ++seg) {
        const int thi = !KSc::ON ? nt : (seg == 0 ? KSc::T1 : (seg == 1 ? KSc::T2 : nt));
        for (; t < thi; t += 2) {
            const bool last = (t == nt - 2);
            const char* a1 = cA + (size_t)(t + 1) * kstep;
            const char* a2 = last ? nA : cA + (size_t)(t + 2) * kstep; const char* b2 = last ? nB : cB + (size_t)(t + 2) * kstep;
            const char* a3 = a2 + kstep; const char* b3 = b2 + kstep;
            if (last && has_next) S.a_ready(nxt);
            if constexpr (SP2) {
            PG8_LDB(B0, 0, 0); PG8_LDB(B1, 0, 1); PG8_SCHED; PG8_LDA(At, 0, 0); PG8_STAGE_A(1, 1, a1, false);
            PG8_WAIT_V(8); PG8_WAIT_L(0); PG8_BAR; PG8_MMA(0, 0, At, B0); PG8_MMA(0, 1, At, B1); PG8_BAR; PG8_SCHED;
            PG8_LDA(At, 0, 1); PG8_STAGE(PG8_SB(0, 0), b2, voffB); PG8_STAGE(PG8_SB(0, 1), b2 + hstep, voffB); PG8_STAGE_A(0, 0, a2, last);
            PG8_WAIT_V(8); PG8_WAIT_L(0); PG8_BAR; PG8_MMA(1, 0, At, B0); PG8_MMA(1, 1, At, B1); PG8_BAR; PG8_SCHED;
            PG8_LDB(B0, 1, 0); PG8_LDB(B1, 1, 1); PG8_SCHED; PG8_LDA(At, 1, 0); PG8_STAGE_A(0, 1, a2, last);
            PG8_WAIT_V(8); PG8_WAIT_L(0); PG8_BAR; PG8_MMA(0, 0, At, B0); PG8_MMA(0, 1, At, B1); PG8_BAR; PG8_SCHED;
            PG8_LDA(At, 1, 1); PG8_STAGE(PG8_SB(1, 0), b3, voffB); PG8_STAGE(PG8_SB(1, 1), b3 + hstep, voffB); PG8_STAGE_A(1, 0, a3, last);
            PG8_WAIT_V(8); PG8_WAIT_L(0); PG8_BAR; PG8_MMA(1, 0, At, B0); PG8_MMA(1, 1, At, B1); PG8_BAR; PG8_SCHED;
            } else {
            PG8_LDB(B0, 0, 0); PG8_SCHED; PG8_LDA(At, 0, 0); PG8_STAGE(PG8_SA(1, 1), a1 + hstep, voffA);
            PG8_WAIT_L(8); PG8_BAR; PG8_WAIT_L(0); PG8_MMA(0, 0, At, B0); PG8_BAR; PG8_SCHED;
            PG8_LDB(B1, 0, 1); PG8_STAGE(PG8_SB(0, 0), b2, voffB);
            PG8_BAR; PG8_WAIT_L(0); PG8_MMA(0, 1, At, B1); PG8_BAR;
            PG8_LDA(At, 0, 1); PG8_STAGE(PG8_SA(0, 0), a2, voffA);
            PG8_BAR; PG8_WAIT_L(0); PG8_MMA(1, 0, At, B0); PG8_BAR; PG8_SCHED;
            PG8_STAGE(PG8_SB(0, 1), b2 + hstep, voffB);
            PG8_WAIT_V(6); PG8_BAR; PG8_MMA(1, 1, At, B1); PG8_BAR;
            PG8_LDB(B0, 1, 0); PG8_SCHED; PG8_LDA(At, 1, 0); PG8_STAGE(PG8_SA(0, 1), a2 + hstep, voffA);
            PG8_WAIT_L(8); PG8_BAR; PG8_WAIT_L(0); PG8_MMA(0, 0, At, B0); PG8_BAR; PG8_SCHED;
            PG8_LDB(B1, 1, 1); PG8_STAGE(PG8_SB(1, 0), b3, voffB);
            PG8_BAR; PG8_WAIT_L(0); PG8_MMA(0, 1, At, B1); PG8_BAR;
            PG8_LDA(At, 1, 1); PG8_STAGE(PG8_SA(1, 0), a3, voffA);
            PG8_BAR; PG8_WAIT_L(0); PG8_MMA(1, 0, At, B0); PG8_BAR; PG8_SCHED;
            PG8_STAGE(PG8_SB(1, 1), b3 + hstep, voffB);
            PG8_WAIT_V(6); PG8_BAR; PG8_MMA(1, 1, At, B1); PG8_BAR;
            }
        }
        if constexpr (KSc::ON) { if (seg < 2) { asm volatile("" ::: "memory"); __builtin_amdgcn_sched_barrier(0); PG8_KSCALE(ui % 3, seg); __builtin_amdgcn_sched_barrier(0); asm volatile("" ::: "memory"); } }
        }
        if constexpr (ALIGN_EPI) { if (wr == 0) PG8_BAR; }
        if constexpr (KSc::ON) { asm volatile("" ::: "memory"); __builtin_amdgcn_sched_barrier(0); PG8_KSCALE(ui % 3, 2); __builtin_amdgcn_sched_barrier(0); }
        if constexpr (!Epi::AFTER_DRAIN) { E(acc, cur, wr, wc, fr, fq); S.done(cur); }
        if (!has_next) break;
#pragma unroll
        for (int a = 0; a < 2; ++a)
#pragma unroll
            for (int b = 0; b < 2; ++b)
#pragma unroll
                for (int m = 0; m < 4; ++m)
#pragma unroll
                    for (int n = 0; n < 2; ++n) acc[a][b][m][n] = (f32x4){0.f, 0.f, 0.f, 0.f};
        cur = nxt; cA = nA; cB = nB; ++ui;
        if constexpr (Gat::ON) {
#pragma unroll
            for (int h = 0; h < 2; ++h) { gcu[h][0] = gnx[h][0]; gcu[h][1] = gnx[h][1]; } }
        if constexpr (ALIGN_EPI) { if (wr == 1) PG8_BAR; }
    }
    PG8_WAIT_V(0);
    if constexpr (!ALIGN_EPI) { if (wr == 0) PG8_BAR; }
    PG8_BAR;
    if constexpr (Epi::AFTER_DRAIN) { E.fused(acc, cur, wr, wc, fr, fq, lds, wid, lane); S.done(cur); }
#undef PG8_SA
#undef PG8_SB
#undef PG8_STAGE
#undef PG8_KSCALE
#undef PG8_STAGE_A
#undef PG8_LDA
#undef PG8_LDB
#undef PG8_MMA
#undef PG8_WAIT_V
#undef PG8_WAIT_L
#undef PG8_BAR
#undef PG8_SCHED
}
}
constexpr int NWAVES = 8;
constexpr int NB = 2, SEQ = 8192, DM = 2048, MTOK = NB * SEQ, DEPTH = 2, HD = 64;
constexpr int NEXP = 32, DEXP = 512, NASSIGN = MTOK * 2;
constexpr int D_IN = 5144;
constexpr int NPROJ = 3712, NVT = 1408, NIN = NPROJ + NVT;
constexpr int P_QA = 0, P_KA = 512, P_QB = 640, P_KBC = 1152, P_VBC = 1280, P_KBS = 1408, P_KBW = 1536, P_QC = 1664, P_KC = 2688;
constexpr int V_C = 0, V_A = 1024, V_BS = 1152, V_BW = 1280;
constexpr float LN_EPS = 1e-5f, RMS_EPS = 1e-6f, ALPHA = 1.41421356237309515f;
constexpr float LOG2E = 1.44269504088896341f, LN2 = 0.693147180559945309f;
constexpr float SC2 = 0.125f * LOG2E;
constexpr int MAXROWS = 40960;
constexpr float SB_EXIT = -104.0f;

constexpr size_t MiB = 1u << 20;
constexpr size_t WS_CTL = 0, CTL_ZERO_BYTES = 1 * MiB;
constexpr size_t WS_MOD = 1 * MiB;
constexpr size_t WS_SMALL = 2 * MiB;
constexpr size_t WS_LIST = 5 * MiB;
constexpr size_t WS_WCMP = 7 * MiB;
constexpr size_t WS_WIN = 9 * MiB;
constexpr size_t WS_WOUT = 30 * MiB;
constexpr size_t WS_WGU = 38 * MiB;
constexpr size_t WS_WD = 166 * MiB;
constexpr size_t WS_XA = 230 * MiB;
constexpr size_t WS_XB = 358 * MiB;
constexpr size_t WS_HB = 486 * MiB;
constexpr size_t WS_PROJ = 550 * MiB;
constexpr size_t WS_VT = WS_PROJ + (size_t)MTOK * NPROJ * 2;
constexpr size_t WS_XS = WS_PROJ;
constexpr size_t WS_OCAT = 720 * MiB;
constexpr size_t WS_YS = WS_OCAT;
constexpr size_t WS_HID = 848 * MiB;
constexpr size_t WS_SSQ = 888 * MiB;
constexpr size_t WS_END = 890 * MiB;
static_assert(WS_VT + (size_t)NVT * MTOK * 2 <= WS_OCAT && WS_XS + (size_t)MAXROWS * DM * 2 <= WS_OCAT, "proj/vT/xs region");
static_assert(WS_WIN + (size_t)NIN * DM * 2 <= WS_WOUT && WS_WGU + (size_t)NEXP * 1024 * DM * 2 <= WS_WD && WS_WD + (size_t)NEXP * DM * DEXP * 2 <= WS_XA, "weight regions");
constexpr size_t SM_KCMP = 0;
constexpr size_t SM_VCMPT = 256 * 1024;
constexpr size_t SM_GATEW = 512 * 1024;
constexpr size_t SM_ROWINFO = 640 * 1024;
constexpr size_t SM_TILE = 800 * 1024;
constexpr size_t WS_GBUF = WS_SMALL + 1024 * 1024;
constexpr int CW_BAR = 4096;
constexpr int CW_CNT = 16384;

constexpr int RING_OFF = 0, RING_BYTES = 131072;
constexpr int TAB_OFF = RING_BYTES;
constexpr int GSC_OFF = RING_BYTES + 1024;
constexpr int LDSCTL_OFF = 143360, MISC_OFF = LDSCTL_OFF + 320;
constexpr int LDS_BYTES = 147456;

#define GAS __attribute__((address_space(1)))
#define LAS __attribute__((address_space(3)))
typedef unsigned short bf16;
typedef unsigned v4u __attribute__((ext_vector_type(4)));
typedef unsigned v2u __attribute__((ext_vector_type(2)));
typedef float f32x4 __attribute__((ext_vector_type(4)));
typedef short bf16x8 __attribute__((ext_vector_type(8)));
typedef GAS unsigned gu32;
#define RLX_AGENT __ATOMIC_RELAXED, __HIP_MEMORY_SCOPE_AGENT
#define LDS_WAIT() asm volatile("s_waitcnt lgkmcnt(0)" ::: "memory")
#define VM_WAIT() asm volatile("s_waitcnt vmcnt(0)" ::: "memory")
__device__ __forceinline__ unsigned f2bf(float f) { unsigned u = __builtin_bit_cast(unsigned, f); return (u + 0x7fffu + ((u >> 16) & 1u)) >> 16; }
__device__ __forceinline__ unsigned pk2(float lo, float hi) { return f2bf(lo) | (f2bf(hi) << 16); }
__device__ __forceinline__ float bf2f(unsigned short h) { return __builtin_bit_cast(float, (unsigned)h << 16); }
__device__ __forceinline__ float bflo(unsigned w) { return __builtin_bit_cast(float, w << 16); }
__device__ __forceinline__ float bfhi(unsigned w) { return __builtin_bit_cast(float, w & 0xffff0000u); }
__device__ __forceinline__ float ex2(float x) { return __builtin_amdgcn_exp2f(x); }
__device__ __forceinline__ float lg2(float x) { return __builtin_amdgcn_logf(x); }
__device__ __forceinline__ bf16x8 ldg8(const bf16* p) { return *(const GAS bf16x8*)p; }
__device__ __forceinline__ f32x4 mfma16(bf16x8 a, bf16x8 b, f32x4 c) { return __builtin_amdgcn_mfma_f32_16x16x32_bf16(a, b, c, 0, 0, 0); }
__device__ __forceinline__ bf16x8 pack8(float a0, float a1, float a2, float a3, float a4, float a5, float a6, float a7) {
    v4u w; w.x = pg8::cvt_pk_bf16(a0, a1); w.y = pg8::cvt_pk_bf16(a2, a3); w.z = pg8::cvt_pk_bf16(a4, a5); w.w = pg8::cvt_pk_bf16(a6, a7);
    return __builtin_bit_cast(bf16x8, w);
}
#define WS_DPP(v, ctrl) __builtin_bit_cast(float, __builtin_amdgcn_update_dpp(0, __builtin_bit_cast(int, (v)), (ctrl), 0xF, 0xF, true))
__device__ __forceinline__ float wave_sum(float v) {
    v += WS_DPP(v, 0xB1); v += WS_DPP(v, 0x4E); v += WS_DPP(v, 0x141); v += WS_DPP(v, 0x140);
    const float r0 = __builtin_bit_cast(float, __builtin_amdgcn_readlane(__builtin_bit_cast(int, v), 0)), r1 = __builtin_bit_cast(float, __builtin_amdgcn_readlane(__builtin_bit_cast(int, v), 16));
    const float r2 = __builtin_bit_cast(float, __builtin_amdgcn_readlane(__builtin_bit_cast(int, v), 32)), r3 = __builtin_bit_cast(float, __builtin_amdgcn_readlane(__builtin_bit_cast(int, v), 48));
    return (r0 + r1) + (r2 + r3);
}
#define XB_TMO      128
#define XB_XCNT(j)  (256  + 64 * (j))
#define XB_XSUB(j)  (1280 + 64 * (j))
#define XB_XGEN(j)  (2304 + 64 * (j))
#define XB_TOP      3328
#define XB_TOPGEN   3392
#define XCD_BAR_WORDS 3456
#define XB_SPIN_CAP (1u << 18)

__device__ __forceinline__ unsigned xb_ld(unsigned* p)              { return __hip_atomic_load(p, __ATOMIC_RELAXED, __HIP_MEMORY_SCOPE_AGENT); }
__device__ __forceinline__ unsigned xb_add(unsigned* p, unsigned v) { return __hip_atomic_fetch_add(p, v, __ATOMIC_RELAXED, __HIP_MEMORY_SCOPE_AGENT); }
__device__ __forceinline__ unsigned xb_xcc_id() { return (unsigned)__builtin_amdgcn_s_getreg((3 << 11) | 20) & 0xFu; }
#define XB_SPIN(cond, bar) do { unsigned _sp = 0; while (cond) { __builtin_amdgcn_s_sleep(1); \
    if ((++_sp & 255u) == 0u) { if (xb_ld(&(bar)[XB_TMO])) break; if (_sp > XB_SPIN_CAP) { atomicAdd(&(bar)[XB_TMO], 1u); break; } } } } while (0)

struct XcdBarrier {
    unsigned* bar; unsigned x;
    volatile LAS unsigned* st;
};

__device__ __forceinline__ XcdBarrier xcd_barrier_post(unsigned* bar, volatile LAS unsigned* st) {
    XcdBarrier b; b.bar = bar; b.x = xb_xcc_id(); b.st = st;
    if (threadIdx.x == 0) (void)xb_add(&bar[XB_XCNT(b.x)], 1u);
    return b;
}
__device__ __forceinline__ void xcd_barrier_complete(unsigned* bar, unsigned x, unsigned& nloc, unsigned& nx) {
    const unsigned G = gridDim.x * gridDim.y * gridDim.z;
    unsigned sum, cnt, mine, sp = 0u;
    for (;;) {
        sum = 0u; cnt = 0u; mine = 0u;
#pragma unroll
        for (unsigned j = 0; j < 16; ++j) { const unsigned c = xb_ld(&bar[XB_XCNT(j)]); sum += c; cnt += (c > 0u) ? 1u : 0u; mine = (j == x) ? c : mine; }
        if (sum == G) break;
        __builtin_amdgcn_s_sleep(1);
        if ((++sp & 255u) == 0u) { if (xb_ld(&bar[XB_TMO])) break; if (sp > XB_SPIN_CAP) { atomicAdd(&bar[XB_TMO], 1u); break; } }
    }
    nloc = mine > 0u ? mine : 1u; nx = cnt > 0u ? cnt : 1u;
}

__device__ __forceinline__ void xcd_barrier(const XcdBarrier& b) {
    asm volatile("s_waitcnt vmcnt(0)" ::: "memory");
    __syncthreads();
    if (threadIdx.x == 0) {
        unsigned* bar = b.bar;
        __builtin_amdgcn_s_waitcnt(0);
        unsigned nloc = b.st[0], nx = b.st[1];
        if (nloc == 0u) { xcd_barrier_complete(bar, b.x, nloc, nx); b.st[0] = nloc; b.st[1] = nx; }
        const unsigned old = xb_add(&bar[XB_XSUB(b.x)], 1u);
        const unsigned gen = old / nloc;
        if (old + 1u == (gen + 1u) * nloc) {
            __builtin_amdgcn_fence(__ATOMIC_RELEASE, "agent");
            asm volatile("s_waitcnt vmcnt(0)" ::: "memory");
            const unsigned og = xb_add(&bar[XB_TOP], 1u);
            const unsigned tg = og / nx;
            if (og + 1u == (tg + 1u) * nx) xb_add(&bar[XB_TOPGEN], 1u);
            else XB_SPIN(xb_ld(&bar[XB_TOPGEN]) == tg, bar);
            __builtin_amdgcn_fence(__ATOMIC_ACQUIRE, "agent");
            xb_add(&bar[XB_XGEN(b.x)], 1u);
            asm volatile("s_waitcnt vmcnt(0)" ::: "memory");
        } else {
            XB_SPIN(xb_ld(&bar[XB_XGEN(b.x)]) == gen, bar);
            __builtin_amdgcn_fence(__ATOMIC_ACQUIRE, "agent");
            asm volatile("s_waitcnt vmcnt(0)" ::: "memory");
        }
    }
    __syncthreads();
}
struct Frame {
    LAS unsigned char* lds;
    volatile LAS unsigned* MISC;
    int tid, lane, wave;
    int vcu, G;
};
constexpr int PTR_OFF = LDSCTL_OFF + 1024;
__device__ __forceinline__ unsigned char* tabp(const Frame& F, int i) {
    const unsigned long long v = ((LAS unsigned long long*)(F.lds + PTR_OFF))[i];
    const unsigned lo = __builtin_amdgcn_readfirstlane((unsigned)v), hi = __builtin_amdgcn_readfirstlane((unsigned)(v >> 32));
    return (unsigned char*)(((unsigned long long)hi << 32) | lo);
}
__device__ __forceinline__ const float* inp(const Frame& F, int i) { return (const float*)tabp(F, i); }
__device__ __forceinline__ unsigned char* wsp(const Frame& F) { return tabp(F, 25); }
__device__ __forceinline__ float* outp(const Frame& F) { return (float*)tabp(F, 26); }
__device__ __forceinline__ gu32* ctlp(const Frame& F) { return (gu32*)(tabp(F, 25) + WS_CTL); }
enum { I_X = 0, I_C, I_WADA, I_BADA, I_WIN, I_SINKS, I_PEK, I_W1K, I_W2K, I_PEV, I_W1V, I_W2V, I_MIXG, I_WOUT, I_LN1G, I_LN1B, I_WRG, I_BRG, I_WRE, I_BRE, I_WGATE, I_WUP, I_WDOWN, I_LN2G, I_LN2B };

__device__ __forceinline__ void ada_phase(Frame& F) {
    LAS float* cs = (LAS float*)(F.lds + 73728);
    LAS float* red = (LAS float*)(F.lds + 73728 + 16384);
    const float* c = inp(F, I_C);
    for (int i = F.tid; i < NB * DM; i += NWAVES * 64) { const float v = c[i]; cs[i] = v / (1.0f + __expf(-v)); }
    __syncthreads();
    float* mod = (float*)(wsp(F) + WS_MOD);
    for (int u = F.vcu; u < DEPTH * 96; u += F.G) {
        const int l = u / 96, cb = u % 96, col = cb * 128 + 2 * F.lane;
        const float* W = inp(F, I_WADA) + (size_t)l * DM * (6 * DM) + col;
        float a00 = 0.f, a01 = 0.f, a10 = 0.f, a11 = 0.f;
        const int k0 = F.wave * 256;
#pragma unroll 8
        for (int kk = 0; kk < 256; ++kk) { const int k = k0 + kk; typedef float f32x2_ __attribute__((ext_vector_type(2))); const f32x2_ w = *(const GAS f32x2_*)(W + (size_t)k * (6 * DM));
            const float s0 = cs[k], s1 = cs[DM + k]; a00 += s0 * w.x; a01 += s0 * w.y; a10 += s1 * w.x; a11 += s1 * w.y; }
        red[(F.wave * 2 + 0) * 128 + 2 * F.lane] = a00; red[(F.wave * 2 + 0) * 128 + 2 * F.lane + 1] = a01;
        red[(F.wave * 2 + 1) * 128 + 2 * F.lane] = a10; red[(F.wave * 2 + 1) * 128 + 2 * F.lane + 1] = a11;
        __syncthreads();
        if (F.tid < 256) { const int b = F.tid >> 7, j = F.tid & 127; float s = 0.f;
#pragma unroll
            for (int w = 0; w < 8; ++w) s += red[(w * 2 + b) * 128 + j];
            mod[((size_t)l * NB + b) * (6 * DM) + cb * 128 + j] = s + inp(F, I_BADA)[(size_t)l * 6 * DM + cb * 128 + j]; }
        __syncthreads();
    }
}

__device__ __forceinline__ void tr_item(const float* W, int ldw, int K, bf16* WT, size_t drow0, int rs, int src0, int nvalid, int k0, LAS float* scr, int lane) {
    const int nn = lane & 31;
#pragma unroll 8
    for (int i = 0; i < 32; ++i) { const int kk = 2 * i + (lane >> 5);
        scr[kk * 33 + nn] = (nn < nvalid) ? *(const GAS float*)(W + (size_t)(k0 + kk) * ldw + src0 + nn) : 0.f; }
    LDS_WAIT(); asm volatile("" ::: "memory");
    const int c = lane & 7;
#pragma unroll
    for (int j = 0; j < 4; ++j) { const int n = (lane >> 3) + 8 * j; const LAS float* s = scr + (8 * c) * 33 + n;
        v4u o; o.x = pk2(s[0 * 33], s[1 * 33]); o.y = pk2(s[2 * 33], s[3 * 33]); o.z = pk2(s[4 * 33], s[5 * 33]); o.w = pk2(s[6 * 33], s[7 * 33]);
        *(GAS v4u*)(WT + (drow0 + (size_t)n * rs) * K + k0 + 8 * c) = o; }
    LDS_WAIT(); asm volatile("" ::: "memory");
}
__device__ __forceinline__ int win_src(int n0) {
    if (n0 < 512) return n0;
    if (n0 < 640) return 512 + (n0 - 512);
    if (n0 < 1152) return 768 + (n0 - 640);
    if (n0 < 1280) return 1280 + (n0 - 1152);
    if (n0 < 1408) return 1408 + (n0 - 1280);
    if (n0 < 1536) return 1536 + (n0 - 1408);
    if (n0 < 1664) return 1792 + (n0 - 1536);
    if (n0 < 2688) return 2072 + (n0 - 1664);
    if (n0 < 3712) return 3096 + (n0 - 2688);
    if (n0 < 4736) return 4120 + (n0 - 3712);
    if (n0 < 4864) return 640 + (n0 - 4736);
    if (n0 < 4992) return 1664 + (n0 - 4864);
    return 1920 + (n0 - 4992);
}
struct TrDesc { const float* src; bf16* dst; int ldw, K, rs; const float* ksc; };
struct TrRegs { f32x4 v[16]; };
__device__ __forceinline__ void tr_load(TrRegs& r, const TrDesc& d) {
#pragma unroll
    for (int i = 0; i < 16; ++i) r.v[i] = *(const GAS f32x4*)(d.src + (size_t)(8 * (i >> 1) + (i & 1)) * d.ldw);
}
__device__ __forceinline__ void tr_store(const TrRegs& r, const TrDesc& d, LAS unsigned* scr, int lane) {
    const int kr = lane >> 4, nc = lane & 15;
#pragma unroll
    for (int i = 0; i < 8; ++i) { f32x4 a = r.v[2 * i], b = r.v[2 * i + 1]; LAS unsigned* w = scr + (4 * nc) * 36 + 4 * i + kr;
        if (d.ksc) { a = a * d.ksc[8 * i]; b = b * d.ksc[8 * i + 1]; }
        w[0] = pk2(a[0], b[0]); w[36] = pk2(a[1], b[1]); w[72] = pk2(a[2], b[2]); w[108] = pk2(a[3], b[3]); }
    LDS_WAIT(); asm volatile("" ::: "memory");
#pragma unroll
    for (int j = 0; j < 8; ++j) { const int ch = lane + 64 * j, n = ch >> 3, kc = ch & 7;
        const v4u o = *(const LAS v4u*)(scr + n * 36 + 4 * kc);
        *(GAS v4u*)(d.dst + (size_t)n * d.rs * d.K + 8 * kc) = o; }
    LDS_WAIT(); asm volatile("" ::: "memory");
}
__device__ __forceinline__ TrDesc tr_decode(Frame& F, int l, int it, int lane) {
    constexpr int I_A = 32 * (NIN / 64), I_B = 32 * 32, I_G = NEXP * 256, I_U = NEXP * 256, I_D = NEXP * 256, I_1 = 64, I_2 = 2;
    const float* W; bf16* WT; int ldw, K, rs = 1, src0, k0; size_t drow0; const float* ksc = nullptr;
    int r = it;
    if (r < I_A) { const int nblk = NIN / 64, kb = r / nblk, nb = r % nblk; W = inp(F, I_WIN) + (size_t)l * DM * D_IN; ldw = D_IN; K = DM; WT = (bf16*)(wsp(F) + WS_WIN); drow0 = (size_t)nb * 64; src0 = win_src(nb * 64); k0 = kb * 64; }
    else if ((r -= I_A) < I_B) { const int kb = r / 32, nb = r % 32; W = inp(F, I_WOUT) + (size_t)l * DM * DM; ldw = DM; K = DM; WT = (bf16*)(wsp(F) + WS_WOUT); drow0 = (size_t)nb * 64; src0 = nb * 64; k0 = kb * 64; ksc = inp(F, I_MIXG) + (size_t)l * DM; }
    else if ((r -= I_B) < I_G) { const int e = r / 256, q = r % 256, kb = q / 8, nb = q % 8; W = inp(F, I_WGATE) + ((size_t)l * NEXP + e) * DM * DEXP; ldw = DEXP; K = DM; WT = (bf16*)(wsp(F) + WS_WGU); drow0 = (size_t)e * 1024 + nb * 128; rs = 2; src0 = nb * 64; k0 = kb * 64; }
    else if ((r -= I_G) < I_U) { const int e = r / 256, q = r % 256, kb = q / 8, nb = q % 8; W = inp(F, I_WUP) + ((size_t)l * NEXP + e) * DM * DEXP; ldw = DEXP; K = DM; WT = (bf16*)(wsp(F) + WS_WGU); drow0 = (size_t)e * 1024 + nb * 128 + 1; rs = 2; src0 = nb * 64; k0 = kb * 64; }
    else if ((r -= I_U) < I_D) { const int e = r / 256, q = r % 256, kb = q / 32, nb = q % 32; W = inp(F, I_WDOWN) + ((size_t)l * NEXP + e) * DEXP * DM; ldw = DM; K = DEXP; WT = (bf16*)(wsp(F) + WS_WD); drow0 = (size_t)e * DM + nb * 64; src0 = nb * 64; k0 = kb * 64; }
    else if ((r -= I_D) < 2 * I_1) { const int kv = r / I_1, q = r % I_1, kb = q / 2, nb = q % 2; W = inp(F, kv ? I_W1V : I_W1K) + (size_t)l * 2048 * 128; ldw = 128; K = 2048; WT = (bf16*)(wsp(F) + WS_WCMP) + (size_t)kv * 128 * 2048; drow0 = (size_t)nb * 64; src0 = nb * 64; k0 = kb * 64; }
    else { r -= 2 * I_1; const int kv = r / I_2, kb = r % I_2; W = inp(F, kv ? I_W2V : I_W2K) + (size_t)l * 128 * 64; ldw = 64; K = 128; WT = (bf16*)(wsp(F) + WS_WCMP + 2 * 128 * 2048 * 2) + (size_t)kv * 64 * 128; drow0 = 0; src0 = 0; k0 = kb * 64; }
    TrDesc d; d.src = W + (size_t)(k0 + 2 * (lane >> 4)) * ldw + src0 + 4 * (lane & 15); d.dst = WT + drow0 * K + k0; d.ldw = ldw; d.K = K; d.rs = rs; d.ksc = ksc ? ksc + k0 + 2 * (lane >> 4) : nullptr;
    return d;
}
constexpr int CV_SMALL0 = 32 * (NIN / 64) + 32 * 32, CV_GU1 = CV_SMALL0 + 2 * NEXP * 256, CV_DN1 = CV_GU1 + NEXP * 256, CV_END = CV_DN1 + 2 * 64 + 2 * 2;
__device__ __forceinline__ void convert_range(Frame& F, int l, int lo, int hi, LAS unsigned* scr) {
    const int gw = F.vcu * NWAVES + F.wave, NGW = F.G * NWAVES;
    if (lo + gw < hi) {
        TrDesc dc = tr_decode(F, l, lo + gw, F.lane); TrRegs rc; tr_load(rc, dc);
        for (int it = lo + gw; it < hi; it += NGW) {
            const int itn = it + NGW < hi ? it + NGW : it;
            const TrDesc dn = tr_decode(F, l, itn, F.lane); TrRegs rn; tr_load(rn, dn);
            tr_store(rc, dc, scr, F.lane);
            rc = rn; dc = dn;
        }
    }
}
__device__ __forceinline__ void convert_small(Frame& F, int l) {
    LAS unsigned* scr = (LAS unsigned*)(F.lds + F.wave * 9216);
    const int gw = F.vcu * NWAVES + F.wave, NGW = F.G * NWAVES;
    convert_range(F, l, 0, CV_SMALL0, scr);
    convert_range(F, l, CV_DN1, CV_END, scr);
    { LAS float* scrf = (LAS float*)scr;
      for (int it = gw; it < 32; it += NGW) tr_item(inp(F, I_WIN) + (size_t)l * DM * D_IN, D_IN, DM, (bf16*)(wsp(F) + WS_WCMP + 1024 * 1024 + 64 * 1024), 0, 1, 2048, 24, it * 64, scrf, F.lane); }
    { bf16* Whi = (bf16*)(wsp(F) + WS_WCMP + 1536 * 1024); bf16* Wlo = Whi + 48 * 2048;
      const float* wrg = inp(F, I_WRG) + (size_t)l * DM * 4; const float* wre = inp(F, I_WRE) + (size_t)l * 4 * DM * 8;
      for (int i = gw * 64 + F.lane; i < 48 * 2048; i += NGW * 64) { const int row = i >> 11, k = i & 2047; float v = 0.f;
          if (row < 4) v = wrg[k * 4 + row]; else if (row < 36) { const int g = (row - 4) >> 3, e = (row - 4) & 7; v = wre[((size_t)g * DM + k) * 8 + e]; }
          const unsigned hi = f2bf(v); Whi[i] = (bf16)hi; Wlo[i] = (bf16)f2bf(v - bf2f((unsigned short)hi)); } }
}

struct Row { f32x4 v[8]; };
__device__ __forceinline__ void row_load(Row& r, const float* p, int lane) {
#pragma unroll
    for (int j = 0; j < 8; ++j) r.v[j] = *((const GAS f32x4*)p + lane + 64 * j);
}
__device__ __forceinline__ void row_load_bf16(Row& r, const bf16* p, int lane) {
#pragma unroll
    for (int j = 0; j < 8; ++j) { const v2u w = *((const GAS v2u*)p + lane + 64 * j); r.v[j] = (f32x4){bflo(w.x), bfhi(w.x), bflo(w.y), bfhi(w.y)}; }
}
struct RawRow { v2u w[8]; };
__device__ __forceinline__ void raw_load(RawRow& r, const bf16* p, int lane) {
#pragma unroll
    for (int j = 0; j < 8; ++j) r.w[j] = *((const GAS v2u*)p + lane + 64 * j);
}
__device__ __forceinline__ void raw_to_row(Row& r, const RawRow& x) {
#pragma unroll
    for (int j = 0; j < 8; ++j) r.v[j] = (f32x4){bflo(x.w[j].x), bfhi(x.w[j].x), bflo(x.w[j].y), bfhi(x.w[j].y)};
}
__device__ __forceinline__ void row_store(const Row& r, float* p, int lane) {
#pragma unroll
    for (int j = 0; j < 8; ++j) *((GAS f32x4*)p + lane + 64 * j) = r.v[j];
}
__device__ __forceinline__ void row_store_bf16(const Row& r, bf16* p, int lane) {
#pragma unroll
    for (int j = 0; j < 8; ++j) { v2u w; w.x = pk2(r.v[j].x, r.v[j].y); w.y = pk2(r.v[j].z, r.v[j].w); *((GAS v2u*)p + lane + 64 * j) = w; }
}
__device__ __forceinline__ void row_normalize(Row& r) {
    float s = 0.f;
#pragma unroll
    for (int j = 0; j < 8; ++j) s += (r.v[j].x + r.v[j].y) + (r.v[j].z + r.v[j].w);
    const float mean = wave_sum(s) * (1.0f / DM); float s2 = 0.f;
#pragma unroll
    for (int j = 0; j < 8; ++j) { r.v[j] = r.v[j] - mean; s2 += (r.v[j].x * r.v[j].x + r.v[j].y * r.v[j].y) + (r.v[j].z * r.v[j].z + r.v[j].w * r.v[j].w); }
    const float rstd = 1.0f / sqrtf(wave_sum(s2) * (1.0f / DM) + LN_EPS);
#pragma unroll
    for (int j = 0; j < 8; ++j) r.v[j] = r.v[j] * rstd;
}
__device__ __forceinline__ void row_affine(Row& r, const float* a, float add1, const float* b, int lane) {
#pragma unroll
    for (int j = 0; j < 8; ++j) { const f32x4 av = *((const GAS f32x4*)a + lane + 64 * j) + add1, bv = *((const GAS f32x4*)b + lane + 64 * j); r.v[j] = r.v[j] * av + bv; }
}
constexpr int VEC_OFF = 73728;
__device__ __forceinline__ void stage_vec(Frame& F, int slot, const float* src) {
    *((LAS f32x4*)(F.lds + VEC_OFF) + slot * (DM / 4) + F.tid) = *((const GAS f32x4*)src + F.tid);
}
__device__ __forceinline__ void row_affine_lds(Row& r, const Frame& F, int slot_a, float add1, int slot_b) {
    const LAS f32x4* a = (const LAS f32x4*)(F.lds + VEC_OFF) + slot_a * (DM / 4) + F.lane; const LAS f32x4* b = (const LAS f32x4*)(F.lds + VEC_OFF) + slot_b * (DM / 4) + F.lane;
#pragma unroll
    for (int j = 0; j < 8; ++j) r.v[j] = r.v[j] * (a[64 * j] + add1) + b[64 * j];
}
__device__ __forceinline__ const float* modp(Frame& F, int l, int b, int which) { return (const float*)(wsp(F) + WS_MOD) + ((size_t)l * NB + b) * (6 * DM) + which * DM; }

__device__ __forceinline__ void ln_in_phase(Frame& F) {
    const int gw = F.vcu * NWAVES + F.wave, NGW = F.G * NWAVES;
    bf16* hb = (bf16*)(wsp(F) + WS_HB);
    stage_vec(F, 0, modp(F, 0, 0, 1)); stage_vec(F, 1, modp(F, 0, 0, 0)); stage_vec(F, 2, modp(F, 0, 1, 1)); stage_vec(F, 3, modp(F, 0, 1, 0));
    __syncthreads();
    Row nx; row_load(nx, inp(F, I_X) + (size_t)gw * DM, F.lane);
    for (int m = gw; m < MTOK; m += NGW) { const int b = m / SEQ; Row r = nx; row_load(nx, inp(F, I_X) + (size_t)(m + NGW < MTOK ? m + NGW : m) * DM, F.lane); row_normalize(r);
        row_affine_lds(r, F, 2 * b, 1.0f, 2 * b + 1); row_store_bf16(r, hb + (size_t)m * DM, F.lane); }
}

__device__ __forceinline__ void merge_phase(Frame& F, int l) {
    const int gw = F.vcu * NWAVES + F.wave, NGW = F.G * NWAVES;
    const bf16* oc = (const bf16*)(wsp(F) + WS_OCAT); bf16* hb = (bf16*)(wsp(F) + WS_HB); const float* mg = inp(F, I_MIXG) + (size_t)l * DM;
    for (int m = gw; m < MTOK; m += NGW) { Row r; row_load_bf16(r, oc + (size_t)m * DM, F.lane);
        float sa = 0.f, sb = 0.f, sc = 0.f;
#pragma unroll
        for (int j = 0; j < 8; ++j) { const float q = (r.v[j].x * r.v[j].x + r.v[j].y * r.v[j].y) + (r.v[j].z * r.v[j].z + r.v[j].w * r.v[j].w); if (j < 2) sa += q; else if (j < 4) sb += q; else sc += q; }
        const float ra = 1.0f / sqrtf(wave_sum(sa) * (1.0f / 512.0f) + RMS_EPS), rb = 1.0f / sqrtf(wave_sum(sb) * (1.0f / 512.0f) + RMS_EPS), rc = 1.0f / sqrtf(wave_sum(sc) * (1.0f / 1024.0f) + RMS_EPS);
#pragma unroll
        for (int j = 0; j < 8; ++j) { const float s = j < 2 ? ra : (j < 4 ? rb : rc); const f32x4 g = *((const GAS f32x4*)mg + F.lane + 64 * j); r.v[j] = r.v[j] * s * g; }
        row_store_bf16(r, hb + (size_t)m * DM, F.lane); }
}

__device__ __forceinline__ void post_mixer_phase(Frame& F, int l) {
    const int gw = F.vcu * NWAVES + F.wave, NGW = F.G * NWAVES;
    bf16* xa = (bf16*)(wsp(F) + WS_XA); bf16* hb = (bf16*)(wsp(F) + WS_HB);
    const float* wrg = inp(F, I_WRG) + (size_t)l * DM * 4; const float* brg = inp(F, I_BRG) + l * 4;
    const float* wre = inp(F, I_WRE) + (size_t)l * 4 * DM * 8; const float* bre = inp(F, I_BRE) + l * 32;
    unsigned* cnt = (unsigned*)(ctlp(F) + CW_CNT + l * 32); int* list = (int*)(wsp(F) + WS_LIST); float* gatew = (float*)(wsp(F) + WS_SMALL + SM_GATEW);
    stage_vec(F, 0, inp(F, I_LN1G) + (size_t)l * DM); stage_vec(F, 1, inp(F, I_LN1B) + (size_t)l * DM);
    stage_vec(F, 2, modp(F, l, 0, 4)); stage_vec(F, 3, modp(F, l, 0, 3)); stage_vec(F, 4, modp(F, l, 1, 4)); stage_vec(F, 5, modp(F, l, 1, 3));
    __syncthreads();
    RawRow nx; raw_load(nx, xa + (size_t)gw * DM, F.lane);
    for (int m = gw; m < MTOK; m += NGW) { const int b = m / SEQ; Row r; raw_to_row(r, nx); raw_load(nx, xa + (size_t)(m + NGW < MTOK ? m + NGW : m) * DM, F.lane); row_normalize(r);
        row_affine_lds(r, F, 0, 0.0f, 1); row_store_bf16(r, xa + (size_t)m * DM, F.lane);
        row_normalize(r); row_affine_lds(r, F, 2 + 2 * b, 1.0f, 3 + 2 * b); row_store_bf16(r, hb + (size_t)m * DM, F.lane);
    }
}

__device__ __forceinline__ void router_phase(Frame& F, int l) {
    const int lane = F.lane, c = lane & 15, kq = lane >> 4, w4 = F.wave & 3, kh = F.wave >> 2;
    const bf16* hb = (const bf16*)(wsp(F) + WS_HB);
    const bf16* Whi = (const bf16*)(wsp(F) + WS_WCMP + 1536 * 1024); const bf16* Wlo = Whi + 48 * 2048;
    const float* brg = inp(F, I_BRG) + l * 4; const float* bre = inp(F, I_BRE) + l * 32;
    unsigned* cnt = (unsigned*)(ctlp(F) + CW_CNT + l * 32); int* list = (int*)(wsp(F) + WS_LIST); float* gatew = (float*)(wsp(F) + WS_SMALL + SM_GATEW);
    LAS float* sl = (LAS float*)(F.lds + w4 * 4096);
    LAS f32x4* part = (LAS f32x4*)(F.lds + 16384 + w4 * 3072);
    for (int u0 = F.vcu; u0 < MTOK / 16; u0 += 4 * F.G) {
        const int u = u0 + w4 * F.G; const bool live = u < MTOK / 16;
        f32x4 acc[3];
#pragma unroll
        for (int t = 0; t < 3; ++t) acc[t] = (f32x4){0.f, 0.f, 0.f, 0.f};
        if (live) {
            const bf16* hrow = hb + (size_t)(u * 16 + c) * DM + 8 * kq + kh * 1024;
            const bf16* wh = Whi + (size_t)c * 2048 + 8 * kq + kh * 1024; const bf16* wl = Wlo + (size_t)c * 2048 + 8 * kq + kh * 1024;
#pragma unroll 4
            for (int ks = 0; ks < 32; ++ks) { const bf16x8 hf = ldg8(hrow + ks * 32);
#pragma unroll
                for (int t = 0; t < 3; ++t) { acc[t] = mfma16(ldg8(wh + (size_t)t * 16 * 2048 + ks * 32), hf, acc[t]); acc[t] = mfma16(ldg8(wl + (size_t)t * 16 * 2048 + ks * 32), hf, acc[t]); } }
            if (kh == 1) {
#pragma unroll
                for (int t = 0; t < 3; ++t) part[t * 64 + lane] = acc[t]; }
        }
        __syncthreads();
        if (live && kh == 0) {
#pragma unroll
            for (int t = 0; t < 3; ++t) { acc[t] += part[t * 64 + lane];
#pragma unroll
                for (int r = 0; r < 4; ++r) sl[c * 49 + 16 * t + 4 * kq + r] = acc[t][r]; }
            LDS_WAIT();
            if (lane < 16) {
                const LAS float* lr = sl + lane * 49; const int m = u * 16 + lane;
                const float g0 = lr[0] + brg[0], g1 = lr[1] + brg[1], g2 = lr[2] + brg[2], g3 = lr[3] + brg[3];
                int gs = 0; float gm = g0; if (g1 > gm) { gm = g1; gs = 1; } if (g2 > gm) { gm = g2; gs = 2; } if (g3 > gm) { gm = g3; gs = 3; }
                const float pgroup = 1.0f / (__expf(g0 - gm) + __expf(g1 - gm) + __expf(g2 - gm) + __expf(g3 - gm));
                int t1 = 0; float m1 = lr[4 + gs * 8] + bre[gs * 8];
#pragma unroll
                for (int i = 1; i < 8; ++i) { const float v = lr[4 + gs * 8 + i] + bre[gs * 8 + i]; if (v > m1) { m1 = v; t1 = i; } }
                int t2 = -1; float m2 = -3.0e38f;
#pragma unroll
                for (int i = 0; i < 8; ++i) { const float v = lr[4 + gs * 8 + i] + bre[gs * 8 + i]; if (i != t1 && v > m2) { m2 = v; t2 = i; } }
                const float e2 = __expf(m2 - m1), inv = pgroup / (1.0f + e2);
                const int x1 = gs * 8 + t1, x2 = gs * 8 + t2;
                const unsigned p1 = __hip_atomic_fetch_add(cnt + x1, 1u, RLX_AGENT); list[(size_t)x1 * MTOK + p1] = m * 2; gatew[m * 2] = inv;
                const unsigned p2 = __hip_atomic_fetch_add(cnt + x2, 1u, RLX_AGENT); list[(size_t)x2 * MTOK + p2] = m * 2 + 1; gatew[m * 2 + 1] = inv * e2;
            }
        }
        __syncthreads();
    }
}

__device__ __forceinline__ void gather_phase(Frame& F, int l) {
    LAS int* tb = (LAS int*)(F.lds + 0);
    const unsigned* cnt = (const unsigned*)(ctlp(F) + CW_CNT + l * 32);
    if (F.tid < 32) tb[F.tid] = (int)__hip_atomic_load(cnt + F.tid, RLX_AGENT);
    __syncthreads();
    if (F.tid == 0) { int row = 0, tile = 0;
        for (int e = 0; e < NEXP; ++e) { tb[32 + e] = row; const int nt = (tb[e] + 255) >> 8; for (int t = 0; t < nt; ++t) tb[64 + tile + t] = e; tile += nt; row += nt * 256; }
        tb[224] = tile; }
    __syncthreads();
    const int ntiles = tb[224];
    int* gt = (int*)(wsp(F) + WS_SMALL + SM_TILE);
    if (blockIdx.x == 0) { if (F.tid < 160) gt[F.tid] = (F.tid < ntiles) ? tb[64 + F.tid] : 0; if (F.tid == 0) gt[200] = ntiles; }
    const int gw = F.vcu * NWAVES + F.wave, NGW = F.G * NWAVES;
    const int* list = (const int*)(wsp(F) + WS_LIST); int* rowinfo = (int*)(wsp(F) + WS_SMALL + SM_ROWINFO);
    const bf16* hb = (const bf16*)(wsp(F) + WS_HB); bf16* xs = (bf16*)(wsp(F) + WS_XS);
    for (int R = gw; R < ntiles * 256; R += NGW) { const int e = tb[64 + (R >> 8)], pos = R - tb[32 + e];
        int aid = -1; if (pos < tb[e]) aid = list[(size_t)e * MTOK + pos];
        GAS v4u* dst = (GAS v4u*)(xs + (size_t)R * DM) + F.lane;
        if (aid >= 0) { const GAS v4u* src = (const GAS v4u*)(hb + (size_t)(aid >> 1) * DM) + F.lane;
#pragma unroll
            for (int j = 0; j < 4; ++j) dst[64 * j] = src[64 * j]; }
        else {
#pragma unroll
            for (int j = 0; j < 4; ++j) dst[64 * j] = (v4u){0u, 0u, 0u, 0u}; }
        if (F.lane == 0) rowinfo[R] = aid; }
    __syncthreads();
}

__device__ __forceinline__ void moe_tables(Frame& F, int l) {
    LAS int* tb = (LAS int*)(F.lds + TAB_OFF);
    const unsigned* cnt = (const unsigned*)(ctlp(F) + CW_CNT + l * 32);
    __syncthreads();
    if (F.tid < 32) tb[F.tid] = (int)__hip_atomic_load(cnt + F.tid, RLX_AGENT);
    __syncthreads();
    if (F.tid == 0) { int row = 0, tile = 0;
        for (int e = 0; e < NEXP; ++e) { tb[32 + e] = row; const int nt = (tb[e] + 255) >> 8; for (int t = 0; t < nt; ++t) tb[64 + tile + t] = e; tile += nt; row += nt * 256; }
        tb[224] = tile; }
    __syncthreads();
}

__device__ __forceinline__ void post_moe_phase(Frame& F, int l, float* dst_f32, bf16* dst_bf16, bool next_h) {
    const int gw = F.vcu * NWAVES + F.wave, NGW = F.G * NWAVES;
    const bf16* xa = (const bf16*)(wsp(F) + WS_XA); const bf16* ys = (const bf16*)(wsp(F) + WS_YS); bf16* hb = (bf16*)(wsp(F) + WS_HB);
    stage_vec(F, 0, inp(F, I_LN2G) + (size_t)l * DM); stage_vec(F, 1, inp(F, I_LN2B) + (size_t)l * DM); stage_vec(F, 2, modp(F, l, 0, 5)); stage_vec(F, 3, modp(F, l, 1, 5));
    if (next_h) { stage_vec(F, 4, modp(F, l + 1, 0, 1)); stage_vec(F, 5, modp(F, l + 1, 0, 0)); stage_vec(F, 6, modp(F, l + 1, 1, 1)); stage_vec(F, 7, modp(F, l + 1, 1, 0)); }
    __syncthreads();
    RawRow nx, ny0, ny1; raw_load(nx, xa + (size_t)gw * DM, F.lane); raw_load(ny0, ys + (size_t)(2 * gw) * DM, F.lane); raw_load(ny1, ys + (size_t)(2 * gw + 1) * DM, F.lane);
    for (int m = gw; m < MTOK; m += NGW) { const int b = m / SEQ; Row r; raw_to_row(r, nx); const RawRow cy0 = ny0, cy1 = ny1;
        { const int mn = m + NGW < MTOK ? m + NGW : m; raw_load(nx, xa + (size_t)mn * DM, F.lane); raw_load(ny0, ys + (size_t)(2 * mn) * DM, F.lane); raw_load(ny1, ys + (size_t)(2 * mn + 1) * DM, F.lane); }
        const LAS f32x4* g2 = (const LAS f32x4*)(F.lds + VEC_OFF) + (2 + b) * (DM / 4) + F.lane;
#pragma unroll
        for (int j = 0; j < 8; ++j) { const v2u y0 = cy0.w[j], y1 = cy1.w[j];
            const f32x4 y = (f32x4){bflo(y0.x) + bflo(y1.x), bfhi(y0.x) + bfhi(y1.x), bflo(y0.y) + bflo(y1.y), bfhi(y0.y) + bfhi(y1.y)};
            const f32x4 gv = g2[64 * j] + 1.0f; r.v[j] = r.v[j] * ALPHA + gv * y; }
        row_normalize(r); row_affine_lds(r, F, 0, 0.0f, 1); if (dst_f32) row_store(r, dst_f32 + (size_t)m * DM, F.lane); else row_store_bf16(r, dst_bf16 + (size_t)m * DM, F.lane);
        if (next_h) { row_normalize(r); row_affine_lds(r, F, 4 + 2 * b, 1.0f, 5 + 2 * b); row_store_bf16(r, hb + (size_t)m * DM, F.lane); } }
}
constexpr int IMP_STRIDE = 130;
constexpr int AW_IMP = 0, AW_SCV = 16 * IMP_STRIDE * 4, AW_SEL = AW_SCV + 512, AW_Q = 9216, AW_BYTES = AW_Q + 8192;
static_assert(AW_SEL + 256 <= AW_Q && NWAVES * AW_BYTES <= LDSCTL_OFF, "per-wave LDS slabs");

struct Flash { f32x4 O[4][4]; f32x4 m, l; };
struct KF { bf16x8 K[2][2]; };
struct VF { bf16x8 V[4]; };

__device__ __forceinline__ void load_k(KF& x, const bf16* Kb, size_t ldk, int kbase) {
    const bf16* kp = Kb + (size_t)kbase * ldk;
    x.K[0][0] = ldg8(kp); x.K[0][1] = ldg8(kp + 32); x.K[1][0] = ldg8(kp + 4 * ldk); x.K[1][1] = ldg8(kp + 4 * ldk + 32);
}
__device__ __forceinline__ void load_v(VF& x, const bf16* Vb, size_t ldv, int kbase) {
    const bf16* vp = Vb + kbase;
#pragma unroll
    for (int db = 0; db < 4; ++db) x.V[db] = ldg8(vp + (size_t)(16 * db) * ldv);
}
__device__ __forceinline__ void q_park(LAS bf16x8* Ql, const bf16* q0p, const bf16* q1p, const bf16* q2p, const bf16* q3p, int lane) {
    Ql[0 * 64 + lane] = ldg8(q0p); Ql[1 * 64 + lane] = ldg8(q0p + 32); Ql[2 * 64 + lane] = ldg8(q1p); Ql[3 * 64 + lane] = ldg8(q1p + 32);
    Ql[4 * 64 + lane] = ldg8(q2p); Ql[5 * 64 + lane] = ldg8(q2p + 32); Ql[6 * 64 + lane] = ldg8(q3p); Ql[7 * 64 + lane] = ldg8(q3p + 32);
}
__device__ __forceinline__ void qk_scores(f32x4 (&Sv)[2][4], const KF& x, const LAS bf16x8* Ql, int lane) {
#pragma unroll
    for (int qb = 0; qb < 4; ++qb) { const bf16x8 q0 = Ql[(2 * qb) * 64 + lane], q1 = Ql[(2 * qb + 1) * 64 + lane];
#pragma unroll
        for (int h = 0; h < 2; ++h) { f32x4 a = mfma16(x.K[h][0], q0, (f32x4){0.f, 0.f, 0.f, 0.f}); Sv[h][qb] = mfma16(x.K[h][1], q1, a); } }
}
__device__ __forceinline__ void flash_init(Flash& S, float m0, float m1, float m2, float m3) {
#pragma unroll
    for (int db = 0; db < 4; ++db)
#pragma unroll
        for (int qb = 0; qb < 4; ++qb) S.O[db][qb] = (f32x4){0.f, 0.f, 0.f, 0.f};
    S.m = (f32x4){m0, m1, m2, m3}; S.l = (f32x4){0.f, 0.f, 0.f, 0.f};
}
__device__ __forceinline__ void flash_step(Flash& S, f32x4 (&Sv)[2][4], const VF& x, const f32x4 b0, const f32x4 bj, unsigned vm) {
    float sv[4][8]; float mxv[4]; bool grow = false;
#pragma unroll
    for (int qb = 0; qb < 4; ++qb) {
#pragma unroll
        for (int h = 0; h < 2; ++h)
#pragma unroll
            for (int r = 0; r < 4; ++r) { const int j = 4 * h + r; const float s2 = Sv[h][qb][r] * SC2 + (b0[qb] + bj[qb] * (float)j); sv[qb][j] = ((vm >> j) & 1u) ? s2 : -INFINITY; }
        float mx = fmaxf(fmaxf(fmaxf(sv[qb][0], sv[qb][1]), fmaxf(sv[qb][2], sv[qb][3])), fmaxf(fmaxf(sv[qb][4], sv[qb][5]), fmaxf(sv[qb][6], sv[qb][7])));
        mx = fmaxf(mx, __shfl_xor(mx, 16)); mx = fmaxf(mx, __shfl_xor(mx, 32));
        mxv[qb] = mx; grow = grow | (mx > S.m[qb] + 8.0f);
    }
    if (__any(grow)) {
#pragma unroll
        for (int qb = 0; qb < 4; ++qb) { const float mn = fmaxf(S.m[qb], mxv[qb]), al = ex2(S.m[qb] - mn); S.m[qb] = mn; S.l[qb] = S.l[qb] * al;
#pragma unroll
            for (int db = 0; db < 4; ++db) S.O[db][qb] = S.O[db][qb] * al; }
    }
    bf16x8 Pf[4];
#pragma unroll
    for (int qb = 0; qb < 4; ++qb) {
        float p[8];
#pragma unroll
        for (int j = 0; j < 8; ++j) p[j] = ex2(sv[qb][j] - S.m[qb]);
        S.l[qb] = S.l[qb] + (((p[0] + p[1]) + (p[2] + p[3])) + ((p[4] + p[5]) + (p[6] + p[7])));
        Pf[qb] = pack8(p[0], p[1], p[2], p[3], p[4], p[5], p[6], p[7]);
    }
#pragma unroll
    for (int db = 0; db < 4; ++db)
#pragma unroll
        for (int qb = 0; qb < 4; ++qb) S.O[db][qb] = mfma16(x.V[db], Pf[qb], S.O[db][qb]);
}
__device__ __forceinline__ float flash_inv(const Flash& S, int qb, bool has_sink, float sink2) {
    float lt = S.l[qb]; lt += __shfl_xor(lt, 16); lt += __shfl_xor(lt, 32);
    if (has_sink) lt += ex2(sink2 - S.m[qb]);
    return lt > 0.f ? 1.0f / lt : 0.f;
}
__device__ __forceinline__ float sigmoidf_(float x) { return 1.0f / (1.0f + __expf(-x)); }
__device__ __forceinline__ float slope2_of(int hidx) { return LOG2E * exp2f(-0.5f * (float)(hidx + 1)); }
#define ITER_FENCE() asm volatile("" ::: "memory")

template <int W, int MODE>
__device__ __forceinline__ void win_unit(Frame& F, int l, int b, int g, int q0) {
    const int lane = F.lane, c = lane & 15, kq = lane >> 4;
    const bf16* proj = (const bf16*)(wsp(F) + WS_PROJ); const bf16* vT = (const bf16*)(wsp(F) + WS_VT); bf16* ocat = (bf16*)(wsp(F) + WS_OCAT);
    constexpr int QOFF = MODE == 0 ? P_QA : P_QB, KOFF = MODE == 0 ? P_KA : P_KBW, VROW = MODE == 0 ? V_A : V_BW, OCOL = MODE == 0 ? 0 : 512, HBASE = MODE == 0 ? 0 : 8;
    LAS bf16x8* Ql = (LAS bf16x8*)(F.lds + F.wave * AW_BYTES + AW_Q);
    const size_t tb = (size_t)b * SEQ; const int t = q0 + c;
    { const bf16* qp = proj + (tb + t) * NPROJ + QOFF + g * 256 + kq * 8; q_park(Ql, qp, qp + 64, qp + 128, qp + 192, lane); }
    f32x4 sl2, sk2;
#pragma unroll
    for (int qb = 0; qb < 4; ++qb) { sl2[qb] = slope2_of(HBASE + g * 4 + qb); sk2[qb] = MODE == 0 ? inp(F, I_SINKS)[l * 8 + g * 4 + qb] * LOG2E : -1.0e30f; }
    Flash S; flash_init(S, sk2[0], sk2[1], sk2[2], sk2[3]);
    int klo = q0 - (W - 1); if (klo < 0) klo = 0; klo &= ~31;
    const int khi = (q0 + 15) & ~31;
    const bf16* Kb = proj + (tb + 8 * (c >> 2) + (c & 3)) * NPROJ + KOFF + g * 64 + kq * 8;
    const bf16* Vb = vT + (size_t)(VROW + g * 64 + c) * MTOK + tb + 8 * kq;
    KF cur, nxt; load_k(cur, Kb, NPROJ, khi);
    for (int kbase = khi; kbase >= klo; kbase -= 32) {
        ITER_FENCE();
        VF vf; load_v(vf, Vb, MTOK, kbase);
        load_k(nxt, Kb, NPROJ, kbase - 32 >= klo ? kbase - 32 : kbase);
        f32x4 Sv[2][4]; qk_scores(Sv, cur, Ql, lane);
        const int d0 = t - kbase - 8 * kq;
        const f32x4 b0 = sl2 * -(float)d0;
        unsigned vm = 0xffu;
        if (!(kbase + 31 <= q0 && kbase >= q0 + 16 - W)) { vm = 0u;
#pragma unroll
            for (int j = 0; j < 8; ++j) { const int dist = d0 - j; vm |= (dist >= 0 && dist < W) ? (1u << j) : 0u; } }
        flash_step(S, Sv, vf, b0, sl2, vm);
        cur = nxt;
    }
#pragma unroll
    for (int qb = 0; qb < 4; ++qb) { const float sc = flash_inv(S, qb, MODE == 0, sk2[qb]);
        bf16* op = ocat + (tb + t) * DM + OCOL + (g * 4 + qb) * 64 + 4 * kq; float q2 = 0.f;
#pragma unroll
        for (int db = 0; db < 4; ++db) { const f32x4 o = S.O[db][qb] * sc; v2u w; w.x = pk2(o[0], o[1]); w.y = pk2(o[2], o[3]); *(GAS v2u*)(op + 16 * db) = w;
            q2 += (bflo(w.x) * bflo(w.x) + bfhi(w.x) * bfhi(w.x)) + (bflo(w.y) * bflo(w.y) + bfhi(w.y) * bfhi(w.y)); }
        if (MODE == 0) { q2 += __shfl_xor(q2, 16); q2 += __shfl_xor(q2, 32); if (kq == 0) ((float*)(wsp(F) + WS_SSQ))[(tb + t) * 32 + g * 4 + qb] = q2; } }
}

constexpr float SB_EXIT_P = 1.0e-37f;
__device__ __forceinline__ void sb_unit(Frame& F, int b, int hc, int q0) {
    const int lane = F.lane, c = lane & 15, kq = lane >> 4;
    const bf16* proj = (const bf16*)(wsp(F) + WS_PROJ); const bf16* vT = (const bf16*)(wsp(F) + WS_VT); bf16* ocat = (bf16*)(wsp(F) + WS_OCAT);
    LAS bf16x8* Ql = (LAS bf16x8*)(F.lds + F.wave * AW_BYTES + AW_Q);
    const size_t tb = (size_t)b * SEQ;
    { const bf16* qp = proj + (tb + q0 + c) * NPROJ + P_QC + hc * 64 + kq * 8; q_park(Ql, qp, qp + (size_t)16 * NPROJ, qp + (size_t)32 * NPROJ, qp + (size_t)48 * NPROJ, lane); }
    f32x4 O[4][4]; float carry[4];
#pragma unroll
    for (int qb = 0; qb < 4; ++qb) { carry[qb] = 1.0f;
#pragma unroll
        for (int db = 0; db < 4; ++db) O[db][qb] = (f32x4){0.f, 0.f, 0.f, 0.f}; }
    const bf16* Kb = proj + (tb + 8 * (c >> 2) + (c & 3)) * NPROJ + P_KC + hc * 64 + kq * 8;
    const bf16* Vb = vT + (size_t)(V_C + hc * 64 + c) * MTOK + tb + 8 * kq;
    KF cur, nxt; load_k(cur, Kb, NPROJ, q0 + 32);
    for (int kbase = q0 + 32; kbase >= 0; kbase -= 32) {
        ITER_FENCE();
        VF vf; load_v(vf, Vb, MTOK, kbase);
        load_k(nxt, Kb, NPROJ, kbase >= 32 ? kbase - 32 : kbase);
        f32x4 Sv[2][4]; qk_scores(Sv, cur, Ql, lane);
        const bool diag = kbase + 31 >= q0;
        bf16x8 Pf[4];
#pragma unroll
        for (int qb = 0; qb < 4; ++qb) { const int lim = q0 + 16 * qb + c - kbase - 8 * kq;
            float om[8], sg[8];
#pragma unroll
            for (int h = 0; h < 2; ++h)
#pragma unroll
                for (int r = 0; r < 4; ++r) { const int j = 4 * h + r; const float e = ex2(fminf(Sv[h][qb][r] * SC2, 115.0f)), rr = __builtin_amdgcn_rcpf(1.0f + e);
                    om[j] = rr; sg[j] = e * rr;
                    if (diag) { const bool msk = j >= lim; om[j] = msk ? 1.0f : om[j]; sg[j] = msk ? 0.f : sg[j]; } }
            float ex_[8]; float run = 1.0f;
#pragma unroll
            for (int j = 7; j >= 0; --j) { ex_[j] = run; run *= om[j]; }
            const float t1 = __shfl_xor(run, 16), t2 = __shfl_xor(run, 32), t3 = __shfl_xor(run, 48);
            const float X = ((kq ^ 1) > kq ? t1 : 1.0f) * ((kq ^ 2) > kq ? t2 : 1.0f) * ((kq ^ 3) > kq ? t3 : 1.0f);
            const float base = carry[qb] * X;
            carry[qb] *= (run * t1) * (t2 * t3);
            Pf[qb] = pack8(sg[0] * (base * ex_[0]), sg[1] * (base * ex_[1]), sg[2] * (base * ex_[2]), sg[3] * (base * ex_[3]), sg[4] * (base * ex_[4]), sg[5] * (base * ex_[5]), sg[6] * (base * ex_[6]), sg[7] * (base * ex_[7])); }
#pragma unroll
        for (int db = 0; db < 4; ++db)
#pragma unroll
            for (int qb = 0; qb < 4; ++qb) O[db][qb] = mfma16(vf.V[db], Pf[qb], O[db][qb]);
        const bool fin = (carry[0] < SB_EXIT_P) && (carry[1] < SB_EXIT_P) && (carry[2] < SB_EXIT_P) && (carry[3] < SB_EXIT_P);
        if (__all(fin)) break;
        cur = nxt;
    }
#pragma unroll
    for (int qb = 0; qb < 4; ++qb) { bf16* op = ocat + (tb + q0 + 16 * qb + c) * DM + 1024 + hc * 64 + 4 * kq;
        float q2 = 0.f;
#pragma unroll
        for (int db = 0; db < 4; ++db) { const f32x4 o = O[db][qb]; v2u w; w.x = pk2(o[0], o[1]); w.y = pk2(o[2], o[3]); *(GAS v2u*)(op + 16 * db) = w;
            q2 += (bflo(w.x) * bflo(w.x) + bfhi(w.x) * bfhi(w.x)) + (bflo(w.y) * bflo(w.y) + bfhi(w.y) * bfhi(w.y)); }
        q2 += __shfl_xor(q2, 16); q2 += __shfl_xor(q2, 32); if (kq == 0) ((float*)(wsp(F) + WS_SSQ))[(tb + q0 + 16 * qb + c) * 32 + 16 + hc] = q2; }
}

__device__ __forceinline__ void gate_unit(Frame& F, int u) {
    const int lane = F.lane, c = lane & 15, kq = lane >> 4;
    const bf16* hrow = (const bf16*)(wsp(F) + WS_HB) + (size_t)(u * 16 + c) * DM + 8 * kq;
    const bf16* wg = (const bf16*)(wsp(F) + WS_WCMP + 1024 * 1024 + 64 * 1024) + (size_t)c * 2048 + 8 * kq;
    f32x4 a0 = (f32x4){0.f, 0.f, 0.f, 0.f}, a1 = (f32x4){0.f, 0.f, 0.f, 0.f};
#pragma unroll 8
    for (int ks = 0; ks < 64; ++ks) { const bf16x8 hf = ldg8(hrow + ks * 32); a0 = mfma16(ldg8(wg + ks * 32), hf, a0); a1 = mfma16(ldg8(wg + (size_t)16 * 2048 + ks * 32), hf, a1); }
    float* gp = (float*)(wsp(F) + WS_GBUF) + (size_t)(u * 16 + c) * 32 + 4 * kq;
    *(GAS f32x4*)gp = a0; *(GAS f32x4*)(gp + 16) = a1;
}

__device__ __forceinline__ float gelu_tanh(float x) { const float u = 0.7978845608028654f * (x + 0.044715f * x * x * x); const float e = __expf(2.0f * u); return 0.5f * x * (2.0f - 2.0f / (e + 1.0f)); }
__device__ __forceinline__ void cmp_mlp_unit(Frame& F, int l, int unit) {
    const int lane = F.lane, c = lane & 15, kq = lane >> 4;
    const int nt = unit & 31, g = (unit >> 5) & 1, b = (unit >> 6) & 1, kv = unit >> 7;
    const bf16* proj = (const bf16*)(wsp(F) + WS_PROJ);
    const bf16* W1t = (const bf16*)(wsp(F) + WS_WCMP) + (size_t)kv * 128 * 2048; const bf16* W2t = (const bf16*)(wsp(F) + WS_WCMP + 2 * 128 * 2048 * 2) + (size_t)kv * 64 * 128;
    const float* pe = inp(F, kv ? I_PEV : I_PEK) + (size_t)l * 32 * 64;
    const int n = nt * 16 + c; const size_t tb = (size_t)b * SEQ; const int xoff = (kv ? P_VBC : P_KBC) + g * 64;
    LAS f32x4* red = (LAS f32x4*)(F.lds);
    f32x4 H[4][2];
#pragma unroll
    for (int s = 0; s < 4; ++s) { H[s][0] = (f32x4){0.f, 0.f, 0.f, 0.f}; H[s][1] = (f32x4){0.f, 0.f, 0.f, 0.f}; }
#pragma unroll 2
    for (int kk = 0; kk < 8; ++kk) {
        const int ks = F.wave * 8 + kk, lt = ks >> 1, d0 = (ks & 1) * 32 + 8 * kq; int tok = 16 * n + lt; if (tok > SEQ - 1) tok = SEQ - 1;
        const bf16x8 xr = ldg8(proj + (tb + tok) * NPROJ + xoff + d0);
        const f32x4 p0 = *(const GAS f32x4*)(pe + lt * 64 + d0), p1 = *(const GAS f32x4*)(pe + lt * 64 + d0 + 4);
        const bf16x8 Xf = pack8(bf2f((unsigned short)xr[0]) + p0[0], bf2f((unsigned short)xr[1]) + p0[1], bf2f((unsigned short)xr[2]) + p0[2], bf2f((unsigned short)xr[3]) + p0[3],
                                bf2f((unsigned short)xr[4]) + p1[0], bf2f((unsigned short)xr[5]) + p1[1], bf2f((unsigned short)xr[6]) + p1[2], bf2f((unsigned short)xr[7]) + p1[3]);
#pragma unroll
        for (int s = 0; s < 4; ++s)
#pragma unroll
            for (int h = 0; h < 2; ++h) { const int hid = 32 * s + 8 * (c >> 2) + 4 * h + (c & 3);
                H[s][h] = mfma16(ldg8(W1t + (size_t)hid * 2048 + ks * 32 + 8 * kq), Xf, H[s][h]); }
    }
#pragma unroll
    for (int s = 0; s < 4; ++s)
#pragma unroll
        for (int h = 0; h < 2; ++h) red[(F.wave * 8 + s * 2 + h) * 64 + lane] = H[s][h];
    __syncthreads();
    if (F.wave == 0) {
#pragma unroll
        for (int s = 0; s < 4; ++s)
#pragma unroll
            for (int h = 0; h < 2; ++h) { f32x4 a = red[(s * 2 + h) * 64 + lane];
#pragma unroll
                for (int w = 1; w < 8; ++w) a += red[(w * 8 + s * 2 + h) * 64 + lane];
                H[s][h] = a; }
        f32x4 Y[4];
#pragma unroll
        for (int eb = 0; eb < 4; ++eb) Y[eb] = (f32x4){0.f, 0.f, 0.f, 0.f};
#pragma unroll
        for (int s = 0; s < 4; ++s) {
            const bf16x8 Hf = pack8(gelu_tanh(H[s][0][0]), gelu_tanh(H[s][0][1]), gelu_tanh(H[s][0][2]), gelu_tanh(H[s][0][3]), gelu_tanh(H[s][1][0]), gelu_tanh(H[s][1][1]), gelu_tanh(H[s][1][2]), gelu_tanh(H[s][1][3]));
#pragma unroll
            for (int eb = 0; eb < 4; ++eb) Y[eb] = mfma16(ldg8(W2t + (size_t)(16 * eb + c) * 128 + 32 * s + 8 * kq), Hf, Y[eb]);
        }
        const bool valid = n <= 510;
        if (kv == 0) { bf16* kc = (bf16*)(wsp(F) + WS_SMALL + SM_KCMP) + ((size_t)(b * 2 + g) * 512 + n) * 64 + 4 * kq;
#pragma unroll
            for (int eb = 0; eb < 4; ++eb) { v2u w; w.x = valid ? pk2(Y[eb][0], Y[eb][1]) : 0u; w.y = valid ? pk2(Y[eb][2], Y[eb][3]) : 0u; *(GAS v2u*)(kc + 16 * eb) = w; } }
        else { bf16* vc = (bf16*)(wsp(F) + WS_SMALL + SM_VCMPT) + (size_t)(b * 2 + g) * 64 * 512 + n;
#pragma unroll
            for (int eb = 0; eb < 4; ++eb)
#pragma unroll
                for (int r = 0; r < 4; ++r) vc[(size_t)(16 * eb + 4 * kq + r) * 512] = valid ? (bf16)f2bf(Y[eb][r]) : (bf16)0; }
    }
    __syncthreads();
}

__device__ __forceinline__ int next_below(unsigned long long ulo, unsigned long long uhi, int j) {
    if (j > 64) { const unsigned long long m = (j >= 128) ? uhi : (uhi & ((1ull << (j - 64)) - 1ull)); if (m) return 127 - __builtin_clzll(m); j = 64; }
    const unsigned long long m = (j >= 64) ? ulo : (ulo & ((1ull << j) - 1ull));
    return m ? 63 - __builtin_clzll(m) : -1;
}
__device__ __forceinline__ void nsa_unit(Frame& F, int b, int g, int q0) {
    const int lane = F.lane, c = lane & 15, kq = lane >> 4;
    const bf16* proj = (const bf16*)(wsp(F) + WS_PROJ); const bf16* vT = (const bf16*)(wsp(F) + WS_VT); bf16* ocat = (bf16*)(wsp(F) + WS_OCAT);
    const bf16* kcmp = (const bf16*)(wsp(F) + WS_SMALL + SM_KCMP) + (size_t)(b * 2 + g) * 512 * 64;
    const bf16* vcmpT = (const bf16*)(wsp(F) + WS_SMALL + SM_VCMPT) + (size_t)(b * 2 + g) * 64 * 512;
    LAS float* imp = (LAS float*)(F.lds + F.wave * AW_BYTES + AW_IMP);
    LAS unsigned* selm = (LAS unsigned*)(F.lds + F.wave * AW_BYTES + AW_SEL);
    LAS bf16x8* Ql = (LAS bf16x8*)(F.lds + F.wave * AW_BYTES + AW_Q);
    const size_t tb = (size_t)b * SEQ; const int t = q0 + c;
    const float* grow = (const float*)(wsp(F) + WS_GBUF) + (tb + t) * 32 + g * 12;
    { const bf16* qp = proj + (tb + t) * NPROJ + P_QB + g * 256 + kq * 8; q_park(Ql, qp, qp + 64, qp + 128, qp + 192, lane); }
    f32x4 sl2;
#pragma unroll
    for (int qb = 0; qb < 4; ++qb) sl2[qb] = slope2_of(8 + g * 4 + qb);
    const f32x4 sl2c = sl2 * 16.0f;
    for (int i = lane; i < 16 * IMP_STRIDE; i += 64) imp[i] = 0.f;
    const int tmax = q0 + 15; const int nmax = tmax >= 31 ? ((tmax - 31) >> 4) : -1; const int ntop = nmax & ~31;
    const bf16* Kc = kcmp + (size_t)(8 * (c >> 2) + (c & 3)) * 64 + kq * 8;
    const bf16* Vc = vcmpT + (size_t)c * 512 + 8 * kq;
    Flash S; flash_init(S, -1.0e30f, -1.0e30f, -1.0e30f, -1.0e30f);
    KF cur, nxt;
    if (nmax >= 0) {
        load_k(cur, Kc, 64, ntop);
        for (int nbase = ntop; nbase >= 0; nbase -= 32) {
            ITER_FENCE();
            VF vf; load_v(vf, Vc, 512, nbase);
            load_k(nxt, Kc, 64, nbase >= 32 ? nbase - 32 : nbase);
            f32x4 Sv[2][4]; qk_scores(Sv, cur, Ql, lane);
            const int d0 = t - 31 - 16 * (nbase + 8 * kq);
            const f32x4 b0 = sl2 * -(float)d0;
            unsigned vm = 0xffu;
            if (!(16 * (nbase + 31) + 31 <= q0)) { vm = 0u;
#pragma unroll
                for (int j = 0; j < 8; ++j) vm |= (d0 - 16 * j >= 0) ? (1u << j) : 0u; }
            flash_step(S, Sv, vf, b0, sl2c, vm);
            cur = nxt;
        }
    }
    f32x4 inv;
#pragma unroll
    for (int qb = 0; qb < 4; ++qb) { inv[qb] = flash_inv(S, qb, false, 0.f);
        const float g0 = sigmoidf_(grow[qb * 3 + 0]), g2 = sigmoidf_(grow[qb * 3 + 2]), sc = inv[qb] * g0;
        bf16* op = ocat + (tb + t) * DM + 512 + (g * 4 + qb) * 64 + 4 * kq;
#pragma unroll
        for (int db = 0; db < 4; ++db) { const v2u ow = *(const GAS v2u*)(op + 16 * db); const f32x4 old = (f32x4){bflo(ow.x), bfhi(ow.x), bflo(ow.y), bfhi(ow.y)};
            const f32x4 o = old * g2 + S.O[db][qb] * sc; v2u w; w.x = pk2(o[0], o[1]); w.y = pk2(o[2], o[3]); *(GAS v2u*)(op + 16 * db) = w; } }
    LDS_WAIT();
    for (int nbase = 0; nbase <= nmax; nbase += 32) {
        ITER_FENCE();
        const bf16* kp = Kc + (size_t)nbase * 64;
        KF x; x.K[0][0] = ldg8(kp); x.K[0][1] = ldg8(kp + 32); x.K[1][0] = ldg8(kp + 4 * 64); x.K[1][1] = ldg8(kp + 4 * 64 + 32);
        f32x4 Sv[2][4]; qk_scores(Sv, x, Ql, lane);
        float G[2], Wl[2];
#pragma unroll
        for (int h = 0; h < 2; ++h) { float gs = 0.f, last = 0.f;
#pragma unroll
            for (int r = 0; r < 4; ++r) { const int dist = t - 16 * (nbase + 8 * kq + 4 * h + r) - 31; const bool vis = dist >= 0; const float fd = (float)dist; float pv = 0.f;
#pragma unroll
                for (int qb = 0; qb < 4; ++qb) pv += vis ? ex2(Sv[h][qb][r] * SC2 - sl2[qb] * fd - S.m[qb]) * inv[qb] : 0.f;
                gs += pv; last = pv; }
            G[h] = gs; Wl[h] = last; }
        const int j0 = (nbase >> 2) + 2 * kq;
        LAS float* ip = imp + c * IMP_STRIDE + j0;
        ip[0] += G[0]; LDS_WAIT();
        ip[1] += G[1]; LDS_WAIT();
        ip[1] += Wl[0]; LDS_WAIT();
        ip[2] += Wl[1]; LDS_WAIT();
    }
    unsigned long long ulo = 0ull, uhi = 0ull, ilo = ~0ull, ihi = ~0ull;
    for (int cq = 0; cq < 16; ++cq) {
        const int tq = q0 + cq, cur_ = tq >> 6;
        const int ja = lane, jb = lane + 64;
        const bool oka = ja <= cur_, okb = jb <= cur_;
        unsigned ka = 0u, kb = 0u;
        if (oka) ka = (ja == 0 || ja == cur_ || ja == cur_ - 1) ? 0x461c4000u : __builtin_bit_cast(unsigned, imp[cq * IMP_STRIDE + ja]) + 1u;
        if (okb) kb = (jb == cur_ || jb == cur_ - 1) ? 0x461c4000u : __builtin_bit_cast(unsigned, imp[cq * IMP_STRIDE + jb]) + 1u;
        unsigned long long mlo, mhi;
        if (cur_ < 16) { mlo = __ballot(oka); mhi = 0ull; }
        else {
            unsigned thr = 0u;
#pragma unroll 1
            for (int bit = 30; bit >= 0; --bit) { const unsigned tr = thr | (1u << bit);
                const int cntv = __popcll(__ballot(ka >= tr)) + __popcll(__ballot(kb >= tr)); if (cntv >= 16) thr = tr; }
            mlo = __ballot(ka > thr); mhi = __ballot(kb > thr);
            int need = 16 - (__popcll(mlo) + __popcll(mhi));
            unsigned long long elo = __ballot(ka == thr), ehi = __ballot(kb == thr);
            while (need > 0 && elo) { const unsigned long long bsel = elo & (~elo + 1ull); mlo |= bsel; elo ^= bsel; --need; }
            while (need > 0 && ehi) { const unsigned long long bsel = ehi & (~ehi + 1ull); mhi |= bsel; ehi ^= bsel; --need; }
        }
        ulo |= mlo; uhi |= mhi; ilo &= mlo; ihi &= mhi;
        if (lane == 0) { selm[cq * 4 + 0] = (unsigned)mlo; selm[cq * 4 + 1] = (unsigned)(mlo >> 32); selm[cq * 4 + 2] = (unsigned)mhi; selm[cq * 4 + 3] = (unsigned)(mhi >> 32); }
    }
    LDS_WAIT();
    const unsigned long long mylo = (unsigned long long)selm[c * 4 + 0] | ((unsigned long long)selm[c * 4 + 1] << 32);
    const unsigned long long myhi = (unsigned long long)selm[c * 4 + 2] | ((unsigned long long)selm[c * 4 + 3] << 32);
    flash_init(S, -1.0e30f, -1.0e30f, -1.0e30f, -1.0e30f);
    const bf16* Kb = proj + (tb + 8 * (c >> 2) + (c & 3)) * NPROJ + P_KBS + g * 64 + kq * 8;
    const bf16* Vb = vT + (size_t)(V_BS + g * 64 + c) * MTOK + tb + 8 * kq;
    int j = next_below(ulo, uhi, (tmax >> 6) + 1), hs = 1;
    load_k(cur, Kb, NPROJ, 64 * j + 32);
    while (j >= 0) {
        ITER_FENCE();
        const int kbase = 64 * j + 32 * hs;
        VF vf; load_v(vf, Vb, MTOK, kbase);
        int jn = j, hn = 0; if (hs == 0) { jn = next_below(ulo, uhi, j); hn = 1; }
        load_k(nxt, Kb, NPROJ, jn >= 0 ? 64 * jn + 32 * hn : kbase);
        const bool mine = j < 64 ? ((mylo >> j) & 1ull) != 0ull : ((myhi >> (j - 64)) & 1ull) != 0ull;
        const bool all16 = j < 64 ? ((ilo >> j) & 1ull) != 0ull : ((ihi >> (j - 64)) & 1ull) != 0ull;
        f32x4 Sv[2][4]; qk_scores(Sv, cur, Ql, lane);
        const int d0 = t - kbase - 8 * kq;
        const f32x4 b0 = sl2 * -(float)d0;
        unsigned vm = 0xffu;
        if (!(all16 && kbase + 31 <= q0)) { vm = 0u;
#pragma unroll
            for (int jj = 0; jj < 8; ++jj) vm |= (mine && d0 - jj >= 0) ? (1u << jj) : 0u; }
        flash_step(S, Sv, vf, b0, sl2, vm);
        cur = nxt; j = jn; hs = hn;
    }
#pragma unroll
    for (int qb = 0; qb < 4; ++qb) { const float sc = flash_inv(S, qb, false, 0.f) * sigmoidf_(grow[qb * 3 + 1]);
        bf16* op = ocat + (tb + t) * DM + 512 + (g * 4 + qb) * 64 + 4 * kq; float q2 = 0.f;
#pragma unroll
        for (int db = 0; db < 4; ++db) { const v2u ow = *(const GAS v2u*)(op + 16 * db); const f32x4 old = (f32x4){bflo(ow.x), bfhi(ow.x), bflo(ow.y), bfhi(ow.y)};
            const f32x4 o = old + S.O[db][qb] * sc; v2u w; w.x = pk2(o[0], o[1]); w.y = pk2(o[2], o[3]); *(GAS v2u*)(op + 16 * db) = w;
            q2 += (bflo(w.x) * bflo(w.x) + bfhi(w.x) * bfhi(w.x)) + (bflo(w.y) * bflo(w.y) + bfhi(w.y) * bfhi(w.y)); }
        q2 += __shfl_xor(q2, 16); q2 += __shfl_xor(q2, 32); if (kq == 0) ((float*)(wsp(F) + WS_SSQ))[(tb + t) * 32 + 8 + g * 4 + qb] = q2; }
    LDS_WAIT();
}

__device__ __forceinline__ void attn1_phase(Frame& F, int l) {
    const int gw = F.vcu * NWAVES + F.wave, NGW = F.G * NWAVES;
    LAS unsigned* scr = (LAS unsigned*)(F.lds + F.wave * AW_BYTES);
    for (int u = F.vcu; u < 256; u += F.G) cmp_mlp_unit(F, l, u);
    if (F.wave >= 4) convert_range(F, l, CV_SMALL0, CV_GU1, scr);
    else for (int u = F.wave * F.G + F.vcu; u < MTOK / 16; u += 4 * F.G) gate_unit(F, u);
    for (int u = gw; u < 2048; u += NGW) win_unit<512, 1>(F, l, u >> 10, (u >> 9) & 1, (u & 511) * 16);
    for (int u = gw; u < 4096; u += NGW) sb_unit(F, u >> 11, (u >> 7) & 15, (u & 127) * 64);
    for (int u = gw; u < 2048; u += NGW) win_unit<128, 0>(F, l, u >> 10, (u >> 9) & 1, (u & 511) * 16);
    if (F.wave < 4) convert_range(F, l, CV_SMALL0, CV_GU1, scr);
}
__device__ __forceinline__ void attn2_phase(Frame& F, int l) {
    const int gw = F.vcu * NWAVES + F.wave, NGW = F.G * NWAVES;
    LAS unsigned* scr = (LAS unsigned*)(F.lds + F.wave * AW_BYTES);
    if (F.wave >= 4) convert_range(F, l, CV_GU1, CV_DN1, scr);
    for (int u = gw; u < 2048; u += NGW) nsa_unit(F, u >> 10, (u >> 9) & 1, (u & 511) * 16);
    if (F.wave < 4) convert_range(F, l, CV_GU1, CV_DN1, scr);
}
#ifndef MK_ONE_LAUNCH
#define MK_ONE_LAUNCH 1
#endif
#ifndef PHASE_MASK
#define PHASE_MASK 0xFFFF
#endif
constexpr int N_PHASES = 2 + 10 * DEPTH;
struct Args { const float* in[25]; float* out; unsigned char* ws; };
#define IN(k) (LO <= (k) && (k) < HI)
#define SEAM(k) do { if constexpr (IN(k) && IN((k) + 1)) xcd_barrier(bar); asm volatile("" : "+v"(F.tid), "+v"(F.lane) :: "memory"); } while (0)
#ifndef DBL_MASK
#define DBL_MASK 0
#endif
#define FENCE() asm volatile("" : "+v"(F.tid), "+v"(F.lane) :: "memory")
#define PHASE(k, bit, ...) do { if constexpr (IN(k) && (PHASE_MASK & (bit))) { __VA_ARGS__ if constexpr ((DBL_MASK & (bit)) != 0) { xcd_barrier(bar); FENCE(); __VA_ARGS__ } } } while (0)
template <int L, int LO, int HI>
__device__ __forceinline__ void layer_phases(Frame& F, const XcdBarrier& bar) {
    constexpr int l = L, pb = 2 + 10 * L;
    PHASE(pb + 0, 4, {
        pg8::Gemm g{(const pg8::bf16_t*)(wsp(F) + WS_HB), (const pg8::bf16_t*)(wsp(F) + WS_WIN), MTOK, NIN, DM}; pg8::StaticOrder S; S.init(MTOK, NIN, F.G, (int)blockIdx.x);
        pg8::EpiProj E{(pg8::bf16_t*)(wsp(F) + WS_PROJ), (pg8::bf16_t*)(wsp(F) + WS_VT), NPROJ, MTOK};
        pg8::gemm_phase<pg8::EpiProj, pg8::StaticOrder, true, true>(F.lds + RING_OFF, g, S, E);
    });
    SEAM(pb + 0);
    PHASE(pb + 1, 8, { attn1_phase(F, l); });
    SEAM(pb + 1);
    PHASE(pb + 2, 16, { attn2_phase(F, l); });
    if constexpr ((DBL_MASK & 0x10000) != 0) { xcd_barrier(bar); FENCE(); attn1_phase(F, l); xcd_barrier(bar); FENCE(); attn2_phase(F, l); }
    SEAM(pb + 2);
    PHASE(pb + 4, 64, {
        pg8::Gemm g{(const pg8::bf16_t*)(wsp(F) + WS_OCAT), (const pg8::bf16_t*)(wsp(F) + WS_WOUT), MTOK, DM, DM}; pg8::StaticOrder S; S.init(MTOK, DM, F.G, (int)blockIdx.x);
        pg8::GroupScale KS{(const float*)(wsp(F) + WS_SSQ), (PG8_LAS float*)(F.lds + GSC_OFF), RMS_EPS};
        const float* g1p = (const float*)(wsp(F) + WS_MOD) + (size_t)l * NB * 6 * DM + 2 * DM;
        if constexpr (l == 0) { pg8::EpiResid<false> E{(const void*)inp(F, I_X), (pg8::bf16_t*)(wsp(F) + WS_XA), g1p, 6 * DM, SEQ, DM, ALPHA};
            pg8::gemm_phase<pg8::EpiResid<false>, pg8::StaticOrder, true, true, pg8::NoGather, pg8::GroupScale>(F.lds + RING_OFF, g, S, E, pg8::NoGather(), KS); }
        else { pg8::EpiResid<true> E{(const void*)(wsp(F) + WS_XB), (pg8::bf16_t*)(wsp(F) + WS_XA), g1p, 6 * DM, SEQ, DM, ALPHA};
            pg8::gemm_phase<pg8::EpiResid<true>, pg8::StaticOrder, true, true, pg8::NoGather, pg8::GroupScale>(F.lds + RING_OFF, g, S, E, pg8::NoGather(), KS); }
    });
    SEAM(pb + 4);
    PHASE(pb + 5, 128, { post_mixer_phase(F, l); });
    if constexpr (IN(pb + 5)) { if constexpr (HI - LO > 1) xcd_barrier(bar); FENCE(); router_phase(F, l); }
    SEAM(pb + 5);
    PHASE(pb + 7, 512, {
        moe_tables(F, l);
        const PG8_LAS_T int* tab = (const PG8_LAS_T int*)(F.lds + TAB_OFF);
        pg8::Gemm g{(const pg8::bf16_t*)(wsp(F) + WS_HB), (const pg8::bf16_t*)(wsp(F) + WS_WGU), MAXROWS, NEXP * 1024, DM};
        pg8::MoeOrder S{4, F.G, (int)blockIdx.x, tab};
        pg8::EpiSwiGLU E{(pg8::bf16_t*)(wsp(F) + WS_HID), DEXP};
        pg8::MoeGather GA{tab, (const int*)(wsp(F) + WS_LIST), MTOK, (unsigned)(DM * 2), 0u};
        pg8::gemm_phase<pg8::EpiSwiGLU, pg8::MoeOrder, true, true, pg8::MoeGather>(F.lds + RING_OFF, g, S, E, GA);
    });
    SEAM(pb + 7);
    PHASE(pb + 8, 1024, {
        moe_tables(F, l);
        const PG8_LAS_T int* tab = (const PG8_LAS_T int*)(F.lds + TAB_OFF);
        pg8::Gemm g{(const pg8::bf16_t*)(wsp(F) + WS_HID), (const pg8::bf16_t*)(wsp(F) + WS_WD), MAXROWS, NEXP * DM, DEXP};
        pg8::MoeOrder S{8, F.G, (int)blockIdx.x, tab};
        pg8::EpiDown E{(pg8::bf16_t*)(wsp(F) + WS_YS), DM, tab, (const int*)(wsp(F) + WS_LIST), MTOK, (const float*)(wsp(F) + WS_SMALL + SM_GATEW)};
        pg8::gemm_phase<pg8::EpiDown, pg8::MoeOrder, true, true>(F.lds + RING_OFF, g, S, E);
    });
    SEAM(pb + 8);
    PHASE(pb + 9, 2048, { post_moe_phase(F, l, (l == DEPTH - 1) ? outp(F) : (float*)nullptr, (bf16*)(wsp(F) + WS_XB), l < DEPTH - 1); });
    PHASE(pb + 9, 4096, { if (l < DEPTH - 1) convert_small(F, l + 1); });
    SEAM(pb + 9);
}
template <int LO, int HI>
__global__ void __launch_bounds__(NWAVES * 64, 2) fwd_kernel(Args args) {
    extern __shared__ __attribute__((aligned(16))) unsigned char lds[];
    Frame F;
    F.lds = (LAS unsigned char*)lds;
    F.MISC = (volatile LAS unsigned*)(F.lds + MISC_OFF);
    F.tid = threadIdx.x; F.lane = F.tid & 63; F.wave = __builtin_amdgcn_readfirstlane(F.tid >> 6);
    F.G = gridDim.x; { const int bx = blockIdx.x; F.vcu = (F.G % 8 == 0) ? (bx % 8) * (F.G / 8) + bx / 8 : bx; }
    for (int u = F.tid; u < (LDS_BYTES - LDSCTL_OFF) / 4; u += NWAVES * 64) ((LAS unsigned*)(F.lds + LDSCTL_OFF))[u] = 0u;
    __syncthreads();
    if (F.tid < 25) ((LAS unsigned long long*)(F.lds + PTR_OFF))[F.tid] = (unsigned long long)args.in[F.tid];
    if (F.tid == 25) ((LAS unsigned long long*)(F.lds + PTR_OFF))[25] = (unsigned long long)args.ws;
    if (F.tid == 26) ((LAS unsigned long long*)(F.lds + PTR_OFF))[26] = (unsigned long long)args.out;
    __syncthreads();
    XcdBarrier bar; bar.bar = (unsigned*)(ctlp(F) + CW_BAR); bar.x = 0; bar.st = nullptr;
    if constexpr (HI - LO > 1) bar = xcd_barrier_post((unsigned*)(ctlp(F) + CW_BAR), F.MISC + 8);
    PHASE(0, 1, { ada_phase(F); });
    PHASE(0, 4096, { __syncthreads(); convert_small(F, 0); });
    SEAM(0);
    PHASE(1, 2, { ln_in_phase(F); });
    SEAM(1);
    layer_phases<0, LO, HI>(F, bar);
    layer_phases<1, LO, HI>(F, bar);
}
#undef IN
#undef SEAM
#undef PHASE

#if MK_ONE_LAUNCH
#define FWD_MAIN (fwd_kernel<0, N_PHASES>)
static bool set_lds_attr() { return hipFuncSetAttribute((const void*)FWD_MAIN, hipFuncAttributeMaxDynamicSharedMemorySize, LDS_BYTES) == hipSuccess; }
#else
#define FWD_MAIN (fwd_kernel<0, 1>)
template <int... P> static bool set_lds_attr_seq(std::integer_sequence<int, P...>) { bool ok = true; ((ok = ok && hipFuncSetAttribute((const void*)(fwd_kernel<P, P + 1>), hipFuncAttributeMaxDynamicSharedMemorySize, LDS_BYTES) == hipSuccess), ...); return ok; }
static bool set_lds_attr() { return set_lds_attr_seq(std::make_integer_sequence<int, N_PHASES>{}); }
template <int P> static void launch_one(int grid, hipStream_t stream, const Args& a) { hipLaunchKernelGGL((fwd_kernel<P, P + 1>), dim3(grid), dim3(NWAVES * 64), LDS_BYTES, stream, a); }
template <int... P> static void launch_phases(std::integer_sequence<int, P...>, int grid, hipStream_t stream, const Args& a) { (launch_one<P>(grid, stream, a), ...); }
#endif
extern "C" void kernel_launch(void* const* d_in, const int* in_sizes, int n_in, void* d_out, int out_size, void* d_ws, size_t ws_size, hipStream_t stream) {
    static int grid = 0;
    if (grid == 0) {
        if (n_in != 25 || out_size != MTOK * DM || ws_size < WS_END) { fprintf(stderr, "kernel_launch: unexpected problem shape (n_in %d, out %d, ws %zu)\n", n_in, out_size, ws_size); grid = -1; return; }
        int dev = 0, cus = 0, per_cu = 0;
        if (hipGetDevice(&dev) != hipSuccess || hipDeviceGetAttribute(&cus, hipDeviceAttributeMultiprocessorCount, dev) != hipSuccess) { grid = -1; return; }
        if (!set_lds_attr()) { fprintf(stderr, "kernel_launch: hipFuncSetAttribute failed\n"); grid = -1; return; }
        if (hipOccupancyMaxActiveBlocksPerMultiprocessor(&per_cu, (const void*)FWD_MAIN, NWAVES * 64, LDS_BYTES) != hipSuccess || per_cu < 1)
            fprintf(stderr, "kernel_launch: note: occupancy query reports %d workgroups per CU\n", per_cu);
        (void)hipGetLastError();
        grid = cus;
        if (grid > 256) grid = 256;
        grid &= ~7;
    }
    if (grid <= 0) return;
    (void)in_sizes;
    if (hipMemsetAsync((char*)d_ws + WS_CTL, 0, CTL_ZERO_BYTES, stream) != hipSuccess) return;
    Args a{};
    for (int i = 0; i < 25; ++i) a.in[i] = (const float*)d_in[i];
    a.out = (float*)d_out; a.ws = (unsigned char*)d_ws;
#if MK_ONE_LAUNCH
    hipLaunchKernelGGL((fwd_kernel<0, N_PHASES>), dim3(grid), dim3(NWAVES * 64), LDS_BYTES, stream, a);
#else
    launch_phases(std::make_integer_sequence<int, N_PHASES>{}, grid, stream, a);
#endif
}
```

```cpp
#include <hip/hip_runtime.h>
#include <cstdio>
#include <cstdint>
#include <utility>
#define MK_ONE_LAUNCH 1
namespace pg8 {
#define PG8_LAS __attribute__((address_space(3)))
#define PG8_LAS_T __attribute__((address_space(3)))
typedef unsigned short bf16_t;
typedef short bf16x8 __attribute__((ext_vector_type(8)));
typedef float f32x4 __attribute__((ext_vector_type(4)));
typedef unsigned u32x4 __attribute__((ext_vector_type(4)));
constexpr int BM = 256, BK = 64, HALF = 128, HTB = HALF * BK * 2  , STAGE_BYTES = 8 * HTB, NXCD = 8, WGM = 8;

__host__ __device__ __forceinline__ int lds_byte(int r, int c) { const int st = (r >> 4) * 2 + (c >> 5), rr = r & 15, cc = c & 31, ob = rr * 64 + cc * 2; return st * 1024 + (ob ^ (((ob >> 9) & 1) << 5)); }
__host__ __device__ __forceinline__ void stage_rc(int b, int& R, int& C) { const int st = b / 1024, sb = b % 1024, swz = sb ^ (((sb >> 9) & 1) << 5); R = (st >> 1) * 16 + swz / 64; C = (st & 1) * 32 + (swz % 64) / 2; }
__host__ __device__ __forceinline__ int perm32(int rho) { const int n = rho >> 4, i = rho & 15; return 8 * (i >> 2) + 4 * n + (i & 3); }

struct Unit { int pm, pn; };
struct Gemm { const bf16_t* A; const bf16_t* Bt; int M, N, K; };

struct StaticOrder {
    int nM, nN, nwg, G, c;
    __host__ __device__ void init(int M, int N, int G_, int c_) { nM = M / BM; nN = N / BM; nwg = nM * nN; G = G_; c = c_; }
    __host__ __device__ bool next(int i, Unit& u) const {
        const long L = (long)i * G + c; if (L >= nwg) return false;
        int wgid = (int)L; { const int q = nwg / NXCD, r = nwg % NXCD, xcd = wgid % NXCD, off = wgid / NXCD; wgid = (xcd < r ? xcd * (q + 1) : r * (q + 1) + (xcd - r) * q) + off; }
        const int nig = WGM * nN, gid = wgid / nig, fm = gid * WGM, gsz = (nM - fm) < WGM ? (nM - fm) : WGM;
        u.pm = fm + ((wgid % nig) % gsz); u.pn = (wgid % nig) / gsz; return true;
    }
    __device__ __forceinline__ void a_ready(const Unit&) const {}
    __device__ __forceinline__ void done(const Unit&) const {}
};
__device__ __forceinline__ unsigned cvt_pk_bf16(float lo, float hi) { unsigned r; asm volatile("s_nop 0\n\tv_cvt_pk_bf16_f32 %0, %1, %2\n\ts_nop 1" : "=v"(r) : "v"(lo), "v"(hi));     return r; }
typedef float f32x2 __attribute__((ext_vector_type(2)));
__device__ __forceinline__ unsigned short f2bf_rne(float f) { unsigned u = __builtin_bit_cast(unsigned, f); return (unsigned short)((u + 0x7fffu + ((u >> 16) & 1u)) >> 16); }

struct EpiProj {
    static constexpr bool PERM = true, AFTER_DRAIN = false;
    bf16_t* P; bf16_t* VT; int ldp; int ldvt;
    __device__ __forceinline__ void operator()(const f32x4 (&acc)[2][2][4][2], const Unit& u, int wr, int wc, int fr, int fq) const {
        const int row0 = u.pm * BM + wr * 64 + fr;
#pragma unroll
        for (int bj = 0; bj < 2; ++bj) {
            const int cb = u.pn * BM + bj * HALF;
            if (cb < ldp) {
                bf16_t* colp = P + (size_t)row0 * ldp + cb + wc * 32 + 8 * fq;
#pragma unroll
                for (int ai = 0; ai < 2; ++ai)
#pragma unroll
                    for (int m = 0; m < 4; ++m) { const f32x4 v0 = acc[ai][bj][m][0], v1 = acc[ai][bj][m][1];
                        u32x4 w; w.x = cvt_pk_bf16(v0[0], v0[1]); w.y = cvt_pk_bf16(v0[2], v0[3]); w.z = cvt_pk_bf16(v1[0], v1[1]); w.w = cvt_pk_bf16(v1[2], v1[3]);
                        *(u32x4*)(colp + (size_t)(ai * HALF + m * 16) * ldp) = w; }
            } else {
                const int c0 = cb - ldp + wc * 32 + 8 * fq;
#pragma unroll
                for (int n = 0; n < 2; ++n)
#pragma unroll
                    for (int e = 0; e < 4; ++e) { bf16_t* cp = VT + (size_t)(c0 + n * 4 + e) * ldvt + row0;
#pragma unroll
                        for (int ai = 0; ai < 2; ++ai)
#pragma unroll
                            for (int m = 0; m < 4; ++m) cp[ai * HALF + m * 16] = f2bf_rne(acc[ai][bj][m][n][e]); }
            }
        }
    }
};

template <bool XBF> struct EpiResid {
    static constexpr bool PERM = true, AFTER_DRAIN = false;
    const void* xin; bf16_t* out; const float* gate0; int gate_bstride; int rows_per_batch; int ldc; float alpha;
    __device__ __forceinline__ void operator()(const f32x4 (&acc)[2][2][4][2], const Unit& u, int wr, int wc, int fr, int fq) const {
        const int col0 = u.pn * BM + wc * 32 + 8 * fq;
        const float* gv = gate0 + (size_t)((u.pm * BM) / rows_per_batch) * gate_bstride;
#pragma unroll
        for (int bj = 0; bj < 2; ++bj) { const int c = col0 + bj * HALF; const f32x4 g0 = *(const f32x4*)(gv + c) + 1.0f, g1 = *(const f32x4*)(gv + c + 4) + 1.0f;
#pragma unroll
            for (int ai = 0; ai < 2; ++ai)
#pragma unroll
                for (int m = 0; m < 4; ++m) { const size_t off = (size_t)(u.pm * BM + ai * HALF + wr * 64 + m * 16 + fr) * ldc + c;
                    if (m & 1) asm volatile("" ::: "memory");
                    f32x4 x0, x1;
                    if (XBF) { const u32x4 xw = *(const u32x4*)((const bf16_t*)xin + off);
                        x0 = (f32x4){__builtin_bit_cast(float, xw.x << 16), __builtin_bit_cast(float, xw.x & 0xffff0000u), __builtin_bit_cast(float, xw.y << 16), __builtin_bit_cast(float, xw.y & 0xffff0000u)};
                        x1 = (f32x4){__builtin_bit_cast(float, xw.z << 16), __builtin_bit_cast(float, xw.z & 0xffff0000u), __builtin_bit_cast(float, xw.w << 16), __builtin_bit_cast(float, xw.w & 0xffff0000u)}; }
                    else { x0 = *(const f32x4*)((const float*)xin + off); x1 = *(const f32x4*)((const float*)xin + off + 4); }
                    const f32x4 v0 = x0 * alpha + g0 * acc[ai][bj][m][0], v1 = x1 * alpha + g1 * acc[ai][bj][m][1];
                    u32x4 w; w.x = cvt_pk_bf16(v0[0], v0[1]); w.y = cvt_pk_bf16(v0[2], v0[3]); w.z = cvt_pk_bf16(v1[0], v1[1]); w.w = cvt_pk_bf16(v1[2], v1[3]);
                    *(u32x4*)(out + off) = w; } }
    }
};

struct EpiSwiGLU {
    static constexpr bool PERM = true, AFTER_DRAIN = false;
    bf16_t* H; int ldh;
    __device__ __forceinline__ void operator()(const f32x4 (&acc)[2][2][4][2], const Unit& u, int wr, int wc, int fr, int fq) const {
        const int row0 = u.pm * BM + wr * 64 + fr, pnl = u.pn & 3;
        const int j0 = pnl * 128 + wc * 16 + 4 * fq;
#pragma unroll
        for (int ai = 0; ai < 2; ++ai)
#pragma unroll
            for (int m = 0; m < 4; ++m) { bf16_t* rowp = H + (size_t)(row0 + ai * HALF + m * 16) * ldh + j0;
#pragma unroll
                for (int bj = 0; bj < 2; ++bj) { const f32x4 v0 = acc[ai][bj][m][0], v1 = acc[ai][bj][m][1];
                    const float h0 = v0[0] / (1.0f + __expf(-v0[0])) * v0[1], h1 = v0[2] / (1.0f + __expf(-v0[2])) * v0[3];
                    const float h2 = v1[0] / (1.0f + __expf(-v1[0])) * v1[1], h3 = v1[2] / (1.0f + __expf(-v1[2])) * v1[3];
                    typedef unsigned u32x2 __attribute__((ext_vector_type(2)));
                    u32x2 w; w.x = cvt_pk_bf16(h0, h1); w.y = cvt_pk_bf16(h2, h3);
                    *(u32x2*)(rowp + bj * 64) = w; } }
    }
};

__device__ __forceinline__ int moe_row_aid(const PG8_LAS int* tab, const int* list, int list_stride, int rt, int row_in_tile) {
    const int e = tab[64 + rt], pos = rt * 256 + row_in_tile - tab[32 + e];
    return pos < tab[e] ? list[(size_t)e * list_stride + pos] : -1;
}
struct MoeGather {
    static constexpr bool ON = true;
    const PG8_LAS int* tab; const int* list; int list_stride; unsigned row_bytes, zero_off;
    __device__ __forceinline__ unsigned row_off(const Unit& u, int h, int r) const { const int aid = moe_row_aid(tab, list, list_stride, u.pm, h * HALF + r); return aid >= 0 ? (unsigned)(aid >> 1) * row_bytes : zero_off; }
};

struct EpiDown {
    static constexpr bool PERM = true, AFTER_DRAIN = false;
    bf16_t* Y; int ldy; const PG8_LAS int* tab; const int* list; int list_stride; const float* gatew;
    __device__ __forceinline__ void operator()(const f32x4 (&acc)[2][2][4][2], const Unit& u, int wr, int wc, int fr, int fq) const {
        const int pnl = u.pn & 7;
        const int col0 = pnl * BM + wc * 32 + 8 * fq;
#pragma unroll
        for (int ai = 0; ai < 2; ++ai)
#pragma unroll
            for (int m = 0; m < 4; ++m) { const int aid = moe_row_aid(tab, list, list_stride, u.pm, wr * 64 + fr + ai * HALF + m * 16);
                if (aid >= 0) { const float gw = gatew[aid]; bf16_t* rowp = Y + (size_t)aid * ldy + col0;
#pragma unroll
                    for (int bj = 0; bj < 2; ++bj) { const f32x4 v0 = acc[ai][bj][m][0] * gw, v1 = acc[ai][bj][m][1] * gw;
                        u32x4 w; w.x = cvt_pk_bf16(v0[0], v0[1]); w.y = cvt_pk_bf16(v0[2], v0[3]); w.z = cvt_pk_bf16(v1[0], v1[1]); w.w = cvt_pk_bf16(v1[2], v1[3]);
                        *(u32x4*)(rowp + bj * HALF) = w; } } }
    }
};

struct MoeOrder {
    int NT, G, c; const PG8_LAS int* tab;
    __device__ __forceinline__ bool next(int i, Unit& u) const {
        const int x = c & 7, ci = c >> 3, per = G >> 3;
        const int q = i * per + ci, rt = x + 8 * (q / NT);
        if (rt >= tab[224]) return false;
        u.pm = rt; u.pn = tab[64 + rt] * NT + (q % NT); return true;
    }
    __device__ __forceinline__ void a_ready(const Unit&) const {}
    __device__ __forceinline__ void done(const Unit&) const {}
};

struct GroupScale {
    static constexpr bool ON = true; static constexpr int T1 = 8, T2 = 16;
    const float* ssq; PG8_LAS float* base; float eps;
    __device__ __forceinline__ const PG8_LAS float* tab(int buf) const { return base + buf * 768; }
    __device__ __forceinline__ void announce(const Unit& u, int buf) const {
        const int tid = threadIdx.x, row = tid >> 1, half = tid & 1;
        const f32x4* p = (const f32x4*)(ssq + (size_t)(u.pm * BM + row) * 32 + half * 16);
        const f32x4 a = p[0], b = p[1], c = p[2], d = p[3];
        const float s01 = (a[0] + a[1]) + (a[2] + a[3]) + (b[0] + b[1]) + (b[2] + b[3]), s23 = (c[0] + c[1]) + (c[2] + c[3]) + (d[0] + d[1]) + (d[2] + d[3]);
        const float o01 = __shfl_xor(s01, 1), o23 = __shfl_xor(s23, 1);
        const float sA = half == 0 ? s01 : o01, sB = half == 0 ? s23 : o23, sC = half == 0 ? (o01 + o23) : (s01 + s23);
        const float mA = sA * (1.0f / 512.0f) + eps, mB = sB * (1.0f / 512.0f) + eps, mC = sC * (1.0f / 1024.0f) + eps;
        PG8_LAS float* t = base + buf * 768 + 3 * row;
        if (half == 0) { t[0] = sqrtf(mB / mA); t[1] = sqrtf(mC / mB); }
        else t[2] = 1.0f / sqrtf(mC);
    }
};
struct NoGather { static constexpr bool ON = false; __device__ __forceinline__ unsigned row_off(const Unit&, int, int) const { return 0u; } };
struct NoKScale { static constexpr bool ON = false; static constexpr int T1 = 0, T2 = 0; __device__ __forceinline__ void announce(const Unit&, int) const {} __device__ __forceinline__ const PG8_LAS float* tab(int) const { return nullptr; } };
template <class Epi, class Sched, bool ALIGN_EPI = false, bool SP2 = false, class Gat = NoGather, class KSc = NoKScale>
__device__ __forceinline__ void gemm_phase(PG8_LAS unsigned char* lds, const Gemm g, const Sched& S, const Epi& E, const Gat& GA = Gat(), const KSc& KS = KSc()) {
    static_assert(!Gat::ON || SP2, "the gathered A operand is wired into the SP2 loop only");
    int tid_ = threadIdx.x; asm volatile("" : "+v"(tid_));
    const int tid = tid_, wid = __builtin_amdgcn_readfirstlane(tid >> 6), lane = tid & 63, wr = wid >> 2, wc = wid & 3, fr = lane & 15, fq = lane >> 4;
    const int K = g.K, nt = K / BK;
    unsigned voffA[2], voffB[2];
    int RA[2]; unsigned CA2[2];
#pragma unroll
    for (int i = 0; i < 2; ++i) { int R, C; stage_rc(tid * 16 + i * 8192, R, C); const int Rb = Epi::PERM ? ((R & ~31) + perm32(R & 31)) : R;
        voffA[i] = (unsigned)(R * K + C) * 2u; voffB[i] = (unsigned)(Rb * K + C) * 2u; RA[i] = R; CA2[i] = (unsigned)C * 2u; }
    unsigned gcu[2][2] = {{0u, 0u}, {0u, 0u}}, gnx[2][2] = {{0u, 0u}, {0u, 0u}};
    const size_t kstep = (size_t)(BK * 2);
    const size_t hstep = (size_t)HALF * K * 2;
    const size_t tstep = 2 * hstep;
    const unsigned ldsw = (unsigned)wid * 1024u;
    const int aoff = lds_byte(wr * 64 + fr, fq * 8), boff = lds_byte(wc * 32 + fr, fq * 8);
#define PG8_SA(b, h) (((b) * 2 + (h)) * HTB)
#define PG8_SB(b, h) ((4 + (b) * 2 + (h)) * HTB)
#define PG8_STAGE(bufoff, gbase, voff) do { _Pragma("unroll") for (int _i = 0; _i < 2; ++_i) \
        __builtin_amdgcn_global_load_lds((const unsigned*)((const char*)(gbase) + (voff)[_i]), (PG8_LAS unsigned*)(lds + (bufoff) + ldsw + _i * 8192), 16, 0, 0); } while (0)
#define PG8_STAGE_A(b, h, ptr, isnext) do { if constexpr (Gat::ON) { const bool _nx = (isnext); unsigned _tv[2] = {_nx ? gnx[h][0] : gcu[h][0], _nx ? gnx[h][1] : gcu[h][1]}; PG8_STAGE(PG8_SA(b, h), ptr, _tv); } \
        else { PG8_STAGE(PG8_SA(b, h), (ptr) + (h) * hstep, voffA); } } while (0)
#define PG8_LDA(dst, b, h) do { _Pragma("unroll") for (int m = 0; m < 4; ++m) _Pragma("unroll") for (int k = 0; k < 2; ++k) dst[m][k] = *(const PG8_LAS bf16x8*)(lds + PG8_SA(b, h) + aoff + m * 2048 + k * 1024); } while (0)
#define PG8_LDB(dst, b, h) do { _Pragma("unroll") for (int n = 0; n < 2; ++n) _Pragma("unroll") for (int k = 0; k < 2; ++k) dst[n][k] = *(const PG8_LAS bf16x8*)(lds + PG8_SB(b, h) + boff + n * 2048 + k * 1024); } while (0)
#define PG8_MMA(ai, bj, At, Bt) do { __builtin_amdgcn_s_setprio(1); _Pragma("unroll") for (int m = 0; m < 4; ++m) _Pragma("unroll") for (int n = 0; n < 2; ++n) _Pragma("unroll") for (int k = 0; k < 2; ++k) \
        acc[ai][bj][m][n] = __builtin_amdgcn_mfma_f32_16x16x32_bf16(Bt[n][k], At[m][k], acc[ai][bj][m][n], 0, 0, 0); __builtin_amdgcn_s_setprio(0); } while (0)
#define PG8_WAIT_V(n) asm volatile("s_waitcnt vmcnt(" #n ")" ::: "memory")
#define PG8_WAIT_L(n) asm volatile("s_waitcnt lgkmcnt(" #n ")" ::: "memory")
#define PG8_BAR __builtin_amdgcn_s_barrier()
#define PG8_SCHED __builtin_amdgcn_sched_barrier(0)
    Unit cur, nxt; int ui = 0;
    if (!S.next(0, cur)) return;
    f32x4 acc[2][2][4][2];
#pragma unroll
    for (int a = 0; a < 2; ++a)
#pragma unroll
        for (int b = 0; b < 2; ++b)
#pragma unroll
            for (int m = 0; m < 4; ++m)
#pragma unroll
                for (int n = 0; n < 2; ++n) acc[a][b][m][n] = (f32x4){0.f, 0.f, 0.f, 0.f};
    bf16x8 At[4][2], B0[2][2], B1[2][2];
#define PG8_KSCALE(buf, which) do { const PG8_LAS float* _tb = KS.tab(buf); _Pragma("unroll") for (int _a = 0; _a < 2; ++_a) _Pragma("unroll") for (int _m = 0; _m < 4; ++_m) { \
        const PG8_LAS float* _r = _tb + 3 * (_a * HALF + wr * 64 + _m * 16 + fr); const float _f = _r[which]; \
        _Pragma("unroll") for (int _b = 0; _b < 2; ++_b) _Pragma("unroll") for (int _n = 0; _n < 2; ++_n) acc[_a][_b][_m][_n] = acc[_a][_b][_m][_n] * _f; } } while (0)
    const char* cA = (const char*)g.A + (Gat::ON ? (size_t)0 : (size_t)cur.pm * tstep); const char* cB = (const char*)g.Bt + (size_t)cur.pn * tstep;
    if constexpr (Gat::ON) {
#pragma unroll
        for (int h = 0; h < 2; ++h)
#pragma unroll
            for (int i = 0; i < 2; ++i) { gcu[h][i] = GA.row_off(cur, h, RA[i]) + CA2[i]; gnx[h][i] = gcu[h][i]; } }
    if constexpr (KSc::ON) KS.announce(cur, 0);
    S.a_ready(cur);
    if constexpr (SP2) {
        PG8_STAGE(PG8_SB(0, 0), cB, voffB); PG8_STAGE(PG8_SB(0, 1), cB + hstep, voffB); PG8_STAGE_A(0, 0, cA, false); PG8_STAGE_A(0, 1, cA, false);
        if (wr == 1) PG8_BAR;
        PG8_WAIT_V(2); PG8_BAR;
        PG8_STAGE(PG8_SB(1, 0), cB + kstep, voffB); PG8_STAGE_A(1, 0, cA + kstep, false); PG8_STAGE(PG8_SB(1, 1), cB + hstep + kstep, voffB);
        PG8_WAIT_V(6); PG8_BAR;
    } else {
        PG8_STAGE(PG8_SB(0, 0), cB, voffB); PG8_STAGE(PG8_SA(0, 0), cA, voffA); PG8_STAGE(PG8_SB(0, 1), cB + hstep, voffB); PG8_STAGE(PG8_SA(0, 1), cA + hstep, voffA);
        if (wr == 1) PG8_BAR;
        PG8_WAIT_V(4); PG8_BAR;
        PG8_STAGE(PG8_SB(1, 0), cB + kstep, voffB); PG8_STAGE(PG8_SA(1, 0), cA + kstep, voffA); PG8_STAGE(PG8_SB(1, 1), cB + hstep + kstep, voffB);
        PG8_WAIT_V(6); PG8_BAR;
    }
    for (;;) {
        const bool has_next = S.next(ui + 1, nxt);
        if constexpr (KSc::ON) { if (has_next) KS.announce(nxt, (ui + 1) % 3); }
        const char* nA = (has_next && !Gat::ON) ? (const char*)g.A + (size_t)nxt.pm * tstep : cA; const char* nB = has_next ? (const char*)g.Bt + (size_t)nxt.pn * tstep : cB;
        if constexpr (Gat::ON) { if (has_next) {
#pragma unroll
            for (int h = 0; h < 2; ++h)
#pragma unroll
                for (int i = 0; i < 2; ++i) gnx[h][i] = GA.row_off(nxt, h, RA[i]) + CA2[i]; } }
        int t = 0;
        for (int seg = 0; seg < (KSc::ON ? 3 : 1); ++seg) {
        const int thi = !KSc::ON ? nt : (seg == 0 ? KSc::T1 : (seg == 1 ? KSc::T2 : nt));
        for (; t < thi; t += 2) {
            const bool last = (t == nt - 2);
            const char* a1 = cA + (size_t)(t + 1) * kstep;
            const char* a2 = last ? nA : cA + (size_t)(t + 2) * kstep; const char* b2 = last ? nB : cB + (size_t)(t + 2) * kstep;
            const char* a3 = a2 + kstep; const char* b3 = b2 + kstep;
            if (last && has_next) S.a_ready(nxt);
            if constexpr (SP2) {
            PG8_LDB(B0, 0, 0); PG8_LDB(B1, 0, 1); PG8_SCHED; PG8_LDA(At, 0, 0); PG8_STAGE_A(1, 1, a1, false);
            PG8_WAIT_V(8); PG8_WAIT_L(0); PG8_BAR; PG8_MMA(0, 0, At, B0); PG8_MMA(0, 1, At, B1); PG8_BAR; PG8_SCHED;
            PG8_LDA(At, 0, 1); PG8_STAGE(PG8_SB(0, 0), b2, voffB); PG8_STAGE(PG8_SB(0, 1), b2 + hstep, voffB); PG8_STAGE_A(0, 0, a2, last);
            PG8_WAIT_V(8); PG8_WAIT_L(0); PG8_BAR; PG8_MMA(1, 0, At, B0); PG8_MMA(1, 1, At, B1); PG8_BAR; PG8_SCHED;
            PG8_LDB(B0, 1, 0); PG8_LDB(B1, 1, 1); PG8_SCHED; PG8_LDA(At, 1, 0); PG8_STAGE_A(0, 1, a2, last);
            PG8_WAIT_V(8); PG8_WAIT_L(0); PG8_BAR; PG8_MMA(0, 0, At, B0); PG8_MMA(0, 1, At, B1); PG8_BAR; PG8_SCHED;
            PG8_LDA(At, 1, 1); PG8_STAGE(PG8_SB(1, 0), b3, voffB); PG8_STAGE(PG8_SB(1, 1), b3 + hstep, voffB); PG8_STAGE_A(1, 0, a3, last);
            PG8_WAIT_V(8); PG8_WAIT_L(0); PG8_BAR; PG8_MMA(1, 0, At, B0); PG8_MMA(1, 1, At, B1); PG8_BAR; PG8_SCHED;
            } else {
            PG8_LDB(B0, 0, 0); PG8_SCHED; PG8_LDA(At, 0, 0); PG8_STAGE(PG8_SA(1, 1), a1 + hstep, voffA);
            PG8_WAIT_L(8); PG8_BAR; PG8_WAIT_L(0); PG8_MMA(0, 0, At, B0); PG8_BAR; PG8_SCHED;
            PG8_LDB(B1, 0, 1); PG8_STAGE(PG8_SB(0, 0), b2, voffB);
            PG8_BAR; PG8_WAIT_L(0); PG8_MMA(0, 1, At, B1); PG8_BAR;
            PG8_LDA(At, 0, 1); PG8_STAGE(PG8_SA(0, 0), a2, voffA);
            PG8_BAR; PG8_WAIT_L(0); PG8_MMA(1, 0, At, B0); PG8_BAR; PG8_SCHED;
            PG8_STAGE(PG8_SB(0, 1), b2 + hstep, voffB);
            PG8_WAIT_V(6); PG8_BAR; PG8_MMA(1, 1, At, B1); PG8_BAR;
            PG8_LDB(B0, 1, 0); PG8_SCHED; PG8_LDA(At, 1, 0); PG8_STAGE(PG8_SA(0, 1), a2 + hstep, voffA);
            PG8_WAIT_L(8); PG8_BAR; PG8_WAIT_L(0); PG8_MMA(0, 0, At, B0); PG8_BAR; PG8_SCHED;
            PG8_LDB(B1, 1, 1); PG8_STAGE(PG8_SB(1, 0), b3, voffB);
            PG8_BAR; PG8_WAIT_L(0); PG8_MMA(0, 1, At, B1); PG8_BAR;
            PG8_LDA(At, 1, 1); PG8_STAGE(PG8_SA(1, 0), a3, voffA);
            PG8_BAR; PG8_WAIT_L(0); PG8_MMA(1, 0, At, B0); PG8_BAR; PG8_SCHED;
            PG8_STAGE(PG8_SB(1, 1), b3 + hstep, voffB);
            PG8_WAIT_V(6); PG8_BAR; PG8_MMA(1, 1, At, B1); PG8_BAR;
            }
        }
        if constexpr (KSc::ON) { if (seg < 2) { asm volatile("" ::: "memory"); __builtin_amdgcn_sched_barrier(0); PG8_KSCALE(ui % 3, seg); __builtin_amdgcn_sched_barrier(0); asm volatile("" ::: "memory"); } }
        }
        if constexpr (ALIGN_EPI) { if (wr == 0) PG8_BAR; }
        if constexpr (KSc::ON) { asm volatile("" ::: "memory"); __builtin_amdgcn_sched_barrier(0); PG8_KSCALE(ui % 3, 2); __builtin_amdgcn_sched_barrier(0); }
        if constexpr (!Epi::AFTER_DRAIN) { E(acc, cur, wr, wc, fr, fq); S.done(cur); }
        if (!has_next) break;
#pragma unroll
        for (int a = 0; a < 2; ++a)
#pragma unroll
            for (int b = 0; b < 2; ++b)
#pragma unroll
                for (int m = 0; m < 4; ++m)
#pragma unroll
                    for (int n = 0; n < 2; ++n) acc[a][b][m][n] = (f32x4){0.f, 0.f, 0.f, 0.f};
        cur = nxt; cA = nA; cB = nB; ++ui;
        if constexpr (Gat::ON) {
#pragma unroll
            for (int h = 0; h < 2; ++h) { gcu[h][0] = gnx[h][0]; gcu[h][1] = gnx[h][1]; } }
        if constexpr (ALIGN_EPI) { if (wr == 1) PG8_BAR; }
    }
    PG8_WAIT_V(0);
    if constexpr (!ALIGN_EPI) { if (wr == 0) PG8_BAR; }
    PG8_BAR;
    if constexpr (Epi::AFTER_DRAIN) { E.fused(acc, cur, wr, wc, fr, fq, lds, wid, lane); S.done(cur); }
#undef PG8_SA
#undef PG8_SB
#undef PG8_STAGE
#undef PG8_KSCALE
#undef PG8_STAGE_A
#undef PG8_LDA
#undef PG8_LDB
#undef PG8_MMA
#undef PG8_WAIT_V
#undef PG8_WAIT_L
#undef PG8_BAR
#undef PG8_SCHED
}
}
constexpr int NWAVES = 8;
constexpr int NB = 2, SEQ = 8192, DM = 2048, MTOK = NB * SEQ, DEPTH = 2, HD = 64;
constexpr int NEXP = 32, DEXP = 512, NASSIGN = MTOK * 2;
constexpr int D_IN = 5144;
constexpr int NPROJ = 3712, NVT = 1408, NIN = NPROJ + NVT;
constexpr int P_QA = 0, P_KA = 512, P_QB = 640, P_KBC = 1152, P_VBC = 1280, P_KBS = 1408, P_KBW = 1536, P_QC = 1664, P_KC = 2688;
constexpr int V_C = 0, V_A = 1024, V_BS = 1152, V_BW = 1280;
constexpr float LN_EPS = 1e-5f, RMS_EPS = 1e-6f, ALPHA = 1.41421356237309515f;
constexpr float LOG2E = 1.44269504088896341f, LN2 = 0.693147180559945309f;
constexpr float SC2 = 0.125f * LOG2E;
constexpr int MAXROWS = 40960;
constexpr float SB_EXIT = -104.0f;

constexpr size_t MiB = 1u << 20;
constexpr size_t WS_CTL = 0, CTL_ZERO_BYTES = 1 * MiB;
constexpr size_t WS_MOD = 1 * MiB;
constexpr size_t WS_SMALL = 2 * MiB;
constexpr size_t WS_LIST = 5 * MiB;
constexpr size_t WS_WCMP = 7 * MiB;
constexpr size_t WS_WIN = 9 * MiB;
constexpr size_t WS_WOUT = 30 * MiB;
constexpr size_t WS_WGU = 38 * MiB;
constexpr size_t WS_WD = 166 * MiB;
constexpr size_t WS_XA = 230 * MiB;
constexpr size_t WS_XB = 358 * MiB;
constexpr size_t WS_HB = 486 * MiB;
constexpr size_t WS_PROJ = 550 * MiB;
constexpr size_t WS_VT = WS_PROJ + (size_t)MTOK * NPROJ * 2;
constexpr size_t WS_XS = WS_PROJ;
constexpr size_t WS_OCAT = 720 * MiB;
constexpr size_t WS_YS = WS_OCAT;
constexpr size_t WS_HID = 848 * MiB;
constexpr size_t WS_SSQ = 888 * MiB;
constexpr size_t WS_END = 890 * MiB;
static_assert(WS_VT + (size_t)NVT * MTOK * 2 <= WS_OCAT && WS_XS + (size_t)MAXROWS * DM * 2 <= WS_OCAT, "proj/vT/xs region");
static_assert(WS_WIN + (size_t)NIN * DM * 2 <= WS_WOUT && WS_WGU + (size_t)NEXP * 1024 * DM * 2 <= WS_WD && WS_WD + (size_t)NEXP * DM * DEXP * 2 <= WS_XA, "weight regions");
constexpr size_t SM_KCMP = 0;
constexpr size_t SM_VCMPT = 256 * 1024;
constexpr size_t SM_GATEW = 512 * 1024;
constexpr size_t SM_ROWINFO = 640 * 1024;
constexpr size_t SM_TILE = 800 * 1024;
constexpr size_t WS_GBUF = WS_SMALL + 1024 * 1024;
constexpr int CW_BAR = 4096;
constexpr int CW_CNT = 16384;

constexpr int RING_OFF = 0, RING_BYTES = 131072;
constexpr int TAB_OFF = RING_BYTES;
constexpr int GSC_OFF = RING_BYTES + 1024;
constexpr int LDSCTL_OFF = 143360, MISC_OFF = LDSCTL_OFF + 320;
constexpr int LDS_BYTES = 147456;

#define GAS __attribute__((address_space(1)))
#define LAS __attribute__((address_space(3)))
typedef unsigned short bf16;
typedef unsigned v4u __attribute__((ext_vector_type(4)));
typedef unsigned v2u __attribute__((ext_vector_type(2)));
typedef float f32x4 __attribute__((ext_vector_type(4)));
typedef short bf16x8 __attribute__((ext_vector_type(8)));
typedef GAS unsigned gu32;
#define RLX_AGENT __ATOMIC_RELAXED, __HIP_MEMORY_SCOPE_AGENT
#define LDS_WAIT() asm volatile("s_waitcnt lgkmcnt(0)" ::: "memory")
#define VM_WAIT() asm volatile("s_waitcnt vmcnt(0)" ::: "memory")
__device__ __forceinline__ unsigned f2bf(float f) { unsigned u = __builtin_bit_cast(unsigned, f); return (u + 0x7fffu + ((u >> 16) & 1u)) >> 16; }
__device__ __forceinline__ unsigned pk2(float lo, float hi) { return f2bf(lo) | (f2bf(hi) << 16); }
__device__ __forceinline__ float bf2f(unsigned short h) { return __builtin_bit_cast(float, (unsigned)h << 16); }
__device__ __forceinline__ float bflo(unsigned w) { return __builtin_bit_cast(float, w << 16); }
__device__ __forceinline__ float bfhi(unsigned w) { return __builtin_bit_cast(float, w & 0xffff0000u); }
__device__ __forceinline__ float ex2(float x) { return __builtin_amdgcn_exp2f(x); }
__device__ __forceinline__ float lg2(float x) { return __builtin_amdgcn_logf(x); }
__device__ __forceinline__ bf16x8 ldg8(const bf16* p) { return *(const GAS bf16x8*)p; }
__device__ __forceinline__ f32x4 mfma16(bf16x8 a, bf16x8 b, f32x4 c) { return __builtin_amdgcn_mfma_f32_16x16x32_bf16(a, b, c, 0, 0, 0); }
__device__ __forceinline__ bf16x8 pack8(float a0, float a1, float a2, float a3, float a4, float a5, float a6, float a7) {
    v4u w;
    asm volatile("s_nop 0\n\tv_cvt_pk_bf16_f32 %0, %4, %5\n\tv_cvt_pk_bf16_f32 %1, %6, %7\n\tv_cvt_pk_bf16_f32 %2, %8, %9\n\tv_cvt_pk_bf16_f32 %3, %10, %11\n\ts_nop 1"
                 : "=&v"(w.x), "=&v"(w.y), "=&v"(w.z), "=&v"(w.w) : "v"(a0), "v"(a1), "v"(a2), "v"(a3), "v"(a4), "v"(a5), "v"(a6), "v"(a7));
    return __builtin_bit_cast(bf16x8, w);
}
#define WS_DPP(v, ctrl) __builtin_bit_cast(float, __builtin_amdgcn_update_dpp(0, __builtin_bit_cast(int, (v)), (ctrl), 0xF, 0xF, true))
__device__ __forceinline__ float wave_sum(float v) {
    v += WS_DPP(v, 0xB1); v += WS_DPP(v, 0x4E); v += WS_DPP(v, 0x141); v += WS_DPP(v, 0x140);
    const float r0 = __builtin_bit_cast(float, __builtin_amdgcn_readlane(__builtin_bit_cast(int, v), 0)), r1 = __builtin_bit_cast(float, __builtin_amdgcn_readlane(__builtin_bit_cast(int, v), 16));
    const float r2 = __builtin_bit_cast(float, __builtin_amdgcn_readlane(__builtin_bit_cast(int, v), 32)), r3 = __builtin_bit_cast(float, __builtin_amdgcn_readlane(__builtin_bit_cast(int, v), 48));
    return (r0 + r1) + (r2 + r3);
}
#define XB_TMO      128
#define XB_XCNT(j)  (256  + 64 * (j))
#define XB_XSUB(j)  (1280 + 64 * (j))
#define XB_XGEN(j)  (2304 + 64 * (j))
#define XB_TOP      3328
#define XB_TOPGEN   3392
#define XCD_BAR_WORDS 3456
#define XB_SPIN_CAP (1u << 18)

__device__ __forceinline__ unsigned xb_ld(unsigned* p)              { return __hip_atomic_load(p, __ATOMIC_RELAXED, __HIP_MEMORY_SCOPE_AGENT); }
__device__ __forceinline__ unsigned xb_add(unsigned* p, unsigned v) { return __hip_atomic_fetch_add(p, v, __ATOMIC_RELAXED, __HIP_MEMORY_SCOPE_AGENT); }
__device__ __forceinline__ unsigned xb_xcc_id() { return (unsigned)__builtin_amdgcn_s_getreg((3 << 11) | 20) & 0xFu; }
#define XB_SPIN(cond, bar) do { unsigned _sp = 0; while (cond) { __builtin_amdgcn_s_sleep(1); \
    if ((++_sp & 255u) == 0u) { if (xb_ld(&(bar)[XB_TMO])) break; if (_sp > XB_SPIN_CAP) { atomicAdd(&(bar)[XB_TMO], 1u); break; } } } } while (0)

struct XcdBarrier {
    unsigned* bar; unsigned x;
    volatile LAS unsigned* st;
};

__device__ __forceinline__ XcdBarrier xcd_barrier_post(unsigned* bar, volatile LAS unsigned* st) {
    XcdBarrier b; b.bar = bar; b.x = xb_xcc_id(); b.st = st;
    if (threadIdx.x == 0) (void)xb_add(&bar[XB_XCNT(b.x)], 1u);
    return b;
}
__device__ __forceinline__ void xcd_barrier_complete(unsigned* bar, unsigned x, unsigned& nloc, unsigned& nx) {
    const unsigned G = gridDim.x * gridDim.y * gridDim.z;
    unsigned sum, cnt, mine, sp = 0u;
    for (;;) {
        sum = 0u; cnt = 0u; mine = 0u;
#pragma unroll
        for (unsigned j = 0; j < 16; ++j) { const unsigned c = xb_ld(&bar[XB_XCNT(j)]); sum += c; cnt += (c > 0u) ? 1u : 0u; mine = (j == x) ? c : mine; }
        if (sum == G) break;
        __builtin_amdgcn_s_sleep(1);
        if ((++sp & 255u) == 0u) { if (xb_ld(&bar[XB_TMO])) break; if (sp > XB_SPIN_CAP) { atomicAdd(&bar[XB_TMO], 1u); break; } }
    }
    nloc = mine > 0u ? mine : 1u; nx = cnt > 0u ? cnt : 1u;
}

__device__ __forceinline__ void xcd_barrier(const XcdBarrier& b) {
    asm volatile("s_waitcnt vmcnt(0)" ::: "memory");
    __syncthreads();
    if (threadIdx.x == 0) {
        unsigned* bar = b.bar;
        __builtin_amdgcn_s_waitcnt(0);
        unsigned nloc = b.st[0], nx = b.st[1];
        if (nloc == 0u) { xcd_barrier_complete(bar, b.x, nloc, nx); b.st[0] = nloc; b.st[1] = nx; }
        const unsigned old = xb_add(&bar[XB_XSUB(b.x)], 1u);
        const unsigned gen = old / nloc;
        if (old + 1u == (gen + 1u) * nloc) {
            __builtin_amdgcn_fence(__ATOMIC_RELEASE, "agent");
            asm volatile("s_waitcnt vmcnt(0)" ::: "memory");
            const unsigned og = xb_add(&bar[XB_TOP], 1u);
            const unsigned tg = og / nx;
            if (og + 1u == (tg + 1u) * nx) xb_add(&bar[XB_TOPGEN], 1u);
            else XB_SPIN(xb_ld(&bar[XB_TOPGEN]) == tg, bar);
            __builtin_amdgcn_fence(__ATOMIC_ACQUIRE, "agent");
            xb_add(&bar[XB_XGEN(b.x)], 1u);
            asm volatile("s_waitcnt vmcnt(0)" ::: "memory");
        } else {
            XB_SPIN(xb_ld(&bar[XB_XGEN(b.x)]) == gen, bar);
            __builtin_amdgcn_fence(__ATOMIC_ACQUIRE, "agent");
            asm volatile("s_waitcnt vmcnt(0)" ::: "memory");
        }
    }
    __syncthreads();
}
struct Frame {
    LAS unsigned char* lds;
    volatile LAS unsigned* MISC;
    int tid, lane, wave;
    int vcu, G;
};
constexpr int PTR_OFF = LDSCTL_OFF + 1024;
__device__ __forceinline__ unsigned char* tabp(const Frame& F, int i) {
    const unsigned long long v = ((LAS unsigned long long*)(F.lds + PTR_OFF))[i];
    const unsigned lo = __builtin_amdgcn_readfirstlane((unsigned)v), hi = __builtin_amdgcn_readfirstlane((unsigned)(v >> 32));
    return (unsigned char*)(((unsigned long long)hi << 32) | lo);
}
__device__ __forceinline__ const float* inp(const Frame& F, int i) { return (const float*)tabp(F, i); }
__device__ __forceinline__ unsigned char* wsp(const Frame& F) { return tabp(F, 25); }
__device__ __forceinline__ float* outp(const Frame& F) { return (float*)tabp(F, 26); }
__device__ __forceinline__ gu32* ctlp(const Frame& F) { return (gu32*)(tabp(F, 25) + WS_CTL); }
enum { I_X = 0, I_C, I_WADA, I_BADA, I_WIN, I_SINKS, I_PEK, I_W1K, I_W2K, I_PEV, I_W1V, I_W2V, I_MIXG, I_WOUT, I_LN1G, I_LN1B, I_WRG, I_BRG, I_WRE, I_BRE, I_WGATE, I_WUP, I_WDOWN, I_LN2G, I_LN2B };

__device__ __forceinline__ void ada_phase(Frame& F) {
    LAS float* cs = (LAS float*)(F.lds + 73728);
    LAS float* red = (LAS float*)(F.lds + 73728 + 16384);
    const float* c = inp(F, I_C);
    for (int i = F.tid; i < NB * DM; i += NWAVES * 64) { const float v = c[i]; cs[i] = v / (1.0f + __expf(-v)); }
    __syncthreads();
    float* mod = (float*)(wsp(F) + WS_MOD);
    for (int u = F.vcu; u < DEPTH * 96; u += F.G) {
        const int l = u / 96, cb = u % 96, col = cb * 128 + 2 * F.lane;
        const float* W = inp(F, I_WADA) + (size_t)l * DM * (6 * DM) + col;
        float a00 = 0.f, a01 = 0.f, a10 = 0.f, a11 = 0.f;
        const int k0 = F.wave * 256;
#pragma unroll 8
        for (int kk = 0; kk < 256; ++kk) { const int k = k0 + kk; typedef float f32x2_ __attribute__((ext_vector_type(2))); const f32x2_ w = *(const GAS f32x2_*)(W + (size_t)k * (6 * DM));
            const float s0 = cs[k], s1 = cs[DM + k]; a00 += s0 * w.x; a01 += s0 * w.y; a10 += s1 * w.x; a11 += s1 * w.y; }
        red[(F.wave * 2 + 0) * 128 + 2 * F.lane] = a00; red[(F.wave * 2 + 0) * 128 + 2 * F.lane + 1] = a01;
        red[(F.wave * 2 + 1) * 128 + 2 * F.lane] = a10; red[(F.wave * 2 + 1) * 128 + 2 * F.lane + 1] = a11;
        __syncthreads();
        if (F.tid < 256) { const int b = F.tid >> 7, j = F.tid & 127; float s = 0.f;
#pragma unroll
            for (int w = 0; w < 8; ++w) s += red[(w * 2 + b) * 128 + j];
            mod[((size_t)l * NB + b) * (6 * DM) + cb * 128 + j] = s + inp(F, I_BADA)[(size_t)l * 6 * DM + cb * 128 + j]; }
        __syncthreads();
    }
}

__device__ __forceinline__ void tr_item(const float* W, int ldw, int K, bf16* WT, size_t drow0, int rs, int src0, int nvalid, int k0, LAS float* scr, int lane) {
    const int nn = lane & 31;
#pragma unroll 8
    for (int i = 0; i < 32; ++i) { const int kk = 2 * i + (lane >> 5);
        scr[kk * 33 + nn] = (nn < nvalid) ? *(const GAS float*)(W + (size_t)(k0 + kk) * ldw + src0 + nn) : 0.f; }
    LDS_WAIT(); asm volatile("" ::: "memory");
    const int c = lane & 7;
#pragma unroll
    for (int j = 0; j < 4; ++j) { const int n = (lane >> 3) + 8 * j; const LAS float* s = scr + (8 * c) * 33 + n;
        v4u o; o.x = pk2(s[0 * 33], s[1 * 33]); o.y = pk2(s[2 * 33], s[3 * 33]); o.z = pk2(s[4 * 33], s[5 * 33]); o.w = pk2(s[6 * 33], s[7 * 33]);
        *(GAS v4u*)(WT + (drow0 + (size_t)n * rs) * K + k0 + 8 * c) = o; }
    LDS_WAIT(); asm volatile("" ::: "memory");
}
__device__ __forceinline__ int win_src(int n0) {
    if (n0 < 512) return n0;
    if (n0 < 640) return 512 + (n0 - 512);
    if (n0 < 1152) return 768 + (n0 - 640);
    if (n0 < 1280) return 1280 + (n0 - 1152);
    if (n0 < 1408) return 1408 + (n0 - 1280);
    if (n0 < 1536) return 1536 + (n0 - 1408);
    if (n0 < 1664) return 1792 + (n0 - 1536);
    if (n0 < 2688) return 2072 + (n0 - 1664);
    if (n0 < 3712) return 3096 + (n0 - 2688);
    if (n0 < 4736) return 4120 + (n0 - 3712);
    if (n0 < 4864) return 640 + (n0 - 4736);
    if (n0 < 4992) return 1664 + (n0 - 4864);
    return 1920 + (n0 - 4992);
}
struct TrDesc { const float* src; bf16* dst; int ldw, K, rs; const float* ksc; };
struct TrRegs { f32x4 v[16]; };
__device__ __forceinline__ void tr_load(TrRegs& r, const TrDesc& d) {
#pragma unroll
    for (int i = 0; i < 16; ++i) r.v[i] = *(const GAS f32x4*)(d.src + (size_t)(8 * (i >> 1) + (i & 1)) * d.ldw);
}
__device__ __forceinline__ void tr_store(const TrRegs& r, const TrDesc& d, LAS unsigned* scr, int lane) {
    const int kr = lane >> 4, nc = lane & 15;
#pragma unroll
    for (int i = 0; i < 8; ++i) { f32x4 a = r.v[2 * i], b = r.v[2 * i + 1]; LAS unsigned* w = scr + (4 * nc) * 36 + 4 * i + kr;
        if (d.ksc) { a = a * d.ksc[8 * i]; b = b * d.ksc[8 * i + 1]; }
        w[0] = pk2(a[0], b[0]); w[36] = pk2(a[1], b[1]); w[72] = pk2(a[2], b[2]); w[108] = pk2(a[3], b[3]); }
    LDS_WAIT(); asm volatile("" ::: "memory");
#pragma unroll
    for (int j = 0; j < 8; ++j) { const int ch = lane + 64 * j, n = ch >> 3, kc = ch & 7;
        const v4u o = *(const LAS v4u*)(scr + n * 36 + 4 * kc);
        *(GAS v4u*)(d.dst + (size_t)n * d.rs * d.K + 8 * kc) = o; }
    LDS_WAIT(); asm volatile("" ::: "memory");
}
__device__ __forceinline__ TrDesc tr_decode(Frame& F, int l, int it, int lane) {
    constexpr int I_A = 32 * (NIN / 64), I_B = 32 * 32, I_G = NEXP * 256, I_U = NEXP * 256, I_D = NEXP * 256, I_1 = 64, I_2 = 2;
    const float* W; bf16* WT; int ldw, K, rs = 1, src0, k0; size_t drow0; const float* ksc = nullptr;
    int r = it;
    if (r < I_A) { const int nblk = NIN / 64, kb = r / nblk, nb = r % nblk; W = inp(F, I_WIN) + (size_t)l * DM * D_IN; ldw = D_IN; K = DM; WT = (bf16*)(wsp(F) + WS_WIN); drow0 = (size_t)nb * 64; src0 = win_src(nb * 64); k0 = kb * 64; }
    else if ((r -= I_A) < I_B) { const int kb = r / 32, nb = r % 32; W = inp(F, I_WOUT) + (size_t)l * DM * DM; ldw = DM; K = DM; WT = (bf16*)(wsp(F) + WS_WOUT); drow0 = (size_t)nb * 64; src0 = nb * 64; k0 = kb * 64; ksc = inp(F, I_MIXG) + (size_t)l * DM; }
    else if ((r -= I_B) < I_G) { const int e = r / 256, q = r % 256, kb = q / 8, nb = q % 8; W = inp(F, I_WGATE) + ((size_t)l * NEXP + e) * DM * DEXP; ldw = DEXP; K = DM; WT = (bf16*)(wsp(F) + WS_WGU); drow0 = (size_t)e * 1024 + nb * 128; rs = 2; src0 = nb * 64; k0 = kb * 64; }
    else if ((r -= I_G) < I_U) { const int e = r / 256, q = r % 256, kb = q / 8, nb = q % 8; W = inp(F, I_WUP) + ((size_t)l * NEXP + e) * DM * DEXP; ldw = DEXP; K = DM; WT = (bf16*)(wsp(F) + WS_WGU); drow0 = (size_t)e * 1024 + nb * 128 + 1; rs = 2; src0 = nb * 64; k0 = kb * 64; }
    else if ((r -= I_U) < I_D) { const int e = r / 256, q = r % 256, kb = q / 32, nb = q % 32; W = inp(F, I_WDOWN) + ((size_t)l * NEXP + e) * DEXP * DM; ldw = DM; K = DEXP; WT = (bf16*)(wsp(F) + WS_WD); drow0 = (size_t)e * DM + nb * 64; src0 = nb * 64; k0 = kb * 64; }
    else if ((r -= I_D) < 2 * I_1) { const int kv = r / I_1, q = r % I_1, kb = q / 2, nb = q % 2; W = inp(F, kv ? I_W1V : I_W1K) + (size_t)l * 2048 * 128; ldw = 128; K = 2048; WT = (bf16*)(wsp(F) + WS_WCMP) + (size_t)kv * 128 * 2048; drow0 = (size_t)nb * 64; src0 = nb * 64; k0 = kb * 64; }
    else { r -= 2 * I_1; const int kv = r / I_2, kb = r % I_2; W = inp(F, kv ? I_W2V : I_W2K) + (size_t)l * 128 * 64; ldw = 64; K = 128; WT = (bf16*)(wsp(F) + WS_WCMP + 2 * 128 * 2048 * 2) + (size_t)kv * 64 * 128; drow0 = 0; src0 = 0; k0 = kb * 64; }
    TrDesc d; d.src = W + (size_t)(k0 + 2 * (lane >> 4)) * ldw + src0 + 4 * (lane & 15); d.dst = WT + drow0 * K + k0; d.ldw = ldw; d.K = K; d.rs = rs; d.ksc = ksc ? ksc + k0 + 2 * (lane >> 4) : nullptr;
    return d;
}
constexpr int CV_SMALL0 = 32 * (NIN / 64) + 32 * 32, CV_GU1 = CV_SMALL0 + 2 * NEXP * 256, CV_DN1 = CV_GU1 + NEXP * 256, CV_END = CV_DN1 + 2 * 64 + 2 * 2;
__device__ __forceinline__ void convert_range(Frame& F, int l, int lo, int hi, LAS unsigned* scr) {
    const int gw = F.vcu * NWAVES + F.wave, NGW = F.G * NWAVES;
    if (lo + gw < hi) {
        TrDesc dc = tr_decode(F, l, lo + gw, F.lane); TrRegs rc; tr_load(rc, dc);
        for (int it = lo + gw; it < hi; it += NGW) {
            const int itn = it + NGW < hi ? it + NGW : it;
            const TrDesc dn = tr_decode(F, l, itn, F.lane); TrRegs rn; tr_load(rn, dn);
            tr_store(rc, dc, scr, F.lane);
            rc = rn; dc = dn;
        }
    }
}
__device__ __forceinline__ void convert_small(Frame& F, int l) {
    LAS unsigned* scr = (LAS unsigned*)(F.lds + F.wave * 9216);
    const int gw = F.vcu * NWAVES + F.wave, NGW = F.G * NWAVES;
    convert_range(F, l, 0, CV_SMALL0, scr);
    convert_range(F, l, CV_DN1, CV_END, scr);
    { LAS float* scrf = (LAS float*)scr;
      for (int it = gw; it < 32; it += NGW) tr_item(inp(F, I_WIN) + (size_t)l * DM * D_IN, D_IN, DM, (bf16*)(wsp(F) + WS_WCMP + 1024 * 1024 + 64 * 1024), 0, 1, 2048, 24, it * 64, scrf, F.lane); }
    { bf16* Whi = (bf16*)(wsp(F) + WS_WCMP + 1536 * 1024); bf16* Wlo = Whi + 48 * 2048;
      const float* wrg = inp(F, I_WRG) + (size_t)l * DM * 4; const float* wre = inp(F, I_WRE) + (size_t)l * 4 * DM * 8;
      for (int i = gw * 64 + F.lane; i < 48 * 2048; i += NGW * 64) { const int row = i >> 11, k = i & 2047; float v = 0.f;
          if (row < 4) v = wrg[k * 4 + row]; else if (row < 36) { const int g = (row - 4) >> 3, e = (row - 4) & 7; v = wre[((size_t)g * DM + k) * 8 + e]; }
          const unsigned hi = f2bf(v); Whi[i] = (bf16)hi; Wlo[i] = (bf16)f2bf(v - bf2f((unsigned short)hi)); } }
}

struct Row { f32x4 v[8]; };
__device__ __forceinline__ void row_load(Row& r, const float* p, int lane) {
#pragma unroll
    for (int j = 0; j < 8; ++j) r.v[j] = *((const GAS f32x4*)p + lane + 64 * j);
}
__device__ __forceinline__ void row_load_bf16(Row& r, const bf16* p, int lane) {
#pragma unroll
    for (int j = 0; j < 8; ++j) { const v2u w = *((const GAS v2u*)p + lane + 64 * j); r.v[j] = (f32x4){bflo(w.x), bfhi(w.x), bflo(w.y), bfhi(w.y)}; }
}
struct RawRow { v2u w[8]; };
__device__ __forceinline__ void raw_load(RawRow& r, const bf16* p, int lane) {
#pragma unroll
    for (int j = 0; j < 8; ++j) r.w[j] = *((const GAS v2u*)p + lane + 64 * j);
}
__device__ __forceinline__ void raw_to_row(Row& r, const RawRow& x) {
#pragma unroll
    for (int j = 0; j < 8; ++j) r.v[j] = (f32x4){bflo(x.w[j].x), bfhi(x.w[j].x), bflo(x.w[j].y), bfhi(x.w[j].y)};
}
__device__ __forceinline__ void row_store(const Row& r, float* p, int lane) {
#pragma unroll
    for (int j = 0; j < 8; ++j) *((GAS f32x4*)p + lane + 64 * j) = r.v[j];
}
__device__ __forceinline__ void row_store_bf16(const Row& r, bf16* p, int lane) {
#pragma unroll
    for (int j = 0; j < 8; ++j) { v2u w; w.x = pk2(r.v[j].x, r.v[j].y); w.y = pk2(r.v[j].z, r.v[j].w); *((GAS v2u*)p + lane + 64 * j) = w; }
}
__device__ __forceinline__ void row_normalize(Row& r) {
    float s = 0.f;
#pragma unroll
    for (int j = 0; j < 8; ++j) s += (r.v[j].x + r.v[j].y) + (r.v[j].z + r.v[j].w);
    const float mean = wave_sum(s) * (1.0f / DM); float s2 = 0.f;
#pragma unroll
    for (int j = 0; j < 8; ++j) { r.v[j] = r.v[j] - mean; s2 += (r.v[j].x * r.v[j].x + r.v[j].y * r.v[j].y) + (r.v[j].z * r.v[j].z + r.v[j].w * r.v[j].w); }
    const float rstd = 1.0f / sqrtf(wave_sum(s2) * (1.0f / DM) + LN_EPS);
#pragma unroll
    for (int j = 0; j < 8; ++j) r.v[j] = r.v[j] * rstd;
}
__device__ __forceinline__ void row_affine(Row& r, const float* a, float add1, const float* b, int lane) {
#pragma unroll
    for (int j = 0; j < 8; ++j) { const f32x4 av = *((const GAS f32x4*)a + lane + 64 * j) + add1, bv = *((const GAS f32x4*)b + lane + 64 * j); r.v[j] = r.v[j] * av + bv; }
}
constexpr int VEC_OFF = 73728;
__device__ __forceinline__ void stage_vec(Frame& F, int slot, const float* src) {
    *((LAS f32x4*)(F.lds + VEC_OFF) + slot * (DM / 4) + F.tid) = *((const GAS f32x4*)src + F.tid);
}
__device__ __forceinline__ void row_affine_lds(Row& r, const Frame& F, int slot_a, float add1, int slot_b) {
    const LAS f32x4* a = (const LAS f32x4*)(F.lds + VEC_OFF) + slot_a * (DM / 4) + F.lane; const LAS f32x4* b = (const LAS f32x4*)(F.lds + VEC_OFF) + slot_b * (DM / 4) + F.lane;
#pragma unroll
    for (int j = 0; j < 8; ++j) r.v[j] = r.v[j] * (a[64 * j] + add1) + b[64 * j];
}
__device__ __forceinline__ const float* modp(Frame& F, int l, int b, int which) { return (const float*)(wsp(F) + WS_MOD) + ((size_t)l * NB + b) * (6 * DM) + which * DM; }

__device__ __forceinline__ void ln_in_phase(Frame& F) {
    const int gw = F.vcu * NWAVES + F.wave, NGW = F.G * NWAVES;
    bf16* hb = (bf16*)(wsp(F) + WS_HB);
    stage_vec(F, 0, modp(F, 0, 0, 1)); stage_vec(F, 1, modp(F, 0, 0, 0)); stage_vec(F, 2, modp(F, 0, 1, 1)); stage_vec(F, 3, modp(F, 0, 1, 0));
    __syncthreads();
    Row nx; row_load(nx, inp(F, I_X) + (size_t)gw * DM, F.lane);
    for (int m = gw; m < MTOK; m += NGW) { const int b = m / SEQ; Row r = nx; row_load(nx, inp(F, I_X) + (size_t)(m + NGW < MTOK ? m + NGW : m) * DM, F.lane); row_normalize(r);
        row_affine_lds(r, F, 2 * b, 1.0f, 2 * b + 1); row_store_bf16(r, hb + (size_t)m * DM, F.lane); }
}

__device__ __forceinline__ void merge_phase(Frame& F, int l) {
    const int gw = F.vcu * NWAVES + F.wave, NGW = F.G * NWAVES;
    const bf16* oc = (const bf16*)(wsp(F) + WS_OCAT); bf16* hb = (bf16*)(wsp(F) + WS_HB); const float* mg = inp(F, I_MIXG) + (size_t)l * DM;
    for (int m = gw; m < MTOK; m += NGW) { Row r; row_load_bf16(r, oc + (size_t)m * DM, F.lane);
        float sa = 0.f, sb = 0.f, sc = 0.f;
#pragma unroll
        for (int j = 0; j < 8; ++j) { const float q = (r.v[j].x * r.v[j].x + r.v[j].y * r.v[j].y) + (r.v[j].z * r.v[j].z + r.v[j].w * r.v[j].w); if (j < 2) sa += q; else if (j < 4) sb += q; else sc += q; }
        const float ra = 1.0f / sqrtf(wave_sum(sa) * (1.0f / 512.0f) + RMS_EPS), rb = 1.0f / sqrtf(wave_sum(sb) * (1.0f / 512.0f) + RMS_EPS), rc = 1.0f / sqrtf(wave_sum(sc) * (1.0f / 1024.0f) + RMS_EPS);
#pragma unroll
        for (int j = 0; j < 8; ++j) { const float s = j < 2 ? ra : (j < 4 ? rb : rc); const f32x4 g = *((const GAS f32x4*)mg + F.lane + 64 * j); r.v[j] = r.v[j] * s * g; }
        row_store_bf16(r, hb + (size_t)m * DM, F.lane); }
}

__device__ __forceinline__ void post_mixer_phase(Frame& F, int l) {
    const int gw = F.vcu * NWAVES + F.wave, NGW = F.G * NWAVES;
    bf16* xa = (bf16*)(wsp(F) + WS_XA); bf16* hb = (bf16*)(wsp(F) + WS_HB);
    const float* wrg = inp(F, I_WRG) + (size_t)l * DM * 4; const float* brg = inp(F, I_BRG) + l * 4;
    const float* wre = inp(F, I_WRE) + (size_t)l * 4 * DM * 8; const float* bre = inp(F, I_BRE) + l * 32;
    unsigned* cnt = (unsigned*)(ctlp(F) + CW_CNT + l * 32); int* list = (int*)(wsp(F) + WS_LIST); float* gatew = (float*)(wsp(F) + WS_SMALL + SM_GATEW);
    stage_vec(F, 0, inp(F, I_LN1G) + (size_t)l * DM); stage_vec(F, 1, inp(F, I_LN1B) + (size_t)l * DM);
    stage_vec(F, 2, modp(F, l, 0, 4)); stage_vec(F, 3, modp(F, l, 0, 3)); stage_vec(F, 4, modp(F, l, 1, 4)); stage_vec(F, 5, modp(F, l, 1, 3));
    __syncthreads();
    RawRow nx; raw_load(nx, xa + (size_t)gw * DM, F.lane);
    for (int m = gw; m < MTOK; m += NGW) { const int b = m / SEQ; Row r; raw_to_row(r, nx); raw_load(nx, xa + (size_t)(m + NGW < MTOK ? m + NGW : m) * DM, F.lane); row_normalize(r);
        row_affine_lds(r, F, 0, 0.0f, 1); row_store_bf16(r, xa + (size_t)m * DM, F.lane);
        row_normalize(r); row_affine_lds(r, F, 2 + 2 * b, 1.0f, 3 + 2 * b); row_store_bf16(r, hb + (size_t)m * DM, F.lane);
    }
}

__device__ __forceinline__ void router_phase(Frame& F, int l) {
    const int lane = F.lane, c = lane & 15, kq = lane >> 4, w4 = F.wave & 3, kh = F.wave >> 2;
    const bf16* hb = (const bf16*)(wsp(F) + WS_HB);
    const bf16* Whi = (const bf16*)(wsp(F) + WS_WCMP + 1536 * 1024); const bf16* Wlo = Whi + 48 * 2048;
    const float* brg = inp(F, I_BRG) + l * 4; const float* bre = inp(F, I_BRE) + l * 32;
    unsigned* cnt = (unsigned*)(ctlp(F) + CW_CNT + l * 32); int* list = (int*)(wsp(F) + WS_LIST); float* gatew = (float*)(wsp(F) + WS_SMALL + SM_GATEW);
    LAS float* sl = (LAS float*)(F.lds + w4 * 4096);
    LAS f32x4* part = (LAS f32x4*)(F.lds + 16384 + w4 * 3072);
    for (int u0 = F.vcu; u0 < MTOK / 16; u0 += 4 * F.G) {
        const int u = u0 + w4 * F.G; const bool live = u < MTOK / 16;
        f32x4 acc[3];
#pragma unroll
        for (int t = 0; t < 3; ++t) acc[t] = (f32x4){0.f, 0.f, 0.f, 0.f};
        if (live) {
            const bf16* hrow = hb + (size_t)(u * 16 + c) * DM + 8 * kq + kh * 1024;
            const bf16* wh = Whi + (size_t)c * 2048 + 8 * kq + kh * 1024; const bf16* wl = Wlo + (size_t)c * 2048 + 8 * kq + kh * 1024;
#pragma unroll 4
            for (int ks = 0; ks < 32; ++ks) { const bf16x8 hf = ldg8(hrow + ks * 32);
#pragma unroll
                for (int t = 0; t < 3; ++t) { acc[t] = mfma16(ldg8(wh + (size_t)t * 16 * 2048 + ks * 32), hf, acc[t]); acc[t] = mfma16(ldg8(wl + (size_t)t * 16 * 2048 + ks * 32), hf, acc[t]); } }
            if (kh == 1) {
#pragma unroll
                for (int t = 0; t < 3; ++t) part[t * 64 + lane] = acc[t]; }
        }
        __syncthreads();
        if (live && kh == 0) {
#pragma unroll
            for (int t = 0; t < 3; ++t) { acc[t] += part[t * 64 + lane];
#pragma unroll
                for (int r = 0; r < 4; ++r) sl[c * 49 + 16 * t + 4 * kq + r] = acc[t][r]; }
            LDS_WAIT();
            if (lane < 16) {
                const LAS float* lr = sl + lane * 49; const int m = u * 16 + lane;
                const float g0 = lr[0] + brg[0], g1 = lr[1] + brg[1], g2 = lr[2] + brg[2], g3 = lr[3] + brg[3];
                int gs = 0; float gm = g0; if (g1 > gm) { gm = g1; gs = 1; } if (g2 > gm) { gm = g2; gs = 2; } if (g3 > gm) { gm = g3; gs = 3; }
                const float pgroup = 1.0f / (__expf(g0 - gm) + __expf(g1 - gm) + __expf(g2 - gm) + __expf(g3 - gm));
                int t1 = 0; float m1 = lr[4 + gs * 8] + bre[gs * 8];
#pragma unroll
                for (int i = 1; i < 8; ++i) { const float v = lr[4 + gs * 8 + i] + bre[gs * 8 + i]; if (v > m1) { m1 = v; t1 = i; } }
                int t2 = -1; float m2 = -3.0e38f;
#pragma unroll
                for (int i = 0; i < 8; ++i) { const float v = lr[4 + gs * 8 + i] + bre[gs * 8 + i]; if (i != t1 && v > m2) { m2 = v; t2 = i; } }
                const float e2 = __expf(m2 - m1), inv = pgroup / (1.0f + e2);
                const int x1 = gs * 8 + t1, x2 = gs * 8 + t2;
                const unsigned p1 = __hip_atomic_fetch_add(cnt + x1, 1u, RLX_AGENT); list[(size_t)x1 * MTOK + p1] = m * 2; gatew[m * 2] = inv;
                const unsigned p2 = __hip_atomic_fetch_add(cnt + x2, 1u, RLX_AGENT); list[(size_t)x2 * MTOK + p2] = m * 2 + 1; gatew[m * 2 + 1] = inv * e2;
            }
        }
        __syncthreads();
    }
}

__device__ __forceinline__ void gather_phase(Frame& F, int l) {
    LAS int* tb = (LAS int*)(F.lds + 0);
    const unsigned* cnt = (const unsigned*)(ctlp(F) + CW_CNT + l * 32);
    if (F.tid < 32) tb[F.tid] = (int)__hip_atomic_load(cnt + F.tid, RLX_AGENT);
    __syncthreads();
    if (F.tid == 0) { int row = 0, tile = 0;
        for (int e = 0; e < NEXP; ++e) { tb[32 + e] = row; const int nt = (tb[e] + 255) >> 8; for (int t = 0; t < nt; ++t) tb[64 + tile + t] = e; tile += nt; row += nt * 256; }
        tb[224] = tile; }
    __syncthreads();
    const int ntiles = tb[224];
    int* gt = (int*)(wsp(F) + WS_SMALL + SM_TILE);
    if (blockIdx.x == 0) { if (F.tid < 160) gt[F.tid] = (F.tid < ntiles) ? tb[64 + F.tid] : 0; if (F.tid == 0) gt[200] = ntiles; }
    const int gw = F.vcu * NWAVES + F.wave, NGW = F.G * NWAVES;
    const int* list = (const int*)(wsp(F) + WS_LIST); int* rowinfo = (int*)(wsp(F) + WS_SMALL + SM_ROWINFO);
    const bf16* hb = (const bf16*)(wsp(F) + WS_HB); bf16* xs = (bf16*)(wsp(F) + WS_XS);
    for (int R = gw; R < ntiles * 256; R += NGW) { const int e = tb[64 + (R >> 8)], pos = R - tb[32 + e];
        int aid = -1; if (pos < tb[e]) aid = list[(size_t)e * MTOK + pos];
        GAS v4u* dst = (GAS v4u*)(xs + (size_t)R * DM) + F.lane;
        if (aid >= 0) { const GAS v4u* src = (const GAS v4u*)(hb + (size_t)(aid >> 1) * DM) + F.lane;
#pragma unroll
            for (int j = 0; j < 4; ++j) dst[64 * j] = src[64 * j]; }
        else {
#pragma unroll
            for (int j = 0; j < 4; ++j) dst[64 * j] = (v4u){0u, 0u, 0u, 0u}; }
        if (F.lane == 0) rowinfo[R] = aid; }
    __syncthreads();
}

__device__ __forceinline__ void moe_tables(Frame& F, int l) {
    LAS int* tb = (LAS int*)(F.lds + TAB_OFF);
    const unsigned* cnt = (const unsigned*)(ctlp(F) + CW_CNT + l * 32);
    __syncthreads();
    if (F.tid < 32) tb[F.tid] = (int)__hip_atomic_load(cnt + F.tid, RLX_AGENT);
    __syncthreads();
    if (F.tid == 0) { int row = 0, tile = 0;
        for (int e = 0; e < NEXP; ++e) { tb[32 + e] = row; const int nt = (tb[e] + 255) >> 8; for (int t = 0; t < nt; ++t) tb[64 + tile + t] = e; tile += nt; row += nt * 256; }
        tb[224] = tile; }
    __syncthreads();
}

__device__ __forceinline__ void post_moe_phase(Frame& F, int l, float* dst_f32, bf16* dst_bf16, bool next_h) {
    const int gw = F.vcu * NWAVES + F.wave, NGW = F.G * NWAVES;
    const bf16* xa = (const bf16*)(wsp(F) + WS_XA); const bf16* ys = (const bf16*)(wsp(F) + WS_YS); bf16* hb = (bf16*)(wsp(F) + WS_HB);
    stage_vec(F, 0, inp(F, I_LN2G) + (size_t)l * DM); stage_vec(F, 1, inp(F, I_LN2B) + (size_t)l * DM); stage_vec(F, 2, modp(F, l, 0, 5)); stage_vec(F, 3, modp(F, l, 1, 5));
    if (next_h) { stage_vec(F, 4, modp(F, l + 1, 0, 1)); stage_vec(F, 5, modp(F, l + 1, 0, 0)); stage_vec(F, 6, modp(F, l + 1, 1, 1)); stage_vec(F, 7, modp(F, l + 1, 1, 0)); }
    __syncthreads();
    RawRow nx, ny0, ny1; raw_load(nx, xa + (size_t)gw * DM, F.lane); raw_load(ny0, ys + (size_t)(2 * gw) * DM, F.lane); raw_load(ny1, ys + (size_t)(2 * gw + 1) * DM, F.lane);
    for (int m = gw; m < MTOK; m += NGW) { const int b = m / SEQ; Row r; raw_to_row(r, nx); const RawRow cy0 = ny0, cy1 = ny1;
        { const int mn = m + NGW < MTOK ? m + NGW : m; raw_load(nx, xa + (size_t)mn * DM, F.lane); raw_load(ny0, ys + (size_t)(2 * mn) * DM, F.lane); raw_load(ny1, ys + (size_t)(2 * mn + 1) * DM, F.lane); }
        const LAS f32x4* g2 = (const LAS f32x4*)(F.lds + VEC_OFF) + (2 + b) * (DM / 4) + F.lane;
#pragma unroll
        for (int j = 0; j < 8; ++j) { const v2u y0 = cy0.w[j], y1 = cy1.w[j];
            const f32x4 y = (f32x4){bflo(y0.x) + bflo(y1.x), bfhi(y0.x) + bfhi(y1.x), bflo(y0.y) + bflo(y1.y), bfhi(y0.y) + bfhi(y1.y)};
            const f32x4 gv = g2[64 * j] + 1.0f; r.v[j] = r.v[j] * ALPHA + gv * y; }
        row_normalize(r); row_affine_lds(r, F, 0, 0.0f, 1); if (dst_f32) row_store(r, dst_f32 + (size_t)m * DM, F.lane); else row_store_bf16(r, dst_bf16 + (size_t)m * DM, F.lane);
        if (next_h) { row_normalize(r); row_affine_lds(r, F, 4 + 2 * b, 1.0f, 5 + 2 * b); row_store_bf16(r, hb + (size_t)m * DM, F.lane); } }
}
constexpr int IMP_STRIDE = 130;
constexpr int AW_IMP = 0, AW_SCV = 16 * IMP_STRIDE * 4, AW_SEL = AW_SCV + 512, AW_Q = 9216, AW_BYTES = AW_Q + 8192;
static_assert(AW_SEL + 256 <= AW_Q && NWAVES * AW_BYTES <= LDSCTL_OFF, "per-wave LDS slabs");

struct Flash { f32x4 O[4][4]; f32x4 m, l; };
struct KF { bf16x8 K[2][2]; };
struct VF { bf16x8 V[4]; };

__device__ __forceinline__ void load_k(KF& x, const bf16* Kb, size_t ldk, int kbase) {
    const bf16* kp = Kb + (size_t)kbase * ldk;
    x.K[0][0] = ldg8(kp); x.K[0][1] = ldg8(kp + 32); x.K[1][0] = ldg8(kp + 4 * ldk); x.K[1][1] = ldg8(kp + 4 * ldk + 32);
}
__device__ __forceinline__ void load_v(VF& x, const bf16* Vb, size_t ldv, int kbase) {
    const bf16* vp = Vb + kbase;
#pragma unroll
    for (int db = 0; db < 4; ++db) x.V[db] = ldg8(vp + (size_t)(16 * db) * ldv);
}
__device__ __forceinline__ void q_park(LAS bf16x8* Ql, const bf16* q0p, const bf16* q1p, const bf16* q2p, const bf16* q3p, int lane) {
    Ql[0 * 64 + lane] = ldg8(q0p); Ql[1 * 64 + lane] = ldg8(q0p + 32); Ql[2 * 64 + lane] = ldg8(q1p); Ql[3 * 64 + lane] = ldg8(q1p + 32);
    Ql[4 * 64 + lane] = ldg8(q2p); Ql[5 * 64 + lane] = ldg8(q2p + 32); Ql[6 * 64 + lane] = ldg8(q3p); Ql[7 * 64 + lane] = ldg8(q3p + 32);
}
__device__ __forceinline__ void qk_scores(f32x4 (&Sv)[2][4], const KF& x, const LAS bf16x8* Ql, int lane) {
#pragma unroll
    for (int qb = 0; qb < 4; ++qb) { const bf16x8 q0 = Ql[(2 * qb) * 64 + lane], q1 = Ql[(2 * qb + 1) * 64 + lane];
#pragma unroll
        for (int h = 0; h < 2; ++h) { f32x4 a = mfma16(x.K[h][0], q0, (f32x4){0.f, 0.f, 0.f, 0.f}); Sv[h][qb] = mfma16(x.K[h][1], q1, a); } }
}
__device__ __forceinline__ void flash_init(Flash& S, float m0, float m1, float m2, float m3) {
#pragma unroll
    for (int db = 0; db < 4; ++db)
#pragma unroll
        for (int qb = 0; qb < 4; ++qb) S.O[db][qb] = (f32x4){0.f, 0.f, 0.f, 0.f};
    S.m = (f32x4){m0, m1, m2, m3}; S.l = (f32x4){0.f, 0.f, 0.f, 0.f};
}
__device__ __forceinline__ void flash_step(Flash& S, f32x4 (&Sv)[2][4], const VF& x, const f32x4 b0, const f32x4 bj, unsigned vm) {
    float sv[4][8]; float mxv[4]; bool grow = false;
#pragma unroll
    for (int qb = 0; qb < 4; ++qb) {
#pragma unroll
        for (int h = 0; h < 2; ++h)
#pragma unroll
            for (int r = 0; r < 4; ++r) { const int j = 4 * h + r; const float s2 = Sv[h][qb][r] * SC2 + (b0[qb] + bj[qb] * (float)j); sv[qb][j] = ((vm >> j) & 1u) ? s2 : -INFINITY; }
        float mx = fmaxf(fmaxf(fmaxf(sv[qb][0], sv[qb][1]), fmaxf(sv[qb][2], sv[qb][3])), fmaxf(fmaxf(sv[qb][4], sv[qb][5]), fmaxf(sv[qb][6], sv[qb][7])));
        mx = fmaxf(mx, __shfl_xor(mx, 16)); mx = fmaxf(mx, __shfl_xor(mx, 32));
        mxv[qb] = mx; grow = grow | (mx > S.m[qb] + 8.0f);
    }
    if (__any(grow)) {
#pragma unroll
        for (int qb = 0; qb < 4; ++qb) { const float mn = fmaxf(S.m[qb], mxv[qb]), al = ex2(S.m[qb] - mn); S.m[qb] = mn; S.l[qb] = S.l[qb] * al;
#pragma unroll
            for (int db = 0; db < 4; ++db) S.O[db][qb] = S.O[db][qb] * al; }
    }
    bf16x8 Pf[4];
#pragma unroll
    for (int qb = 0; qb < 4; ++qb) {
        float p[8];
#pragma unroll
        for (int j = 0; j < 8; ++j) p[j] = ex2(sv[qb][j] - S.m[qb]);
        S.l[qb] = S.l[qb] + (((p[0] + p[1]) + (p[2] + p[3])) + ((p[4] + p[5]) + (p[6] + p[7])));
        Pf[qb] = pack8(p[0], p[1], p[2], p[3], p[4], p[5], p[6], p[7]);
    }
#pragma unroll
    for (int db = 0; db < 4; ++db)
#pragma unroll
        for (int qb = 0; qb < 4; ++qb) S.O[db][qb] = mfma16(x.V[db], Pf[qb], S.O[db][qb]);
}
__device__ __forceinline__ float flash_inv(const Flash& S, int qb, bool has_sink, float sink2) {
    float lt = S.l[qb]; lt += __shfl_xor(lt, 16); lt += __shfl_xor(lt, 32);
    if (has_sink) lt += ex2(sink2 - S.m[qb]);
    return lt > 0.f ? 1.0f / lt : 0.f;
}
__device__ __forceinline__ float sigmoidf_(float x) { return 1.0f / (1.0f + __expf(-x)); }
__device__ __forceinline__ float slope2_of(int hidx) { return LOG2E * exp2f(-0.5f * (float)(hidx + 1)); }
#define ITER_FENCE() asm volatile("" ::: "memory")

template <int W, int MODE>
__device__ __forceinline__ void win_unit(Frame& F, int l, int b, int g, int q0) {
    const int lane = F.lane, c = lane & 15, kq = lane >> 4;
    const bf16* proj = (const bf16*)(wsp(F) + WS_PROJ); const bf16* vT = (const bf16*)(wsp(F) + WS_VT); bf16* ocat = (bf16*)(wsp(F) + WS_OCAT);
    constexpr int QOFF = MODE == 0 ? P_QA : P_QB, KOFF = MODE == 0 ? P_KA : P_KBW, VROW = MODE == 0 ? V_A : V_BW, OCOL = MODE == 0 ? 0 : 512, HBASE = MODE == 0 ? 0 : 8;
    LAS bf16x8* Ql = (LAS bf16x8*)(F.lds + F.wave * AW_BYTES + AW_Q);
    const size_t tb = (size_t)b * SEQ; const int t = q0 + c;
    { const bf16* qp = proj + (tb + t) * NPROJ + QOFF + g * 256 + kq * 8; q_park(Ql, qp, qp + 64, qp + 128, qp + 192, lane); }
    f32x4 sl2, sk2;
#pragma unroll
    for (int qb = 0; qb < 4; ++qb) { sl2[qb] = slope2_of(HBASE + g * 4 + qb); sk2[qb] = MODE == 0 ? inp(F, I_SINKS)[l * 8 + g * 4 + qb] * LOG2E : -1.0e30f; }
    Flash S; flash_init(S, sk2[0], sk2[1], sk2[2], sk2[3]);
    int klo = q0 - (W - 1); if (klo < 0) klo = 0; klo &= ~31;
    const int khi = (q0 + 15) & ~31;
    const bf16* Kb = proj + (tb + 8 * (c >> 2) + (c & 3)) * NPROJ + KOFF + g * 64 + kq * 8;
    const bf16* Vb = vT + (size_t)(VROW + g * 64 + c) * MTOK + tb + 8 * kq;
    KF cur, nxt; load_k(cur, Kb, NPROJ, khi);
    for (int kbase = khi; kbase >= klo; kbase -= 32) {
        ITER_FENCE();
        VF vf; load_v(vf, Vb, MTOK, kbase);
        load_k(nxt, Kb, NPROJ, kbase - 32 >= klo ? kbase - 32 : kbase);
        f32x4 Sv[2][4]; qk_scores(Sv, cur, Ql, lane);
        const int d0 = t - kbase - 8 * kq;
        const f32x4 b0 = sl2 * -(float)d0;
        unsigned vm = 0xffu;
        if (!(kbase + 31 <= q0 && kbase >= q0 + 16 - W)) { vm = 0u;
#pragma unroll
            for (int j = 0; j < 8; ++j) { const int dist = d0 - j; vm |= (dist >= 0 && dist < W) ? (1u << j) : 0u; } }
        flash_step(S, Sv, vf, b0, sl2, vm);
        cur = nxt;
    }
#pragma unroll
    for (int qb = 0; qb < 4; ++qb) { const float sc = flash_inv(S, qb, MODE == 0, sk2[qb]);
        bf16* op = ocat + (tb + t) * DM + OCOL + (g * 4 + qb) * 64 + 4 * kq; float q2 = 0.f;
#pragma unroll
        for (int db = 0; db < 4; ++db) { const f32x4 o = S.O[db][qb] * sc; v2u w; w.x = pk2(o[0], o[1]); w.y = pk2(o[2], o[3]); *(GAS v2u*)(op + 16 * db) = w;
            q2 += (bflo(w.x) * bflo(w.x) + bfhi(w.x) * bfhi(w.x)) + (bflo(w.y) * bflo(w.y) + bfhi(w.y) * bfhi(w.y)); }
        if (MODE == 0) { q2 += __shfl_xor(q2, 16); q2 += __shfl_xor(q2, 32); if (kq == 0) ((float*)(wsp(F) + WS_SSQ))[(tb + t) * 32 + g * 4 + qb] = q2; } }
}

constexpr float SB_EXIT_P = 1.0e-37f;
__device__ __forceinline__ void sb_unit(Frame& F, int b, int hc, int q0) {
    const int lane = F.lane, c = lane & 15, kq = lane >> 4;
    const bf16* proj = (const bf16*)(wsp(F) + WS_PROJ); const bf16* vT = (const bf16*)(wsp(F) + WS_VT); bf16* ocat = (bf16*)(wsp(F) + WS_OCAT);
    LAS bf16x8* Ql = (LAS bf16x8*)(F.lds + F.wave * AW_BYTES + AW_Q);
    const size_t tb = (size_t)b * SEQ;
    { const bf16* qp = proj + (tb + q0 + c) * NPROJ + P_QC + hc * 64 + kq * 8; q_park(Ql, qp, qp + (size_t)16 * NPROJ, qp + (size_t)32 * NPROJ, qp + (size_t)48 * NPROJ, lane); }
    f32x4 O[4][4]; float carry[4];
#pragma unroll
    for (int qb = 0; qb < 4; ++qb) { carry[qb] = 1.0f;
#pragma unroll
        for (int db = 0; db < 4; ++db) O[db][qb] = (f32x4){0.f, 0.f, 0.f, 0.f}; }
    const bf16* Kb = proj + (tb + 8 * (c >> 2) + (c & 3)) * NPROJ + P_KC + hc * 64 + kq * 8;
    const bf16* Vb = vT + (size_t)(V_C + hc * 64 + c) * MTOK + tb + 8 * kq;
    KF cur, nxt; load_k(cur, Kb, NPROJ, q0 + 32);
    for (int kbase = q0 + 32; kbase >= 0; kbase -= 32) {
        ITER_FENCE();
        VF vf; load_v(vf, Vb, MTOK, kbase);
        load_k(nxt, Kb, NPROJ, kbase >= 32 ? kbase - 32 : kbase);
        f32x4 Sv[2][4]; qk_scores(Sv, cur, Ql, lane);
        const bool diag = kbase + 31 >= q0;
        bf16x8 Pf[4];
#pragma unroll
        for (int qb = 0; qb < 4; ++qb) { const int lim = q0 + 16 * qb + c - kbase - 8 * kq;
            float om[8], sg[8];
#pragma unroll
            for (int h = 0; h < 2; ++h)
#pragma unroll
                for (int r = 0; r < 4; ++r) { const int j = 4 * h + r; const float e = ex2(fminf(Sv[h][qb][r] * SC2, 115.0f)), rr = __builtin_amdgcn_rcpf(1.0f + e);
                    om[j] = rr; sg[j] = e * rr;
                    if (diag) { const bool msk = j >= lim; om[j] = msk ? 1.0f : om[j]; sg[j] = msk ? 0.f : sg[j]; } }
            float ex_[8]; float run = 1.0f;
#pragma unroll
            for (int j = 7; j >= 0; --j) { ex_[j] = run; run *= om[j]; }
            const float t1 = __shfl_xor(run, 16), t2 = __shfl_xor(run, 32), t3 = __shfl_xor(run, 48);
            const float X = ((kq ^ 1) > kq ? t1 : 1.0f) * ((kq ^ 2) > kq ? t2 : 1.0f) * ((kq ^ 3) > kq ? t3 : 1.0f);
            const float base = carry[qb] * X;
            carry[qb] *= (run * t1) * (t2 * t3);
            Pf[qb] = pack8(sg[0] * (base * ex_[0]), sg[1] * (base * ex_[1]), sg[2] * (base * ex_[2]), sg[3] * (base * ex_[3]), sg[4] * (base * ex_[4]), sg[5] * (base * ex_[5]), sg[6] * (base * ex_[6]), sg[7] * (base * ex_[7])); }
#pragma unroll
        for (int db = 0; db < 4; ++db)
#pragma unroll
            for (int qb = 0; qb < 4; ++qb) O[db][qb] = mfma16(vf.V[db], Pf[qb], O[db][qb]);
        const bool fin = (carry[0] < SB_EXIT_P) && (carry[1] < SB_EXIT_P) && (carry[2] < SB_EXIT_P) && (carry[3] < SB_EXIT_P);
        if (__all(fin)) break;
        cur = nxt;
    }
#pragma unroll
    for (int qb = 0; qb < 4; ++qb) { bf16* op = ocat + (tb + q0 + 16 * qb + c) * DM + 1024 + hc * 64 + 4 * kq;
        float q2 = 0.f;
#pragma unroll
        for (int db = 0; db < 4; ++db) { const f32x4 o = O[db][qb]; v2u w; w.x = pk2(o[0], o[1]); w.y = pk2(o[2], o[3]); *(GAS v2u*)(op + 16 * db) = w;
            q2 += (bflo(w.x) * bflo(w.x) + bfhi(w.x) * bfhi(w.x)) + (bflo(w.y) * bflo(w.y) + bfhi(w.y) * bfhi(w.y)); }
        q2 += __shfl_xor(q2, 16); q2 += __shfl_xor(q2, 32); if (kq == 0) ((float*)(wsp(F) + WS_SSQ))[(tb + q0 + 16 * qb + c) * 32 + 16 + hc] = q2; }
}

__device__ __forceinline__ void gate_unit(Frame& F, int u) {
    const int lane = F.lane, c = lane & 15, kq = lane >> 4;
    const bf16* hrow = (const bf16*)(wsp(F) + WS_HB) + (size_t)(u * 16 + c) * DM + 8 * kq;
    const bf16* wg = (const bf16*)(wsp(F) + WS_WCMP + 1024 * 1024 + 64 * 1024) + (size_t)c * 2048 + 8 * kq;
    f32x4 a0 = (f32x4){0.f, 0.f, 0.f, 0.f}, a1 = (f32x4){0.f, 0.f, 0.f, 0.f};
#pragma unroll 8
    for (int ks = 0; ks < 64; ++ks) { const bf16x8 hf = ldg8(hrow + ks * 32); a0 = mfma16(ldg8(wg + ks * 32), hf, a0); a1 = mfma16(ldg8(wg + (size_t)16 * 2048 + ks * 32), hf, a1); }
    float* gp = (float*)(wsp(F) + WS_GBUF) + (size_t)(u * 16 + c) * 32 + 4 * kq;
    *(GAS f32x4*)gp = a0; *(GAS f32x4*)(gp + 16) = a1;
}

__device__ __forceinline__ float gelu_tanh(float x) { const float u = 0.7978845608028654f * (x + 0.044715f * x * x * x); const float e = __expf(2.0f * u); return 0.5f * x * (2.0f - 2.0f / (e + 1.0f)); }
__device__ __forceinline__ void cmp_mlp_unit(Frame& F, int l, int unit) {
    const int lane = F.lane, c = lane & 15, kq = lane >> 4;
    const int nt = unit & 31, g = (unit >> 5) & 1, b = (unit >> 6) & 1, kv = unit >> 7;
    const bf16* proj = (const bf16*)(wsp(F) + WS_PROJ);
    const bf16* W1t = (const bf16*)(wsp(F) + WS_WCMP) + (size_t)kv * 128 * 2048; const bf16* W2t = (const bf16*)(wsp(F) + WS_WCMP + 2 * 128 * 2048 * 2) + (size_t)kv * 64 * 128;
    const float* pe = inp(F, kv ? I_PEV : I_PEK) + (size_t)l * 32 * 64;
    const int n = nt * 16 + c; const size_t tb = (size_t)b * SEQ; const int xoff = (kv ? P_VBC : P_KBC) + g * 64;
    LAS f32x4* red = (LAS f32x4*)(F.lds);
    f32x4 H[4][2];
#pragma unroll
    for (int s = 0; s < 4; ++s) { H[s][0] = (f32x4){0.f, 0.f, 0.f, 0.f}; H[s][1] = (f32x4){0.f, 0.f, 0.f, 0.f}; }
#pragma unroll 2
    for (int kk = 0; kk < 8; ++kk) {
        const int ks = F.wave * 8 + kk, lt = ks >> 1, d0 = (ks & 1) * 32 + 8 * kq; int tok = 16 * n + lt; if (tok > SEQ - 1) tok = SEQ - 1;
        const bf16x8 xr = ldg8(proj + (tb + tok) * NPROJ + xoff + d0);
        const f32x4 p0 = *(const GAS f32x4*)(pe + lt * 64 + d0), p1 = *(const GAS f32x4*)(pe + lt * 64 + d0 + 4);
        const bf16x8 Xf = pack8(bf2f((unsigned short)xr[0]) + p0[0], bf2f((unsigned short)xr[1]) + p0[1], bf2f((unsigned short)xr[2]) + p0[2], bf2f((unsigned short)xr[3]) + p0[3],
                                bf2f((unsigned short)xr[4]) + p1[0], bf2f((unsigned short)xr[5]) + p1[1], bf2f((unsigned short)xr[6]) + p1[2], bf2f((unsigned short)xr[7]) + p1[3]);
#pragma unroll
        for (int s = 0; s < 4; ++s)
#pragma unroll
            for (int h = 0; h < 2; ++h) { const int hid = 32 * s + 8 * (c >> 2) + 4 * h + (c & 3);
                H[s][h] = mfma16(ldg8(W1t + (size_t)hid * 2048 + ks * 32 + 8 * kq), Xf, H[s][h]); }
    }
#pragma unroll
    for (int s = 0; s < 4; ++s)
#pragma unroll
        for (int h = 0; h < 2; ++h) red[(F.wave * 8 + s * 2 + h) * 64 + lane] = H[s][h];
    __syncthreads();
    if (F.wave == 0) {
#pragma unroll
        for (int s = 0; s < 4; ++s)
#pragma unroll
            for (int h = 0; h < 2; ++h) { f32x4 a = red[(s * 2 + h) * 64 + lane];
#pragma unroll
                for (int w = 1; w < 8; ++w) a += red[(w * 8 + s * 2 + h) * 64 + lane];
                H[s][h] = a; }
        f32x4 Y[4];
#pragma unroll
        for (int eb = 0; eb < 4; ++eb) Y[eb] = (f32x4){0.f, 0.f, 0.f, 0.f};
#pragma unroll
        for (int s = 0; s < 4; ++s) {
            const bf16x8 Hf = pack8(gelu_tanh(H[s][0][0]), gelu_tanh(H[s][0][1]), gelu_tanh(H[s][0][2]), gelu_tanh(H[s][0][3]), gelu_tanh(H[s][1][0]), gelu_tanh(H[s][1][1]), gelu_tanh(H[s][1][2]), gelu_tanh(H[s][1][3]));
#pragma unroll
            for (int eb = 0; eb < 4; ++eb) Y[eb] = mfma16(ldg8(W2t + (size_t)(16 * eb + c) * 128 + 32 * s + 8 * kq), Hf, Y[eb]);
        }
        const bool valid = n <= 510;
        if (kv == 0) { bf16* kc = (bf16*)(wsp(F) + WS_SMALL + SM_KCMP) + ((size_t)(b * 2 + g) * 512 + n) * 64 + 4 * kq;
#pragma unroll
            for (int eb = 0; eb < 4; ++eb) { v2u w; w.x = valid ? pk2(Y[eb][0], Y[eb][1]) : 0u; w.y = valid ? pk2(Y[eb][2], Y[eb][3]) : 0u; *(GAS v2u*)(kc + 16 * eb) = w; } }
        else { bf16* vc = (bf16*)(wsp(F) + WS_SMALL + SM_VCMPT) + (size_t)(b * 2 + g) * 64 * 512 + n;
#pragma unroll
            for (int eb = 0; eb < 4; ++eb)
#pragma unroll
                for (int r = 0; r < 4; ++r) vc[(size_t)(16 * eb + 4 * kq + r) * 512] = valid ? (bf16)f2bf(Y[eb][r]) : (bf16)0; }
    }
    __syncthreads();
}

__device__ __forceinline__ int next_below(unsigned long long ulo, unsigned long long uhi, int j) {
    if (j > 64) { const unsigned long long m = (j >= 128) ? uhi : (uhi & ((1ull << (j - 64)) - 1ull)); if (m) return 127 - __builtin_clzll(m); j = 64; }
    const unsigned long long m = (j >= 64) ? ulo : (ulo & ((1ull << j) - 1ull));
    return m ? 63 - __builtin_clzll(m) : -1;
}
__device__ __forceinline__ void nsa_unit(Frame& F, int b, int g, int q0) {
    const int lane = F.lane, c = lane & 15, kq = lane >> 4;
    const bf16* proj = (const bf16*)(wsp(F) + WS_PROJ); const bf16* vT = (const bf16*)(wsp(F) + WS_VT); bf16* ocat = (bf16*)(wsp(F) + WS_OCAT);
    const bf16* kcmp = (const bf16*)(wsp(F) + WS_SMALL + SM_KCMP) + (size_t)(b * 2 + g) * 512 * 64;
    const bf16* vcmpT = (const bf16*)(wsp(F) + WS_SMALL + SM_VCMPT) + (size_t)(b * 2 + g) * 64 * 512;
    LAS float* imp = (LAS float*)(F.lds + F.wave * AW_BYTES + AW_IMP);
    LAS unsigned* selm = (LAS unsigned*)(F.lds + F.wave * AW_BYTES + AW_SEL);
    LAS bf16x8* Ql = (LAS bf16x8*)(F.lds + F.wave * AW_BYTES + AW_Q);
    const size_t tb = (size_t)b * SEQ; const int t = q0 + c;
    const float* grow = (const float*)(wsp(F) + WS_GBUF) + (tb + t) * 32 + g * 12;
    { const bf16* qp = proj + (tb + t) * NPROJ + P_QB + g * 256 + kq * 8; q_park(Ql, qp, qp + 64, qp + 128, qp + 192, lane); }
    f32x4 sl2;
#pragma unroll
    for (int qb = 0; qb < 4; ++qb) sl2[qb] = slope2_of(8 + g * 4 + qb);
    const f32x4 sl2c = sl2 * 16.0f;
    for (int i = lane; i < 16 * IMP_STRIDE; i += 64) imp[i] = 0.f;
    const int tmax = q0 + 15; const int nmax = tmax >= 31 ? ((tmax - 31) >> 4) : -1; const int ntop = nmax & ~31;
    const bf16* Kc = kcmp + (size_t)(8 * (c >> 2) + (c & 3)) * 64 + kq * 8;
    const bf16* Vc = vcmpT + (size_t)c * 512 + 8 * kq;
    Flash S; flash_init(S, -1.0e30f, -1.0e30f, -1.0e30f, -1.0e30f);
    KF cur, nxt;
    if (nmax >= 0) {
        load_k(cur, Kc, 64, ntop);
        for (int nbase = ntop; nbase >= 0; nbase -= 32) {
            ITER_FENCE();
            VF vf; load_v(vf, Vc, 512, nbase);
            load_k(nxt, Kc, 64, nbase >= 32 ? nbase - 32 : nbase);
            f32x4 Sv[2][4]; qk_scores(Sv, cur, Ql, lane);
            const int d0 = t - 31 - 16 * (nbase + 8 * kq);
            const f32x4 b0 = sl2 * -(float)d0;
            unsigned vm = 0xffu;
            if (!(16 * (nbase + 31) + 31 <= q0)) { vm = 0u;
#pragma unroll
                for (int j = 0; j < 8; ++j) vm |= (d0 - 16 * j >= 0) ? (1u << j) : 0u; }
            flash_step(S, Sv, vf, b0, sl2c, vm);
            cur = nxt;
        }
    }
    f32x4 inv;
#pragma unroll
    for (int qb = 0; qb < 4; ++qb) { inv[qb] = flash_inv(S, qb, false, 0.f);
        const float g0 = sigmoidf_(grow[qb * 3 + 0]), g2 = sigmoidf_(grow[qb * 3 + 2]), sc = inv[qb] * g0;
        bf16* op = ocat + (tb + t) * DM + 512 + (g * 4 + qb) * 64 + 4 * kq;
#pragma unroll
        for (int db = 0; db < 4; ++db) { const v2u ow = *(const GAS v2u*)(op + 16 * db); const f32x4 old = (f32x4){bflo(ow.x), bfhi(ow.x), bflo(ow.y), bfhi(ow.y)};
            const f32x4 o = old * g2 + S.O[db][qb] * sc; v2u w; w.x = pk2(o[0], o[1]); w.y = pk2(o[2], o[3]); *(GAS v2u*)(op + 16 * db) = w; } }
    LDS_WAIT();
    for (int nbase = 0; nbase <= nmax; nbase += 32) {
        ITER_FENCE();
        const bf16* kp = Kc + (size_t)nbase * 64;
        KF x; x.K[0][0] = ldg8(kp); x.K[0][1] = ldg8(kp + 32); x.K[1][0] = ldg8(kp + 4 * 64); x.K[1][1] = ldg8(kp + 4 * 64 + 32);
        f32x4 Sv[2][4]; qk_scores(Sv, x, Ql, lane);
        float G[2], Wl[2];
#pragma unroll
        for (int h = 0; h < 2; ++h) { float gs = 0.f, last = 0.f;
#pragma unroll
            for (int r = 0; r < 4; ++r) { const int dist = t - 16 * (nbase + 8 * kq + 4 * h + r) - 31; const bool vis = dist >= 0; const float fd = (float)dist; float pv = 0.f;
#pragma unroll
                for (int qb = 0; qb < 4; ++qb) pv += vis ? ex2(Sv[h][qb][r] * SC2 - sl2[qb] * fd - S.m[qb]) * inv[qb] : 0.f;
                gs += pv; last = pv; }
            G[h] = gs; Wl[h] = last; }
        const int j0 = (nbase >> 2) + 2 * kq;
        LAS float* ip = imp + c * IMP_STRIDE + j0;
        ip[0] += G[0]; LDS_WAIT();
        ip[1] += G[1]; LDS_WAIT();
        ip[1] += Wl[0]; LDS_WAIT();
        ip[2] += Wl[1]; LDS_WAIT();
    }
    unsigned long long ulo = 0ull, uhi = 0ull, ilo = ~0ull, ihi = ~0ull;
    for (int cq = 0; cq < 16; ++cq) {
        const int tq = q0 + cq, cur_ = tq >> 6;
        const int ja = lane, jb = lane + 64;
        const bool oka = ja <= cur_, okb = jb <= cur_;
        unsigned ka = 0u, kb = 0u;
        if (oka) ka = (ja == 0 || ja == cur_ || ja == cur_ - 1) ? 0x461c4000u : __builtin_bit_cast(unsigned, imp[cq * IMP_STRIDE + ja]) + 1u;
        if (okb) kb = (jb == cur_ || jb == cur_ - 1) ? 0x461c4000u : __builtin_bit_cast(unsigned, imp[cq * IMP_STRIDE + jb]) + 1u;
        unsigned long long mlo, mhi;
        if (cur_ < 16) { mlo = __ballot(oka); mhi = 0ull; }
        else {
            unsigned thr = 0u;
#pragma unroll 1
            for (int bit = 30; bit >= 0; --bit) { const unsigned tr = thr | (1u << bit);
                const int cntv = __popcll(__ballot(ka >= tr)) + __popcll(__ballot(kb >= tr)); if (cntv >= 16) thr = tr; }
            mlo = __ballot(ka > thr); mhi = __ballot(kb > thr);
            int need = 16 - (__popcll(mlo) + __popcll(mhi));
            unsigned long long elo = __ballot(ka == thr), ehi = __ballot(kb == thr);
            while (need > 0 && elo) { const unsigned long long bsel = elo & (~elo + 1ull); mlo |= bsel; elo ^= bsel; --need; }
            while (need > 0 && ehi) { const unsigned long long bsel = ehi & (~ehi + 1ull); mhi |= bsel; ehi ^= bsel; --need; }
        }
        ulo |= mlo; uhi |= mhi; ilo &= mlo; ihi &= mhi;
        if (lane == 0) { selm[cq * 4 + 0] = (unsigned)mlo; selm[cq * 4 + 1] = (unsigned)(mlo >> 32); selm[cq * 4 + 2] = (unsigned)mhi; selm[cq * 4 + 3] = (unsigned)(mhi >> 32); }
    }
    LDS_WAIT();
    const unsigned long long mylo = (unsigned long long)selm[c * 4 + 0] | ((unsigned long long)selm[c * 4 + 1] << 32);
    const unsigned long long myhi = (unsigned long long)selm[c * 4 + 2] | ((unsigned long long)selm[c * 4 + 3] << 32);
    flash_init(S, -1.0e30f, -1.0e30f, -1.0e30f, -1.0e30f);
    const bf16* Kb = proj + (tb + 8 * (c >> 2) + (c & 3)) * NPROJ + P_KBS + g * 64 + kq * 8;
    const bf16* Vb = vT + (size_t)(V_BS + g * 64 + c) * MTOK + tb + 8 * kq;
    int j = next_below(ulo, uhi, (tmax >> 6) + 1), hs = 1;
    load_k(cur, Kb, NPROJ, 64 * j + 32);
    while (j >= 0) {
        ITER_FENCE();
        const int kbase = 64 * j + 32 * hs;
        VF vf; load_v(vf, Vb, MTOK, kbase);
        int jn = j, hn = 0; if (hs == 0) { jn = next_below(ulo, uhi, j); hn = 1; }
        load_k(nxt, Kb, NPROJ, jn >= 0 ? 64 * jn + 32 * hn : kbase);
        const bool mine = j < 64 ? ((mylo >> j) & 1ull) != 0ull : ((myhi >> (j - 64)) & 1ull) != 0ull;
        const bool all16 = j < 64 ? ((ilo >> j) & 1ull) != 0ull : ((ihi >> (j - 64)) & 1ull) != 0ull;
        f32x4 Sv[2][4]; qk_scores(Sv, cur, Ql, lane);
        const int d0 = t - kbase - 8 * kq;
        const f32x4 b0 = sl2 * -(float)d0;
        unsigned vm = 0xffu;
        if (!(all16 && kbase + 31 <= q0)) { vm = 0u;
#pragma unroll
            for (int jj = 0; jj < 8; ++jj) vm |= (mine && d0 - jj >= 0) ? (1u << jj) : 0u; }
        flash_step(S, Sv, vf, b0, sl2, vm);
        cur = nxt; j = jn; hs = hn;
    }
#pragma unroll
    for (int qb = 0; qb < 4; ++qb) { const float sc = flash_inv(S, qb, false, 0.f) * sigmoidf_(grow[qb * 3 + 1]);
        bf16* op = ocat + (tb + t) * DM + 512 + (g * 4 + qb) * 64 + 4 * kq; float q2 = 0.f;
#pragma unroll
        for (int db = 0; db < 4; ++db) { const v2u ow = *(const GAS v2u*)(op + 16 * db); const f32x4 old = (f32x4){bflo(ow.x), bfhi(ow.x), bflo(ow.y), bfhi(ow.y)};
            const f32x4 o = old + S.O[db][qb] * sc; v2u w; w.x = pk2(o[0], o[1]); w.y = pk2(o[2], o[3]); *(GAS v2u*)(op + 16 * db) = w;
            q2 += (bflo(w.x) * bflo(w.x) + bfhi(w.x) * bfhi(w.x)) + (bflo(w.y) * bflo(w.y) + bfhi(w.y) * bfhi(w.y)); }
        q2 += __shfl_xor(q2, 16); q2 += __shfl_xor(q2, 32); if (kq == 0) ((float*)(wsp(F) + WS_SSQ))[(tb + t) * 32 + 8 + g * 4 + qb] = q2; }
    LDS_WAIT();
}

__device__ __forceinline__ void attn1_phase(Frame& F, int l) {
    const int gw = F.vcu * NWAVES + F.wave, NGW = F.G * NWAVES;
    LAS unsigned* scr = (LAS unsigned*)(F.lds + F.wave * AW_BYTES);
    for (int u = F.vcu; u < 256; u += F.G) cmp_mlp_unit(F, l, u);
    if (F.wave >= 4) convert_range(F, l, CV_SMALL0, CV_GU1, scr);
    else for (int u = F.wave * F.G + F.vcu; u < MTOK / 16; u += 4 * F.G) gate_unit(F, u);
    for (int u = gw; u < 2048; u += NGW) win_unit<512, 1>(F, l, u >> 10, (u >> 9) & 1, (u & 511) * 16);
    for (int u = gw; u < 4096; u += NGW) sb_unit(F, u >> 11, (u >> 7) & 15, (u & 127) * 64);
    for (int u = gw; u < 2048; u += NGW) win_unit<128, 0>(F, l, u >> 10, (u >> 9) & 1, (u & 511) * 16);
    if (F.wave < 4) convert_range(F, l, CV_SMALL0, CV_GU1, scr);
}
__device__ __forceinline__ void attn2_phase(Frame& F, int l) {
    const int gw = F.vcu * NWAVES + F.wave, NGW = F.G * NWAVES;
    LAS unsigned* scr = (LAS unsigned*)(F.lds + F.wave * AW_BYTES);
    if (F.wave >= 4) convert_range(F, l, CV_GU1, CV_DN1, scr);
    for (int u = gw; u < 2048; u += NGW) nsa_unit(F, u >> 10, (u >> 9) & 1, (u & 511) * 16);
    if (F.wave < 4) convert_range(F, l, CV_GU1, CV_DN1, scr);
}
#ifndef MK_ONE_LAUNCH
#define MK_ONE_LAUNCH 1
#endif
#ifndef PHASE_MASK
#define PHASE_MASK 0xFFFF
#endif
constexpr int N_PHASES = 2 + 10 * DEPTH;
struct Args { const float* in[25]; float* out; unsigned char* ws; };
#define IN(k) (LO <= (k) && (k) < HI)
#define SEAM(k) do { if constexpr (IN(k) && IN((k) + 1)) xcd_barrier(bar); asm volatile("" : "+v"(F.tid), "+v"(F.lane) :: "memory"); } while (0)
#ifndef DBL_MASK
#define DBL_MASK 0
#endif
#define FENCE() asm volatile("" : "+v"(F.tid), "+v"(F.lane) :: "memory")
#define PHASE(k, bit, ...) do { if constexpr (IN(k) && (PHASE_MASK & (bit))) { __VA_ARGS__ if constexpr ((DBL_MASK & (bit)) != 0) { xcd_barrier(bar); FENCE(); __VA_ARGS__ } } } while (0)
template <int L, int LO, int HI>
__device__ __forceinline__ void layer_phases(Frame& F, const XcdBarrier& bar) {
    constexpr int l = L, pb = 2 + 10 * L;
    PHASE(pb + 0, 4, {
        pg8::Gemm g{(const pg8::bf16_t*)(wsp(F) + WS_HB), (const pg8::bf16_t*)(wsp(F) + WS_WIN), MTOK, NIN, DM}; pg8::StaticOrder S; S.init(MTOK, NIN, F.G, (int)blockIdx.x);
        pg8::EpiProj E{(pg8::bf16_t*)(wsp(F) + WS_PROJ), (pg8::bf16_t*)(wsp(F) + WS_VT), NPROJ, MTOK};
        pg8::gemm_phase<pg8::EpiProj, pg8::StaticOrder, true, true>(F.lds + RING_OFF, g, S, E);
    });
    SEAM(pb + 0);
    PHASE(pb + 1, 8, { attn1_phase(F, l); });
    SEAM(pb + 1);
    PHASE(pb + 2, 16, { attn2_phase(F, l); });
    if constexpr ((DBL_MASK & 0x10000) != 0) { xcd_barrier(bar); FENCE(); attn1_phase(F, l); xcd_barrier(bar); FENCE(); attn2_phase(F, l); }
    SEAM(pb + 2);
    PHASE(pb + 4, 64, {
        pg8::Gemm g{(const pg8::bf16_t*)(wsp(F) + WS_OCAT), (const pg8::bf16_t*)(wsp(F) + WS_WOUT), MTOK, DM, DM}; pg8::StaticOrder S; S.init(MTOK, DM, F.G, (int)blockIdx.x);
        pg8::GroupScale KS{(const float*)(wsp(F) + WS_SSQ), (PG8_LAS float*)(F.lds + GSC_OFF), RMS_EPS};
        const float* g1p = (const float*)(wsp(F) + WS_MOD) + (size_t)l * NB * 6 * DM + 2 * DM;
        if constexpr (l == 0) { pg8::EpiResid<false> E{(const void*)inp(F, I_X), (pg8::bf16_t*)(wsp(F) + WS_XA), g1p, 6 * DM, SEQ, DM, ALPHA};
            pg8::gemm_phase<pg8::EpiResid<false>, pg8::StaticOrder, true, true, pg8::NoGather, pg8::GroupScale>(F.lds + RING_OFF, g, S, E, pg8::NoGather(), KS); }
        else { pg8::EpiResid<true> E{(const void*)(wsp(F) + WS_XB), (pg8::bf16_t*)(wsp(F) + WS_XA), g1p, 6 * DM, SEQ, DM, ALPHA};
            pg8::gemm_phase<pg8::EpiResid<true>, pg8::StaticOrder, true, true, pg8::NoGather, pg8::GroupScale>(F.lds + RING_OFF, g, S, E, pg8::NoGather(), KS); }
    });
    SEAM(pb + 4);
    PHASE(pb + 5, 128, { post_mixer_phase(F, l); });
    if constexpr (IN(pb + 5)) { if constexpr (HI - LO > 1) xcd_barrier(bar); FENCE(); router_phase(F, l); }
    SEAM(pb + 5);
    PHASE(pb + 7, 512, {
        moe_tables(F, l);
        const PG8_LAS_T int* tab = (const PG8_LAS_T int*)(F.lds + TAB_OFF);
        pg8::Gemm g{(const pg8::bf16_t*)(wsp(F) + WS_HB), (const pg8::bf16_t*)(wsp(F) + WS_WGU), MAXROWS, NEXP * 1024, DM};
        pg8::MoeOrder S{4, F.G, (int)blockIdx.x, tab};
        pg8::EpiSwiGLU E{(pg8::bf16_t*)(wsp(F) + WS_HID), DEXP};
        pg8::MoeGather GA{tab, (const int*)(wsp(F) + WS_LIST), MTOK, (unsigned)(DM * 2), 0u};
        pg8::gemm_phase<pg8::EpiSwiGLU, pg8::MoeOrder, true, true, pg8::MoeGather>(F.lds + RING_OFF, g, S, E, GA);
    });
    SEAM(pb + 7);
    PHASE(pb + 8, 1024, {
        moe_tables(F, l);
        const PG8_LAS_T int* tab = (const PG8_LAS_T int*)(F.lds + TAB_OFF);
        pg8::Gemm g{(const pg8::bf16_t*)(wsp(F) + WS_HID), (const pg8::bf16_t*)(wsp(F) + WS_WD), MAXROWS, NEXP * DM, DEXP};
        pg8::MoeOrder S{8, F.G, (int)blockIdx.x, tab};
        pg8::EpiDown E{(pg8::bf16_t*)(wsp(F) + WS_YS), DM, tab, (const int*)(wsp(F) + WS_LIST), MTOK, (const float*)(wsp(F) + WS_SMALL + SM_GATEW)};
        pg8::gemm_phase<pg8::EpiDown, pg8::MoeOrder, true, true>(F.lds + RING_OFF, g, S, E);
    });
    SEAM(pb + 8);
    PHASE(pb + 9, 2048, { post_moe_phase(F, l, (l == DEPTH - 1) ? outp(F) : (float*)nullptr, (bf16*)(wsp(F) + WS_XB), l < DEPTH - 1); });
    PHASE(pb + 9, 4096, { if (l < DEPTH - 1) convert_small(F, l + 1); });
    SEAM(pb + 9);
}
template <int LO, int HI>
__global__ void __launch_bounds__(NWAVES * 64, 2) fwd_kernel(Args args) {
    extern __shared__ __attribute__((aligned(16))) unsigned char lds[];
    Frame F;
    F.lds = (LAS unsigned char*)lds;
    F.MISC = (volatile LAS unsigned*)(F.lds + MISC_OFF);
    F.tid = threadIdx.x; F.lane = F.tid & 63; F.wave = __builtin_amdgcn_readfirstlane(F.tid >> 6);
    F.G = gridDim.x; { const int bx = blockIdx.x; F.vcu = (F.G % 8 == 0) ? (bx % 8) * (F.G / 8) + bx / 8 : bx; }
    for (int u = F.tid; u < (LDS_BYTES - LDSCTL_OFF) / 4; u += NWAVES * 64) ((LAS unsigned*)(F.lds + LDSCTL_OFF))[u] = 0u;
    __syncthreads();
    if (F.tid < 25) ((LAS unsigned long long*)(F.lds + PTR_OFF))[F.tid] = (unsigned long long)args.in[F.tid];
    if (F.tid == 25) ((LAS unsigned long long*)(F.lds + PTR_OFF))[25] = (unsigned long long)args.ws;
    if (F.tid == 26) ((LAS unsigned long long*)(F.lds + PTR_OFF))[26] = (unsigned long long)args.out;
    __syncthreads();
    XcdBarrier bar; bar.bar = (unsigned*)(ctlp(F) + CW_BAR); bar.x = 0; bar.st = nullptr;
    if constexpr (HI - LO > 1) bar = xcd_barrier_post((unsigned*)(ctlp(F) + CW_BAR), F.MISC + 8);
    PHASE(0, 1, { ada_phase(F); });
    PHASE(0, 4096, { __syncthreads(); convert_small(F, 0); });
    SEAM(0);
    PHASE(1, 2, { ln_in_phase(F); });
    SEAM(1);
    layer_phases<0, LO, HI>(F, bar);
    layer_phases<1, LO, HI>(F, bar);
}
#undef IN
#undef SEAM
#undef PHASE

#if MK_ONE_LAUNCH
#define FWD_MAIN (fwd_kernel<0, N_PHASES>)
static bool set_lds_attr() { return hipFuncSetAttribute((const void*)FWD_MAIN, hipFuncAttributeMaxDynamicSharedMemorySize, LDS_BYTES) == hipSuccess; }
#else
#define FWD_MAIN (fwd_kernel<0, 1>)
template <int... P> static bool set_lds_attr_seq(std::integer_sequence<int, P...>) { bool ok = true; ((ok = ok && hipFuncSetAttribute((const void*)(fwd_kernel<P, P + 1>), hipFuncAttributeMaxDynamicSharedMemorySize, LDS_BYTES) == hipSuccess), ...); return ok; }
static bool set_lds_attr() { return set_lds_attr_seq(std::make_integer_sequence<int, N_PHASES>{}); }
template <int P> static void launch_one(int grid, hipStream_t stream, const Args& a) { hipLaunchKernelGGL((fwd_kernel<P, P + 1>), dim3(grid), dim3(NWAVES * 64), LDS_BYTES, stream, a); }
template <int... P> static void launch_phases(std::integer_sequence<int, P...>, int grid, hipStream_t stream, const Args& a) { (launch_one<P>(grid, stream, a), ...); }
#endif
extern "C" void kernel_launch(void* const* d_in, const int* in_sizes, int n_in, void* d_out, int out_size, void* d_ws, size_t ws_size, hipStream_t stream) {
    static int grid = 0;
    if (grid == 0) {
        if (n_in != 25 || out_size != MTOK * DM || ws_size < WS_END) { fprintf(stderr, "kernel_launch: unexpected problem shape (n_in %d, out %d, ws %zu)\n", n_in, out_size, ws_size); grid = -1; return; }
        int dev = 0, cus = 0, per_cu = 0;
        if (hipGetDevice(&dev) != hipSuccess || hipDeviceGetAttribute(&cus, hipDeviceAttributeMultiprocessorCount, dev) != hipSuccess) { grid = -1; return; }
        if (!set_lds_attr()) { fprintf(stderr, "kernel_launch: hipFuncSetAttribute failed\n"); grid = -1; return; }
        if (hipOccupancyMaxActiveBlocksPerMultiprocessor(&per_cu, (const void*)FWD_MAIN, NWAVES * 64, LDS_BYTES) != hipSuccess || per_cu < 1)
            fprintf(stderr, "kernel_launch: note: occupancy query reports %d workgroups per CU\n", per_cu);
        (void)hipGetLastError();
        grid = cus;
        if (grid > 256) grid = 256;
        grid &= ~7;
    }
    if (grid <= 0) return;
    (void)in_sizes;
    if (hipMemsetAsync((char*)d_ws + WS_CTL, 0, CTL_ZERO_BYTES, stream) != hipSuccess) return;
    Args a{};
    for (int i = 0; i < 25; ++i) a.in[i] = (const float*)d_in[i];
    a.out = (float*)d_out; a.ws = (unsigned char*)d_ws;
#if MK_ONE_LAUNCH
    hipLaunchKernelGGL((fwd_kernel<0, N_PHASES>), dim3(grid), dim3(NWAVES * 64), LDS_BYTES, stream, a);
#else
    launch_phases(std::make_integer_sequence<int, N_PHASES>{}, grid, stream, a);
#endif
}
```
